# Optimizing an MI355X kernel written in HIP

```python
import jax, jax.numpy as jnp
from jax import lax
import numpy as np

D_MODEL = 1024
BATCH = 4
SEQ = 4096
DEPTH = 2

GRID_W = 64
CTX_LEN = 256
HEAD_DIM = 64
NORM_EPS = 1e-6
ROPE_BASE = 10000.0

POOL_WIDTH = 512
POOL_GROUPS = 4
POOL_WINDOWS = (2, 4, 8, 16)
POOL_GROUP_W = POOL_WIDTH // POOL_GROUPS

NA_HEADS = 8
NA_KH = 8
NA_KW = 16
NA_QC = 16
NA_KC = 32

SWA_HEADS = 8
SWA_KV_HEADS = 2
SWA_WINDOW = 128
SWA_BLOCK = 128

PEER_HEADS = 8
PEER_NKEYS = 128
PEER_EXPERTS = PEER_NKEYS * PEER_NKEYS
PEER_DKEY = 256
PEER_TOPK = 16
PEER_CHUNK = 128

NA_WIDTH = NA_HEADS * HEAD_DIM
SWA_Q_WIDTH = SWA_HEADS * HEAD_DIM
SWA_KV_WIDTH = SWA_KV_HEADS * HEAD_DIM
OFF_KN = 0
OFF_VN = OFF_KN + NA_WIDTH
OFF_KW = OFF_VN + NA_WIDTH
OFF_VW = OFF_KW + SWA_KV_WIDTH
CTX_KV_COLS = OFF_VW + SWA_KV_WIDTH
OFF_QN = CTX_KV_COLS
OFF_QW = OFF_QN + NA_WIDTH
OFF_A = OFF_QW + SWA_Q_WIDTH
OFF_G = OFF_A + POOL_WIDTH
IN_COLS = OFF_G + 3 * D_MODEL

kernel_name = 'hybrid_pool_natten_swa_peer_dit'


def rms_norm(x, g):
    xf = x.astype(jnp.float32)
    y = xf * lax.rsqrt(jnp.mean(xf * xf, axis=-1, keepdims=True) + NORM_EPS)
    return (y * g.astype(jnp.float32)).astype(x.dtype)


def modulate(h, shift, scale):
    return h * (1 + scale) + shift


def heads(z, off, n):
    return z[..., off:off + n * HEAD_DIM].reshape(*z.shape[:-1], n, HEAD_DIM)


def rope_axis(x, pos):
    f = x.shape[-1] // 2
    inv = ROPE_BASE ** (-jnp.arange(f, dtype=jnp.float32) / f)
    ang = pos.astype(jnp.float32)[:, None] * inv[None, :]
    cos = jnp.cos(ang)[None, :, None, :]
    sin = jnp.sin(ang)[None, :, None, :]
    xf = x.astype(jnp.float32)
    x1, x2 = xf[..., :f], xf[..., f:]
    return jnp.concatenate([x1 * cos - x2 * sin, x1 * sin + x2 * cos], axis=-1).astype(x.dtype)


def rope_2d(x, row, col):
    half = x.shape[-1] // 2
    return jnp.concatenate([rope_axis(x[..., :half], row), rope_axis(x[..., half:], col)], axis=-1)


def centred_pool_minus_self(a, w):
    T = a.shape[1]
    af = a.astype(jnp.float32)
    csum = jnp.concatenate([jnp.zeros_like(af[:, :1]), jnp.cumsum(af, axis=1)], axis=1)
    t = jnp.arange(T)
    lo = jnp.clip(t - w // 2, 0, T)
    hi = jnp.clip(t - w // 2 + w, 0, T)
    mean = (csum[:, hi] - csum[:, lo]) / (hi - lo).astype(jnp.float32)[None, :, None]
    return (mean - af).astype(a.dtype)


def pool_mixer(a, w_pool, pool_scale):
    B, T, _ = a.shape
    ag = a.reshape(B, T, POOL_GROUPS, POOL_GROUP_W)
    pooled = jnp.stack([centred_pool_minus_self(ag[:, :, g], w) for g, w in enumerate(POOL_WINDOWS)], axis=2)
    y = jnp.einsum('btgc,gce->btge', pooled, w_pool).reshape(B, T, POOL_WIDTH)
    return y * pool_scale


def neighbourhood_attention(q, k, v, k_ctx, v_ctx, rpb):
    B, S, H, d = q.shape
    rows = S // GRID_W
    kh = min(NA_KH, rows)
    ncb = GRID_W // NA_QC
    r = jnp.arange(rows)
    row_idx = jnp.clip(r - kh // 2, 0, rows - kh)[:, None] + jnp.arange(kh)[None, :]
    cb = jnp.arange(ncb)
    kcol_idx = jnp.clip(cb * NA_QC - NA_KW // 2, 0, GRID_W - NA_KC)[:, None] + jnp.arange(NA_KC)[None, :]
    qcol = cb[:, None] * NA_QC + jnp.arange(NA_QC)[None, :]
    qcol_start = jnp.clip(qcol - NA_KW // 2, 0, GRID_W - NA_KW)
    col_ok = (kcol_idx[:, None, :] >= qcol_start[:, :, None]) & (kcol_idx[:, None, :] < qcol_start[:, :, None] + NA_KW)
    dr = row_idx - r[:, None] + NA_KH - 1
    dc = jnp.clip(kcol_idx[:, None, :] - qcol[:, :, None] + NA_KW - 1, 0, 2 * NA_KW - 2)
    bias = rpb.astype(jnp.float32)[:, dr[:, None, None, :, None], dc[None, :, :, None, :]]
    scale = d ** -0.5
    qg = q.reshape(B, rows, ncb, NA_QC, H, d)
    kgrid = k.reshape(B, rows, GRID_W, H, d)
    vgrid = v.reshape(B, rows, GRID_W, H, d)
    kg = kgrid[:, row_idx[:, :, None, None], kcol_idx[None, None, :, :]]
    vg = vgrid[:, row_idx[:, :, None, None], kcol_idx[None, None, :, :]]
    s_loc = jnp.einsum('brnqhd,brinjhd->bhrnqij', qg, kg).astype(jnp.float32) * scale + bias[None]
    s_loc = jnp.where(col_ok[:, :, None, :], s_loc, -jnp.inf)
    s_loc = s_loc.reshape(B, H, rows, ncb, NA_QC, kh * NA_KC)
    s_ctx = jnp.einsum('brnqhd,bmhd->bhrnqm', qg, k_ctx).astype(jnp.float32) * scale
    p = jax.nn.softmax(jnp.concatenate([s_loc, s_ctx], axis=-1), axis=-1).astype(v.dtype)
    p_loc = p[..., :kh * NA_KC].reshape(B, H, rows, ncb, NA_QC, kh, NA_KC)
    p_ctx = p[..., kh * NA_KC:]
    o = jnp.einsum('bhrnqij,brinjhd->brnqhd', p_loc, vg) + jnp.einsum('bhrnqm,bmhd->brnqhd', p_ctx, v_ctx)
    return o.reshape(B, S, H * d)


def window_attention(q, k, v, k_ctx, v_ctx, sink):
    B, S, Hq, d = q.shape
    G = k.shape[2]
    rep = Hq // G
    L = k_ctx.shape[1]
    nb = S // SWA_BLOCK
    span = 3 * SWA_BLOCK
    scale = d ** -0.5
    qb = q.reshape(B, nb, SWA_BLOCK, G, rep, d)
    pad = ((0, 0), (SWA_BLOCK, SWA_BLOCK), (0, 0), (0, 0))
    kp = jnp.pad(k, pad)
    vp = jnp.pad(v, pad)
    idx = jnp.arange(nb)[:, None] * SWA_BLOCK + jnp.arange(span)[None, :]
    kwin = kp[:, idx]
    vwin = vp[:, idx]
    kpos = idx - SWA_BLOCK
    qpos = jnp.arange(nb)[:, None] * SWA_BLOCK + jnp.arange(SWA_BLOCK)[None, :]
    ok = (kpos[:, None, :] >= 0) & (kpos[:, None, :] < S) & (jnp.abs(qpos[:, :, None] - kpos[:, None, :]) <= SWA_WINDOW)
    s_loc = jnp.einsum('bnqgrd,bnkgd->bgrnqk', qb, kwin).astype(jnp.float32) * scale
    s_loc = jnp.where(ok, s_loc, -jnp.inf)
    s_ctx = jnp.einsum('bnqgrd,bmgd->bgrnqm', qb, k_ctx).astype(jnp.float32) * scale
    s_sink = jnp.broadcast_to(sink.astype(jnp.float32).reshape(G, rep)[None, :, :, None, None, None], s_loc.shape[:-1] + (1,))
    p = jax.nn.softmax(jnp.concatenate([s_loc, s_ctx, s_sink], axis=-1), axis=-1).astype(v.dtype)
    p_loc = p[..., :span]
    p_ctx = p[..., span:span + L]
    o = jnp.einsum('bgrnqk,bnkgd->bnqgrd', p_loc, vwin) + jnp.einsum('bgrnqm,bmgd->bnqgrd', p_ctx, v_ctx)
    return o.reshape(B, S, Hq * d)


def context_attention(q, k, v, sink=None):
    B, L, Hq, d = q.shape
    G = k.shape[2]
    rep = Hq // G
    qg = q.reshape(B, L, G, rep, d)
    s = jnp.einsum('blgrd,bmgd->bgrlm', qg, k).astype(jnp.float32) * (d ** -0.5)
    if sink is not None:
        s_sink = jnp.broadcast_to(sink.astype(jnp.float32).reshape(G, rep)[None, :, :, None, None], s.shape[:-1] + (1,))
        s = jnp.concatenate([s, s_sink], axis=-1)
    p = jax.nn.softmax(s, axis=-1)[..., :L].astype(v.dtype)
    o = jnp.einsum('bgrlm,bmgd->blgrd', p, v)
    return o.reshape(B, L, Hq * d)


def merge_branches(z, ya, yb, yc, w_out):
    g = jax.nn.sigmoid(z[..., OFF_G:OFF_G + 3 * D_MODEL]).reshape(*z.shape[:-1], 3, D_MODEL)
    m = g[..., 0, :] * ya + g[..., 1, :] * yb + g[..., 2, :] * yc
    return m @ w_out


def peer_ffn(h, w_q, sub_keys, u_tab, v_tab):
    lead = h.shape[:-1]
    hf = h.reshape(-1, D_MODEL)
    T = hf.shape[0]
    q = (hf @ w_q).reshape(T, PEER_HEADS, 2, PEER_DKEY // 2)
    s = jnp.einsum('thpc,hpkc->thpk', q, sub_keys).astype(jnp.float32)
    top_s, top_i = lax.top_k(s, PEER_TOPK)
    cand_s = top_s[:, :, 0, :, None] + top_s[:, :, 1, None, :]
    cand_i = top_i[:, :, 0, :, None] * PEER_NKEYS + top_i[:, :, 1, None, :]
    best_s, best_j = lax.top_k(cand_s.reshape(T, PEER_HEADS, PEER_TOPK * PEER_TOPK), PEER_TOPK)
    expert = jnp.take_along_axis(cand_i.reshape(T, PEER_HEADS, PEER_TOPK * PEER_TOPK), best_j, axis=-1)
    gate = jax.nn.softmax(best_s, axis=-1).astype(h.dtype)
    hk = PEER_HEADS * PEER_TOPK
    nc = T // PEER_CHUNK

    def chunk(args):
        xc, ec, gc = args
        u = u_tab[ec]
        vv = v_tab[ec]
        a = jnp.einsum('ced,cd->ce', u, xc)
        return jnp.einsum('ce,ced->cd', gc * jax.nn.gelu(a, approximate=False), vv)

    out = lax.map(chunk, (hf.reshape(nc, PEER_CHUNK, D_MODEL),
                          expert.reshape(nc, PEER_CHUNK, hk),
                          gate.reshape(nc, PEER_CHUNK, hk)))
    return out.reshape(*lead, D_MODEL)


def setup_inputs(seed: int = 0) -> dict:
    key = jax.random.key(seed)
    ks = jax.random.split(key, 24)
    f32 = jnp.float32
    nrm = lambda k, shape, s: jax.random.normal(k, shape, f32) * s
    return {
        'x': nrm(ks[0], (BATCH, SEQ, D_MODEL), 1.0),
        'c': nrm(ks[1], (BATCH, D_MODEL), 1.0),
        'ctx': nrm(ks[2], (BATCH, CTX_LEN, D_MODEL), 1.0),
        'c_ctx': nrm(ks[3], (D_MODEL,), 1.0),
        'ada_w': nrm(ks[4], (DEPTH, D_MODEL, 6 * D_MODEL), D_MODEL ** -0.5),
        'ada_b': nrm(ks[5], (DEPTH, 6 * D_MODEL), 0.02),
        'norm1_g': 1.0 + nrm(ks[6], (DEPTH, D_MODEL), 0.02),
        'norm2_g': 1.0 + nrm(ks[7], (DEPTH, D_MODEL), 0.02),
        'w_in': nrm(ks[8], (DEPTH, D_MODEL, IN_COLS), D_MODEL ** -0.5),
        'pool_w': nrm(ks[9], (DEPTH, POOL_GROUPS, POOL_GROUP_W, POOL_GROUP_W), POOL_GROUP_W ** -0.5),
        'pool_scale': 1.0 + nrm(ks[10], (DEPTH, POOL_WIDTH), 0.1),
        'na_rpb': nrm(ks[11], (DEPTH, NA_HEADS, 2 * NA_KH - 1, 2 * NA_KW - 1), 0.1),
        'swa_sink': nrm(ks[12], (DEPTH, SWA_HEADS), 0.5),
        'w_branch_a': nrm(ks[13], (DEPTH, POOL_WIDTH, D_MODEL), POOL_WIDTH ** -0.5),
        'w_branch_b': nrm(ks[14], (DEPTH, NA_WIDTH, D_MODEL), NA_WIDTH ** -0.5),
        'w_branch_c': nrm(ks[15], (DEPTH, SWA_Q_WIDTH, D_MODEL), SWA_Q_WIDTH ** -0.5),
        'w_out': nrm(ks[16], (DEPTH, D_MODEL, D_MODEL), D_MODEL ** -0.5),
        'peer_wq': nrm(ks[17], (DEPTH, D_MODEL, PEER_HEADS * PEER_DKEY), D_MODEL ** -0.5),
        'peer_keys': nrm(ks[18], (DEPTH, PEER_HEADS, 2, PEER_NKEYS, PEER_DKEY // 2), (PEER_DKEY // 2) ** -0.5),
        'peer_u': nrm(ks[19], (DEPTH, PEER_EXPERTS, D_MODEL), D_MODEL ** -0.5),
        'peer_v': nrm(ks[20], (DEPTH, PEER_EXPERTS, D_MODEL), 0.5),
        'final_g': 1.0 + nrm(ks[21], (D_MODEL,), 0.02),
    }


def reference(x, c, ctx, c_ctx, ada_w, ada_b, norm1_g, norm2_g, w_in, pool_w, pool_scale,
              na_rpb, swa_sink, w_branch_a, w_branch_b, w_branch_c, w_out,
              peer_wq, peer_keys, peer_u, peer_v, final_g):
    S = x.shape[1]
    t = jnp.arange(S)
    row = t // GRID_W
    col = t % GRID_W
    xc = ctx
    for l in range(DEPTH):
        last = l == DEPTH - 1
        mod_l = jax.nn.silu(c) @ ada_w[l] + ada_b[l]
        mod_c = jax.nn.silu(c_ctx) @ ada_w[l] + ada_b[l]
        sh1, sc1, gt1, sh2, sc2, gt2 = jnp.split(mod_l[:, None, :], 6, axis=-1)
        csh1, csc1, cgt1, csh2, csc2, cgt2 = jnp.split(mod_c, 6, axis=-1)

        h = modulate(rms_norm(x, norm1_g[l]), sh1, sc1)
        hc = modulate(rms_norm(xc, norm1_g[l]), csh1, csc1)
        z = h @ w_in[l]
        zc = hc @ (w_in[l][:, :CTX_KV_COLS] if last else w_in[l])
        kn_c = heads(zc, OFF_KN, NA_HEADS)
        vn_c = heads(zc, OFF_VN, NA_HEADS)
        kw_c = heads(zc, OFF_KW, SWA_KV_HEADS)
        vw_c = heads(zc, OFF_VW, SWA_KV_HEADS)

        qn = heads(z, OFF_QN, NA_HEADS)
        kn = heads(z, OFF_KN, NA_HEADS)
        vn = heads(z, OFF_VN, NA_HEADS)
        qw = rope_2d(heads(z, OFF_QW, SWA_HEADS), row, col)
        kw = rope_2d(heads(z, OFF_KW, SWA_KV_HEADS), row, col)
        vw = heads(z, OFF_VW, SWA_KV_HEADS)
        ya = pool_mixer(z[..., OFF_A:OFF_G], pool_w[l], pool_scale[l]) @ w_branch_a[l]
        yb = neighbourhood_attention(qn, kn, vn, kn_c, vn_c, na_rpb[l]) @ w_branch_b[l]
        yc = window_attention(qw, kw, vw, kw_c, vw_c, swa_sink[l]) @ w_branch_c[l]
        x = x + gt1 * merge_branches(z, ya, yb, yc, w_out[l])
        if not last:
            ya_c = pool_mixer(zc[..., OFF_A:OFF_G], pool_w[l], pool_scale[l]) @ w_branch_a[l]
            yb_c = context_attention(heads(zc, OFF_QN, NA_HEADS), kn_c, vn_c) @ w_branch_b[l]
            yc_c = context_attention(heads(zc, OFF_QW, SWA_HEADS), kw_c, vw_c, swa_sink[l]) @ w_branch_c[l]
            xc = xc + cgt1 * merge_branches(zc, ya_c, yb_c, yc_c, w_out[l])

        h2 = modulate(rms_norm(x, norm2_g[l]), sh2, sc2)
        x = x + gt2 * peer_ffn(h2, peer_wq[l], peer_keys[l], peer_u[l], peer_v[l])
        if not last:
            h2c = modulate(rms_norm(xc, norm2_g[l]), csh2, csc2)
            xc = xc + cgt2 * peer_ffn(h2c, peer_wq[l], peer_keys[l], peer_u[l], peer_v[l])
    return rms_norm(x, final_g)
```

```cpp
#include <hip/hip_runtime.h>
#include <stdint.h>
#include <stdio.h>

typedef unsigned short bf16_t;

constexpr int D = 1024, NB = 4, S = 4096, L = 256, GW = 64;
constexpr int T_LAT = NB * S, T_CTX = NB * L, T_ALL = T_LAT + T_CTX;
constexpr int IN_COLS = 5888;
constexpr int OFF_KN = 0, OFF_VN = 512, OFF_KW = 1024, OFF_VW = 1152, CTX_KV_COLS = 1280, OFF_QN = 1280, OFF_QW = 1792, OFF_A = 2304, OFF_G = 2816;
constexpr int NEXP = 16384, PEER_H = 8, PEER_K = 16;
constexpr float EPS = 1e-6f;

constexpr size_t al256(size_t x) { return (x + 255) & ~(size_t)255; }
constexpr size_t WS_MOD = 0;
constexpr size_t WS_ROPE = al256(WS_MOD + 2 * 5 * 6144 * 4);
constexpr size_t WS_XC = al256(WS_ROPE + 2 * 64 * 16 * 4);
constexpr size_t WS_H = al256(WS_XC + (size_t)T_CTX * D * 4);
constexpr size_t WS_Z = al256(WS_H + (size_t)T_ALL * D * 2);
constexpr size_t WS_VTN = al256(WS_Z + (size_t)T_ALL * IN_COLS * 2);
constexpr size_t WS_VTNC = al256(WS_VTN + (size_t)NB * 8 * 64 * S * 2);
constexpr size_t WS_VTW = al256(WS_VTNC + (size_t)NB * 8 * 64 * L * 2);
constexpr size_t WS_VTWC = al256(WS_VTW + (size_t)NB * 2 * 64 * S * 2);
constexpr size_t WS_AT = al256(WS_VTWC + (size_t)NB * 2 * 64 * L * 2);
constexpr size_t WS_EIDX = al256(WS_AT + (size_t)3 * T_ALL * 512 * 2);
constexpr size_t WS_EGATE = al256(WS_EIDX + (size_t)T_ALL * 128 * 4);
constexpr size_t WS_W = al256(WS_EGATE + (size_t)T_ALL * 128 * 4);
constexpr size_t W_WIN = 0;
constexpr size_t W_WA = W_WIN + (size_t)IN_COLS * D * 2;
constexpr size_t W_WB = W_WA + (size_t)D * 512 * 2;
constexpr size_t W_WC = W_WB + (size_t)D * 512 * 2;
constexpr size_t W_WO = W_WC + (size_t)D * 512 * 2;
constexpr size_t W_WQ = W_WO + (size_t)D * D * 2;
constexpr size_t W_KEYS = W_WQ + (size_t)2048 * D * 2;
constexpr size_t W_LAYER = al256(W_KEYS + (size_t)8 * 2 * 128 * 128 * 2);
constexpr size_t WS_TAB = al256(WS_W + 2 * W_LAYER);
constexpr size_t TAB_LAYER = (size_t)2 * NEXP * D * 2;
constexpr size_t WS_END = WS_TAB + 2 * TAB_LAYER;

__device__ __forceinline__ float bf2f(bf16_t v) { return __uint_as_float((unsigned)v << 16); }
__device__ __forceinline__ bf16_t f2bf(float f) { unsigned u = __float_as_uint(f); u += 0x7fffu + ((u >> 16) & 1u); return (bf16_t)(u >> 16); }

__global__ void k_transpose_bf16(const float* __restrict__ W, bf16_t* __restrict__ Wt, int K, int N) {
    __shared__ float tile[32][33];
    const int n0 = blockIdx.x * 32, k0 = blockIdx.y * 32;
    for (int i = threadIdx.y; i < 32; i += 8) tile[i][threadIdx.x] = W[(size_t)(k0 + i) * N + n0 + threadIdx.x];
    __syncthreads();
    for (int i = threadIdx.y; i < 32; i += 8) Wt[(size_t)(n0 + i) * K + k0 + threadIdx.x] = f2bf(tile[threadIdx.x][i]);
}
__global__ void k_fold_wa(const float* __restrict__ pool_w, const float* __restrict__ pool_scale, const float* __restrict__ wba, bf16_t* __restrict__ WaT) {
    const int idx = blockIdx.x * blockDim.x + threadIdx.x;
    const int n = idx % D, kk = idx / D;
    if (kk >= 512) return;
    const int g = kk / 128, c = kk % 128;
    float acc = 0.f;
    for (int e = 0; e < 128; ++e) acc += pool_w[(g * 128 + c) * 128 + e] * pool_scale[g * 128 + e] * wba[(size_t)(g * 128 + e) * D + n];
    WaT[(size_t)n * 512 + kk] = f2bf(acc);
}
__global__ void k_convert_bf16(const float* __restrict__ src, bf16_t* __restrict__ dst, size_t n4) {
    for (size_t i = (size_t)blockIdx.x * blockDim.x + threadIdx.x; i < n4; i += (size_t)gridDim.x * blockDim.x) {
        const float4 v = ((const float4*)src)[i];
        uint2 o; o.x = (unsigned)f2bf(v.x) | ((unsigned)f2bf(v.y) << 16); o.y = (unsigned)f2bf(v.z) | ((unsigned)f2bf(v.w) << 16);
        ((uint2*)dst)[i] = o;
    }
}
__global__ void k_mods(const float* __restrict__ c, const float* __restrict__ c_ctx, const float* __restrict__ ada_w, const float* __restrict__ ada_b, float* __restrict__ mod) {
    __shared__ float sv[5][1024];
    const int l = blockIdx.y, j = blockIdx.x * 256 + threadIdx.x;
    for (int i = threadIdx.x; i < 5 * 1024; i += 256) { const int r = i / 1024, k = i % 1024; const float v = r < 4 ? c[r * 1024 + k] : c_ctx[k]; sv[r][k] = v / (1.f + __expf(-v)); }
    __syncthreads();
    float a0 = 0.f, a1 = 0.f, a2 = 0.f, a3 = 0.f, a4 = 0.f;
    const float* w = ada_w + (size_t)l * 1024 * 6144 + j;
    for (int k = 0; k < 1024; ++k) { const float x = w[(size_t)k * 6144]; a0 += sv[0][k] * x; a1 += sv[1][k] * x; a2 += sv[2][k] * x; a3 += sv[3][k] * x; a4 += sv[4][k] * x; }
    const float bb = ada_b[l * 6144 + j];
    float* m = mod + (size_t)l * 5 * 6144 + j;
    m[0] = a0 + bb; m[6144] = a1 + bb; m[2 * 6144] = a2 + bb; m[3 * 6144] = a3 + bb; m[4 * 6144] = a4 + bb;
}
__global__ void k_rope_table(float* __restrict__ tab) {
    const int i = blockIdx.x * blockDim.x + threadIdx.x; if (i >= 1024) return;
    const int pos = i / 16, fi = i % 16;
    const float inv = powf(10000.0f, -(float)fi / 16.0f), ang = (float)pos * inv;
    tab[i] = cosf(ang); tab[1024 + i] = sinf(ang);
}

__device__ __forceinline__ float block_sum_256(float v, float* red) {
    for (int o = 32; o > 0; o >>= 1) v += __shfl_xor(v, o);
    if ((threadIdx.x & 63) == 0) red[threadIdx.x >> 6] = v;
    __syncthreads();
    const float r = red[0] + red[1] + red[2] + red[3];
    __syncthreads();
    return r;
}
__global__ void k_norm_mod(const float* __restrict__ Xl, const float* __restrict__ Xc, const float* __restrict__ g, const float* __restrict__ mod, int shift_idx, int scale_idx, bf16_t* __restrict__ H) {
    __shared__ float red[4];
    const int row = blockIdx.x;
    const float* src = row < T_LAT ? Xl + (size_t)row * D : Xc + (size_t)(row - T_LAT) * D;
    const int mrow = row < T_LAT ? row / S : 4;
    const float4 v = ((const float4*)src)[threadIdx.x];
    const float ss = block_sum_256(v.x * v.x + v.y * v.y + v.z * v.z + v.w * v.w, red);
    const float rstd = rsqrtf(ss * (1.0f / D) + EPS);
    const int k = threadIdx.x * 4;
    const float* sh = mod + (size_t)mrow * 6144 + shift_idx * 1024 + k; const float* sc = mod + (size_t)mrow * 6144 + scale_idx * 1024 + k;
    const float xs[4] = {v.x, v.y, v.z, v.w};
    bf16_t o[4];
#pragma unroll
    for (int i = 0; i < 4; ++i) o[i] = f2bf(xs[i] * rstd * g[k + i] * (1.f + sc[i]) + sh[i]);
    uint2 w; w.x = (unsigned)o[0] | ((unsigned)o[1] << 16); w.y = (unsigned)o[2] | ((unsigned)o[3] << 16);
    ((uint2*)(H + (size_t)row * D))[threadIdx.x] = w;
}
__global__ void k_final_norm(float* __restrict__ X, const float* __restrict__ g) {
    __shared__ float red[4];
    const int row = blockIdx.x;
    float4 v = ((float4*)(X + (size_t)row * D))[threadIdx.x];
    const float ss = block_sum_256(v.x * v.x + v.y * v.y + v.z * v.z + v.w * v.w, red);
    const float rstd = rsqrtf(ss * (1.0f / D) + EPS);
    const float4 gg = ((const float4*)g)[threadIdx.x];
    v.x *= rstd * gg.x; v.y *= rstd * gg.y; v.z *= rstd * gg.z; v.w *= rstd * gg.w;
    ((float4*)(X + (size_t)row * D))[threadIdx.x] = v;
}

struct EpiStore { bf16_t* C; int ldc; int pad; __device__ __forceinline__ void operator()(int row, int col, float v) const { C[(size_t)row * ldc + col] = f2bf(v); } };
struct EpiMerge { const bf16_t* Z; bf16_t* M; int seg; int pad; __device__ __forceinline__ void operator()(int row, int col, float v) const {
    const float g = bf2f(Z[(size_t)row * IN_COLS + OFF_G + seg * 1024 + col]); bf16_t* p = M + (size_t)row * D + col;
    const float r = g * v + (seg ? bf2f(*p) : 0.f); *p = f2bf(r); } };
struct EpiResid { float* Xl; float* Xc; const float* mod; int gate_idx; int pad; __device__ __forceinline__ void operator()(int row, int col, float v) const {
    const int mrow = row < T_LAT ? row / S : 4; float* p = row < T_LAT ? Xl + (size_t)row * D + col : Xc + (size_t)(row - T_LAT) * D + col;
    *p += mod[(size_t)mrow * 6144 + gate_idx * 1024 + col] * v; } };

template <class Epi>
__global__ void __launch_bounds__(256) k_gemm_naive(const bf16_t* __restrict__ A, const bf16_t* __restrict__ Bt, int M, int N, int K, Epi E) {
    __shared__ float As[16][68], Bs[16][68];
    const int tid = threadIdx.x, tx = tid & 15, ty = tid >> 4;
    const int m0 = blockIdx.y * 64, n0 = blockIdx.x * 64;
    const int lr = tid >> 2, lk = (tid & 3) * 4;
    float acc[4][4];
#pragma unroll
    for (int i = 0; i < 4; ++i)
#pragma unroll
        for (int j = 0; j < 4; ++j) acc[i][j] = 0.f;
    for (int k0 = 0; k0 < K; k0 += 16) {
        const uint2 av = *(const uint2*)(A + (size_t)(m0 + lr) * K + k0 + lk);
        const uint2 bv = *(const uint2*)(Bt + (size_t)(n0 + lr) * K + k0 + lk);
        As[lk + 0][lr] = __uint_as_float(av.x << 16); As[lk + 1][lr] = __uint_as_float(av.x & 0xffff0000u); As[lk + 2][lr] = __uint_as_float(av.y << 16); As[lk + 3][lr] = __uint_as_float(av.y & 0xffff0000u);
        Bs[lk + 0][lr] = __uint_as_float(bv.x << 16); Bs[lk + 1][lr] = __uint_as_float(bv.x & 0xffff0000u); Bs[lk + 2][lr] = __uint_as_float(bv.y << 16); Bs[lk + 3][lr] = __uint_as_float(bv.y & 0xffff0000u);
        __syncthreads();
#pragma unroll
        for (int k = 0; k < 16; ++k) {
            const float4 a = *(const float4*)&As[k][ty * 4]; const float4 b = *(const float4*)&Bs[k][tx * 4];
            const float aa[4] = {a.x, a.y, a.z, a.w}, bb[4] = {b.x, b.y, b.z, b.w};
#pragma unroll
            for (int i = 0; i < 4; ++i)
#pragma unroll
                for (int j = 0; j < 4; ++j) acc[i][j] += aa[i] * bb[j];
        }
        __syncthreads();
    }
#pragma unroll
    for (int i = 0; i < 4; ++i)
#pragma unroll
        for (int j = 0; j < 4; ++j) E(m0 + ty * 4 + i, n0 + tx * 4 + j, acc[i][j]);
}

__global__ void k_rope(bf16_t* __restrict__ Z, const float* __restrict__ tab) {
    const int idx = blockIdx.x * blockDim.x + threadIdx.x;
    const int i = idx & 15, hh = (idx >> 4) & 1, hs = (idx >> 5) % 10, row = idx / 320;
    if (row >= T_LAT) return;
    const int s = row % S, pos = hh ? (s % GW) : (s / GW);
    const int colbase = (hs < 2 ? OFF_KW + hs * 64 : OFF_QW + (hs - 2) * 64) + hh * 32 + i;
    bf16_t* p = Z + (size_t)row * IN_COLS + colbase;
    const float x1 = bf2f(p[0]), x2 = bf2f(p[16]);
    const float cs = tab[pos * 16 + i], sn = tab[1024 + pos * 16 + i];
    p[0] = f2bf(x1 * cs - x2 * sn); p[16] = f2bf(x1 * sn + x2 * cs);
}
__global__ void k_sigmoid(bf16_t* __restrict__ Z, int nrows) {
    const size_t idx = (size_t)blockIdx.x * blockDim.x + threadIdx.x;
    const int col = (int)(idx % 3072); const size_t row = idx / 3072;
    if (row >= (size_t)nrows) return;
    bf16_t* p = Z + row * IN_COLS + OFF_G + col;
    *p = f2bf(1.f / (1.f + __expf(-bf2f(*p))));
}
__global__ void k_vt(const bf16_t* __restrict__ Z, bf16_t* __restrict__ vtn, bf16_t* __restrict__ vtnc, bf16_t* __restrict__ vtw, bf16_t* __restrict__ vtwc) {
    const size_t idx = (size_t)blockIdx.x * blockDim.x + threadIdx.x;
    const int row = (int)(idx % T_ALL), j = (int)(idx / T_ALL);
    if (j >= 640) return;
    const bool lat = row < T_LAT; const int b = lat ? row / S : (row - T_LAT) / L, t = lat ? row % S : (row - T_LAT) % L, len = lat ? S : L;
    if (j < 512) { const bf16_t v = Z[(size_t)row * IN_COLS + OFF_VN + j]; bf16_t* dst = lat ? vtn : vtnc; dst[((size_t)(b * 8 + j / 64) * 64 + (j % 64)) * len + t] = v; }
    else { const int jj = j - 512; const bf16_t v = Z[(size_t)row * IN_COLS + OFF_VW + jj]; bf16_t* dst = lat ? vtw : vtwc; dst[((size_t)(b * 2 + jj / 64) * 64 + (jj % 64)) * len + t] = v; }
}
__global__ void k_pool(const bf16_t* __restrict__ Z, bf16_t* __restrict__ Pa) {
    const size_t idx = (size_t)blockIdx.x * blockDim.x + threadIdx.x;
    const int c = (int)(idx % 512), row = (int)(idx / 512);
    if (row >= T_ALL) return;
    const int g = c / 128, w = 2 << g;
    const bool lat = row < T_LAT; const int len = lat ? S : L; const int t = lat ? row % S : (row - T_LAT) % L; const int base = row - t;
    int lo = t - w / 2; if (lo < 0) lo = 0; int hi = t - w / 2 + w; if (hi > len) hi = len;
    float sum = 0.f;
    for (int tt = lo; tt < hi; ++tt) sum += bf2f(Z[(size_t)(base + tt) * IN_COLS + OFF_A + c]);
    Pa[(size_t)row * 512 + c] = f2bf(sum / (float)(hi - lo) - bf2f(Z[(size_t)row * IN_COLS + OFF_A + c]));
}

struct AttnState { float q[64]; float o[64]; float m, l; };
__device__ __forceinline__ void attn_init(AttnState& st, const bf16_t* qp) {
#pragma unroll
    for (int d = 0; d < 64; ++d) { st.q[d] = bf2f(qp[d]) * 0.125f; st.o[d] = 0.f; }
    st.m = -1e30f; st.l = 0.f;
}
__device__ __forceinline__ void attn_key(AttnState& st, const bf16_t* kp, float bias, const bf16_t* vtp, size_t vstride) {
    float s = bias;
#pragma unroll
    for (int d8 = 0; d8 < 8; ++d8) {
        const uint4 kv = *(const uint4*)(kp + d8 * 8);
        const unsigned w[4] = {kv.x, kv.y, kv.z, kv.w};
#pragma unroll
        for (int j = 0; j < 4; ++j) { s += st.q[d8 * 8 + 2 * j] * __uint_as_float(w[j] << 16); s += st.q[d8 * 8 + 2 * j + 1] * __uint_as_float(w[j] & 0xffff0000u); }
    }
    const float mn = fmaxf(st.m, s), alpha = __expf(st.m - mn), p = __expf(s - mn);
    st.l = st.l * alpha + p; st.m = mn;
#pragma unroll
    for (int d = 0; d < 64; ++d) st.o[d] = st.o[d] * alpha + p * bf2f(vtp[(size_t)d * vstride]);
}
__device__ __forceinline__ void attn_sink(AttnState& st, float s) {
    const float mn = fmaxf(st.m, s), alpha = __expf(st.m - mn), p = __expf(s - mn);
    st.l = st.l * alpha + p; st.m = mn;
#pragma unroll
    for (int d = 0; d < 64; ++d) st.o[d] *= alpha;
}
__device__ __forceinline__ void attn_store(const AttnState& st, bf16_t* op) {
    const float inv = 1.f / st.l;
#pragma unroll
    for (int d = 0; d < 64; ++d) op[d] = f2bf(st.o[d] * inv);
}
__global__ void __launch_bounds__(64) k_na_naive(const bf16_t* __restrict__ Z, const bf16_t* __restrict__ vtn, const bf16_t* __restrict__ vtnc, const float* __restrict__ rpb, bf16_t* __restrict__ Ob) {
    const int idx = blockIdx.x * 64 + threadIdx.x;
    const int t = idx % T_LAT, h = idx / T_LAT;
    const int b = t / S, s = t % S, r = s / GW, qc = s % GW;
    int R0 = r - 4; R0 = R0 < 0 ? 0 : (R0 > 56 ? 56 : R0);
    int qs = qc - 8; qs = qs < 0 ? 0 : (qs > 48 ? 48 : qs);
    AttnState st; attn_init(st, Z + (size_t)t * IN_COLS + OFF_QN + h * 64);
    const bf16_t* vt = vtn + (size_t)(b * 8 + h) * 64 * S;
    for (int i = 0; i < 8; ++i) for (int j = 0; j < 16; ++j) {
        const int kr = R0 + i, kc = qs + j, ks = kr * GW + kc;
        int dc = kc - qc + 15; dc = dc < 0 ? 0 : (dc > 30 ? 30 : dc);
        const float bias = rpb[(h * 15 + (kr - r + 7)) * 31 + dc];
        attn_key(st, Z + (size_t)(b * S + ks) * IN_COLS + OFF_KN + h * 64, bias, vt + ks, S);
    }
    const bf16_t* vtc = vtnc + (size_t)(b * 8 + h) * 64 * L;
    for (int m = 0; m < L; ++m) attn_key(st, Z + (size_t)(T_LAT + b * L + m) * IN_COLS + OFF_KN + h * 64, 0.f, vtc + m, L);
    attn_store(st, Ob + (size_t)t * 512 + h * 64);
}
__global__ void __launch_bounds__(64) k_swa_naive(const bf16_t* __restrict__ Z, const bf16_t* __restrict__ vtw, const bf16_t* __restrict__ vtwc, const float* __restrict__ sink, bf16_t* __restrict__ Oc) {
    const int idx = blockIdx.x * 64 + threadIdx.x;
    const int t = idx % T_LAT, hq = idx / T_LAT, g = hq / 4;
    const int b = t / S, s = t % S;
    AttnState st; attn_init(st, Z + (size_t)t * IN_COLS + OFF_QW + hq * 64);
    const bf16_t* vt = vtw + (size_t)(b * 2 + g) * 64 * S;
    const int lo = s - 128 < 0 ? 0 : s - 128, hi = s + 128 > S - 1 ? S - 1 : s + 128;
    for (int ks = lo; ks <= hi; ++ks) attn_key(st, Z + (size_t)(b * S + ks) * IN_COLS + OFF_KW + g * 64, 0.f, vt + ks, S);
    const bf16_t* vtc = vtwc + (size_t)(b * 2 + g) * 64 * L;
    for (int m = 0; m < L; ++m) attn_key(st, Z + (size_t)(T_LAT + b * L + m) * IN_COLS + OFF_KW + g * 64, 0.f, vtc + m, L);
    attn_sink(st, sink[hq]);
    attn_store(st, Oc + (size_t)t * 512 + hq * 64);
}
__global__ void __launch_bounds__(64) k_ctxattn_naive(const bf16_t* __restrict__ Z, const bf16_t* __restrict__ vtnc, const bf16_t* __restrict__ vtwc, const float* __restrict__ sink, bf16_t* __restrict__ Ob, bf16_t* __restrict__ Oc) {
    const int idx = blockIdx.x * 64 + threadIdx.x;
    const int rr = idx % T_CTX, h = (idx / T_CTX) % 8, which = idx / (T_CTX * 8);
    const int b = rr / L, row = T_LAT + rr;
    AttnState st;
    if (which == 0) {
        attn_init(st, Z + (size_t)row * IN_COLS + OFF_QN + h * 64);
        const bf16_t* vtc = vtnc + (size_t)(b * 8 + h) * 64 * L;
        for (int m = 0; m < L; ++m) attn_key(st, Z + (size_t)(T_LAT + b * L + m) * IN_COLS + OFF_KN + h * 64, 0.f, vtc + m, L);
        attn_store(st, Ob + (size_t)row * 512 + h * 64);
    } else {
        const int g = h / 4;
        attn_init(st, Z + (size_t)row * IN_COLS + OFF_QW + h * 64);
        const bf16_t* vtc = vtwc + (size_t)(b * 2 + g) * 64 * L;
        for (int m = 0; m < L; ++m) attn_key(st, Z + (size_t)(T_LAT + b * L + m) * IN_COLS + OFF_KW + g * 64, 0.f, vtc + m, L);
        attn_sink(st, sink[h]);
        attn_store(st, Oc + (size_t)row * 512 + h * 64);
    }
}

__device__ __forceinline__ void wave_argmax(float& v, int& i) {
#pragma unroll
    for (int o = 32; o > 0; o >>= 1) { const float v2 = __shfl_xor(v, o); const int i2 = __shfl_xor(i, o); if (v2 > v || (v2 == v && i2 < i)) { v = v2; i = i2; } }
}
__global__ void __launch_bounds__(256) k_peer_topk(const bf16_t* __restrict__ Q, const bf16_t* __restrict__ keys, int* __restrict__ eidx, float* __restrict__ egate) {
    __shared__ float qs[2048];
    __shared__ float sc[16][128];
    __shared__ float tops[16][16];
    __shared__ int topi[16][16];
    const int t = blockIdx.x, tid = threadIdx.x, lane = tid & 63, wid = tid >> 6;
    for (int i = tid; i < 2048; i += 256) qs[i] = bf2f(Q[(size_t)t * 2048 + i]);
    __syncthreads();
    for (int o = tid; o < 2048; o += 256) {
        const int hp = o >> 7; const bf16_t* kp = keys + (size_t)o * 128; const float* qp = qs + hp * 128;
        float a = 0.f;
        for (int c8 = 0; c8 < 16; ++c8) { const uint4 kv = *(const uint4*)(kp + c8 * 8); const unsigned w[4] = {kv.x, kv.y, kv.z, kv.w};
#pragma unroll
            for (int j = 0; j < 4; ++j) { a += qp[c8 * 8 + 2 * j] * __uint_as_float(w[j] << 16); a += qp[c8 * 8 + 2 * j + 1] * __uint_as_float(w[j] & 0xffff0000u); } }
        sc[hp][o & 127] = a;
    }
    __syncthreads();
    for (int li = wid; li < 16; li += 4) {
        float v0 = sc[li][lane], v1 = sc[li][lane + 64];
        for (int r = 0; r < 16; ++r) {
            float v = v0; int i = lane; if (v1 > v0) { v = v1; i = lane + 64; }
            wave_argmax(v, i);
            if (lane == 0) { tops[li][r] = v; topi[li][r] = i; }
            if (i == lane) v0 = -3e38f; if (i == lane + 64) v1 = -3e38f;
        }
    }
    __syncthreads();
    for (int h = wid; h < 8; h += 4) {
        float cv[4];
#pragma unroll
        for (int q = 0; q < 4; ++q) { const int c = lane + 64 * q; cv[q] = tops[2 * h][c >> 4] + tops[2 * h + 1][c & 15]; }
        float bs = 0.f; int be = 0; float mx = 0.f;
        for (int r = 0; r < 16; ++r) {
            float v = cv[0]; int i = lane;
#pragma unroll
            for (int q = 1; q < 4; ++q) if (cv[q] > v) { v = cv[q]; i = lane + 64 * q; }
            wave_argmax(v, i);
            if (r == 0) mx = v;
            if (lane == r) { bs = v; be = topi[2 * h][i >> 4] * 128 + topi[2 * h + 1][i & 15]; }
#pragma unroll
            for (int q = 0; q < 4; ++q) if (i == lane + 64 * q) cv[q] = -3e38f;
        }
        float e = lane < 16 ? __expf(bs - mx) : 0.f, sum = e;
#pragma unroll
        for (int o = 32; o > 0; o >>= 1) sum += __shfl_xor(sum, o);
        if (lane < 16) { eidx[(size_t)t * 128 + h * 16 + lane] = be; egate[(size_t)t * 128 + h * 16 + lane] = e / sum; }
    }
}
__global__ void __launch_bounds__(256) k_peer_gather(const bf16_t* __restrict__ H, const bf16_t* __restrict__ U, const bf16_t* __restrict__ V, const int* __restrict__ eidx, const float* __restrict__ egate,
                                                     const float* __restrict__ mod, float* __restrict__ Xl, float* __restrict__ Xc) {
    __shared__ float wgt[128];
    __shared__ int eid[128];
    const int t = blockIdx.x, tid = threadIdx.x, lane = tid & 63, wid = tid >> 6;
    if (tid < 128) eid[tid] = eidx[(size_t)t * 128 + tid];
    float hx[16];
    { const uint4 a = *(const uint4*)(H + (size_t)t * D + lane * 16), b = *(const uint4*)(H + (size_t)t * D + lane * 16 + 8);
      const unsigned w[8] = {a.x, a.y, a.z, a.w, b.x, b.y, b.z, b.w};
#pragma unroll
      for (int j = 0; j < 8; ++j) { hx[2 * j] = __uint_as_float(w[j] << 16); hx[2 * j + 1] = __uint_as_float(w[j] & 0xffff0000u); } }
    __syncthreads();
    for (int e = wid; e < 128; e += 4) {
        const bf16_t* up = U + (size_t)eid[e] * D + lane * 16;
        const uint4 a = *(const uint4*)up, b = *(const uint4*)(up + 8);
        const unsigned w[8] = {a.x, a.y, a.z, a.w, b.x, b.y, b.z, b.w};
        float acc = 0.f;
#pragma unroll
        for (int j = 0; j < 8; ++j) { acc += hx[2 * j] * __uint_as_float(w[j] << 16); acc += hx[2 * j + 1] * __uint_as_float(w[j] & 0xffff0000u); }
#pragma unroll
        for (int o = 32; o > 0; o >>= 1) acc += __shfl_xor(acc, o);
        if (lane == 0) wgt[e] = egate[(size_t)t * 128 + e] * 0.5f * acc * (1.f + erff(acc * 0.70710678118654752f));
    }
    __syncthreads();
    float o[4] = {0.f, 0.f, 0.f, 0.f};
    for (int e = 0; e < 128; ++e) {
        const uint2 vv = *(const uint2*)(V + (size_t)eid[e] * D + tid * 4); const float w = wgt[e];
        o[0] += w * __uint_as_float(vv.x << 16); o[1] += w * __uint_as_float(vv.x & 0xffff0000u); o[2] += w * __uint_as_float(vv.y << 16); o[3] += w * __uint_as_float(vv.y & 0xffff0000u);
    }
    const int mrow = t < T_LAT ? t / S : 4;
    float* xp = t < T_LAT ? Xl + (size_t)t * D + tid * 4 : Xc + (size_t)(t - T_LAT) * D + tid * 4;
    const float* gt = mod + (size_t)mrow * 6144 + 5 * 1024 + tid * 4;
    float4 x = *(float4*)xp; x.x += gt[0] * o[0]; x.y += gt[1] * o[1]; x.z += gt[2] * o[2]; x.w += gt[3] * o[3]; *(float4*)xp = x;
}

template <class Epi> static void gemm(hipStream_t st, const bf16_t* A, const bf16_t* Bt, int M, int N, int K, Epi E) {
    k_gemm_naive<Epi><<<dim3(N / 64, M / 64), 256, 0, st>>>(A, Bt, M, N, K, E);
}
extern "C" void kernel_launch(void* const* d_in, const int* in_sizes, int n_in, void* d_out, int out_size, void* d_ws, size_t ws_size, hipStream_t stream) {
    if (ws_size < WS_END) { fprintf(stderr, "workspace too small: %zu < %zu\n", ws_size, (size_t)WS_END); return; }
    const float* x = (const float*)d_in[0]; const float* c = (const float*)d_in[1]; const float* ctx = (const float*)d_in[2]; const float* c_ctx = (const float*)d_in[3];
    const float* ada_w = (const float*)d_in[4]; const float* ada_b = (const float*)d_in[5]; const float* norm1_g = (const float*)d_in[6]; const float* norm2_g = (const float*)d_in[7];
    const float* w_in = (const float*)d_in[8]; const float* pool_w = (const float*)d_in[9]; const float* pool_scale = (const float*)d_in[10]; const float* na_rpb = (const float*)d_in[11];
    const float* swa_sink = (const float*)d_in[12]; const float* wba = (const float*)d_in[13]; const float* wbb = (const float*)d_in[14]; const float* wbc = (const float*)d_in[15];
    const float* w_out = (const float*)d_in[16]; const float* peer_wq = (const float*)d_in[17]; const float* peer_keys = (const float*)d_in[18]; const float* peer_u = (const float*)d_in[19];
    const float* peer_v = (const float*)d_in[20]; const float* final_g = (const float*)d_in[21];
    unsigned char* ws = (unsigned char*)d_ws;
    float* mod = (float*)(ws + WS_MOD); float* rope = (float*)(ws + WS_ROPE); float* XC = (float*)(ws + WS_XC); float* X = (float*)d_out;
    bf16_t* H = (bf16_t*)(ws + WS_H); bf16_t* MM = H; bf16_t* Z = (bf16_t*)(ws + WS_Z); bf16_t* Q = Z;
    bf16_t* vtn = (bf16_t*)(ws + WS_VTN); bf16_t* vtnc = (bf16_t*)(ws + WS_VTNC); bf16_t* vtw = (bf16_t*)(ws + WS_VTW); bf16_t* vtwc = (bf16_t*)(ws + WS_VTWC);
    bf16_t* AT = (bf16_t*)(ws + WS_AT); int* eidx = (int*)(ws + WS_EIDX); float* egate = (float*)(ws + WS_EGATE);

    for (int l = 0; l < 2; ++l) {
        unsigned char* wl = ws + WS_W + l * W_LAYER;
        k_transpose_bf16<<<dim3(IN_COLS / 32, D / 32), dim3(32, 8), 0, stream>>>(w_in + (size_t)l * D * IN_COLS, (bf16_t*)(wl + W_WIN), D, IN_COLS);
        k_fold_wa<<<512 * D / 256, 256, 0, stream>>>(pool_w + (size_t)l * 4 * 128 * 128, pool_scale + l * 512, wba + (size_t)l * 512 * D, (bf16_t*)(wl + W_WA));
        k_transpose_bf16<<<dim3(D / 32, 512 / 32), dim3(32, 8), 0, stream>>>(wbb + (size_t)l * 512 * D, (bf16_t*)(wl + W_WB), 512, D);
        k_transpose_bf16<<<dim3(D / 32, 512 / 32), dim3(32, 8), 0, stream>>>(wbc + (size_t)l * 512 * D, (bf16_t*)(wl + W_WC), 512, D);
        k_transpose_bf16<<<dim3(D / 32, D / 32), dim3(32, 8), 0, stream>>>(w_out + (size_t)l * D * D, (bf16_t*)(wl + W_WO), D, D);
        k_transpose_bf16<<<dim3(2048 / 32, D / 32), dim3(32, 8), 0, stream>>>(peer_wq + (size_t)l * D * 2048, (bf16_t*)(wl + W_WQ), D, 2048);
        k_convert_bf16<<<256, 256, 0, stream>>>(peer_keys + (size_t)l * 8 * 2 * 128 * 128, (bf16_t*)(wl + W_KEYS), (size_t)8 * 2 * 128 * 128 / 4);
        unsigned char* tl = ws + WS_TAB + l * TAB_LAYER;
        k_convert_bf16<<<2048, 256, 0, stream>>>(peer_u + (size_t)l * NEXP * D, (bf16_t*)tl, (size_t)NEXP * D / 4);
        k_convert_bf16<<<2048, 256, 0, stream>>>(peer_v + (size_t)l * NEXP * D, (bf16_t*)(tl + (size_t)NEXP * D * 2), (size_t)NEXP * D / 4);
    }
    k_mods<<<dim3(6144 / 256, 2), 256, 0, stream>>>(c, c_ctx, ada_w, ada_b, mod);
    k_rope_table<<<4, 256, 0, stream>>>(rope);
    (void)hipMemcpyAsync(X, x, (size_t)T_LAT * D * 4, hipMemcpyDeviceToDevice, stream);
    (void)hipMemcpyAsync(XC, ctx, (size_t)T_CTX * D * 4, hipMemcpyDeviceToDevice, stream);

    for (int l = 0; l < 2; ++l) {
        const bool last = (l == 1);
        const int rows = last ? T_LAT : T_ALL;
        unsigned char* wl = ws + WS_W + l * W_LAYER; const float* modl = mod + (size_t)l * 5 * 6144;
        const bf16_t* U = (const bf16_t*)(ws + WS_TAB + l * TAB_LAYER); const bf16_t* V = U + (size_t)NEXP * D;
        k_norm_mod<<<T_ALL, 256, 0, stream>>>(X, XC, norm1_g + l * D, modl, 0, 1, H);
        gemm(stream, H, (const bf16_t*)(wl + W_WIN), T_ALL, IN_COLS, D, EpiStore{Z, IN_COLS, 0});
        k_rope<<<T_LAT * 320 / 256, 256, 0, stream>>>(Z, rope);
        k_sigmoid<<<(unsigned)(((size_t)T_ALL * 3072 + 255) / 256), 256, 0, stream>>>(Z, T_ALL);
        k_vt<<<(unsigned)(((size_t)T_ALL * 640 + 255) / 256), 256, 0, stream>>>(Z, vtn, vtnc, vtw, vtwc);
        k_pool<<<(unsigned)(((size_t)T_ALL * 512 + 255) / 256), 256, 0, stream>>>(Z, AT);
        k_na_naive<<<T_LAT * 8 / 64, 64, 0, stream>>>(Z, vtn, vtnc, na_rpb + (size_t)l * 8 * 15 * 31, AT + (size_t)T_ALL * 512);
        k_swa_naive<<<T_LAT * 8 / 64, 64, 0, stream>>>(Z, vtw, vtwc, swa_sink + l * 8, AT + (size_t)2 * T_ALL * 512);
        if (!last) k_ctxattn_naive<<<T_CTX * 8 * 2 / 64, 64, 0, stream>>>(Z, vtnc, vtwc, swa_sink + l * 8, AT + (size_t)T_ALL * 512, AT + (size_t)2 * T_ALL * 512);
        for (int seg = 0; seg < 3; ++seg)
            gemm(stream, AT + (size_t)seg * T_ALL * 512, (const bf16_t*)(wl + W_WA + (size_t)seg * D * 512 * 2), rows, D, 512, EpiMerge{Z, MM, seg, 0});
        gemm(stream, MM, (const bf16_t*)(wl + W_WO), rows, D, D, EpiResid{X, XC, modl, 2, 0});
        k_norm_mod<<<rows, 256, 0, stream>>>(X, XC, norm2_g + l * D, modl, 3, 4, H);
        gemm(stream, H, (const bf16_t*)(wl + W_WQ), rows, 2048, D, EpiStore{Q, 2048, 0});
        k_peer_topk<<<rows, 256, 0, stream>>>(Q, (const bf16_t*)(wl + W_KEYS), eidx, egate);
        k_peer_gather<<<rows, 256, 0, stream>>>(H, U, V, eidx, egate, modl, X, XC);
    }
    k_final_norm<<<T_LAT, 256, 0, stream>>>(X, final_g);
}
```

```cpp
#include <hip/hip_runtime.h>
#include <hip/hip_cooperative_groups.h>
#include <stdint.h>
#include <stdio.h>
namespace cg = cooperative_groups;

typedef unsigned short bf16_t;

constexpr int D = 1024, NB = 4, S = 4096, L = 256, GW = 64;
constexpr int T_LAT = NB * S, T_CTX = NB * L, T_ALL = T_LAT + T_CTX;
constexpr int IN_COLS = 5888;
constexpr int OFF_KN = 0, OFF_VN = 512, OFF_KW = 1024, OFF_VW = 1152, CTX_KV_COLS = 1280, OFF_QN = 1280, OFF_QW = 1792, OFF_A = 2304, OFF_G = 2816;
constexpr int NEXP = 16384;
constexpr float EPS = 1e-6f;
constexpr int NTHREADS = 512;
constexpr int LDS_BYTES = 147456;

constexpr size_t al256(size_t x) { return (x + 255) & ~(size_t)255; }
constexpr size_t WS_MOD = 0;
constexpr size_t WS_ROPE = al256(WS_MOD + 2 * 5 * 6144 * 4);
constexpr size_t WS_XC = al256(WS_ROPE + 2 * 64 * 16 * 4);
constexpr size_t WS_H = al256(WS_XC + (size_t)T_CTX * D * 4);
constexpr size_t WS_Z = al256(WS_H + (size_t)T_ALL * D * 2);
constexpr size_t WS_VTN = al256(WS_Z + (size_t)T_ALL * IN_COLS * 2);
constexpr size_t WS_VTNC = al256(WS_VTN + (size_t)NB * 8 * 64 * S * 2);
constexpr size_t WS_VTW = al256(WS_VTNC + (size_t)NB * 8 * 64 * L * 2);
constexpr size_t WS_VTWC = al256(WS_VTW + (size_t)NB * 2 * 64 * S * 2);
constexpr size_t WS_AT = al256(WS_VTWC + (size_t)NB * 2 * 64 * L * 2);
constexpr size_t WS_EIDX = al256(WS_AT + (size_t)3 * T_ALL * 512 * 2);
constexpr size_t WS_EGATE = al256(WS_EIDX + (size_t)T_ALL * 128 * 4);
constexpr size_t WS_W = al256(WS_EGATE + (size_t)T_ALL * 128 * 4);
constexpr size_t W_WIN = 0;
constexpr size_t W_WA = W_WIN + (size_t)IN_COLS * D * 2;
constexpr size_t W_WB = W_WA + (size_t)D * 512 * 2;
constexpr size_t W_WC = W_WB + (size_t)D * 512 * 2;
constexpr size_t W_WO = W_WC + (size_t)D * 512 * 2;
constexpr size_t W_WQ = W_WO + (size_t)D * D * 2;
constexpr size_t W_KEYS = W_WQ + (size_t)2048 * D * 2;
constexpr size_t W_LAYER = al256(W_KEYS + (size_t)8 * 2 * 128 * 128 * 2);
constexpr size_t WS_TAB = al256(WS_W + 2 * W_LAYER);
constexpr size_t TAB_LAYER = (size_t)2 * NEXP * D * 2;
constexpr size_t WS_END = WS_TAB + 2 * TAB_LAYER;

__device__ __forceinline__ float bf2f(bf16_t v) { return __uint_as_float((unsigned)v << 16); }
__device__ __forceinline__ bf16_t f2bf(float f) { unsigned u = __float_as_uint(f); u += 0x7fffu + ((u >> 16) & 1u); return (bf16_t)(u >> 16); }
__device__ __forceinline__ unsigned pk2(float lo, float hi) { return (unsigned)f2bf(lo) | ((unsigned)f2bf(hi) << 16); }
__device__ __forceinline__ float lo16(unsigned w) { return __uint_as_float(w << 16); }
__device__ __forceinline__ float hi16(unsigned w) { return __uint_as_float(w & 0xffff0000u); }

__device__ __forceinline__ int opaque_tid() { int t = threadIdx.x; asm volatile("" : "+v"(t)); return t; }
namespace pg8 {
#define PG8_LAS __attribute__((address_space(3)))
typedef unsigned short bf16_t;
typedef short bf16x8 __attribute__((ext_vector_type(8)));
typedef float f32x4 __attribute__((ext_vector_type(4)));
typedef unsigned u32x4 __attribute__((ext_vector_type(4)));
constexpr int BM = 256, BK = 64, HALF = 128, HTB = HALF * BK * 2  , STAGE_BYTES = 8 * HTB, NXCD = 8, WGM = 8;

__host__ __device__ __forceinline__ int lds_byte(int r, int c) { const int st = (r >> 4) * 2 + (c >> 5), rr = r & 15, cc = c & 31, ob = rr * 64 + cc * 2; return st * 1024 + (ob ^ (((ob >> 9) & 1) << 5)); }
__host__ __device__ __forceinline__ void stage_rc(int b, int& R, int& C) { const int st = b / 1024, sb = b % 1024, swz = sb ^ (((sb >> 9) & 1) << 5); R = (st >> 1) * 16 + swz / 64; C = (st & 1) * 32 + (swz % 64) / 2; }
__host__ __device__ __forceinline__ int perm32(int rho) { const int n = rho >> 4, i = rho & 15; return 8 * (i >> 2) + 4 * n + (i & 3); }

struct Unit { int pm, pn; };
struct Gemm { const bf16_t* A; const bf16_t* Bt; int M, N, K; };

struct StaticOrder {
    int nM, nN, nwg, G, c;
    __host__ __device__ void init(int M, int N, int G_, int c_) { nM = M / BM; nN = N / BM; nwg = nM * nN; G = G_; c = c_; }
    __host__ __device__ bool next(int i, Unit& u) const {
        const long L = (long)i * G + c; if (L >= nwg) return false;
        int wgid = (int)L; { const int q = nwg / NXCD, r = nwg % NXCD, xcd = wgid % NXCD, off = wgid / NXCD; wgid = (xcd < r ? xcd * (q + 1) : r * (q + 1) + (xcd - r) * q) + off; }
        const int nig = WGM * nN, gid = wgid / nig, fm = gid * WGM, gsz = (nM - fm) < WGM ? (nM - fm) : WGM;
        u.pm = fm + ((wgid % nig) % gsz); u.pn = (wgid % nig) / gsz; return true;
    }
    __device__ __forceinline__ void a_ready(const Unit&) const {}
    __device__ __forceinline__ void done(const Unit&) const {}
};
__device__ __forceinline__ unsigned cvt_pk_bf16(float lo, float hi) { unsigned r; asm volatile("v_cvt_pk_bf16_f32 %0, %1, %2" : "=v"(r) : "v"(lo), "v"(hi)); return r; }
typedef unsigned u32x4 __attribute__((ext_vector_type(4)));
struct EpiStoreBf16 {
    static constexpr bool PERM = true, AFTER_DRAIN = false;
    bf16_t* O; int ldc; int pad;
    __device__ __forceinline__ void operator()(const f32x4 (&acc)[2][2][4][2], const Unit& u, int wr, int wc, int fr, int fq) const {
        const int row0 = u.pm * BM + wr * 64 + fr, col0 = u.pn * BM + wc * 32 + 8 * fq;
#pragma unroll
        for (int ai = 0; ai < 2; ++ai)
#pragma unroll
            for (int m = 0; m < 4; ++m) { bf16_t* rowp = O + (size_t)(row0 + ai * HALF + m * 16) * ldc + col0;
#pragma unroll
                for (int bj = 0; bj < 2; ++bj) { const f32x4 v0 = acc[ai][bj][m][0], v1 = acc[ai][bj][m][1];
                    u32x4 w; w.x = cvt_pk_bf16(v0[0], v0[1]); w.y = cvt_pk_bf16(v0[2], v0[3]); w.z = cvt_pk_bf16(v1[0], v1[1]); w.w = cvt_pk_bf16(v1[2], v1[3]);
                    *(u32x4*)(rowp + bj * HALF) = w; } }
    }
};
constexpr int NTM_STACK = 68;
struct EpiMergeSeg {
    static constexpr bool PERM = true, AFTER_DRAIN = false;
    const bf16_t* Z; bf16_t* M;
    __device__ __forceinline__ void operator()(const f32x4 (&acc)[2][2][4][2], const Unit& u, int wr, int wc, int fr, int fq) const {
        const int seg = u.pn >> 2, tn = u.pn & 3, tm = u.pm - seg * NTM_STACK;
        const int row0 = tm * BM + wr * 64 + fr, col0 = tn * BM + wc * 32 + 8 * fq;
#pragma unroll
        for (int ai = 0; ai < 2; ++ai)
#pragma unroll
            for (int m = 0; m < 4; ++m) { const int row = row0 + ai * HALF + m * 16;
#pragma unroll
                for (int bj = 0; bj < 2; ++bj) { const int col = col0 + bj * HALF;
                    const u32x4 g = *(const u32x4*)(Z + (size_t)row * 5888 + 2816 + seg * 1024 + col);
                    bf16_t* mp = M + (size_t)row * 1024 + col;
                    u32x4 o = (u32x4){0u, 0u, 0u, 0u}; if (seg) o = *(const u32x4*)mp;
                    const f32x4 v0 = acc[ai][bj][m][0], v1 = acc[ai][bj][m][1];
                    u32x4 w;
                    w.x = cvt_pk_bf16(__uint_as_float(g.x << 16) * v0[0] + __uint_as_float(o.x << 16), __uint_as_float(g.x & 0xffff0000u) * v0[1] + __uint_as_float(o.x & 0xffff0000u));
                    w.y = cvt_pk_bf16(__uint_as_float(g.y << 16) * v0[2] + __uint_as_float(o.y << 16), __uint_as_float(g.y & 0xffff0000u) * v0[3] + __uint_as_float(o.y & 0xffff0000u));
                    w.z = cvt_pk_bf16(__uint_as_float(g.z << 16) * v1[0] + __uint_as_float(o.z << 16), __uint_as_float(g.z & 0xffff0000u) * v1[1] + __uint_as_float(o.z & 0xffff0000u));
                    w.w = cvt_pk_bf16(__uint_as_float(g.w << 16) * v1[2] + __uint_as_float(o.w << 16), __uint_as_float(g.w & 0xffff0000u) * v1[3] + __uint_as_float(o.w & 0xffff0000u));
                    *(u32x4*)mp = w; } }
    }
};
struct MergeOrder {
    int ntiles, G, c, pad;
    __device__ bool next(int i, Unit& u) const { const int ti = (i / 3) * G + c, seg = i % 3; if (ti >= ntiles) return false; u.pm = seg * NTM_STACK + (ti >> 2); u.pn = seg * 4 + (ti & 3); return true; }
    __device__ __forceinline__ void a_ready(const Unit&) const {}
    __device__ __forceinline__ void done(const Unit&) const {}
};
struct EpiResid {
    static constexpr bool PERM = false, AFTER_DRAIN = false;
    float* Xl; float* Xc; const float* modl; int gate_idx; int pad;
    __device__ __forceinline__ void operator()(const f32x4 (&acc)[2][2][4][2], const Unit& u, int wr, int wc, int fr, int fq) const {
        const int mrow = u.pm < 64 ? (u.pm >> 4) : 4;
        float* base = u.pm < 64 ? Xl + (size_t)u.pm * BM * 1024 : Xc + (size_t)(u.pm - 64) * BM * 1024;
        const float* gt = modl + (size_t)mrow * 6144 + gate_idx * 1024;
        const int col0 = u.pn * BM + wc * 32 + 4 * fq;
#pragma unroll
        for (int bj = 0; bj < 2; ++bj)
#pragma unroll
            for (int n = 0; n < 2; ++n) { const int col = col0 + bj * HALF + 16 * n; const f32x4 gv = *(const f32x4*)(gt + col);
#pragma unroll
                for (int ai = 0; ai < 2; ++ai)
#pragma unroll
                    for (int m = 0; m < 4; ++m) { float* xp = base + (size_t)(ai * HALF + wr * 64 + m * 16 + fr) * 1024 + col;
                        f32x4 x = *(f32x4*)xp; x = x + gv * acc[ai][bj][m][n]; *(f32x4*)xp = x; } }
    }
};
template <class Epi, class Sched, bool ALIGN_EPI = false, bool SP2 = false>
__device__ __forceinline__ void gemm_phase(PG8_LAS unsigned char* lds, const Gemm g, const Sched& S, const Epi& E) {
    const int tid = opaque_tid(), wid = __builtin_amdgcn_readfirstlane(tid >> 6), lane = tid & 63, wr = wid >> 2, wc = wid & 3, fr = lane & 15, fq = lane >> 4;
    const int K = g.K, nt = K / BK;
    unsigned voffA[2], voffB[2];
#pragma unroll
    for (int i = 0; i < 2; ++i) { int R, C; stage_rc(tid * 16 + i * 8192, R, C); const int Rb = Epi::PERM ? ((R & ~31) + perm32(R & 31)) : R;
        voffA[i] = (unsigned)(R * K + C) * 2u; voffB[i] = (unsigned)(Rb * K + C) * 2u; }
    const size_t kstep = (size_t)(BK * 2);
    const size_t hstep = (size_t)HALF * K * 2;
    const size_t tstep = 2 * hstep;
    const unsigned ldsw = (unsigned)wid * 1024u;
    const int aoff = lds_byte(wr * 64 + fr, fq * 8), boff = lds_byte(wc * 32 + fr, fq * 8);
#define PG8_SA(b, h) (((b) * 2 + (h)) * HTB)
#define PG8_SB(b, h) ((4 + (b) * 2 + (h)) * HTB)
#define PG8_STAGE(bufoff, gbase, voff) do { _Pragma("unroll") for (int _i = 0; _i < 2; ++_i) \
        __builtin_amdgcn_global_load_lds((const unsigned*)((const char*)(gbase) + (voff)[_i]), (PG8_LAS unsigned*)(lds + (bufoff) + ldsw + _i * 8192), 16, 0, 0); } while (0)
#define PG8_LDA(dst, b, h) do { _Pragma("unroll") for (int m = 0; m < 4; ++m) _Pragma("unroll") for (int k = 0; k < 2; ++k) dst[m][k] = *(const PG8_LAS bf16x8*)(lds + PG8_SA(b, h) + aoff + m * 2048 + k * 1024); } while (0)
#define PG8_LDB(dst, b, h) do { _Pragma("unroll") for (int n = 0; n < 2; ++n) _Pragma("unroll") for (int k = 0; k < 2; ++k) dst[n][k] = *(const PG8_LAS bf16x8*)(lds + PG8_SB(b, h) + boff + n * 2048 + k * 1024); } while (0)
#define PG8_MMA(ai, bj, At, Bt) do { __builtin_amdgcn_s_setprio(1); _Pragma("unroll") for (int m = 0; m < 4; ++m) _Pragma("unroll") for (int n = 0; n < 2; ++n) _Pragma("unroll") for (int k = 0; k < 2; ++k) \
        acc[ai][bj][m][n] = __builtin_amdgcn_mfma_f32_16x16x32_bf16(Bt[n][k], At[m][k], acc[ai][bj][m][n], 0, 0, 0); __builtin_amdgcn_s_setprio(0); } while (0)
#define PG8_WAIT_V(n) asm volatile("s_waitcnt vmcnt(" #n ")" ::: "memory")
#define PG8_WAIT_L(n) asm volatile("s_waitcnt lgkmcnt(" #n ")" ::: "memory")
#define PG8_BAR __builtin_amdgcn_s_barrier()
#define PG8_SCHED __builtin_amdgcn_sched_barrier(0)
    Unit cur, nxt; int ui = 0;
    if (!S.next(0, cur)) return;
    f32x4 acc[2][2][4][2];
#pragma unroll
    for (int a = 0; a < 2; ++a)
#pragma unroll
        for (int b = 0; b < 2; ++b)
#pragma unroll
            for (int m = 0; m < 4; ++m)
#pragma unroll
                for (int n = 0; n < 2; ++n) acc[a][b][m][n] = (f32x4){0.f, 0.f, 0.f, 0.f};
    bf16x8 At[4][2], B0[2][2], B1[2][2];
    const char* cA = (const char*)g.A + (size_t)cur.pm * tstep; const char* cB = (const char*)g.Bt + (size_t)cur.pn * tstep;
    S.a_ready(cur);
    if constexpr (SP2) {
        PG8_STAGE(PG8_SB(0, 0), cB, voffB); PG8_STAGE(PG8_SB(0, 1), cB + hstep, voffB); PG8_STAGE(PG8_SA(0, 0), cA, voffA); PG8_STAGE(PG8_SA(0, 1), cA + hstep, voffA);
        if (wr == 1) PG8_BAR;
        PG8_WAIT_V(2); PG8_BAR;
        PG8_STAGE(PG8_SB(1, 0), cB + kstep, voffB); PG8_STAGE(PG8_SA(1, 0), cA + kstep, voffA); PG8_STAGE(PG8_SB(1, 1), cB + hstep + kstep, voffB);
        PG8_WAIT_V(6); PG8_BAR;
    } else {
        PG8_STAGE(PG8_SB(0, 0), cB, voffB); PG8_STAGE(PG8_SA(0, 0), cA, voffA); PG8_STAGE(PG8_SB(0, 1), cB + hstep, voffB); PG8_STAGE(PG8_SA(0, 1), cA + hstep, voffA);
        if (wr == 1) PG8_BAR;
        PG8_WAIT_V(4); PG8_BAR;
        PG8_STAGE(PG8_SB(1, 0), cB + kstep, voffB); PG8_STAGE(PG8_SA(1, 0), cA + kstep, voffA); PG8_STAGE(PG8_SB(1, 1), cB + hstep + kstep, voffB);
        PG8_WAIT_V(6); PG8_BAR;
    }
    for (;;) {
        const bool has_next = S.next(ui + 1, nxt);
        const char* nA = has_next ? (const char*)g.A + (size_t)nxt.pm * tstep : cA; const char* nB = has_next ? (const char*)g.Bt + (size_t)nxt.pn * tstep : cB;
        for (int t = 0; t < nt; t += 2) {
            const bool last = (t == nt - 2);
            const char* a1 = cA + (size_t)(t + 1) * kstep;
            const char* a2 = last ? nA : cA + (size_t)(t + 2) * kstep; const char* b2 = last ? nB : cB + (size_t)(t + 2) * kstep;
            const char* a3 = a2 + kstep; const char* b3 = b2 + kstep;
            if (last && has_next) S.a_ready(nxt);
            if constexpr (SP2) {
            PG8_LDB(B0, 0, 0); PG8_LDB(B1, 0, 1); PG8_SCHED; PG8_LDA(At, 0, 0); PG8_STAGE(PG8_SA(1, 1), a1 + hstep, voffA);
            PG8_WAIT_V(8); PG8_WAIT_L(0); PG8_BAR; PG8_MMA(0, 0, At, B0); PG8_MMA(0, 1, At, B1); PG8_BAR; PG8_SCHED;
            PG8_LDA(At, 0, 1); PG8_STAGE(PG8_SB(0, 0), b2, voffB); PG8_STAGE(PG8_SB(0, 1), b2 + hstep, voffB); PG8_STAGE(PG8_SA(0, 0), a2, voffA);
            PG8_WAIT_V(8); PG8_WAIT_L(0); PG8_BAR; PG8_MMA(1, 0, At, B0); PG8_MMA(1, 1, At, B1); PG8_BAR; PG8_SCHED;
            PG8_LDB(B0, 1, 0); PG8_LDB(B1, 1, 1); PG8_SCHED; PG8_LDA(At, 1, 0); PG8_STAGE(PG8_SA(0, 1), a2 + hstep, voffA);
            PG8_WAIT_V(8); PG8_WAIT_L(0); PG8_BAR; PG8_MMA(0, 0, At, B0); PG8_MMA(0, 1, At, B1); PG8_BAR; PG8_SCHED;
            PG8_LDA(At, 1, 1); PG8_STAGE(PG8_SB(1, 0), b3, voffB); PG8_STAGE(PG8_SB(1, 1), b3 + hstep, voffB); PG8_STAGE(PG8_SA(1, 0), a3, voffA);
            PG8_WAIT_V(8); PG8_WAIT_L(0); PG8_BAR; PG8_MMA(1, 0, At, B0); PG8_MMA(1, 1, At, B1); PG8_BAR; PG8_SCHED;
            } else {
            PG8_LDB(B0, 0, 0); PG8_SCHED; PG8_LDA(At, 0, 0); PG8_STAGE(PG8_SA(1, 1), a1 + hstep, voffA);
            PG8_WAIT_L(8); PG8_BAR; PG8_WAIT_L(0); PG8_MMA(0, 0, At, B0); PG8_BAR; PG8_SCHED;
            PG8_LDB(B1, 0, 1); PG8_STAGE(PG8_SB(0, 0), b2, voffB);
            PG8_BAR; PG8_WAIT_L(0); PG8_MMA(0, 1, At, B1); PG8_BAR;
            PG8_LDA(At, 0, 1); PG8_STAGE(PG8_SA(0, 0), a2, voffA);
            PG8_BAR; PG8_WAIT_L(0); PG8_MMA(1, 0, At, B0); PG8_BAR; PG8_SCHED;
            PG8_STAGE(PG8_SB(0, 1), b2 + hstep, voffB);
            PG8_WAIT_V(6); PG8_BAR; PG8_MMA(1, 1, At, B1); PG8_BAR;
            PG8_LDB(B0, 1, 0); PG8_SCHED; PG8_LDA(At, 1, 0); PG8_STAGE(PG8_SA(0, 1), a2 + hstep, voffA);
            PG8_WAIT_L(8); PG8_BAR; PG8_WAIT_L(0); PG8_MMA(0, 0, At, B0); PG8_BAR; PG8_SCHED;
            PG8_LDB(B1, 1, 1); PG8_STAGE(PG8_SB(1, 0), b3, voffB);
            PG8_BAR; PG8_WAIT_L(0); PG8_MMA(0, 1, At, B1); PG8_BAR;
            PG8_LDA(At, 1, 1); PG8_STAGE(PG8_SA(1, 0), a3, voffA);
            PG8_BAR; PG8_WAIT_L(0); PG8_MMA(1, 0, At, B0); PG8_BAR; PG8_SCHED;
            PG8_STAGE(PG8_SB(1, 1), b3 + hstep, voffB);
            PG8_WAIT_V(6); PG8_BAR; PG8_MMA(1, 1, At, B1); PG8_BAR;
            }
        }
        if constexpr (ALIGN_EPI) { if (wr == 0) PG8_BAR; }
        if constexpr (!Epi::AFTER_DRAIN) { E(acc, cur, wr, wc, fr, fq); S.done(cur); }
        if (!has_next) break;
#pragma unroll
        for (int a = 0; a < 2; ++a)
#pragma unroll
            for (int b = 0; b < 2; ++b)
#pragma unroll
                for (int m = 0; m < 4; ++m)
#pragma unroll
                    for (int n = 0; n < 2; ++n) acc[a][b][m][n] = (f32x4){0.f, 0.f, 0.f, 0.f};
        cur = nxt; cA = nA; cB = nB; ++ui;
        if constexpr (ALIGN_EPI) { if (wr == 1) PG8_BAR; }
    }
    PG8_WAIT_V(0);
    if constexpr (!ALIGN_EPI) { if (wr == 0) PG8_BAR; }
    PG8_BAR;
    if constexpr (Epi::AFTER_DRAIN) { E.fused(acc, cur, wr, wc, fr, fq, lds, wid, lane); S.done(cur); }
#undef PG8_SA
#undef PG8_SB
#undef PG8_STAGE
#undef PG8_LDA
#undef PG8_LDB
#undef PG8_MMA
#undef PG8_WAIT_V
#undef PG8_WAIT_L
#undef PG8_BAR
#undef PG8_SCHED
}
}

struct Params {
    const float *x, *c, *ctx, *c_ctx, *ada_w, *ada_b, *norm1_g, *norm2_g, *w_in, *pool_w, *pool_scale, *na_rpb, *swa_sink, *wba, *wbb, *wbc, *w_out, *peer_wq, *peer_keys, *peer_u, *peer_v, *final_g;
    float* out; unsigned char* ws;
};
#define TID (opaque_tid())
#define BID ((int)blockIdx.x)
#define NBLK ((int)gridDim.x)

__device__ __forceinline__ void tr_tiles(const float* __restrict__ W, bf16_t* __restrict__ Wt, int K, int N, float* tile  ) {
    const int ntn = N / 64, ntiles = (K / 64) * ntn, tid = TID, c = tid & 63, r8 = tid >> 6;
    for (int vb = BID; vb < ntiles; vb += NBLK) {
        const int k0 = (vb / ntn) * 64, n0 = (vb % ntn) * 64;
#pragma unroll
        for (int i = 0; i < 8; ++i) tile[(i * 8 + r8) * 65 + c] = W[(size_t)(k0 + i * 8 + r8) * N + n0 + c];
        __syncthreads();
#pragma unroll
        for (int i = 0; i < 8; ++i) Wt[(size_t)(n0 + i * 8 + r8) * K + k0 + c] = f2bf(tile[c * 65 + i * 8 + r8]);
        __syncthreads();
    }
}
__device__ __forceinline__ void conv_bf16(const float* __restrict__ src, bf16_t* __restrict__ dst, size_t n8) {
    for (size_t i = (size_t)BID * NTHREADS + TID; i < n8; i += (size_t)NBLK * NTHREADS) {
        const float4 a = ((const float4*)src)[2 * i], b = ((const float4*)src)[2 * i + 1];
        uint4 o; o.x = pk2(a.x, a.y); o.y = pk2(a.z, a.w); o.z = pk2(b.x, b.y); o.w = pk2(b.z, b.w);
        ((uint4*)dst)[i] = o;
    }
}
__device__ __forceinline__ void copy_f4(const float* __restrict__ src, float* __restrict__ dst, size_t n4) {
    for (size_t i = (size_t)BID * NTHREADS + TID; i < n4; i += (size_t)NBLK * NTHREADS) ((float4*)dst)[i] = ((const float4*)src)[i];
}
__device__ __forceinline__ void ph_prep(const Params& p, float* smem) {
    unsigned char* ws = p.ws;
    for (int l = 0; l < 2; ++l) {
        unsigned char* wl = ws + WS_W + l * W_LAYER;
        tr_tiles(p.w_in + (size_t)l * D * IN_COLS, (bf16_t*)(wl + W_WIN), D, IN_COLS, smem);
        tr_tiles(p.wbb + (size_t)l * 512 * D, (bf16_t*)(wl + W_WB), 512, D, smem);
        tr_tiles(p.wbc + (size_t)l * 512 * D, (bf16_t*)(wl + W_WC), 512, D, smem);
        tr_tiles(p.w_out + (size_t)l * D * D, (bf16_t*)(wl + W_WO), D, D, smem);
        tr_tiles(p.peer_wq + (size_t)l * D * 2048, (bf16_t*)(wl + W_WQ), D, 2048, smem);
        {
            const float* pw = p.pool_w + (size_t)l * 4 * 128 * 128; const float* ps = p.pool_scale + l * 512; const float* wba = p.wba + (size_t)l * 512 * D; bf16_t* WaT = (bf16_t*)(wl + W_WA);
            for (int idx = BID * NTHREADS + TID; idx < 512 * D; idx += NBLK * NTHREADS) {
                const int n = idx % D, kk = idx / D, g = kk / 128, c = kk % 128;
                float acc = 0.f;
                for (int e = 0; e < 128; ++e) acc += pw[(g * 128 + c) * 128 + e] * ps[g * 128 + e] * wba[(size_t)(g * 128 + e) * D + n];
                WaT[(size_t)n * 512 + kk] = f2bf(acc);
            }
        }
        conv_bf16(p.peer_keys + (size_t)l * 8 * 2 * 128 * 128, (bf16_t*)(wl + W_KEYS), (size_t)8 * 2 * 128 * 128 / 8);
        unsigned char* tl = ws + WS_TAB + l * TAB_LAYER;
        conv_bf16(p.peer_u + (size_t)l * NEXP * D, (bf16_t*)tl, (size_t)NEXP * D / 8);
        conv_bf16(p.peer_v + (size_t)l * NEXP * D, (bf16_t*)(tl + (size_t)NEXP * D * 2), (size_t)NEXP * D / 8);
    }
    {
        float* sv = smem; float* part = smem + 5 * 1024; float* mod = (float*)(ws + WS_MOD);
        const int tid = TID, lane = tid & 63, wid = tid >> 6;
        for (int vb = BID; vb < 2 * 96; vb += NBLK) {
            const int l = vb / 96, j0 = (vb % 96) * 64;
            for (int i = tid; i < 5 * 1024; i += NTHREADS) { const int r = i >> 10, k = i & 1023; const float v = r < 4 ? p.c[r * 1024 + k] : p.c_ctx[k]; sv[i] = v / (1.f + __expf(-v)); }
            __syncthreads();
            float a0 = 0.f, a1 = 0.f, a2 = 0.f, a3 = 0.f, a4 = 0.f;
            const float* w = p.ada_w + ((size_t)l * 1024 + wid * 128) * 6144 + j0 + lane;
            for (int k = 0; k < 128; ++k) { const float xw = w[(size_t)k * 6144]; const int kk = wid * 128 + k;
                a0 += sv[kk] * xw; a1 += sv[1024 + kk] * xw; a2 += sv[2048 + kk] * xw; a3 += sv[3072 + kk] * xw; a4 += sv[4096 + kk] * xw; }
            part[(wid * 5 + 0) * 64 + lane] = a0; part[(wid * 5 + 1) * 64 + lane] = a1; part[(wid * 5 + 2) * 64 + lane] = a2; part[(wid * 5 + 3) * 64 + lane] = a3; part[(wid * 5 + 4) * 64 + lane] = a4;
            __syncthreads();
            if (tid < 320) { const int r = tid >> 6; float s = 0.f;
#pragma unroll
                for (int w8 = 0; w8 < 8; ++w8) s += part[(w8 * 5 + r) * 64 + lane];
                mod[((size_t)l * 5 + r) * 6144 + j0 + lane] = s + p.ada_b[l * 6144 + j0 + lane]; }
            __syncthreads();
        }
    }
    {
        float* tab = (float*)(ws + WS_ROPE);
        for (int i = BID * NTHREADS + TID; i < 1024; i += NBLK * NTHREADS) { const int pos = i / 16, fi = i % 16; const float inv = powf(10000.0f, -(float)fi / 16.0f), ang = (float)pos * inv; tab[i] = cosf(ang); tab[1024 + i] = sinf(ang); }
    }
    copy_f4(p.x, p.out, (size_t)T_LAT * D / 4);
    copy_f4(p.ctx, (float*)(ws + WS_XC), (size_t)T_CTX * D / 4);
}

__device__ __forceinline__ float wave_sum(float v) {
#pragma unroll
    for (int o = 32; o > 0; o >>= 1) v += __shfl_xor(v, o);
    return v;
}
__device__ __forceinline__ void ph_norm_mod(const float* __restrict__ Xl, const float* __restrict__ Xc, const float* __restrict__ g, const float* __restrict__ modl, int shift_idx, int scale_idx, bf16_t* __restrict__ H, int nrows) {
    const int lane = TID & 63, gw = BID * 8 + (TID >> 6);
    for (int row = gw; row < nrows; row += NBLK * 8) {
        const float* src = row < T_LAT ? Xl + (size_t)row * D : Xc + (size_t)(row - T_LAT) * D;
        const int mrow = row < T_LAT ? row / S : 4;
        float4 v[4]; float ss = 0.f;
#pragma unroll
        for (int i = 0; i < 4; ++i) { v[i] = ((const float4*)src)[i * 64 + lane]; ss += v[i].x * v[i].x + v[i].y * v[i].y + v[i].z * v[i].z + v[i].w * v[i].w; }
        ss = wave_sum(ss);
        const float rstd = rsqrtf(ss * (1.0f / D) + EPS);
        const float* sh = modl + (size_t)mrow * 6144 + shift_idx * 1024; const float* sc = modl + (size_t)mrow * 6144 + scale_idx * 1024;
#pragma unroll
        for (int i = 0; i < 4; ++i) { const int k = (i * 64 + lane) * 4;
            const float4 gg = *(const float4*)(g + k), s4 = *(const float4*)(sc + k), h4 = *(const float4*)(sh + k);
            uint2 w; w.x = pk2(v[i].x * rstd * gg.x * (1.f + s4.x) + h4.x, v[i].y * rstd * gg.y * (1.f + s4.y) + h4.y);
            w.y = pk2(v[i].z * rstd * gg.z * (1.f + s4.z) + h4.z, v[i].w * rstd * gg.w * (1.f + s4.w) + h4.w);
            *(uint2*)(H + (size_t)row * D + k) = w; }
    }
}
__device__ __forceinline__ void ph_final_norm(float* __restrict__ X, const float* __restrict__ g) {
    const int lane = TID & 63, gw = BID * 8 + (TID >> 6);
    for (int row = gw; row < T_LAT; row += NBLK * 8) {
        float4* src = (float4*)(X + (size_t)row * D);
        float4 v[4]; float ss = 0.f;
#pragma unroll
        for (int i = 0; i < 4; ++i) { v[i] = src[i * 64 + lane]; ss += v[i].x * v[i].x + v[i].y * v[i].y + v[i].z * v[i].z + v[i].w * v[i].w; }
        ss = wave_sum(ss);
        const float rstd = rsqrtf(ss * (1.0f / D) + EPS);
#pragma unroll
        for (int i = 0; i < 4; ++i) { const float4 gg = ((const float4*)g)[i * 64 + lane]; float4 o = v[i]; o.x *= rstd * gg.x; o.y *= rstd * gg.y; o.z *= rstd * gg.z; o.w *= rstd * gg.w; src[i * 64 + lane] = o; }
    }
}

__device__ __forceinline__ void ph_postz(bf16_t* __restrict__ Z, const float* __restrict__ tab, bf16_t* __restrict__ vtn, bf16_t* __restrict__ vtnc, bf16_t* __restrict__ vtw, bf16_t* __restrict__ vtwc, bf16_t* __restrict__ Pa, int rows) {
    const size_t gtid = (size_t)BID * NTHREADS + TID, gsz = (size_t)NBLK * NTHREADS;
    for (size_t idx = gtid; idx < (size_t)T_LAT * 320; idx += gsz) {
        const int i = (int)(idx & 15), hh = (int)((idx >> 4) & 1), hs = (int)((idx >> 5) % 10), row = (int)(idx / 320);
        const int s = row % S, pos = hh ? (s % GW) : (s / GW);
        const int colbase = (hs < 2 ? OFF_KW + hs * 64 : OFF_QW + (hs - 2) * 64) + hh * 32 + i;
        bf16_t* pz = Z + (size_t)row * IN_COLS + colbase;
        const float x1 = bf2f(pz[0]), x2 = bf2f(pz[16]);
        const float cs = tab[pos * 16 + i], sn = tab[1024 + pos * 16 + i];
        pz[0] = f2bf(x1 * cs - x2 * sn); pz[16] = f2bf(x1 * sn + x2 * cs);
    }
    for (size_t idx = gtid; idx < (size_t)rows * 384; idx += gsz) {
        const int c8 = (int)(idx % 384); const size_t row = idx / 384;
        uint4* pz = (uint4*)(Z + row * IN_COLS + OFF_G + c8 * 8);
        uint4 v = *pz; unsigned w[4] = {v.x, v.y, v.z, v.w};
#pragma unroll
        for (int j = 0; j < 4; ++j) w[j] = pk2(1.f / (1.f + __expf(-lo16(w[j]))), 1.f / (1.f + __expf(-hi16(w[j]))));
        v.x = w[0]; v.y = w[1]; v.z = w[2]; v.w = w[3]; *pz = v;
    }
    for (size_t idx = gtid; idx < (size_t)T_ALL * 640; idx += gsz) {
        const int row = (int)(idx % T_ALL), j = (int)(idx / T_ALL);
        const bool lat = row < T_LAT; const int b = lat ? row / S : (row - T_LAT) / L, t = lat ? row % S : (row - T_LAT) % L, len = lat ? S : L;
        if (j < 512) { const bf16_t v = Z[(size_t)row * IN_COLS + OFF_VN + j]; bf16_t* dst = lat ? vtn : vtnc; dst[((size_t)(b * 8 + j / 64) * 64 + (j % 64)) * len + t] = v; }
        else { const int jj = j - 512; const bf16_t v = Z[(size_t)row * IN_COLS + OFF_VW + jj]; bf16_t* dst = lat ? vtw : vtwc; dst[((size_t)(b * 2 + jj / 64) * 64 + (jj % 64)) * len + t] = v; }
    }
    for (size_t idx = gtid; idx < (size_t)rows * 512; idx += gsz) {
        const int c = (int)(idx % 512), row = (int)(idx / 512);
        const int g = c / 128, w = 2 << g;
        const bool lat = row < T_LAT; const int len = lat ? S : L; const int t = lat ? row % S : (row - T_LAT) % L; const int base = row - t;
        int lo = t - w / 2; if (lo < 0) lo = 0; int hi = t - w / 2 + w; if (hi > len) hi = len;
        float sum = 0.f;
        for (int tt = lo; tt < hi; ++tt) sum += bf2f(Z[(size_t)(base + tt) * IN_COLS + OFF_A + c]);
        Pa[(size_t)row * 512 + c] = f2bf(sum / (float)(hi - lo) - bf2f(Z[(size_t)row * IN_COLS + OFF_A + c]));
    }
}

struct AttnState { float q[64]; float o[64]; float m, l; };
__device__ __forceinline__ void attn_init(AttnState& st, const bf16_t* qp) {
#pragma unroll
    for (int d = 0; d < 64; ++d) { st.q[d] = bf2f(qp[d]) * 0.125f; st.o[d] = 0.f; }
    st.m = -1e30f; st.l = 0.f;
}
__device__ __forceinline__ void attn_key(AttnState& st, const bf16_t* kp, float bias, const bf16_t* vtp, size_t vstride) {
    float s = bias;
#pragma unroll
    for (int d8 = 0; d8 < 8; ++d8) {
        const uint4 kv = *(const uint4*)(kp + d8 * 8);
        const unsigned w[4] = {kv.x, kv.y, kv.z, kv.w};
#pragma unroll
        for (int j = 0; j < 4; ++j) { s += st.q[d8 * 8 + 2 * j] * lo16(w[j]); s += st.q[d8 * 8 + 2 * j + 1] * hi16(w[j]); }
    }
    const float mn = fmaxf(st.m, s), alpha = __expf(st.m - mn), pr = __expf(s - mn);
    st.l = st.l * alpha + pr; st.m = mn;
#pragma unroll
    for (int d = 0; d < 64; ++d) st.o[d] = st.o[d] * alpha + pr * bf2f(vtp[(size_t)d * vstride]);
}
__device__ __forceinline__ void attn_sink(AttnState& st, float s) {
    const float mn = fmaxf(st.m, s), alpha = __expf(st.m - mn), pr = __expf(s - mn);
    st.l = st.l * alpha + pr; st.m = mn;
#pragma unroll
    for (int d = 0; d < 64; ++d) st.o[d] *= alpha;
}
__device__ __forceinline__ void attn_store(const AttnState& st, bf16_t* op) {
    const float inv = 1.f / st.l;
#pragma unroll
    for (int d = 0; d < 64; ++d) op[d] = f2bf(st.o[d] * inv);
}
__device__ __forceinline__ void ph_attn_naive(const bf16_t* __restrict__ Z, const bf16_t* __restrict__ vtn, const bf16_t* __restrict__ vtnc, const bf16_t* __restrict__ vtw, const bf16_t* __restrict__ vtwc,
                                              const float* __restrict__ rpb, const float* __restrict__ sink, bf16_t* __restrict__ Ob, bf16_t* __restrict__ Oc, bool do_ctx) {
    const int gtid = BID * NTHREADS + TID, gsz = NBLK * NTHREADS;
    for (int idx = gtid; idx < T_LAT * 8; idx += gsz) {
        const int t = idx % T_LAT, h = idx / T_LAT;
        const int b = t / S, s = t % S, r = s / GW, qc = s % GW;
        int R0 = r - 4; R0 = R0 < 0 ? 0 : (R0 > 56 ? 56 : R0);
        int qs = qc - 8; qs = qs < 0 ? 0 : (qs > 48 ? 48 : qs);
        AttnState st; attn_init(st, Z + (size_t)t * IN_COLS + OFF_QN + h * 64);
        const bf16_t* vt = vtn + (size_t)(b * 8 + h) * 64 * S;
        for (int i = 0; i < 8; ++i) for (int j = 0; j < 16; ++j) {
            const int kr = R0 + i, kc = qs + j, ks = kr * GW + kc;
            int dc = kc - qc + 15; dc = dc < 0 ? 0 : (dc > 30 ? 30 : dc);
            const float bias = rpb[(h * 15 + (kr - r + 7)) * 31 + dc];
            attn_key(st, Z + (size_t)(b * S + ks) * IN_COLS + OFF_KN + h * 64, bias, vt + ks, S);
        }
        const bf16_t* vtc = vtnc + (size_t)(b * 8 + h) * 64 * L;
        for (int m = 0; m < L; ++m) attn_key(st, Z + (size_t)(T_LAT + b * L + m) * IN_COLS + OFF_KN + h * 64, 0.f, vtc + m, L);
        attn_store(st, Ob + (size_t)t * 512 + h * 64);
    }
    for (int idx = gtid; idx < T_LAT * 8; idx += gsz) {
        const int t = idx % T_LAT, hq = idx / T_LAT, g = hq / 4;
        const int b = t / S, s = t % S;
        AttnState st; attn_init(st, Z + (size_t)t * IN_COLS + OFF_QW + hq * 64);
        const bf16_t* vt = vtw + (size_t)(b * 2 + g) * 64 * S;
        const int lo = s - 128 < 0 ? 0 : s - 128, hi = s + 128 > S - 1 ? S - 1 : s + 128;
        for (int ks = lo; ks <= hi; ++ks) attn_key(st, Z + (size_t)(b * S + ks) * IN_COLS + OFF_KW + g * 64, 0.f, vt + ks, S);
        const bf16_t* vtc = vtwc + (size_t)(b * 2 + g) * 64 * L;
        for (int m = 0; m < L; ++m) attn_key(st, Z + (size_t)(T_LAT + b * L + m) * IN_COLS + OFF_KW + g * 64, 0.f, vtc + m, L);
        attn_sink(st, sink[hq]);
        attn_store(st, Oc + (size_t)t * 512 + hq * 64);
    }
    if (do_ctx) for (int idx = gtid; idx < T_CTX * 16; idx += gsz) {
        const int rr = idx % T_CTX, h = (idx / T_CTX) % 8, which = idx / (T_CTX * 8);
        const int b = rr / L, row = T_LAT + rr;
        AttnState st;
        if (which == 0) {
            attn_init(st, Z + (size_t)row * IN_COLS + OFF_QN + h * 64);
            const bf16_t* vtc = vtnc + (size_t)(b * 8 + h) * 64 * L;
            for (int m = 0; m < L; ++m) attn_key(st, Z + (size_t)(T_LAT + b * L + m) * IN_COLS + OFF_KN + h * 64, 0.f, vtc + m, L);
            attn_store(st, Ob + (size_t)row * 512 + h * 64);
        } else {
            const int g = h / 4;
            attn_init(st, Z + (size_t)row * IN_COLS + OFF_QW + h * 64);
            const bf16_t* vtc = vtwc + (size_t)(b * 2 + g) * 64 * L;
            for (int m = 0; m < L; ++m) attn_key(st, Z + (size_t)(T_LAT + b * L + m) * IN_COLS + OFF_KW + g * 64, 0.f, vtc + m, L);
            attn_sink(st, sink[h]);
            attn_store(st, Oc + (size_t)row * 512 + h * 64);
        }
    }
}

__device__ __forceinline__ void wave_argmax(float& v, int& i) {
#pragma unroll
    for (int o = 32; o > 0; o >>= 1) { const float v2 = __shfl_xor(v, o); const int i2 = __shfl_xor(i, o); if (v2 > v || (v2 == v && i2 < i)) { v = v2; i = i2; } }
}
__device__ __forceinline__ void ph_peer_topk(const bf16_t* __restrict__ Q, const bf16_t* __restrict__ keys, int* __restrict__ eidx, float* __restrict__ egate, int rows, float* smem) {
    const int half = TID >> 8, tid = TID & 255, lane = tid & 63, wid = tid >> 6;
    float* qs = smem + half * 4608;
    float* sc = qs + 2048;
    float* tops = sc + 2048;
    int* topi = (int*)(tops + 256);
    for (int vb = BID; vb < rows / 2; vb += NBLK) {
        const int t = vb * 2 + half;
        for (int i = tid; i < 2048; i += 256) qs[i] = bf2f(Q[(size_t)t * 2048 + i]);
        __syncthreads();
        for (int o = tid; o < 2048; o += 256) {
            const int hp = o >> 7; const bf16_t* kp = keys + (size_t)o * 128; const float* qp = qs + hp * 128;
            float a = 0.f;
            for (int c8 = 0; c8 < 16; ++c8) { const uint4 kv = *(const uint4*)(kp + c8 * 8); const unsigned w[4] = {kv.x, kv.y, kv.z, kv.w};
#pragma unroll
                for (int j = 0; j < 4; ++j) { a += qp[c8 * 8 + 2 * j] * lo16(w[j]); a += qp[c8 * 8 + 2 * j + 1] * hi16(w[j]); } }
            sc[o] = a;
        }
        __syncthreads();
        for (int li = wid; li < 16; li += 4) {
            float v0 = sc[li * 128 + lane], v1 = sc[li * 128 + lane + 64];
            for (int r = 0; r < 16; ++r) {
                float v = v0; int i = lane; if (v1 > v0) { v = v1; i = lane + 64; }
                wave_argmax(v, i);
                if (lane == 0) { tops[li * 16 + r] = v; topi[li * 16 + r] = i; }
                if (i == lane) v0 = -3e38f; if (i == lane + 64) v1 = -3e38f;
            }
        }
        __syncthreads();
        for (int h = wid; h < 8; h += 4) {
            float cv[4];
#pragma unroll
            for (int q = 0; q < 4; ++q) { const int c = lane + 64 * q; cv[q] = tops[(2 * h) * 16 + (c >> 4)] + tops[(2 * h + 1) * 16 + (c & 15)]; }
            float bs = 0.f; int be = 0; float mx = 0.f;
            for (int r = 0; r < 16; ++r) {
                float v = cv[0]; int i = lane;
#pragma unroll
                for (int q = 1; q < 4; ++q) if (cv[q] > v) { v = cv[q]; i = lane + 64 * q; }
                wave_argmax(v, i);
                if (r == 0) mx = v;
                if (lane == r) { bs = v; be = topi[(2 * h) * 16 + (i >> 4)] * 128 + topi[(2 * h + 1) * 16 + (i & 15)]; }
#pragma unroll
                for (int q = 0; q < 4; ++q) if (i == lane + 64 * q) cv[q] = -3e38f;
            }
            const float e = lane < 16 ? __expf(bs - mx) : 0.f; const float sum = wave_sum(e);
            if (lane < 16) { eidx[(size_t)t * 128 + h * 16 + lane] = be; egate[(size_t)t * 128 + h * 16 + lane] = e / sum; }
        }
        __syncthreads();
    }
}
__device__ __forceinline__ void ph_peer_gather(const bf16_t* __restrict__ H, const bf16_t* __restrict__ U, const bf16_t* __restrict__ V, const int* __restrict__ eidx, const float* __restrict__ egate,
                                               const float* __restrict__ modl, float* __restrict__ Xl, float* __restrict__ Xc, int rows, float* smem) {
    const int half = TID >> 8, tid = TID & 255, lane = tid & 63, wid = tid >> 6;
    float* wgt = smem + half * 256; int* eid = (int*)(wgt + 128);
    for (int vb = BID; vb < rows / 2; vb += NBLK) {
        const int t = vb * 2 + half;
        if (tid < 128) eid[tid] = eidx[(size_t)t * 128 + tid];
        float hx[16];
        { const uint4 a = *(const uint4*)(H + (size_t)t * D + lane * 16), b = *(const uint4*)(H + (size_t)t * D + lane * 16 + 8);
          const unsigned w[8] = {a.x, a.y, a.z, a.w, b.x, b.y, b.z, b.w};
#pragma unroll
          for (int j = 0; j < 8; ++j) { hx[2 * j] = lo16(w[j]); hx[2 * j + 1] = hi16(w[j]); } }
        __syncthreads();
        for (int e = wid; e < 128; e += 4) {
            const bf16_t* up = U + (size_t)eid[e] * D + lane * 16;
            const uint4 a = *(const uint4*)up, b = *(const uint4*)(up + 8);
            const unsigned w[8] = {a.x, a.y, a.z, a.w, b.x, b.y, b.z, b.w};
            float acc = 0.f;
#pragma unroll
            for (int j = 0; j < 8; ++j) { acc += hx[2 * j] * lo16(w[j]); acc += hx[2 * j + 1] * hi16(w[j]); }
            acc = wave_sum(acc);
            if (lane == 0) wgt[e] = egate[(size_t)t * 128 + e] * 0.5f * acc * (1.f + erff(acc * 0.70710678118654752f));
        }
        __syncthreads();
        float o[4] = {0.f, 0.f, 0.f, 0.f};
        for (int e = 0; e < 128; ++e) {
            const uint2 vv = *(const uint2*)(V + (size_t)eid[e] * D + tid * 4); const float w = wgt[e];
            o[0] += w * lo16(vv.x); o[1] += w * hi16(vv.x); o[2] += w * lo16(vv.y); o[3] += w * hi16(vv.y);
        }
        const int mrow = t < T_LAT ? t / S : 4;
        float* xp = t < T_LAT ? Xl + (size_t)t * D + tid * 4 : Xc + (size_t)(t - T_LAT) * D + tid * 4;
        const float* gt = modl + (size_t)mrow * 6144 + 5 * 1024 + tid * 4;
        float4 x = *(float4*)xp; x.x += gt[0] * o[0]; x.y += gt[1] * o[1]; x.z += gt[2] * o[2]; x.w += gt[3] * o[3]; *(float4*)xp = x;
        __syncthreads();
    }
}

__device__ __forceinline__ unsigned char* launder(unsigned char* q) { asm volatile("" : "+s"(q)); return q; }
struct WsPtrs { float *mod, *rope, *XC, *X; bf16_t *H, *Z, *vtn, *vtnc, *vtw, *vtwc, *AT; int* eidx; float* egate; unsigned char* wl; const float* modl; const bf16_t *U, *V; };
__device__ __forceinline__ WsPtrs mkptrs(const Params& p, int l) {
    unsigned char* ws = launder(p.ws); WsPtrs P;
    P.mod = (float*)(ws + WS_MOD); P.rope = (float*)(ws + WS_ROPE); P.XC = (float*)(ws + WS_XC); P.X = (float*)launder((unsigned char*)p.out);
    P.H = (bf16_t*)(ws + WS_H); P.Z = (bf16_t*)(ws + WS_Z); P.vtn = (bf16_t*)(ws + WS_VTN); P.vtnc = (bf16_t*)(ws + WS_VTNC); P.vtw = (bf16_t*)(ws + WS_VTW); P.vtwc = (bf16_t*)(ws + WS_VTWC);
    P.AT = (bf16_t*)(ws + WS_AT); P.eidx = (int*)(ws + WS_EIDX); P.egate = (float*)(ws + WS_EGATE);
    P.wl = ws + WS_W + l * W_LAYER; P.modl = P.mod + (size_t)l * 5 * 6144; P.U = (const bf16_t*)(ws + WS_TAB + l * TAB_LAYER); P.V = P.U + (size_t)NEXP * D;
    return P;
}
__global__ void __launch_bounds__(NTHREADS, 2) mega_fwd(Params p) {
    extern __shared__ __attribute__((aligned(16))) unsigned char lds[];
    cg::grid_group grid = cg::this_grid();
    PG8_LAS unsigned char* ldsr = (PG8_LAS unsigned char*)lds;
    float* smem = (float*)lds;

    ph_prep(p, smem);
    grid.sync();
#pragma unroll 1
    for (int l = 0; l < 2; ++l) {
        const bool last = (l == 1);
        const int rows = last ? T_LAT : T_ALL;
        { const WsPtrs P = mkptrs(p, l); ph_norm_mod(P.X, P.XC, p.norm1_g + l * D, P.modl, 0, 1, P.H, T_ALL); }
        grid.sync();
        {
            const WsPtrs P = mkptrs(p, l);
            pg8::EpiStoreBf16 E{P.Z, IN_COLS, 0};
            if (!last) { pg8::Gemm g{P.H, (const bf16_t*)(P.wl + W_WIN), T_ALL, IN_COLS, D}; pg8::StaticOrder So; So.init(T_ALL, IN_COLS, NBLK, BID);
                pg8::gemm_phase<pg8::EpiStoreBf16, pg8::StaticOrder, true, true>(ldsr, g, So, E); }
            else { pg8::Gemm g{P.H, (const bf16_t*)(P.wl + W_WIN), T_LAT, IN_COLS, D}; pg8::StaticOrder So; So.init(T_LAT, IN_COLS, NBLK, BID);
                pg8::gemm_phase<pg8::EpiStoreBf16, pg8::StaticOrder, true, true>(ldsr, g, So, E);
                const WsPtrs P2 = mkptrs(p, l);
                pg8::EpiStoreBf16 E2{P2.Z + (size_t)T_LAT * IN_COLS, IN_COLS, 0};
                pg8::Gemm g2{P2.H + (size_t)T_LAT * D, (const bf16_t*)(P2.wl + W_WIN), T_CTX, CTX_KV_COLS, D}; pg8::StaticOrder S2; S2.init(T_CTX, CTX_KV_COLS, NBLK, BID);
                pg8::gemm_phase<pg8::EpiStoreBf16, pg8::StaticOrder, true, true>(ldsr, g2, S2, E2); }
        }
        grid.sync();
        { const WsPtrs P = mkptrs(p, l); ph_postz(P.Z, P.rope, P.vtn, P.vtnc, P.vtw, P.vtwc, P.AT, rows); }
        grid.sync();
        { const WsPtrs P = mkptrs(p, l); ph_attn_naive(P.Z, P.vtn, P.vtnc, P.vtw, P.vtwc, p.na_rpb + (size_t)l * 8 * 15 * 31, p.swa_sink + l * 8, P.AT + (size_t)T_ALL * 512, P.AT + (size_t)2 * T_ALL * 512, !last); }
        grid.sync();
        {
            const WsPtrs P = mkptrs(p, l);
            pg8::Gemm g{P.AT, (const bf16_t*)(P.wl + W_WA), 3 * T_ALL, 3 * D, 512}; pg8::MergeOrder Mo{(rows / 256) * 4, NBLK, BID, 0}; pg8::EpiMergeSeg E{P.Z, P.H};
            pg8::gemm_phase<pg8::EpiMergeSeg, pg8::MergeOrder, false, true>(ldsr, g, Mo, E);
        }
        grid.sync();
        {
            const WsPtrs P = mkptrs(p, l);
            pg8::Gemm g{P.H, (const bf16_t*)(P.wl + W_WO), rows, D, D}; pg8::StaticOrder So; So.init(rows, D, NBLK, BID); pg8::EpiResid E{P.X, P.XC, P.modl, 2, 0};
            pg8::gemm_phase<pg8::EpiResid, pg8::StaticOrder, true, true>(ldsr, g, So, E);
        }
        grid.sync();
        { const WsPtrs P = mkptrs(p, l); ph_norm_mod(P.X, P.XC, p.norm2_g + l * D, P.modl, 3, 4, P.H, rows); }
        grid.sync();
        {   const WsPtrs P = mkptrs(p, l);
            pg8::Gemm g{P.H, (const bf16_t*)(P.wl + W_WQ), rows, 2048, D}; pg8::StaticOrder So; So.init(rows, 2048, NBLK, BID); pg8::EpiStoreBf16 E{P.Z, 2048, 0};
            pg8::gemm_phase<pg8::EpiStoreBf16, pg8::StaticOrder, true, true>(ldsr, g, So, E);
        }
        grid.sync();
        { const WsPtrs P = mkptrs(p, l); ph_peer_topk(P.Z, (const bf16_t*)(P.wl + W_KEYS), P.eidx, P.egate, rows, smem); }
        grid.sync();
        { const WsPtrs P = mkptrs(p, l); ph_peer_gather(P.H, P.U, P.V, P.eidx, P.egate, P.modl, P.X, P.XC, rows, smem); }
        grid.sync();
    }
    { float* X = (float*)launder((unsigned char*)p.out); ph_final_norm(X, p.final_g); }
}

extern "C" void kernel_launch(void* const* d_in, const int* in_sizes, int n_in, void* d_out, int out_size, void* d_ws, size_t ws_size, hipStream_t stream) {
    static int grid_blocks = 0;
    if (grid_blocks == 0) {
        if (ws_size < WS_END || n_in != 22) { fprintf(stderr, "kernel_launch: workspace %zu < %zu or n_in %d != 22\n", ws_size, (size_t)WS_END, n_in); grid_blocks = -1; return; }
        int dev = 0, cus = 0, per_cu = 0;
        (void)hipGetDevice(&dev); (void)hipDeviceGetAttribute(&cus, hipDeviceAttributeMultiprocessorCount, dev);
        if (hipFuncSetAttribute((const void*)mega_fwd, hipFuncAttributeMaxDynamicSharedMemorySize, LDS_BYTES) != hipSuccess) { fprintf(stderr, "kernel_launch: hipFuncSetAttribute failed\n"); grid_blocks = -1; return; }
        if (hipOccupancyMaxActiveBlocksPerMultiprocessor(&per_cu, (const void*)mega_fwd, NTHREADS, LDS_BYTES) != hipSuccess || per_cu < 1) { fprintf(stderr, "kernel_launch: occupancy query says %d\n", per_cu); per_cu = 1; }
        (void)hipGetLastError();
        grid_blocks = cus * 1;
        fprintf(stderr, "kernel_launch: %d CUs, occupancy query %d per CU, grid %d\n", cus, per_cu, grid_blocks);
    }
    if (grid_blocks < 0) return;
    Params p{};
    p.x = (const float*)d_in[0]; p.c = (const float*)d_in[1]; p.ctx = (const float*)d_in[2]; p.c_ctx = (const float*)d_in[3]; p.ada_w = (const float*)d_in[4]; p.ada_b = (const float*)d_in[5];
    p.norm1_g = (const float*)d_in[6]; p.norm2_g = (const float*)d_in[7]; p.w_in = (const float*)d_in[8]; p.pool_w = (const float*)d_in[9]; p.pool_scale = (const float*)d_in[10]; p.na_rpb = (const float*)d_in[11];
    p.swa_sink = (const float*)d_in[12]; p.wba = (const float*)d_in[13]; p.wbb = (const float*)d_in[14]; p.wbc = (const float*)d_in[15]; p.w_out = (const float*)d_in[16]; p.peer_wq = (const float*)d_in[17];
    p.peer_keys = (const float*)d_in[18]; p.peer_u = (const float*)d_in[19]; p.peer_v = (const float*)d_in[20]; p.final_g = (const float*)d_in[21];
    p.out = (float*)d_out; p.ws = (unsigned char*)d_ws;
    void* args[] = {&p};
    const hipError_t e = hipLaunchCooperativeKernel((const void*)mega_fwd, dim3(grid_blocks), dim3(NTHREADS), args, LDS_BYTES, stream);
    if (e != hipSuccess) fprintf(stderr, "kernel_launch: cooperative launch failed: %s (grid %d)\n", hipGetErrorString(e), grid_blocks);
}
```

```cpp
#include <hip/hip_runtime.h>
#include <hip/hip_cooperative_groups.h>
#include <stdint.h>
#include <stdio.h>
namespace cg = cooperative_groups;

typedef unsigned short bf16_t;

constexpr int D = 1024, NB = 4, S = 4096, L = 256, GW = 64;
constexpr int T_LAT = NB * S, T_CTX = NB * L, T_ALL = T_LAT + T_CTX;
constexpr int IN_COLS = 5888;
constexpr int OFF_KN = 0, OFF_VN = 512, OFF_KW = 1024, OFF_VW = 1152, CTX_KV_COLS = 1280, OFF_QN = 1280, OFF_QW = 1792, OFF_A = 2304, OFF_G = 2816;
constexpr int NEXP = 16384;
constexpr float EPS = 1e-6f;
constexpr int NTHREADS = 512;
constexpr int LDS_BYTES = 147456;

constexpr size_t al256(size_t x) { return (x + 255) & ~(size_t)255; }
constexpr size_t WS_MOD = 0;
constexpr size_t WS_ROPE = al256(WS_MOD + 2 * 5 * 6144 * 4);
constexpr size_t WS_XC = al256(WS_ROPE + 2 * 64 * 16 * 4);
constexpr size_t WS_H = al256(WS_XC + (size_t)T_CTX * D * 4);
constexpr size_t WS_Z = al256(WS_H + (size_t)T_ALL * D * 2);
constexpr size_t WS_VTN = al256(WS_Z + (size_t)T_ALL * IN_COLS * 2);
constexpr size_t WS_VTNC = al256(WS_VTN + (size_t)NB * 8 * 64 * S * 2);
constexpr size_t WS_VTW = al256(WS_VTNC + (size_t)NB * 8 * 64 * L * 2);
constexpr size_t WS_VTWC = al256(WS_VTW + (size_t)NB * 2 * 64 * S * 2);
constexpr size_t WS_AT = al256(WS_VTWC + (size_t)NB * 2 * 64 * L * 2);
constexpr size_t WS_EIDX = al256(WS_AT + (size_t)3 * T_ALL * 512 * 2);
constexpr size_t WS_EGATE = al256(WS_EIDX + (size_t)T_ALL * 128 * 4);
constexpr size_t WS_W = al256(WS_EGATE + (size_t)T_ALL * 128 * 4);
constexpr size_t W_WIN = 0;
constexpr size_t W_WA = W_WIN + (size_t)IN_COLS * D * 2;
constexpr size_t W_WB = W_WA + (size_t)D * 512 * 2;
constexpr size_t W_WC = W_WB + (size_t)D * 512 * 2;
constexpr size_t W_WO = W_WC + (size_t)D * 512 * 2;
constexpr size_t W_WQ = W_WO + (size_t)D * D * 2;
constexpr size_t W_KEYS = W_WQ + (size_t)2048 * D * 2;
constexpr size_t W_LAYER = al256(W_KEYS + (size_t)8 * 2 * 128 * 128 * 2);
constexpr size_t WS_TAB = al256(WS_W + 2 * W_LAYER);
constexpr size_t TAB_LAYER = (size_t)2 * NEXP * D * 2;
constexpr size_t WS_END = WS_TAB + 2 * TAB_LAYER;

__device__ __forceinline__ float bf2f(bf16_t v) { return __uint_as_float((unsigned)v << 16); }
__device__ __forceinline__ bf16_t f2bf(float f) { unsigned u = __float_as_uint(f); u += 0x7fffu + ((u >> 16) & 1u); return (bf16_t)(u >> 16); }
__device__ __forceinline__ unsigned pk2(float lo, float hi) { return (unsigned)f2bf(lo) | ((unsigned)f2bf(hi) << 16); }
__device__ __forceinline__ float lo16(unsigned w) { return __uint_as_float(w << 16); }
__device__ __forceinline__ float hi16(unsigned w) { return __uint_as_float(w & 0xffff0000u); }

__device__ __forceinline__ int opaque_tid() { int t = threadIdx.x; asm volatile("" : "+v"(t)); return t; }
namespace pg8 {
#define PG8_LAS __attribute__((address_space(3)))
typedef unsigned short bf16_t;
typedef short bf16x8 __attribute__((ext_vector_type(8)));
typedef float f32x4 __attribute__((ext_vector_type(4)));
typedef unsigned u32x4 __attribute__((ext_vector_type(4)));
constexpr int BM = 256, BK = 64, HALF = 128, HTB = HALF * BK * 2  , STAGE_BYTES = 8 * HTB, NXCD = 8, WGM = 8;

__host__ __device__ __forceinline__ int lds_byte(int r, int c) { const int st = (r >> 4) * 2 + (c >> 5), rr = r & 15, cc = c & 31, ob = rr * 64 + cc * 2; return st * 1024 + (ob ^ (((ob >> 9) & 1) << 5)); }
__host__ __device__ __forceinline__ void stage_rc(int b, int& R, int& C) { const int st = b / 1024, sb = b % 1024, swz = sb ^ (((sb >> 9) & 1) << 5); R = (st >> 1) * 16 + swz / 64; C = (st & 1) * 32 + (swz % 64) / 2; }
__host__ __device__ __forceinline__ int perm32(int rho) { const int n = rho >> 4, i = rho & 15; return 8 * (i >> 2) + 4 * n + (i & 3); }

struct Unit { int pm, pn; };
struct Gemm { const bf16_t* A; const bf16_t* Bt; int M, N, K; };

struct StaticOrder {
    int nM, nN, nwg, G, c;
    __host__ __device__ void init(int M, int N, int G_, int c_) { nM = M / BM; nN = N / BM; nwg = nM * nN; G = G_; c = c_; }
    __host__ __device__ bool next(int i, Unit& u) const {
        const long L = (long)i * G + c; if (L >= nwg) return false;
        int wgid = (int)L; { const int q = nwg / NXCD, r = nwg % NXCD, xcd = wgid % NXCD, off = wgid / NXCD; wgid = (xcd < r ? xcd * (q + 1) : r * (q + 1) + (xcd - r) * q) + off; }
        const int nig = WGM * nN, gid = wgid / nig, fm = gid * WGM, gsz = (nM - fm) < WGM ? (nM - fm) : WGM;
        u.pm = fm + ((wgid % nig) % gsz); u.pn = (wgid % nig) / gsz; return true;
    }
    __device__ __forceinline__ void a_ready(const Unit&) const {}
    __device__ __forceinline__ void done(const Unit&) const {}
};
__device__ __forceinline__ unsigned cvt_pk_bf16(float lo, float hi) { unsigned r; asm volatile("v_cvt_pk_bf16_f32 %0, %1, %2" : "=v"(r) : "v"(lo), "v"(hi)); return r; }
typedef unsigned u32x4 __attribute__((ext_vector_type(4)));
struct EpiStoreBf16 {
    static constexpr bool PERM = true, AFTER_DRAIN = false;
    bf16_t* O; int ldc; int pad;
    __device__ __forceinline__ void operator()(const f32x4 (&acc)[2][2][4][2], const Unit& u, int wr, int wc, int fr, int fq) const {
        const int row0 = u.pm * BM + wr * 64 + fr, col0 = u.pn * BM + wc * 32 + 8 * fq;
#pragma unroll
        for (int ai = 0; ai < 2; ++ai)
#pragma unroll
            for (int m = 0; m < 4; ++m) { bf16_t* rowp = O + (size_t)(row0 + ai * HALF + m * 16) * ldc + col0;
#pragma unroll
                for (int bj = 0; bj < 2; ++bj) { const f32x4 v0 = acc[ai][bj][m][0], v1 = acc[ai][bj][m][1];
                    u32x4 w; w.x = cvt_pk_bf16(v0[0], v0[1]); w.y = cvt_pk_bf16(v0[2], v0[3]); w.z = cvt_pk_bf16(v1[0], v1[1]); w.w = cvt_pk_bf16(v1[2], v1[3]);
                    *(u32x4*)(rowp + bj * HALF) = w; } }
    }
};
constexpr int NTM_STACK = 68;
struct EpiMergeSeg {
    static constexpr bool PERM = true, AFTER_DRAIN = false;
    const bf16_t* Z; bf16_t* M;
    __device__ __forceinline__ void operator()(const f32x4 (&acc)[2][2][4][2], const Unit& u, int wr, int wc, int fr, int fq) const {
        const int seg = u.pn >> 2, tn = u.pn & 3, tm = u.pm - seg * NTM_STACK;
        const int row0 = tm * BM + wr * 64 + fr, col0 = tn * BM + wc * 32 + 8 * fq;
#pragma unroll
        for (int ai = 0; ai < 2; ++ai)
#pragma unroll
            for (int m = 0; m < 4; ++m) { const int row = row0 + ai * HALF + m * 16;
#pragma unroll
                for (int bj = 0; bj < 2; ++bj) { const int col = col0 + bj * HALF;
                    const u32x4 g = *(const u32x4*)(Z + (size_t)row * 5888 + 2816 + seg * 1024 + col);
                    bf16_t* mp = M + (size_t)row * 1024 + col;
                    u32x4 o = (u32x4){0u, 0u, 0u, 0u}; if (seg) o = *(const u32x4*)mp;
                    const f32x4 v0 = acc[ai][bj][m][0], v1 = acc[ai][bj][m][1];
                    u32x4 w;
                    w.x = cvt_pk_bf16(__uint_as_float(g.x << 16) * v0[0] + __uint_as_float(o.x << 16), __uint_as_float(g.x & 0xffff0000u) * v0[1] + __uint_as_float(o.x & 0xffff0000u));
                    w.y = cvt_pk_bf16(__uint_as_float(g.y << 16) * v0[2] + __uint_as_float(o.y << 16), __uint_as_float(g.y & 0xffff0000u) * v0[3] + __uint_as_float(o.y & 0xffff0000u));
                    w.z = cvt_pk_bf16(__uint_as_float(g.z << 16) * v1[0] + __uint_as_float(o.z << 16), __uint_as_float(g.z & 0xffff0000u) * v1[1] + __uint_as_float(o.z & 0xffff0000u));
                    w.w = cvt_pk_bf16(__uint_as_float(g.w << 16) * v1[2] + __uint_as_float(o.w << 16), __uint_as_float(g.w & 0xffff0000u) * v1[3] + __uint_as_float(o.w & 0xffff0000u));
                    *(u32x4*)mp = w; } }
    }
};
struct MergeOrder {
    int ntiles, G, c, pad;
    __device__ bool next(int i, Unit& u) const { const int ti = (i / 3) * G + c, seg = i % 3; if (ti >= ntiles) return false; u.pm = seg * NTM_STACK + (ti >> 2); u.pn = seg * 4 + (ti & 3); return true; }
    __device__ __forceinline__ void a_ready(const Unit&) const {}
    __device__ __forceinline__ void done(const Unit&) const {}
};
struct EpiResid {
    static constexpr bool PERM = false, AFTER_DRAIN = false;
    float* Xl; float* Xc; const float* modl; int gate_idx; int pad;
    __device__ __forceinline__ void operator()(const f32x4 (&acc)[2][2][4][2], const Unit& u, int wr, int wc, int fr, int fq) const {
        const int mrow = u.pm < 64 ? (u.pm >> 4) : 4;
        float* base = u.pm < 64 ? Xl + (size_t)u.pm * BM * 1024 : Xc + (size_t)(u.pm - 64) * BM * 1024;
        const float* gt = modl + (size_t)mrow * 6144 + gate_idx * 1024;
        const int col0 = u.pn * BM + wc * 32 + 4 * fq;
#pragma unroll
        for (int bj = 0; bj < 2; ++bj)
#pragma unroll
            for (int n = 0; n < 2; ++n) { const int col = col0 + bj * HALF + 16 * n; const f32x4 gv = *(const f32x4*)(gt + col);
#pragma unroll
                for (int ai = 0; ai < 2; ++ai)
#pragma unroll
                    for (int m = 0; m < 4; ++m) { float* xp = base + (size_t)(ai * HALF + wr * 64 + m * 16 + fr) * 1024 + col;
                        f32x4 x = *(f32x4*)xp; x = x + gv * acc[ai][bj][m][n]; *(f32x4*)xp = x; } }
    }
};
template <class Epi, class Sched, bool ALIGN_EPI = false, bool SP2 = false>
__device__ __forceinline__ void gemm_phase(PG8_LAS unsigned char* lds, const Gemm g, const Sched& S, const Epi& E) {
    const int tid = opaque_tid(), wid = __builtin_amdgcn_readfirstlane(tid >> 6), lane = tid & 63, wr = wid >> 2, wc = wid & 3, fr = lane & 15, fq = lane >> 4;
    const int K = g.K, nt = K / BK;
    unsigned voffA[2], voffB[2];
#pragma unroll
    for (int i = 0; i < 2; ++i) { int R, C; stage_rc(tid * 16 + i * 8192, R, C); const int Rb = Epi::PERM ? ((R & ~31) + perm32(R & 31)) : R;
        voffA[i] = (unsigned)(R * K + C) * 2u; voffB[i] = (unsigned)(Rb * K + C) * 2u; }
    const size_t kstep = (size_t)(BK * 2);
    const size_t hstep = (size_t)HALF * K * 2;
    const size_t tstep = 2 * hstep;
    const unsigned ldsw = (unsigned)wid * 1024u;
    const int aoff = lds_byte(wr * 64 + fr, fq * 8), boff = lds_byte(wc * 32 + fr, fq * 8);
#define PG8_SA(b, h) (((b) * 2 + (h)) * HTB)
#define PG8_SB(b, h) ((4 + (b) * 2 + (h)) * HTB)
#define PG8_STAGE(bufoff, gbase, voff) do { _Pragma("unroll") for (int _i = 0; _i < 2; ++_i) \
        __builtin_amdgcn_global_load_lds((const unsigned*)((const char*)(gbase) + (voff)[_i]), (PG8_LAS unsigned*)(lds + (bufoff) + ldsw + _i * 8192), 16, 0, 0); } while (0)
#define PG8_LDA(dst, b, h) do { _Pragma("unroll") for (int m = 0; m < 4; ++m) _Pragma("unroll") for (int k = 0; k < 2; ++k) dst[m][k] = *(const PG8_LAS bf16x8*)(lds + PG8_SA(b, h) + aoff + m * 2048 + k * 1024); } while (0)
#define PG8_LDB(dst, b, h) do { _Pragma("unroll") for (int n = 0; n < 2; ++n) _Pragma("unroll") for (int k = 0; k < 2; ++k) dst[n][k] = *(const PG8_LAS bf16x8*)(lds + PG8_SB(b, h) + boff + n * 2048 + k * 1024); } while (0)
#define PG8_MMA(ai, bj, At, Bt) do { __builtin_amdgcn_s_setprio(1); _Pragma("unroll") for (int m = 0; m < 4; ++m) _Pragma("unroll") for (int n = 0; n < 2; ++n) _Pragma("unroll") for (int k = 0; k < 2; ++k) \
        acc[ai][bj][m][n] = __builtin_amdgcn_mfma_f32_16x16x32_bf16(Bt[n][k], At[m][k], acc[ai][bj][m][n], 0, 0, 0); __builtin_amdgcn_s_setprio(0); } while (0)
#define PG8_WAIT_V(n) asm volatile("s_waitcnt vmcnt(" #n ")" ::: "memory")
#define PG8_WAIT_L(n) asm volatile("s_waitcnt lgkmcnt(" #n ")" ::: "memory")
#define PG8_BAR __builtin_amdgcn_s_barrier()
#define PG8_SCHED __builtin_amdgcn_sched_barrier(0)
    Unit cur, nxt; int ui = 0;
    if (!S.next(0, cur)) return;
    f32x4 acc[2][2][4][2];
#pragma unroll
    for (int a = 0; a < 2; ++a)
#pragma unroll
        for (int b = 0; b < 2; ++b)
#pragma unroll
            for (int m = 0; m < 4; ++m)
#pragma unroll
                for (int n = 0; n < 2; ++n) acc[a][b][m][n] = (f32x4){0.f, 0.f, 0.f, 0.f};
    bf16x8 At[4][2], B0[2][2], B1[2][2];
    const char* cA = (const char*)g.A + (size_t)cur.pm * tstep; const char* cB = (const char*)g.Bt + (size_t)cur.pn * tstep;
    S.a_ready(cur);
    if constexpr (SP2) {
        PG8_STAGE(PG8_SB(0, 0), cB, voffB); PG8_STAGE(PG8_SB(0, 1), cB + hstep, voffB); PG8_STAGE(PG8_SA(0, 0), cA, voffA); PG8_STAGE(PG8_SA(0, 1), cA + hstep, voffA);
        if (wr == 1) PG8_BAR;
        PG8_WAIT_V(2); PG8_BAR;
        PG8_STAGE(PG8_SB(1, 0), cB + kstep, voffB); PG8_STAGE(PG8_SA(1, 0), cA + kstep, voffA); PG8_STAGE(PG8_SB(1, 1), cB + hstep + kstep, voffB);
        PG8_WAIT_V(6); PG8_BAR;
    } else {
        PG8_STAGE(PG8_SB(0, 0), cB, voffB); PG8_STAGE(PG8_SA(0, 0), cA, voffA); PG8_STAGE(PG8_SB(0, 1), cB + hstep, voffB); PG8_STAGE(PG8_SA(0, 1), cA + hstep, voffA);
        if (wr == 1) PG8_BAR;
        PG8_WAIT_V(4); PG8_BAR;
        PG8_STAGE(PG8_SB(1, 0), cB + kstep, voffB); PG8_STAGE(PG8_SA(1, 0), cA + kstep, voffA); PG8_STAGE(PG8_SB(1, 1), cB + hstep + kstep, voffB);
        PG8_WAIT_V(6); PG8_BAR;
    }
    for (;;) {
        const bool has_next = S.next(ui + 1, nxt);
        const char* nA = has_next ? (const char*)g.A + (size_t)nxt.pm * tstep : cA; const char* nB = has_next ? (const char*)g.Bt + (size_t)nxt.pn * tstep : cB;
        for (int t = 0; t < nt; t += 2) {
            const bool last = (t == nt - 2);
            const char* a1 = cA + (size_t)(t + 1) * kstep;
            const char* a2 = last ? nA : cA + (size_t)(t + 2) * kstep; const char* b2 = last ? nB : cB + (size_t)(t + 2) * kstep;
            const char* a3 = a2 + kstep; const char* b3 = b2 + kstep;
            if (last && has_next) S.a_ready(nxt);
            if constexpr (SP2) {
            PG8_LDB(B0, 0, 0); PG8_LDB(B1, 0, 1); PG8_SCHED; PG8_LDA(At, 0, 0); PG8_STAGE(PG8_SA(1, 1), a1 + hstep, voffA);
            PG8_WAIT_V(8); PG8_WAIT_L(0); PG8_BAR; PG8_MMA(0, 0, At, B0); PG8_MMA(0, 1, At, B1); PG8_BAR; PG8_SCHED;
            PG8_LDA(At, 0, 1); PG8_STAGE(PG8_SB(0, 0), b2, voffB); PG8_STAGE(PG8_SB(0, 1), b2 + hstep, voffB); PG8_STAGE(PG8_SA(0, 0), a2, voffA);
            PG8_WAIT_V(8); PG8_WAIT_L(0); PG8_BAR; PG8_MMA(1, 0, At, B0); PG8_MMA(1, 1, At, B1); PG8_BAR; PG8_SCHED;
            PG8_LDB(B0, 1, 0); PG8_LDB(B1, 1, 1); PG8_SCHED; PG8_LDA(At, 1, 0); PG8_STAGE(PG8_SA(0, 1), a2 + hstep, voffA);
            PG8_WAIT_V(8); PG8_WAIT_L(0); PG8_BAR; PG8_MMA(0, 0, At, B0); PG8_MMA(0, 1, At, B1); PG8_BAR; PG8_SCHED;
            PG8_LDA(At, 1, 1); PG8_STAGE(PG8_SB(1, 0), b3, voffB); PG8_STAGE(PG8_SB(1, 1), b3 + hstep, voffB); PG8_STAGE(PG8_SA(1, 0), a3, voffA);
            PG8_WAIT_V(8); PG8_WAIT_L(0); PG8_BAR; PG8_MMA(1, 0, At, B0); PG8_MMA(1, 1, At, B1); PG8_BAR; PG8_SCHED;
            } else {
            PG8_LDB(B0, 0, 0); PG8_SCHED; PG8_LDA(At, 0, 0); PG8_STAGE(PG8_SA(1, 1), a1 + hstep, voffA);
            PG8_WAIT_L(8); PG8_BAR; PG8_WAIT_L(0); PG8_MMA(0, 0, At, B0); PG8_BAR; PG8_SCHED;
            PG8_LDB(B1, 0, 1); PG8_STAGE(PG8_SB(0, 0), b2, voffB);
            PG8_BAR; PG8_WAIT_L(0); PG8_MMA(0, 1, At, B1); PG8_BAR;
            PG8_LDA(At, 0, 1); PG8_STAGE(PG8_SA(0, 0), a2, voffA);
            PG8_BAR; PG8_WAIT_L(0); PG8_MMA(1, 0, At, B0); PG8_BAR; PG8_SCHED;
            PG8_STAGE(PG8_SB(0, 1), b2 + hstep, voffB);
            PG8_WAIT_V(6); PG8_BAR; PG8_MMA(1, 1, At, B1); PG8_BAR;
            PG8_LDB(B0, 1, 0); PG8_SCHED; PG8_LDA(At, 1, 0); PG8_STAGE(PG8_SA(0, 1), a2 + hstep, voffA);
            PG8_WAIT_L(8); PG8_BAR; PG8_WAIT_L(0); PG8_MMA(0, 0, At, B0); PG8_BAR; PG8_SCHED;
            PG8_LDB(B1, 1, 1); PG8_STAGE(PG8_SB(1, 0), b3, voffB);
            PG8_BAR; PG8_WAIT_L(0); PG8_MMA(0, 1, At, B1); PG8_BAR;
            PG8_LDA(At, 1, 1); PG8_STAGE(PG8_SA(1, 0), a3, voffA);
            PG8_BAR; PG8_WAIT_L(0); PG8_MMA(1, 0, At, B0); PG8_BAR; PG8_SCHED;
            PG8_STAGE(PG8_SB(1, 1), b3 + hstep, voffB);
            PG8_WAIT_V(6); PG8_BAR; PG8_MMA(1, 1, At, B1); PG8_BAR;
            }
        }
        if constexpr (ALIGN_EPI) { if (wr == 0) PG8_BAR; }
        if constexpr (!Epi::AFTER_DRAIN) { E(acc, cur, wr, wc, fr, fq); S.done(cur); }
        if (!has_next) break;
#pragma unroll
        for (int a = 0; a < 2; ++a)
#pragma unroll
            for (int b = 0; b < 2; ++b)
#pragma unroll
                for (int m = 0; m < 4; ++m)
#pragma unroll
                    for (int n = 0; n < 2; ++n) acc[a][b][m][n] = (f32x4){0.f, 0.f, 0.f, 0.f};
        cur = nxt; cA = nA; cB = nB; ++ui;
        if constexpr (ALIGN_EPI) { if (wr == 1) PG8_BAR; }
    }
    PG8_WAIT_V(0);
    if constexpr (!ALIGN_EPI) { if (wr == 0) PG8_BAR; }
    PG8_BAR;
    if constexpr (Epi::AFTER_DRAIN) { E.fused(acc, cur, wr, wc, fr, fq, lds, wid, lane); S.done(cur); }
#undef PG8_SA
#undef PG8_SB
#undef PG8_STAGE
#undef PG8_LDA
#undef PG8_LDB
#undef PG8_MMA
#undef PG8_WAIT_V
#undef PG8_WAIT_L
#undef PG8_BAR
#undef PG8_SCHED
}
}

struct Params {
    const float *x, *c, *ctx, *c_ctx, *ada_w, *ada_b, *norm1_g, *norm2_g, *w_in, *pool_w, *pool_scale, *na_rpb, *swa_sink, *wba, *wbb, *wbc, *w_out, *peer_wq, *peer_keys, *peer_u, *peer_v, *final_g;
    float* out; unsigned char* ws;
};
#define TID (opaque_tid())
#define BID ((int)blockIdx.x)
#define NBLK ((int)gridDim.x)

__device__ __forceinline__ void tr_tiles(const float* __restrict__ W, bf16_t* __restrict__ Wt, int K, int N, float* tile  ) {
    const int ntn = N / 64, ntiles = (K / 64) * ntn, tid = TID, c = tid & 63, r8 = tid >> 6;
    for (int vb = BID; vb < ntiles; vb += NBLK) {
        const int k0 = (vb / ntn) * 64, n0 = (vb % ntn) * 64;
#pragma unroll
        for (int i = 0; i < 8; ++i) tile[(i * 8 + r8) * 65 + c] = W[(size_t)(k0 + i * 8 + r8) * N + n0 + c];
        __syncthreads();
#pragma unroll
        for (int i = 0; i < 8; ++i) Wt[(size_t)(n0 + i * 8 + r8) * K + k0 + c] = f2bf(tile[c * 65 + i * 8 + r8]);
        __syncthreads();
    }
}
__device__ __forceinline__ void conv_bf16(const float* __restrict__ src, bf16_t* __restrict__ dst, size_t n8) {
    for (size_t i = (size_t)BID * NTHREADS + TID; i < n8; i += (size_t)NBLK * NTHREADS) {
        const float4 a = ((const float4*)src)[2 * i], b = ((const float4*)src)[2 * i + 1];
        uint4 o; o.x = pk2(a.x, a.y); o.y = pk2(a.z, a.w); o.z = pk2(b.x, b.y); o.w = pk2(b.z, b.w);
        ((uint4*)dst)[i] = o;
    }
}
__device__ __forceinline__ void copy_f4(const float* __restrict__ src, float* __restrict__ dst, size_t n4) {
    for (size_t i = (size_t)BID * NTHREADS + TID; i < n4; i += (size_t)NBLK * NTHREADS) ((float4*)dst)[i] = ((const float4*)src)[i];
}
__device__ __forceinline__ void ph_prep(const Params& p, float* smem) {
    unsigned char* ws = p.ws;
    for (int l = 0; l < 2; ++l) {
        unsigned char* wl = ws + WS_W + l * W_LAYER;
        tr_tiles(p.w_in + (size_t)l * D * IN_COLS, (bf16_t*)(wl + W_WIN), D, IN_COLS, smem);
        tr_tiles(p.wbb + (size_t)l * 512 * D, (bf16_t*)(wl + W_WB), 512, D, smem);
        tr_tiles(p.wbc + (size_t)l * 512 * D, (bf16_t*)(wl + W_WC), 512, D, smem);
        tr_tiles(p.w_out + (size_t)l * D * D, (bf16_t*)(wl + W_WO), D, D, smem);
        tr_tiles(p.peer_wq + (size_t)l * D * 2048, (bf16_t*)(wl + W_WQ), D, 2048, smem);
        {
            const float* pw = p.pool_w + (size_t)l * 4 * 128 * 128; const float* ps = p.pool_scale + l * 512; const float* wba = p.wba + (size_t)l * 512 * D; bf16_t* WaT = (bf16_t*)(wl + W_WA);
            for (int idx = BID * NTHREADS + TID; idx < 512 * D; idx += NBLK * NTHREADS) {
                const int n = idx % D, kk = idx / D, g = kk / 128, c = kk % 128;
                float acc = 0.f;
                for (int e = 0; e < 128; ++e) acc += pw[(g * 128 + c) * 128 + e] * ps[g * 128 + e] * wba[(size_t)(g * 128 + e) * D + n];
                WaT[(size_t)n * 512 + kk] = f2bf(acc);
            }
        }
        conv_bf16(p.peer_keys + (size_t)l * 8 * 2 * 128 * 128, (bf16_t*)(wl + W_KEYS), (size_t)8 * 2 * 128 * 128 / 8);
        unsigned char* tl = ws + WS_TAB + l * TAB_LAYER;
        conv_bf16(p.peer_u + (size_t)l * NEXP * D, (bf16_t*)tl, (size_t)NEXP * D / 8);
        conv_bf16(p.peer_v + (size_t)l * NEXP * D, (bf16_t*)(tl + (size_t)NEXP * D * 2), (size_t)NEXP * D / 8);
    }
    {
        float* sv = smem; float* part = smem + 5 * 1024; float* mod = (float*)(ws + WS_MOD);
        const int tid = TID, lane = tid & 63, wid = tid >> 6;
        for (int vb = BID; vb < 2 * 96; vb += NBLK) {
            const int l = vb / 96, j0 = (vb % 96) * 64;
            for (int i = tid; i < 5 * 1024; i += NTHREADS) { const int r = i >> 10, k = i & 1023; const float v = r < 4 ? p.c[r * 1024 + k] : p.c_ctx[k]; sv[i] = v / (1.f + __expf(-v)); }
            __syncthreads();
            float a0 = 0.f, a1 = 0.f, a2 = 0.f, a3 = 0.f, a4 = 0.f;
            const float* w = p.ada_w + ((size_t)l * 1024 + wid * 128) * 6144 + j0 + lane;
            for (int k = 0; k < 128; ++k) { const float xw = w[(size_t)k * 6144]; const int kk = wid * 128 + k;
                a0 += sv[kk] * xw; a1 += sv[1024 + kk] * xw; a2 += sv[2048 + kk] * xw; a3 += sv[3072 + kk] * xw; a4 += sv[4096 + kk] * xw; }
            part[(wid * 5 + 0) * 64 + lane] = a0; part[(wid * 5 + 1) * 64 + lane] = a1; part[(wid * 5 + 2) * 64 + lane] = a2; part[(wid * 5 + 3) * 64 + lane] = a3; part[(wid * 5 + 4) * 64 + lane] = a4;
            __syncthreads();
            if (tid < 320) { const int r = tid >> 6; float s = 0.f;
#pragma unroll
                for (int w8 = 0; w8 < 8; ++w8) s += part[(w8 * 5 + r) * 64 + lane];
                mod[((size_t)l * 5 + r) * 6144 + j0 + lane] = s + p.ada_b[l * 6144 + j0 + lane]; }
            __syncthreads();
        }
    }
    {
        float* tab = (float*)(ws + WS_ROPE);
        for (int i = BID * NTHREADS + TID; i < 1024; i += NBLK * NTHREADS) { const int pos = i / 16, fi = i % 16; const float inv = powf(10000.0f, -(float)fi / 16.0f), ang = (float)pos * inv; tab[i] = cosf(ang); tab[1024 + i] = sinf(ang); }
    }
    copy_f4(p.x, p.out, (size_t)T_LAT * D / 4);
    copy_f4(p.ctx, (float*)(ws + WS_XC), (size_t)T_CTX * D / 4);
}

__device__ __forceinline__ float wave_sum(float v) {
#pragma unroll
    for (int o = 32; o > 0; o >>= 1) v += __shfl_xor(v, o);
    return v;
}
__device__ __forceinline__ void ph_norm_mod(const float* __restrict__ Xl, const float* __restrict__ Xc, const float* __restrict__ g, const float* __restrict__ modl, int shift_idx, int scale_idx, bf16_t* __restrict__ H, int nrows) {
    const int lane = TID & 63, gw = BID * 8 + (TID >> 6);
    for (int row = gw; row < nrows; row += NBLK * 8) {
        const float* src = row < T_LAT ? Xl + (size_t)row * D : Xc + (size_t)(row - T_LAT) * D;
        const int mrow = row < T_LAT ? row / S : 4;
        float4 v[4]; float ss = 0.f;
#pragma unroll
        for (int i = 0; i < 4; ++i) { v[i] = ((const float4*)src)[i * 64 + lane]; ss += v[i].x * v[i].x + v[i].y * v[i].y + v[i].z * v[i].z + v[i].w * v[i].w; }
        ss = wave_sum(ss);
        const float rstd = rsqrtf(ss * (1.0f / D) + EPS);
        const float* sh = modl + (size_t)mrow * 6144 + shift_idx * 1024; const float* sc = modl + (size_t)mrow * 6144 + scale_idx * 1024;
#pragma unroll
        for (int i = 0; i < 4; ++i) { const int k = (i * 64 + lane) * 4;
            const float4 gg = *(const float4*)(g + k), s4 = *(const float4*)(sc + k), h4 = *(const float4*)(sh + k);
            uint2 w; w.x = pk2(v[i].x * rstd * gg.x * (1.f + s4.x) + h4.x, v[i].y * rstd * gg.y * (1.f + s4.y) + h4.y);
            w.y = pk2(v[i].z * rstd * gg.z * (1.f + s4.z) + h4.z, v[i].w * rstd * gg.w * (1.f + s4.w) + h4.w);
            *(uint2*)(H + (size_t)row * D + k) = w; }
    }
}
__device__ __forceinline__ void ph_final_norm(float* __restrict__ X, const float* __restrict__ g) {
    const int lane = TID & 63, gw = BID * 8 + (TID >> 6);
    for (int row = gw; row < T_LAT; row += NBLK * 8) {
        float4* src = (float4*)(X + (size_t)row * D);
        float4 v[4]; float ss = 0.f;
#pragma unroll
        for (int i = 0; i < 4; ++i) { v[i] = src[i * 64 + lane]; ss += v[i].x * v[i].x + v[i].y * v[i].y + v[i].z * v[i].z + v[i].w * v[i].w; }
        ss = wave_sum(ss);
        const float rstd = rsqrtf(ss * (1.0f / D) + EPS);
#pragma unroll
        for (int i = 0; i < 4; ++i) { const float4 gg = ((const float4*)g)[i * 64 + lane]; float4 o = v[i]; o.x *= rstd * gg.x; o.y *= rstd * gg.y; o.z *= rstd * gg.z; o.w *= rstd * gg.w; src[i * 64 + lane] = o; }
    }
}

__device__ __forceinline__ void ph_postz(bf16_t* __restrict__ Z, const float* __restrict__ tab, bf16_t* __restrict__ vtn, bf16_t* __restrict__ vtnc, bf16_t* __restrict__ vtw, bf16_t* __restrict__ vtwc, bf16_t* __restrict__ Pa, int rows) {
    const size_t gtid = (size_t)BID * NTHREADS + TID, gsz = (size_t)NBLK * NTHREADS;
    for (size_t idx = gtid; idx < (size_t)T_LAT * 320; idx += gsz) {
        const int i = (int)(idx & 15), hh = (int)((idx >> 4) & 1), hs = (int)((idx >> 5) % 10), row = (int)(idx / 320);
        const int s = row % S, pos = hh ? (s % GW) : (s / GW);
        const int colbase = (hs < 2 ? OFF_KW + hs * 64 : OFF_QW + (hs - 2) * 64) + hh * 32 + i;
        bf16_t* pz = Z + (size_t)row * IN_COLS + colbase;
        const float x1 = bf2f(pz[0]), x2 = bf2f(pz[16]);
        const float cs = tab[pos * 16 + i], sn = tab[1024 + pos * 16 + i];
        pz[0] = f2bf(x1 * cs - x2 * sn); pz[16] = f2bf(x1 * sn + x2 * cs);
    }
    for (size_t idx = gtid; idx < (size_t)rows * 384; idx += gsz) {
        const int c8 = (int)(idx % 384); const size_t row = idx / 384;
        uint4* pz = (uint4*)(Z + row * IN_COLS + OFF_G + c8 * 8);
        uint4 v = *pz; unsigned w[4] = {v.x, v.y, v.z, v.w};
#pragma unroll
        for (int j = 0; j < 4; ++j) w[j] = pk2(1.f / (1.f + __expf(-lo16(w[j]))), 1.f / (1.f + __expf(-hi16(w[j]))));
        v.x = w[0]; v.y = w[1]; v.z = w[2]; v.w = w[3]; *pz = v;
    }
    for (size_t idx = gtid; idx < (size_t)T_ALL * 640; idx += gsz) {
        const int row = (int)(idx % T_ALL), j = (int)(idx / T_ALL);
        const bool lat = row < T_LAT; const int b = lat ? row / S : (row - T_LAT) / L, t = lat ? row % S : (row - T_LAT) % L, len = lat ? S : L;
        if (j < 512) { const bf16_t v = Z[(size_t)row * IN_COLS + OFF_VN + j]; bf16_t* dst = lat ? vtn : vtnc; dst[((size_t)(b * 8 + j / 64) * 64 + (j % 64)) * len + t] = v; }
        else { const int jj = j - 512; const bf16_t v = Z[(size_t)row * IN_COLS + OFF_VW + jj]; bf16_t* dst = lat ? vtw : vtwc; dst[((size_t)(b * 2 + jj / 64) * 64 + (jj % 64)) * len + t] = v; }
    }
    for (size_t idx = gtid; idx < (size_t)rows * 512; idx += gsz) {
        const int c = (int)(idx % 512), row = (int)(idx / 512);
        const int g = c / 128, w = 2 << g;
        const bool lat = row < T_LAT; const int len = lat ? S : L; const int t = lat ? row % S : (row - T_LAT) % L; const int base = row - t;
        int lo = t - w / 2; if (lo < 0) lo = 0; int hi = t - w / 2 + w; if (hi > len) hi = len;
        float sum = 0.f;
        for (int tt = lo; tt < hi; ++tt) sum += bf2f(Z[(size_t)(base + tt) * IN_COLS + OFF_A + c]);
        Pa[(size_t)row * 512 + c] = f2bf(sum / (float)(hi - lo) - bf2f(Z[(size_t)row * IN_COLS + OFF_A + c]));
    }
}

typedef short bf16x8v __attribute__((ext_vector_type(8)));
typedef float f32x4v __attribute__((ext_vector_type(4)));
constexpr float LOG2E = 1.4426950408889634f;
constexpr float QK_SCALE2 = 0.125f * LOG2E;
constexpr float MASKED = -3.0e38f;
__device__ __forceinline__ unsigned cvtpk(float lo, float hi) { unsigned r; asm volatile("v_cvt_pk_bf16_f32 %0, %1, %2" : "=v"(r) : "v"(lo), "v"(hi)); return r; }
__device__ __forceinline__ f32x4v mfma16(bf16x8v a, bf16x8v b, f32x4v c) { return __builtin_amdgcn_mfma_f32_16x16x32_bf16(a, b, c, 0, 0, 0); }
struct AttnSt { f32x4v o[4]; float m, l; };
template <class Dsc>
__device__ __forceinline__ void attn_group(const Dsc& dsc, int c0, const bf16x8v qf0, const bf16x8v qf1, AttnSt& st, int lane) {
    f32x4v s[2][2]; bool live[2];
#pragma unroll
    for (int j = 0; j < 2; ++j) {
        live[j] = dsc.live(c0 + j);
        if (live[j]) {
#pragma unroll
            for (int tt = 0; tt < 2; ++tt) {
                const bf16_t* kp = dsc.kptr(c0 + j, tt);
                const bf16x8v a0 = *(const bf16x8v*)kp, a1 = *(const bf16x8v*)(kp + 32);
                f32x4v acc = (f32x4v){0.f, 0.f, 0.f, 0.f};
                acc = mfma16(a0, qf0, acc); acc = mfma16(a1, qf1, acc);
#pragma unroll
                for (int r = 0; r < 4; ++r) acc[r] = dsc.score(c0 + j, tt, r, acc[r]);
                s[j][tt] = acc;
            }
        } else { s[j][0] = (f32x4v){MASKED, MASKED, MASKED, MASKED}; s[j][1] = s[j][0]; }
    }
    float gmax = MASKED;
#pragma unroll
    for (int j = 0; j < 2; ++j)
#pragma unroll
        for (int tt = 0; tt < 2; ++tt)
#pragma unroll
            for (int r = 0; r < 4; ++r) gmax = fmaxf(gmax, s[j][tt][r]);
    gmax = fmaxf(gmax, __shfl_xor(gmax, 16)); gmax = fmaxf(gmax, __shfl_xor(gmax, 32));
    const float mnew = fmaxf(st.m, gmax), alpha = __builtin_amdgcn_exp2f(st.m - mnew);
    st.m = mnew;
    float psum = 0.f;
#pragma unroll
    for (int j = 0; j < 2; ++j)
#pragma unroll
        for (int tt = 0; tt < 2; ++tt)
#pragma unroll
            for (int r = 0; r < 4; ++r) { const float pv = __builtin_amdgcn_exp2f(s[j][tt][r] - mnew); s[j][tt][r] = pv; psum += pv; }
    st.l = st.l * alpha + psum;
    if (!__all(alpha == 1.0f)) {
        const int gb = (lane >> 4) * 4;
#pragma unroll
        for (int r = 0; r < 4; ++r) { const float ar = __shfl(alpha, gb + r);
#pragma unroll
            for (int dt = 0; dt < 4; ++dt) st.o[dt][r] *= ar; }
    }
#pragma unroll
    for (int j = 0; j < 2; ++j) if (live[j]) {
        union { unsigned u[4]; bf16x8v v; } pf;
        pf.u[0] = cvtpk(s[j][0][0], s[j][0][1]); pf.u[1] = cvtpk(s[j][0][2], s[j][0][3]); pf.u[2] = cvtpk(s[j][1][0], s[j][1][1]); pf.u[3] = cvtpk(s[j][1][2], s[j][1][3]);
        const bf16_t* vp = dsc.vptr(c0 + j); const size_t vs = dsc.vstride16();
#pragma unroll
        for (int dt = 0; dt < 4; ++dt) { const bf16x8v vf = *(const bf16x8v*)(vp + dt * vs); st.o[dt] = mfma16(pf.v, vf, st.o[dt]); }
    }
}
__device__ __forceinline__ void attn_finish(AttnSt& st, float sink2, bool has_sink, bf16_t* orow  , int lane) {
    float l = st.l; l += __shfl_xor(l, 16); l += __shfl_xor(l, 32);
    if (has_sink) l += __builtin_amdgcn_exp2f(sink2 - st.m);
    const float inv = 1.0f / l;
    const int gb = (lane >> 4) * 4, d = lane & 15;
#pragma unroll
    for (int r = 0; r < 4; ++r) { const float ir = __shfl(inv, gb + r);
#pragma unroll
        for (int dt = 0; dt < 4; ++dt) orow[(size_t)(gb + r) * 512 + dt * 16 + d] = f2bf(st.o[dt][r] * ir); }
}
__device__ __forceinline__ void attn_init_st(AttnSt& st) {
#pragma unroll
    for (int dt = 0; dt < 4; ++dt) st.o[dt] = (f32x4v){0.f, 0.f, 0.f, 0.f};
    st.m = -1.0e30f; st.l = 0.f;
}
__device__ __forceinline__ int clampi(int v, int lo, int hi) { return v < lo ? lo : (v > hi ? hi : v); }
struct NaLocalDsc {
    const bf16_t* kbase;
    const bf16_t* vbase;
    const float* rpb;
    int kc0, qc, qs, dr0;
    __device__ __forceinline__ bool live(int) const { return true; }
    __device__ __forceinline__ const bf16_t* kptr(int c, int tt) const { return kbase + (size_t)(c * 64 + 4 * tt) * IN_COLS; }
    __device__ __forceinline__ const bf16_t* vptr(int c) const { return vbase + c * 64; }
    __device__ __forceinline__ size_t vstride16() const { return (size_t)16 * S; }
    __device__ __forceinline__ float score(int c, int tt, int r, float raw) const {
        const int kc = kc0 + 4 * tt + r; const int dc = clampi(kc - qc + 15, 0, 30);
        const float bias = rpb[(dr0 + c) * 31 + dc];
        return (kc >= qs && kc < qs + 16) ? raw * QK_SCALE2 + bias : MASKED;
    }
};
struct CtxDsc {
    const bf16_t* kbase;
    const bf16_t* vbase;
    __device__ __forceinline__ bool live(int) const { return true; }
    __device__ __forceinline__ const bf16_t* kptr(int c, int tt) const { return kbase + (size_t)(c * 32 + 4 * tt) * IN_COLS; }
    __device__ __forceinline__ const bf16_t* vptr(int c) const { return vbase + c * 32; }
    __device__ __forceinline__ size_t vstride16() const { return (size_t)16 * L; }
    __device__ __forceinline__ float score(int, int, int, float raw) const { return raw * QK_SCALE2; }
};
struct SwaLocalDsc {
    const bf16_t* zrow;
    const bf16_t* vrow;
    int p0, kslot0, g8, qpos;
    __device__ __forceinline__ bool live(int c) const { const int pos0 = p0 - 128 + 32 * c; return c < 9 && pos0 + 31 >= 0 && pos0 < S; }
    __device__ __forceinline__ const bf16_t* kptr(int c, int tt) const { const int pos = clampi(p0 - 128 + 32 * c + kslot0 + 4 * tt, 0, S - 1); return zrow + (size_t)pos * IN_COLS; }
    __device__ __forceinline__ const bf16_t* vptr(int c) const { const int pos = clampi(p0 - 128 + 32 * c + g8, 0, S - 8); return vrow + pos; }
    __device__ __forceinline__ size_t vstride16() const { return (size_t)16 * S; }
    __device__ __forceinline__ float score(int c, int tt, int r, float raw) const {
        const int pos = p0 - 128 + 32 * c + g8 + 4 * tt + r; const int dlt = qpos - pos;
        return (pos >= 0 && pos < S && dlt <= 128 && dlt >= -128) ? raw * QK_SCALE2 : MASKED;
    }
};
__device__ __forceinline__ void ph_attn(const bf16_t* __restrict__ Z, const bf16_t* __restrict__ vtn, const bf16_t* __restrict__ vtnc, const bf16_t* __restrict__ vtw, const bf16_t* __restrict__ vtwc,
                                        const float* __restrict__ rpb, const float* __restrict__ sink, bf16_t* __restrict__ Ob, bf16_t* __restrict__ Oc, bool do_ctx, float* smem) {
    const int tid = TID, lane = tid & 63, wid = tid >> 6;
    for (int i = tid; i < 8 * 465; i += NTHREADS) smem[i] = rpb[i] * LOG2E;
    __syncthreads();
    const int q = lane & 15, g = lane >> 4, kslot0 = (q >> 2) * 8 + (q & 3);
    const int vcu = (NBLK % 8 == 0) ? (BID % 8) * (NBLK / 8) + BID / 8 : BID;
    const int nunits = 8192 + 8192 + (do_ctx ? 1024 : 0);
    for (int u = vcu * 8 + wid; u < nunits; u += NBLK * 8) {
        AttnSt st; attn_init_st(st);
        if (u < 8192) {
            const int cb = u & 3, h = (u >> 2) & 7, r = (u >> 5) & 63, b = u >> 11;
            const int R0 = clampi(r - 4, 0, 56), C0 = clampi(cb * 16 - 8, 0, 32), qc = cb * 16 + q;
            const size_t t0 = (size_t)b * S + r * GW + cb * 16;
            const bf16_t* qp = Z + (t0 + q) * IN_COLS + OFF_QN + h * 64 + 8 * g;
            const bf16x8v qf0 = *(const bf16x8v*)qp, qf1 = *(const bf16x8v*)(qp + 32);
            NaLocalDsc dl; dl.kbase = Z + ((size_t)b * S + R0 * GW + C0 + kslot0) * IN_COLS + OFF_KN + h * 64 + 8 * g;
            dl.vbase = vtn + ((size_t)(b * 8 + h) * 64 + q) * S + R0 * GW + C0 + 8 * g; dl.rpb = smem + h * 465;
            dl.kc0 = C0 + 8 * g; dl.qc = qc; dl.qs = clampi(qc - 8, 0, 48); dl.dr0 = R0 - r + 7;
#pragma unroll 1
            for (int gi = 0; gi < 4; ++gi) attn_group(dl, 2 * gi, qf0, qf1, st, lane);
            CtxDsc dc; dc.kbase = Z + ((size_t)T_LAT + b * L + kslot0) * IN_COLS + OFF_KN + h * 64 + 8 * g; dc.vbase = vtnc + ((size_t)(b * 8 + h) * 64 + q) * L + 8 * g;
#pragma unroll 1
            for (int gi = 0; gi < 4; ++gi) attn_group(dc, 2 * gi, qf0, qf1, st, lane);
            attn_finish(st, 0.f, false, Ob + t0 * 512 + h * 64, lane);
        } else if (u < 16384) {
            const int v = u - 8192, rep = v & 3, qt = (v >> 2) & 255, g2 = (v >> 10) & 1, b = v >> 11, hq = g2 * 4 + rep, p0 = qt * 16;
            const size_t t0 = (size_t)b * S + p0;
            const bf16_t* qp = Z + (t0 + q) * IN_COLS + OFF_QW + hq * 64 + 8 * g;
            const bf16x8v qf0 = *(const bf16x8v*)qp, qf1 = *(const bf16x8v*)(qp + 32);
            SwaLocalDsc dl; dl.zrow = Z + (size_t)b * S * IN_COLS + OFF_KW + g2 * 64 + 8 * g; dl.vrow = vtw + ((size_t)(b * 2 + g2) * 64 + q) * S;
            dl.p0 = p0; dl.kslot0 = kslot0; dl.g8 = 8 * g; dl.qpos = p0 + q;
#pragma unroll 1
            for (int gi = 0; gi < 5; ++gi) attn_group(dl, 2 * gi, qf0, qf1, st, lane);
            CtxDsc dc; dc.kbase = Z + ((size_t)T_LAT + b * L + kslot0) * IN_COLS + OFF_KW + g2 * 64 + 8 * g; dc.vbase = vtwc + ((size_t)(b * 2 + g2) * 64 + q) * L + 8 * g;
#pragma unroll 1
            for (int gi = 0; gi < 4; ++gi) attn_group(dc, 2 * gi, qf0, qf1, st, lane);
            attn_finish(st, sink[hq] * LOG2E, true, Oc + t0 * 512 + hq * 64, lane);
        } else {
            const int v = u - 16384, qt = v & 15, h = (v >> 4) & 7, b = (v >> 7) & 3, which = v >> 9;
            const size_t t0 = (size_t)T_LAT + b * L + qt * 16;
            const int qoff = which ? OFF_QW : OFF_QN, koff = which ? OFF_KW + (h >> 2) * 64 : OFF_KN + h * 64;
            const bf16_t* qp = Z + (t0 + q) * IN_COLS + qoff + h * 64 + 8 * g;
            const bf16x8v qf0 = *(const bf16x8v*)qp, qf1 = *(const bf16x8v*)(qp + 32);
            CtxDsc dc; dc.kbase = Z + ((size_t)T_LAT + b * L + kslot0) * IN_COLS + koff + 8 * g;
            dc.vbase = which ? vtwc + ((size_t)(b * 2 + (h >> 2)) * 64 + q) * L + 8 * g : vtnc + ((size_t)(b * 8 + h) * 64 + q) * L + 8 * g;
#pragma unroll 1
            for (int gi = 0; gi < 4; ++gi) attn_group(dc, 2 * gi, qf0, qf1, st, lane);
            attn_finish(st, which ? sink[h] * LOG2E : 0.f, which != 0, (which ? Oc : Ob) + t0 * 512 + h * 64, lane);
        }
    }
}

__device__ __forceinline__ void wave_argmax(float& v, int& i) {
#pragma unroll
    for (int o = 32; o > 0; o >>= 1) { const float v2 = __shfl_xor(v, o); const int i2 = __shfl_xor(i, o); if (v2 > v || (v2 == v && i2 < i)) { v = v2; i = i2; } }
}
__device__ __forceinline__ void ph_peer_topk(const bf16_t* __restrict__ Q, const bf16_t* __restrict__ keys, int* __restrict__ eidx, float* __restrict__ egate, int rows, float* smem) {
    const int half = TID >> 8, tid = TID & 255, lane = tid & 63, wid = tid >> 6;
    float* qs = smem + half * 4608;
    float* sc = qs + 2048;
    float* tops = sc + 2048;
    int* topi = (int*)(tops + 256);
    for (int vb = BID; vb < rows / 2; vb += NBLK) {
        const int t = vb * 2 + half;
        for (int i = tid; i < 2048; i += 256) qs[i] = bf2f(Q[(size_t)t * 2048 + i]);
        __syncthreads();
        for (int o = tid; o < 2048; o += 256) {
            const int hp = o >> 7; const bf16_t* kp = keys + (size_t)o * 128; const float* qp = qs + hp * 128;
            float a = 0.f;
            for (int c8 = 0; c8 < 16; ++c8) { const uint4 kv = *(const uint4*)(kp + c8 * 8); const unsigned w[4] = {kv.x, kv.y, kv.z, kv.w};
#pragma unroll
                for (int j = 0; j < 4; ++j) { a += qp[c8 * 8 + 2 * j] * lo16(w[j]); a += qp[c8 * 8 + 2 * j + 1] * hi16(w[j]); } }
            sc[o] = a;
        }
        __syncthreads();
        for (int li = wid; li < 16; li += 4) {
            float v0 = sc[li * 128 + lane], v1 = sc[li * 128 + lane + 64];
            for (int r = 0; r < 16; ++r) {
                float v = v0; int i = lane; if (v1 > v0) { v = v1; i = lane + 64; }
                wave_argmax(v, i);
                if (lane == 0) { tops[li * 16 + r] = v; topi[li * 16 + r] = i; }
                if (i == lane) v0 = -3e38f; if (i == lane + 64) v1 = -3e38f;
            }
        }
        __syncthreads();
        for (int h = wid; h < 8; h += 4) {
            float cv[4];
#pragma unroll
            for (int q = 0; q < 4; ++q) { const int c = lane + 64 * q; cv[q] = tops[(2 * h) * 16 + (c >> 4)] + tops[(2 * h + 1) * 16 + (c & 15)]; }
            float bs = 0.f; int be = 0; float mx = 0.f;
            for (int r = 0; r < 16; ++r) {
                float v = cv[0]; int i = lane;
#pragma unroll
                for (int q = 1; q < 4; ++q) if (cv[q] > v) { v = cv[q]; i = lane + 64 * q; }
                wave_argmax(v, i);
                if (r == 0) mx = v;
                if (lane == r) { bs = v; be = topi[(2 * h) * 16 + (i >> 4)] * 128 + topi[(2 * h + 1) * 16 + (i & 15)]; }
#pragma unroll
                for (int q = 0; q < 4; ++q) if (i == lane + 64 * q) cv[q] = -3e38f;
            }
            const float e = lane < 16 ? __expf(bs - mx) : 0.f; const float sum = wave_sum(e);
            if (lane < 16) { eidx[(size_t)t * 128 + h * 16 + lane] = be; egate[(size_t)t * 128 + h * 16 + lane] = e / sum; }
        }
        __syncthreads();
    }
}
__device__ __forceinline__ void ph_peer_gather(const bf16_t* __restrict__ H, const bf16_t* __restrict__ U, const bf16_t* __restrict__ V, const int* __restrict__ eidx, const float* __restrict__ egate,
                                               const float* __restrict__ modl, float* __restrict__ Xl, float* __restrict__ Xc, int rows, float* smem) {
    const int half = TID >> 8, tid = TID & 255, lane = tid & 63, wid = tid >> 6;
    float* wgt = smem + half * 256; int* eid = (int*)(wgt + 128);
    for (int vb = BID; vb < rows / 2; vb += NBLK) {
        const int t = vb * 2 + half;
        if (tid < 128) eid[tid] = eidx[(size_t)t * 128 + tid];
        float hx[16];
        { const uint4 a = *(const uint4*)(H + (size_t)t * D + lane * 16), b = *(const uint4*)(H + (size_t)t * D + lane * 16 + 8);
          const unsigned w[8] = {a.x, a.y, a.z, a.w, b.x, b.y, b.z, b.w};
#pragma unroll
          for (int j = 0; j < 8; ++j) { hx[2 * j] = lo16(w[j]); hx[2 * j + 1] = hi16(w[j]); } }
        __syncthreads();
        for (int e = wid; e < 128; e += 4) {
            const bf16_t* up = U + (size_t)eid[e] * D + lane * 16;
            const uint4 a = *(const uint4*)up, b = *(const uint4*)(up + 8);
            const unsigned w[8] = {a.x, a.y, a.z, a.w, b.x, b.y, b.z, b.w};
            float acc = 0.f;
#pragma unroll
            for (int j = 0; j < 8; ++j) { acc += hx[2 * j] * lo16(w[j]); acc += hx[2 * j + 1] * hi16(w[j]); }
            acc = wave_sum(acc);
            if (lane == 0) wgt[e] = egate[(size_t)t * 128 + e] * 0.5f * acc * (1.f + erff(acc * 0.70710678118654752f));
        }
        __syncthreads();
        float o[4] = {0.f, 0.f, 0.f, 0.f};
        for (int e = 0; e < 128; ++e) {
            const uint2 vv = *(const uint2*)(V + (size_t)eid[e] * D + tid * 4); const float w = wgt[e];
            o[0] += w * lo16(vv.x); o[1] += w * hi16(vv.x); o[2] += w * lo16(vv.y); o[3] += w * hi16(vv.y);
        }
        const int mrow = t < T_LAT ? t / S : 4;
        float* xp = t < T_LAT ? Xl + (size_t)t * D + tid * 4 : Xc + (size_t)(t - T_LAT) * D + tid * 4;
        const float* gt = modl + (size_t)mrow * 6144 + 5 * 1024 + tid * 4;
        float4 x = *(float4*)xp; x.x += gt[0] * o[0]; x.y += gt[1] * o[1]; x.z += gt[2] * o[2]; x.w += gt[3] * o[3]; *(float4*)xp = x;
        __syncthreads();
    }
}

__device__ __forceinline__ unsigned char* launder(unsigned char* q) { asm volatile("" : "+s"(q)); return q; }
struct WsPtrs { float *mod, *rope, *XC, *X; bf16_t *H, *Z, *vtn, *vtnc, *vtw, *vtwc, *AT; int* eidx; float* egate; unsigned char* wl; const float* modl; const bf16_t *U, *V; };
__device__ __forceinline__ WsPtrs mkptrs(const Params& p, int l) {
    unsigned char* ws = launder(p.ws); WsPtrs P;
    P.mod = (float*)(ws + WS_MOD); P.rope = (float*)(ws + WS_ROPE); P.XC = (float*)(ws + WS_XC); P.X = (float*)launder((unsigned char*)p.out);
    P.H = (bf16_t*)(ws + WS_H); P.Z = (bf16_t*)(ws + WS_Z); P.vtn = (bf16_t*)(ws + WS_VTN); P.vtnc = (bf16_t*)(ws + WS_VTNC); P.vtw = (bf16_t*)(ws + WS_VTW); P.vtwc = (bf16_t*)(ws + WS_VTWC);
    P.AT = (bf16_t*)(ws + WS_AT); P.eidx = (int*)(ws + WS_EIDX); P.egate = (float*)(ws + WS_EGATE);
    P.wl = ws + WS_W + l * W_LAYER; P.modl = P.mod + (size_t)l * 5 * 6144; P.U = (const bf16_t*)(ws + WS_TAB + l * TAB_LAYER); P.V = P.U + (size_t)NEXP * D;
    return P;
}
__global__ void __launch_bounds__(NTHREADS, 2) mega_fwd(Params p) {
    extern __shared__ __attribute__((aligned(16))) unsigned char lds[];
    cg::grid_group grid = cg::this_grid();
    PG8_LAS unsigned char* ldsr = (PG8_LAS unsigned char*)lds;
    float* smem = (float*)lds;

    ph_prep(p, smem);
    grid.sync();
#pragma unroll 1
    for (int l = 0; l < 2; ++l) {
        const bool last = (l == 1);
        const int rows = last ? T_LAT : T_ALL;
        { const WsPtrs P = mkptrs(p, l); ph_norm_mod(P.X, P.XC, p.norm1_g + l * D, P.modl, 0, 1, P.H, T_ALL); }
        grid.sync();
        {
            const WsPtrs P = mkptrs(p, l);
            pg8::EpiStoreBf16 E{P.Z, IN_COLS, 0};
            if (!last) { pg8::Gemm g{P.H, (const bf16_t*)(P.wl + W_WIN), T_ALL, IN_COLS, D}; pg8::StaticOrder So; So.init(T_ALL, IN_COLS, NBLK, BID);
                pg8::gemm_phase<pg8::EpiStoreBf16, pg8::StaticOrder, true, true>(ldsr, g, So, E); }
            else { pg8::Gemm g{P.H, (const bf16_t*)(P.wl + W_WIN), T_LAT, IN_COLS, D}; pg8::StaticOrder So; So.init(T_LAT, IN_COLS, NBLK, BID);
                pg8::gemm_phase<pg8::EpiStoreBf16, pg8::StaticOrder, true, true>(ldsr, g, So, E);
                const WsPtrs P2 = mkptrs(p, l);
                pg8::EpiStoreBf16 E2{P2.Z + (size_t)T_LAT * IN_COLS, IN_COLS, 0};
                pg8::Gemm g2{P2.H + (size_t)T_LAT * D, (const bf16_t*)(P2.wl + W_WIN), T_CTX, CTX_KV_COLS, D}; pg8::StaticOrder S2; S2.init(T_CTX, CTX_KV_COLS, NBLK, BID);
                pg8::gemm_phase<pg8::EpiStoreBf16, pg8::StaticOrder, true, true>(ldsr, g2, S2, E2); }
        }
        grid.sync();
        { const WsPtrs P = mkptrs(p, l); ph_postz(P.Z, P.rope, P.vtn, P.vtnc, P.vtw, P.vtwc, P.AT, rows); }
        grid.sync();
        { const WsPtrs P = mkptrs(p, l); ph_attn(P.Z, P.vtn, P.vtnc, P.vtw, P.vtwc, p.na_rpb + (size_t)l * 8 * 15 * 31, p.swa_sink + l * 8, P.AT + (size_t)T_ALL * 512, P.AT + (size_t)2 * T_ALL * 512, !last, smem); }
        grid.sync();
        {
            const WsPtrs P = mkptrs(p, l);
            pg8::Gemm g{P.AT, (const bf16_t*)(P.wl + W_WA), 3 * T_ALL, 3 * D, 512}; pg8::MergeOrder Mo{(rows / 256) * 4, NBLK, BID, 0}; pg8::EpiMergeSeg E{P.Z, P.H};
            pg8::gemm_phase<pg8::EpiMergeSeg, pg8::MergeOrder, false, true>(ldsr, g, Mo, E);
        }
        grid.sync();
        {
            const WsPtrs P = mkptrs(p, l);
            pg8::Gemm g{P.H, (const bf16_t*)(P.wl + W_WO), rows, D, D}; pg8::StaticOrder So; So.init(rows, D, NBLK, BID); pg8::EpiResid E{P.X, P.XC, P.modl, 2, 0};
            pg8::gemm_phase<pg8::EpiResid, pg8::StaticOrder, true, true>(ldsr, g, So, E);
        }
        grid.sync();
        { const WsPtrs P = mkptrs(p, l); ph_norm_mod(P.X, P.XC, p.norm2_g + l * D, P.modl, 3, 4, P.H, rows); }
        grid.sync();
        {   const WsPtrs P = mkptrs(p, l);
            pg8::Gemm g{P.H, (const bf16_t*)(P.wl + W_WQ), rows, 2048, D}; pg8::StaticOrder So; So.init(rows, 2048, NBLK, BID); pg8::EpiStoreBf16 E{P.Z, 2048, 0};
            pg8::gemm_phase<pg8::EpiStoreBf16, pg8::StaticOrder, true, true>(ldsr, g, So, E);
        }
        grid.sync();
        { const WsPtrs P = mkptrs(p, l); ph_peer_topk(P.Z, (const bf16_t*)(P.wl + W_KEYS), P.eidx, P.egate, rows, smem); }
        grid.sync();
        { const WsPtrs P = mkptrs(p, l); ph_peer_gather(P.H, P.U, P.V, P.eidx, P.egate, P.modl, P.X, P.XC, rows, smem); }
        grid.sync();
    }
    { float* X = (float*)launder((unsigned char*)p.out); ph_final_norm(X, p.final_g); }
}

extern "C" void kernel_launch(void* const* d_in, const int* in_sizes, int n_in, void* d_out, int out_size, void* d_ws, size_t ws_size, hipStream_t stream) {
    static int grid_blocks = 0;
    if (grid_blocks == 0) {
        if (ws_size < WS_END || n_in != 22) { fprintf(stderr, "kernel_launch: workspace %zu < %zu or n_in %d != 22\n", ws_size, (size_t)WS_END, n_in); grid_blocks = -1; return; }
        int dev = 0, cus = 0, per_cu = 0;
        (void)hipGetDevice(&dev); (void)hipDeviceGetAttribute(&cus, hipDeviceAttributeMultiprocessorCount, dev);
        if (hipFuncSetAttribute((const void*)mega_fwd, hipFuncAttributeMaxDynamicSharedMemorySize, LDS_BYTES) != hipSuccess) { fprintf(stderr, "kernel_launch: hipFuncSetAttribute failed\n"); grid_blocks = -1; return; }
        if (hipOccupancyMaxActiveBlocksPerMultiprocessor(&per_cu, (const void*)mega_fwd, NTHREADS, LDS_BYTES) != hipSuccess || per_cu < 1) { fprintf(stderr, "kernel_launch: occupancy query says %d\n", per_cu); per_cu = 1; }
        (void)hipGetLastError();
        grid_blocks = cus * 1;
        fprintf(stderr, "kernel_launch: %d CUs, occupancy query %d per CU, grid %d\n", cus, per_cu, grid_blocks);
    }
    if (grid_blocks < 0) return;
    Params p{};
    p.x = (const float*)d_in[0]; p.c = (const float*)d_in[1]; p.ctx = (const float*)d_in[2]; p.c_ctx = (const float*)d_in[3]; p.ada_w = (const float*)d_in[4]; p.ada_b = (const float*)d_in[5];
    p.norm1_g = (const float*)d_in[6]; p.norm2_g = (const float*)d_in[7]; p.w_in = (const float*)d_in[8]; p.pool_w = (const float*)d_in[9]; p.pool_scale = (const float*)d_in[10]; p.na_rpb = (const float*)d_in[11];
    p.swa_sink = (const float*)d_in[12]; p.wba = (const float*)d_in[13]; p.wbb = (const float*)d_in[14]; p.wbc = (const float*)d_in[15]; p.w_out = (const float*)d_in[16]; p.peer_wq = (const float*)d_in[17];
    p.peer_keys = (const float*)d_in[18]; p.peer_u = (const float*)d_in[19]; p.peer_v = (const float*)d_in[20]; p.final_g = (const float*)d_in[21];
    p.out = (float*)d_out; p.ws = (unsigned char*)d_ws;
    void* args[] = {&p};
    const hipError_t e = hipLaunchCooperativeKernel((const void*)mega_fwd, dim3(grid_blocks), dim3(NTHREADS), args, LDS_BYTES, stream);
    if (e != hipSuccess) fprintf(stderr, "kernel_launch: cooperative launch failed: %s (grid %d)\n", hipGetErrorString(e), grid_blocks);
}
```

```cpp
#include <hip/hip_runtime.h>
#include <hip/hip_cooperative_groups.h>
#include <stdint.h>
#include <stdio.h>
namespace cg = cooperative_groups;

typedef unsigned short bf16_t;

constexpr int D = 1024, NB = 4, S = 4096, L = 256, GW = 64;
constexpr int T_LAT = NB * S, T_CTX = NB * L, T_ALL = T_LAT + T_CTX;
constexpr int IN_COLS = 5888;
constexpr int OFF_KN = 0, OFF_VN = 512, OFF_KW = 1024, OFF_VW = 1152, CTX_KV_COLS = 1280, OFF_QN = 1280, OFF_QW = 1792, OFF_A = 2304, OFF_G = 2816;
constexpr int NEXP = 16384;
constexpr float EPS = 1e-6f;
constexpr int NTHREADS = 512;
constexpr int LDS_BYTES = 147456;

constexpr size_t al256(size_t x) { return (x + 255) & ~(size_t)255; }
constexpr size_t WS_MOD = 0;
constexpr size_t WS_ROPE = al256(WS_MOD + 2 * 5 * 6144 * 4);
constexpr size_t WS_XC = al256(WS_ROPE + 2 * 64 * 16 * 4);
constexpr size_t WS_H = al256(WS_XC + (size_t)T_CTX * D * 4);
constexpr size_t WS_Z = al256(WS_H + (size_t)T_ALL * D * 2);
constexpr size_t WS_VTN = al256(WS_Z + (size_t)T_ALL * IN_COLS * 2);
constexpr size_t WS_VTNC = al256(WS_VTN + (size_t)NB * 8 * 64 * S * 2);
constexpr size_t WS_VTW = al256(WS_VTNC + (size_t)NB * 8 * 64 * L * 2);
constexpr size_t WS_VTWC = al256(WS_VTW + (size_t)NB * 2 * 64 * S * 2);
constexpr size_t WS_AT = al256(WS_VTWC + (size_t)NB * 2 * 64 * L * 2);
constexpr size_t WS_EIDX = al256(WS_AT + (size_t)3 * T_ALL * 512 * 2);
constexpr size_t WS_EGATE = al256(WS_EIDX + (size_t)T_ALL * 128 * 4);
constexpr size_t WS_W = al256(WS_EGATE + (size_t)T_ALL * 128 * 4);
constexpr size_t W_WIN = 0;
constexpr size_t W_WA = W_WIN + (size_t)IN_COLS * D * 2;
constexpr size_t W_WB = W_WA + (size_t)D * 512 * 2;
constexpr size_t W_WC = W_WB + (size_t)D * 512 * 2;
constexpr size_t W_WO = W_WC + (size_t)D * 512 * 2;
constexpr size_t W_WQ = W_WO + (size_t)D * D * 2;
constexpr size_t W_KEYS = W_WQ + (size_t)2048 * D * 2;
constexpr size_t W_LAYER = al256(W_KEYS + (size_t)8 * 2 * 128 * 128 * 2);
constexpr size_t WS_TAB = al256(WS_W + 2 * W_LAYER);
constexpr size_t TAB_LAYER = (size_t)2 * NEXP * D * 2;
constexpr size_t WS_END = WS_TAB + 2 * TAB_LAYER;

__device__ __forceinline__ float bf2f(bf16_t v) { return __uint_as_float((unsigned)v << 16); }
__device__ __forceinline__ bf16_t f2bf(float f) { unsigned u = __float_as_uint(f); u += 0x7fffu + ((u >> 16) & 1u); return (bf16_t)(u >> 16); }
__device__ __forceinline__ unsigned pk2(float lo, float hi) { return (unsigned)f2bf(lo) | ((unsigned)f2bf(hi) << 16); }
__device__ __forceinline__ float lo16(unsigned w) { return __uint_as_float(w << 16); }
__device__ __forceinline__ float hi16(unsigned w) { return __uint_as_float(w & 0xffff0000u); }

__device__ __forceinline__ int opaque_tid() { int t = threadIdx.x; asm volatile("" : "+v"(t)); return t; }
namespace pg8 {
#define PG8_LAS __attribute__((address_space(3)))
typedef unsigned short bf16_t;
typedef short bf16x8 __attribute__((ext_vector_type(8)));
typedef float f32x4 __attribute__((ext_vector_type(4)));
typedef unsigned u32x4 __attribute__((ext_vector_type(4)));
constexpr int BM = 256, BK = 64, HALF = 128, HTB = HALF * BK * 2  , STAGE_BYTES = 8 * HTB, NXCD = 8, WGM = 8;

__host__ __device__ __forceinline__ int lds_byte(int r, int c) { const int st = (r >> 4) * 2 + (c >> 5), rr = r & 15, cc = c & 31, ob = rr * 64 + cc * 2; return st * 1024 + (ob ^ (((ob >> 9) & 1) << 5)); }
__host__ __device__ __forceinline__ void stage_rc(int b, int& R, int& C) { const int st = b / 1024, sb = b % 1024, swz = sb ^ (((sb >> 9) & 1) << 5); R = (st >> 1) * 16 + swz / 64; C = (st & 1) * 32 + (swz % 64) / 2; }
__host__ __device__ __forceinline__ int perm32(int rho) { const int n = rho >> 4, i = rho & 15; return 8 * (i >> 2) + 4 * n + (i & 3); }

struct Unit { int pm, pn; };
struct Gemm { const bf16_t* A; const bf16_t* Bt; int M, N, K; };

struct StaticOrder {
    int nM, nN, nwg, G, c;
    __host__ __device__ void init(int M, int N, int G_, int c_) { nM = M / BM; nN = N / BM; nwg = nM * nN; G = G_; c = c_; }
    __host__ __device__ bool next(int i, Unit& u) const {
        const long L = (long)i * G + c; if (L >= nwg) return false;
        int wgid = (int)L; { const int q = nwg / NXCD, r = nwg % NXCD, xcd = wgid % NXCD, off = wgid / NXCD; wgid = (xcd < r ? xcd * (q + 1) : r * (q + 1) + (xcd - r) * q) + off; }
        const int nig = WGM * nN, gid = wgid / nig, fm = gid * WGM, gsz = (nM - fm) < WGM ? (nM - fm) : WGM;
        u.pm = fm + ((wgid % nig) % gsz); u.pn = (wgid % nig) / gsz; return true;
    }
    __device__ __forceinline__ void a_ready(const Unit&) const {}
    __device__ __forceinline__ void done(const Unit&) const {}
};
__device__ __forceinline__ unsigned cvt_pk_bf16(float lo, float hi) { unsigned r; asm volatile("v_cvt_pk_bf16_f32 %0, %1, %2" : "=v"(r) : "v"(lo), "v"(hi)); return r; }
typedef unsigned u32x4 __attribute__((ext_vector_type(4)));
struct EpiStoreBf16 {
    static constexpr bool PERM = true, AFTER_DRAIN = false;
    bf16_t* O; int ldc; int pad;
    __device__ __forceinline__ void operator()(const f32x4 (&acc)[2][2][4][2], const Unit& u, int wr, int wc, int fr, int fq) const {
        const int row0 = u.pm * BM + wr * 64 + fr, col0 = u.pn * BM + wc * 32 + 8 * fq;
#pragma unroll
        for (int ai = 0; ai < 2; ++ai)
#pragma unroll
            for (int m = 0; m < 4; ++m) { bf16_t* rowp = O + (size_t)(row0 + ai * HALF + m * 16) * ldc + col0;
#pragma unroll
                for (int bj = 0; bj < 2; ++bj) { const f32x4 v0 = acc[ai][bj][m][0], v1 = acc[ai][bj][m][1];
                    u32x4 w; w.x = cvt_pk_bf16(v0[0], v0[1]); w.y = cvt_pk_bf16(v0[2], v0[3]); w.z = cvt_pk_bf16(v1[0], v1[1]); w.w = cvt_pk_bf16(v1[2], v1[3]);
                    *(u32x4*)(rowp + bj * HALF) = w; } }
    }
};
constexpr int NTM_STACK = 68;
struct EpiMergeSeg {
    static constexpr bool PERM = true, AFTER_DRAIN = false;
    const bf16_t* Z; bf16_t* M;
    __device__ __forceinline__ void operator()(const f32x4 (&acc)[2][2][4][2], const Unit& u, int wr, int wc, int fr, int fq) const {
        const int seg = u.pn >> 2, tn = u.pn & 3, tm = u.pm - seg * NTM_STACK;
        const int row0 = tm * BM + wr * 64 + fr, col0 = tn * BM + wc * 32 + 8 * fq;
#pragma unroll
        for (int ai = 0; ai < 2; ++ai)
#pragma unroll
            for (int m = 0; m < 4; ++m) { const int row = row0 + ai * HALF + m * 16;
#pragma unroll
                for (int bj = 0; bj < 2; ++bj) { const int col = col0 + bj * HALF;
                    const u32x4 g = *(const u32x4*)(Z + (size_t)row * 5888 + 2816 + seg * 1024 + col);
                    bf16_t* mp = M + (size_t)row * 1024 + col;
                    u32x4 o = (u32x4){0u, 0u, 0u, 0u}; if (seg) o = *(const u32x4*)mp;
                    const f32x4 v0 = acc[ai][bj][m][0], v1 = acc[ai][bj][m][1];
                    u32x4 w;
                    w.x = cvt_pk_bf16(__uint_as_float(g.x << 16) * v0[0] + __uint_as_float(o.x << 16), __uint_as_float(g.x & 0xffff0000u) * v0[1] + __uint_as_float(o.x & 0xffff0000u));
                    w.y = cvt_pk_bf16(__uint_as_float(g.y << 16) * v0[2] + __uint_as_float(o.y << 16), __uint_as_float(g.y & 0xffff0000u) * v0[3] + __uint_as_float(o.y & 0xffff0000u));
                    w.z = cvt_pk_bf16(__uint_as_float(g.z << 16) * v1[0] + __uint_as_float(o.z << 16), __uint_as_float(g.z & 0xffff0000u) * v1[1] + __uint_as_float(o.z & 0xffff0000u));
                    w.w = cvt_pk_bf16(__uint_as_float(g.w << 16) * v1[2] + __uint_as_float(o.w << 16), __uint_as_float(g.w & 0xffff0000u) * v1[3] + __uint_as_float(o.w & 0xffff0000u));
                    *(u32x4*)mp = w; } }
    }
};
struct MergeOrder {
    int ntiles, G, c, pad;
    __device__ bool next(int i, Unit& u) const { const int ti = (i / 3) * G + c, seg = i % 3; if (ti >= ntiles) return false; u.pm = seg * NTM_STACK + (ti >> 2); u.pn = seg * 4 + (ti & 3); return true; }
    __device__ __forceinline__ void a_ready(const Unit&) const {}
    __device__ __forceinline__ void done(const Unit&) const {}
};
struct EpiResid {
    static constexpr bool PERM = false, AFTER_DRAIN = false;
    float* Xl; float* Xc; const float* modl; int gate_idx; int pad;
    __device__ __forceinline__ void operator()(const f32x4 (&acc)[2][2][4][2], const Unit& u, int wr, int wc, int fr, int fq) const {
        const int mrow = u.pm < 64 ? (u.pm >> 4) : 4;
        float* base = u.pm < 64 ? Xl + (size_t)u.pm * BM * 1024 : Xc + (size_t)(u.pm - 64) * BM * 1024;
        const float* gt = modl + (size_t)mrow * 6144 + gate_idx * 1024;
        const int col0 = u.pn * BM + wc * 32 + 4 * fq;
#pragma unroll
        for (int bj = 0; bj < 2; ++bj)
#pragma unroll
            for (int n = 0; n < 2; ++n) { const int col = col0 + bj * HALF + 16 * n; const f32x4 gv = *(const f32x4*)(gt + col);
#pragma unroll
                for (int ai = 0; ai < 2; ++ai)
#pragma unroll
                    for (int m = 0; m < 4; ++m) { float* xp = base + (size_t)(ai * HALF + wr * 64 + m * 16 + fr) * 1024 + col;
                        f32x4 x = *(f32x4*)xp; x = x + gv * acc[ai][bj][m][n]; *(f32x4*)xp = x; } }
    }
};
template <class Epi, class Sched, bool ALIGN_EPI = false, bool SP2 = false>
__device__ __forceinline__ void gemm_phase(PG8_LAS unsigned char* lds, const Gemm g, const Sched& S, const Epi& E) {
    const int tid = opaque_tid(), wid = __builtin_amdgcn_readfirstlane(tid >> 6), lane = tid & 63, wr = wid >> 2, wc = wid & 3, fr = lane & 15, fq = lane >> 4;
    const int K = g.K, nt = K / BK;
    unsigned voffA[2], voffB[2];
#pragma unroll
    for (int i = 0; i < 2; ++i) { int R, C; stage_rc(tid * 16 + i * 8192, R, C); const int Rb = Epi::PERM ? ((R & ~31) + perm32(R & 31)) : R;
        voffA[i] = (unsigned)(R * K + C) * 2u; voffB[i] = (unsigned)(Rb * K + C) * 2u; }
    const size_t kstep = (size_t)(BK * 2);
    const size_t hstep = (size_t)HALF * K * 2;
    const size_t tstep = 2 * hstep;
    const unsigned ldsw = (unsigned)wid * 1024u;
    const int aoff = lds_byte(wr * 64 + fr, fq * 8), boff = lds_byte(wc * 32 + fr, fq * 8);
#define PG8_SA(b, h) (((b) * 2 + (h)) * HTB)
#define PG8_SB(b, h) ((4 + (b) * 2 + (h)) * HTB)
#define PG8_STAGE(bufoff, gbase, voff) do { _Pragma("unroll") for (int _i = 0; _i < 2; ++_i) \
        __builtin_amdgcn_global_load_lds((const unsigned*)((const char*)(gbase) + (voff)[_i]), (PG8_LAS unsigned*)(lds + (bufoff) + ldsw + _i * 8192), 16, 0, 0); } while (0)
#define PG8_LDA(dst, b, h) do { _Pragma("unroll") for (int m = 0; m < 4; ++m) _Pragma("unroll") for (int k = 0; k < 2; ++k) dst[m][k] = *(const PG8_LAS bf16x8*)(lds + PG8_SA(b, h) + aoff + m * 2048 + k * 1024); } while (0)
#define PG8_LDB(dst, b, h) do { _Pragma("unroll") for (int n = 0; n < 2; ++n) _Pragma("unroll") for (int k = 0; k < 2; ++k) dst[n][k] = *(const PG8_LAS bf16x8*)(lds + PG8_SB(b, h) + boff + n * 2048 + k * 1024); } while (0)
#define PG8_MMA(ai, bj, At, Bt) do { __builtin_amdgcn_s_setprio(1); _Pragma("unroll") for (int m = 0; m < 4; ++m) _Pragma("unroll") for (int n = 0; n < 2; ++n) _Pragma("unroll") for (int k = 0; k < 2; ++k) \
        acc[ai][bj][m][n] = __builtin_amdgcn_mfma_f32_16x16x32_bf16(Bt[n][k], At[m][k], acc[ai][bj][m][n], 0, 0, 0); __builtin_amdgcn_s_setprio(0); } while (0)
#define PG8_WAIT_V(n) asm volatile("s_waitcnt vmcnt(" #n ")" ::: "memory")
#define PG8_WAIT_L(n) asm volatile("s_waitcnt lgkmcnt(" #n ")" ::: "memory")
#define PG8_BAR __builtin_amdgcn_s_barrier()
#define PG8_SCHED __builtin_amdgcn_sched_barrier(0)
    Unit cur, nxt; int ui = 0;
    if (!S.next(0, cur)) return;
    f32x4 acc[2][2][4][2];
#pragma unroll
    for (int a = 0; a < 2; ++a)
#pragma unroll
        for (int b = 0; b < 2; ++b)
#pragma unroll
            for (int m = 0; m < 4; ++m)
#pragma unroll
                for (int n = 0; n < 2; ++n) acc[a][b][m][n] = (f32x4){0.f, 0.f, 0.f, 0.f};
    bf16x8 At[4][2], B0[2][2], B1[2][2];
    const char* cA = (const char*)g.A + (size_t)cur.pm * tstep; const char* cB = (const char*)g.Bt + (size_t)cur.pn * tstep;
    S.a_ready(cur);
    if constexpr (SP2) {
        PG8_STAGE(PG8_SB(0, 0), cB, voffB); PG8_STAGE(PG8_SB(0, 1), cB + hstep, voffB); PG8_STAGE(PG8_SA(0, 0), cA, voffA); PG8_STAGE(PG8_SA(0, 1), cA + hstep, voffA);
        if (wr == 1) PG8_BAR;
        PG8_WAIT_V(2); PG8_BAR;
        PG8_STAGE(PG8_SB(1, 0), cB + kstep, voffB); PG8_STAGE(PG8_SA(1, 0), cA + kstep, voffA); PG8_STAGE(PG8_SB(1, 1), cB + hstep + kstep, voffB);
        PG8_WAIT_V(6); PG8_BAR;
    } else {
        PG8_STAGE(PG8_SB(0, 0), cB, voffB); PG8_STAGE(PG8_SA(0, 0), cA, voffA); PG8_STAGE(PG8_SB(0, 1), cB + hstep, voffB); PG8_STAGE(PG8_SA(0, 1), cA + hstep, voffA);
        if (wr == 1) PG8_BAR;
        PG8_WAIT_V(4); PG8_BAR;
        PG8_STAGE(PG8_SB(1, 0), cB + kstep, voffB); PG8_STAGE(PG8_SA(1, 0), cA + kstep, voffA); PG8_STAGE(PG8_SB(1, 1), cB + hstep + kstep, voffB);
        PG8_WAIT_V(6); PG8_BAR;
    }
    for (;;) {
        const bool has_next = S.next(ui + 1, nxt);
        const char* nA = has_next ? (const char*)g.A + (size_t)nxt.pm * tstep : cA; const char* nB = has_next ? (const char*)g.Bt + (size_t)nxt.pn * tstep : cB;
        for (int t = 0; t < nt; t += 2) {
            const bool last = (t == nt - 2);
            const char* a1 = cA + (size_t)(t + 1) * kstep;
            const char* a2 = last ? nA : cA + (size_t)(t + 2) * kstep; const char* b2 = last ? nB : cB + (size_t)(t + 2) * kstep;
            const char* a3 = a2 + kstep; const char* b3 = b2 + kstep;
            if (last && has_next) S.a_ready(nxt);
            if constexpr (SP2) {
            PG8_LDB(B0, 0, 0); PG8_LDB(B1, 0, 1); PG8_SCHED; PG8_LDA(At, 0, 0); PG8_STAGE(PG8_SA(1, 1), a1 + hstep, voffA);
            PG8_WAIT_V(8); PG8_WAIT_L(0); PG8_BAR; PG8_MMA(0, 0, At, B0); PG8_MMA(0, 1, At, B1); PG8_BAR; PG8_SCHED;
            PG8_LDA(At, 0, 1); PG8_STAGE(PG8_SB(0, 0), b2, voffB); PG8_STAGE(PG8_SB(0, 1), b2 + hstep, voffB); PG8_STAGE(PG8_SA(0, 0), a2, voffA);
            PG8_WAIT_V(8); PG8_WAIT_L(0); PG8_BAR; PG8_MMA(1, 0, At, B0); PG8_MMA(1, 1, At, B1); PG8_BAR; PG8_SCHED;
            PG8_LDB(B0, 1, 0); PG8_LDB(B1, 1, 1); PG8_SCHED; PG8_LDA(At, 1, 0); PG8_STAGE(PG8_SA(0, 1), a2 + hstep, voffA);
            PG8_WAIT_V(8); PG8_WAIT_L(0); PG8_BAR; PG8_MMA(0, 0, At, B0); PG8_MMA(0, 1, At, B1); PG8_BAR; PG8_SCHED;
            PG8_LDA(At, 1, 1); PG8_STAGE(PG8_SB(1, 0), b3, voffB); PG8_STAGE(PG8_SB(1, 1), b3 + hstep, voffB); PG8_STAGE(PG8_SA(1, 0), a3, voffA);
            PG8_WAIT_V(8); PG8_WAIT_L(0); PG8_BAR; PG8_MMA(1, 0, At, B0); PG8_MMA(1, 1, At, B1); PG8_BAR; PG8_SCHED;
            } else {
            PG8_LDB(B0, 0, 0); PG8_SCHED; PG8_LDA(At, 0, 0); PG8_STAGE(PG8_SA(1, 1), a1 + hstep, voffA);
            PG8_WAIT_L(8); PG8_BAR; PG8_WAIT_L(0); PG8_MMA(0, 0, At, B0); PG8_BAR; PG8_SCHED;
            PG8_LDB(B1, 0, 1); PG8_STAGE(PG8_SB(0, 0), b2, voffB);
            PG8_BAR; PG8_WAIT_L(0); PG8_MMA(0, 1, At, B1); PG8_BAR;
            PG8_LDA(At, 0, 1); PG8_STAGE(PG8_SA(0, 0), a2, voffA);
            PG8_BAR; PG8_WAIT_L(0); PG8_MMA(1, 0, At, B0); PG8_BAR; PG8_SCHED;
            PG8_STAGE(PG8_SB(0, 1), b2 + hstep, voffB);
            PG8_WAIT_V(6); PG8_BAR; PG8_MMA(1, 1, At, B1); PG8_BAR;
            PG8_LDB(B0, 1, 0); PG8_SCHED; PG8_LDA(At, 1, 0); PG8_STAGE(PG8_SA(0, 1), a2 + hstep, voffA);
            PG8_WAIT_L(8); PG8_BAR; PG8_WAIT_L(0); PG8_MMA(0, 0, At, B0); PG8_BAR; PG8_SCHED;
            PG8_LDB(B1, 1, 1); PG8_STAGE(PG8_SB(1, 0), b3, voffB);
            PG8_BAR; PG8_WAIT_L(0); PG8_MMA(0, 1, At, B1); PG8_BAR;
            PG8_LDA(At, 1, 1); PG8_STAGE(PG8_SA(1, 0), a3, voffA);
            PG8_BAR; PG8_WAIT_L(0); PG8_MMA(1, 0, At, B0); PG8_BAR; PG8_SCHED;
            PG8_STAGE(PG8_SB(1, 1), b3 + hstep, voffB);
            PG8_WAIT_V(6); PG8_BAR; PG8_MMA(1, 1, At, B1); PG8_BAR;
            }
        }
        if constexpr (ALIGN_EPI) { if (wr == 0) PG8_BAR; }
        if constexpr (!Epi::AFTER_DRAIN) { E(acc, cur, wr, wc, fr, fq); S.done(cur); }
        if (!has_next) break;
#pragma unroll
        for (int a = 0; a < 2; ++a)
#pragma unroll
            for (int b = 0; b < 2; ++b)
#pragma unroll
                for (int m = 0; m < 4; ++m)
#pragma unroll
                    for (int n = 0; n < 2; ++n) acc[a][b][m][n] = (f32x4){0.f, 0.f, 0.f, 0.f};
        cur = nxt; cA = nA; cB = nB; ++ui;
        if constexpr (ALIGN_EPI) { if (wr == 1) PG8_BAR; }
    }
    PG8_WAIT_V(0);
    if constexpr (!ALIGN_EPI) { if (wr == 0) PG8_BAR; }
    PG8_BAR;
    if constexpr (Epi::AFTER_DRAIN) { E.fused(acc, cur, wr, wc, fr, fq, lds, wid, lane); S.done(cur); }
#undef PG8_SA
#undef PG8_SB
#undef PG8_STAGE
#undef PG8_LDA
#undef PG8_LDB
#undef PG8_MMA
#undef PG8_WAIT_V
#undef PG8_WAIT_L
#undef PG8_BAR
#undef PG8_SCHED
}
}

struct Params {
    const float *x, *c, *ctx, *c_ctx, *ada_w, *ada_b, *norm1_g, *norm2_g, *w_in, *pool_w, *pool_scale, *na_rpb, *swa_sink, *wba, *wbb, *wbc, *w_out, *peer_wq, *peer_keys, *peer_u, *peer_v, *final_g;
    float* out; unsigned char* ws;
};
#define TID (opaque_tid())
#define BID ((int)blockIdx.x)
#define NBLK ((int)gridDim.x)

__device__ __forceinline__ void tr_tiles(const float* __restrict__ W, bf16_t* __restrict__ Wt, int K, int N, float* tile  ) {
    const int ntn = N / 64, ntiles = (K / 64) * ntn, tid = TID, c = tid & 63, r8 = tid >> 6;
    for (int vb = BID; vb < ntiles; vb += NBLK) {
        const int k0 = (vb / ntn) * 64, n0 = (vb % ntn) * 64;
#pragma unroll
        for (int i = 0; i < 8; ++i) tile[(i * 8 + r8) * 65 + c] = W[(size_t)(k0 + i * 8 + r8) * N + n0 + c];
        __syncthreads();
#pragma unroll
        for (int i = 0; i < 8; ++i) Wt[(size_t)(n0 + i * 8 + r8) * K + k0 + c] = f2bf(tile[c * 65 + i * 8 + r8]);
        __syncthreads();
    }
}
__device__ __forceinline__ void conv_bf16(const float* __restrict__ src, bf16_t* __restrict__ dst, size_t n8) {
    for (size_t i = (size_t)BID * NTHREADS + TID; i < n8; i += (size_t)NBLK * NTHREADS) {
        const float4 a = ((const float4*)src)[2 * i], b = ((const float4*)src)[2 * i + 1];
        uint4 o; o.x = pk2(a.x, a.y); o.y = pk2(a.z, a.w); o.z = pk2(b.x, b.y); o.w = pk2(b.z, b.w);
        ((uint4*)dst)[i] = o;
    }
}
__device__ __forceinline__ void copy_f4(const float* __restrict__ src, float* __restrict__ dst, size_t n4) {
    for (size_t i = (size_t)BID * NTHREADS + TID; i < n4; i += (size_t)NBLK * NTHREADS) ((float4*)dst)[i] = ((const float4*)src)[i];
}
__device__ __forceinline__ void ph_prep(const Params& p, float* smem) {
    unsigned char* ws = p.ws;
    for (int l = 0; l < 2; ++l) {
        unsigned char* wl = ws + WS_W + l * W_LAYER;
        tr_tiles(p.w_in + (size_t)l * D * IN_COLS, (bf16_t*)(wl + W_WIN), D, IN_COLS, smem);
        tr_tiles(p.wbb + (size_t)l * 512 * D, (bf16_t*)(wl + W_WB), 512, D, smem);
        tr_tiles(p.wbc + (size_t)l * 512 * D, (bf16_t*)(wl + W_WC), 512, D, smem);
        tr_tiles(p.w_out + (size_t)l * D * D, (bf16_t*)(wl + W_WO), D, D, smem);
        tr_tiles(p.peer_wq + (size_t)l * D * 2048, (bf16_t*)(wl + W_WQ), D, 2048, smem);
        {
            const float* pw = p.pool_w + (size_t)l * 4 * 128 * 128; const float* ps = p.pool_scale + l * 512; const float* wba = p.wba + (size_t)l * 512 * D; bf16_t* WaT = (bf16_t*)(wl + W_WA);
            for (int idx = BID * NTHREADS + TID; idx < 512 * D; idx += NBLK * NTHREADS) {
                const int n = idx % D, kk = idx / D, g = kk / 128, c = kk % 128;
                float acc = 0.f;
                for (int e = 0; e < 128; ++e) acc += pw[(g * 128 + c) * 128 + e] * ps[g * 128 + e] * wba[(size_t)(g * 128 + e) * D + n];
                WaT[(size_t)n * 512 + kk] = f2bf(acc);
            }
        }
        conv_bf16(p.peer_keys + (size_t)l * 8 * 2 * 128 * 128, (bf16_t*)(wl + W_KEYS), (size_t)8 * 2 * 128 * 128 / 8);
        unsigned char* tl = ws + WS_TAB + l * TAB_LAYER;
        conv_bf16(p.peer_u + (size_t)l * NEXP * D, (bf16_t*)tl, (size_t)NEXP * D / 8);
        conv_bf16(p.peer_v + (size_t)l * NEXP * D, (bf16_t*)(tl + (size_t)NEXP * D * 2), (size_t)NEXP * D / 8);
    }
    {
        float* sv = smem; float* part = smem + 5 * 1024; float* mod = (float*)(ws + WS_MOD);
        const int tid = TID, lane = tid & 63, wid = tid >> 6;
        for (int vb = BID; vb < 2 * 96; vb += NBLK) {
            const int l = vb / 96, j0 = (vb % 96) * 64;
            for (int i = tid; i < 5 * 1024; i += NTHREADS) { const int r = i >> 10, k = i & 1023; const float v = r < 4 ? p.c[r * 1024 + k] : p.c_ctx[k]; sv[i] = v / (1.f + __expf(-v)); }
            __syncthreads();
            float a0 = 0.f, a1 = 0.f, a2 = 0.f, a3 = 0.f, a4 = 0.f;
            const float* w = p.ada_w + ((size_t)l * 1024 + wid * 128) * 6144 + j0 + lane;
            for (int k = 0; k < 128; ++k) { const float xw = w[(size_t)k * 6144]; const int kk = wid * 128 + k;
                a0 += sv[kk] * xw; a1 += sv[1024 + kk] * xw; a2 += sv[2048 + kk] * xw; a3 += sv[3072 + kk] * xw; a4 += sv[4096 + kk] * xw; }
            part[(wid * 5 + 0) * 64 + lane] = a0; part[(wid * 5 + 1) * 64 + lane] = a1; part[(wid * 5 + 2) * 64 + lane] = a2; part[(wid * 5 + 3) * 64 + lane] = a3; part[(wid * 5 + 4) * 64 + lane] = a4;
            __syncthreads();
            if (tid < 320) { const int r = tid >> 6; float s = 0.f;
#pragma unroll
                for (int w8 = 0; w8 < 8; ++w8) s += part[(w8 * 5 + r) * 64 + lane];
                mod[((size_t)l * 5 + r) * 6144 + j0 + lane] = s + p.ada_b[l * 6144 + j0 + lane]; }
            __syncthreads();
        }
    }
    {
        float* tab = (float*)(ws + WS_ROPE);
        for (int i = BID * NTHREADS + TID; i < 1024; i += NBLK * NTHREADS) { const int pos = i / 16, fi = i % 16; const float inv = powf(10000.0f, -(float)fi / 16.0f), ang = (float)pos * inv; tab[i] = cosf(ang); tab[1024 + i] = sinf(ang); }
    }
    copy_f4(p.x, p.out, (size_t)T_LAT * D / 4);
    copy_f4(p.ctx, (float*)(ws + WS_XC), (size_t)T_CTX * D / 4);
}

__device__ __forceinline__ float wave_sum(float v) {
#pragma unroll
    for (int o = 32; o > 0; o >>= 1) v += __shfl_xor(v, o);
    return v;
}
__device__ __forceinline__ void ph_norm_mod(const float* __restrict__ Xl, const float* __restrict__ Xc, const float* __restrict__ g, const float* __restrict__ modl, int shift_idx, int scale_idx, bf16_t* __restrict__ H, int nrows) {
    const int lane = TID & 63, gw = BID * 8 + (TID >> 6);
    for (int row = gw; row < nrows; row += NBLK * 8) {
        const float* src = row < T_LAT ? Xl + (size_t)row * D : Xc + (size_t)(row - T_LAT) * D;
        const int mrow = row < T_LAT ? row / S : 4;
        float4 v[4]; float ss = 0.f;
#pragma unroll
        for (int i = 0; i < 4; ++i) { v[i] = ((const float4*)src)[i * 64 + lane]; ss += v[i].x * v[i].x + v[i].y * v[i].y + v[i].z * v[i].z + v[i].w * v[i].w; }
        ss = wave_sum(ss);
        const float rstd = rsqrtf(ss * (1.0f / D) + EPS);
        const float* sh = modl + (size_t)mrow * 6144 + shift_idx * 1024; const float* sc = modl + (size_t)mrow * 6144 + scale_idx * 1024;
#pragma unroll
        for (int i = 0; i < 4; ++i) { const int k = (i * 64 + lane) * 4;
            const float4 gg = *(const float4*)(g + k), s4 = *(const float4*)(sc + k), h4 = *(const float4*)(sh + k);
            uint2 w; w.x = pk2(v[i].x * rstd * gg.x * (1.f + s4.x) + h4.x, v[i].y * rstd * gg.y * (1.f + s4.y) + h4.y);
            w.y = pk2(v[i].z * rstd * gg.z * (1.f + s4.z) + h4.z, v[i].w * rstd * gg.w * (1.f + s4.w) + h4.w);
            *(uint2*)(H + (size_t)row * D + k) = w; }
    }
}
__device__ __forceinline__ void ph_final_norm(float* __restrict__ X, const float* __restrict__ g) {
    const int lane = TID & 63, gw = BID * 8 + (TID >> 6);
    for (int row = gw; row < T_LAT; row += NBLK * 8) {
        float4* src = (float4*)(X + (size_t)row * D);
        float4 v[4]; float ss = 0.f;
#pragma unroll
        for (int i = 0; i < 4; ++i) { v[i] = src[i * 64 + lane]; ss += v[i].x * v[i].x + v[i].y * v[i].y + v[i].z * v[i].z + v[i].w * v[i].w; }
        ss = wave_sum(ss);
        const float rstd = rsqrtf(ss * (1.0f / D) + EPS);
#pragma unroll
        for (int i = 0; i < 4; ++i) { const float4 gg = ((const float4*)g)[i * 64 + lane]; float4 o = v[i]; o.x *= rstd * gg.x; o.y *= rstd * gg.y; o.z *= rstd * gg.z; o.w *= rstd * gg.w; src[i * 64 + lane] = o; }
    }
}

__device__ __forceinline__ void ph_postz(bf16_t* __restrict__ Z, const float* __restrict__ tab, bf16_t* __restrict__ vtn, bf16_t* __restrict__ vtnc, bf16_t* __restrict__ vtw, bf16_t* __restrict__ vtwc, bf16_t* __restrict__ Pa, int rows) {
    const size_t gtid = (size_t)BID * NTHREADS + TID, gsz = (size_t)NBLK * NTHREADS;
    for (size_t idx = gtid; idx < (size_t)T_LAT * 320; idx += gsz) {
        const int i = (int)(idx & 15), hh = (int)((idx >> 4) & 1), hs = (int)((idx >> 5) % 10), row = (int)(idx / 320);
        const int s = row % S, pos = hh ? (s % GW) : (s / GW);
        const int colbase = (hs < 2 ? OFF_KW + hs * 64 : OFF_QW + (hs - 2) * 64) + hh * 32 + i;
        bf16_t* pz = Z + (size_t)row * IN_COLS + colbase;
        const float x1 = bf2f(pz[0]), x2 = bf2f(pz[16]);
        const float cs = tab[pos * 16 + i], sn = tab[1024 + pos * 16 + i];
        pz[0] = f2bf(x1 * cs - x2 * sn); pz[16] = f2bf(x1 * sn + x2 * cs);
    }
    for (size_t idx = gtid; idx < (size_t)rows * 384; idx += gsz) {
        const int c8 = (int)(idx % 384); const size_t row = idx / 384;
        uint4* pz = (uint4*)(Z + row * IN_COLS + OFF_G + c8 * 8);
        uint4 v = *pz; unsigned w[4] = {v.x, v.y, v.z, v.w};
#pragma unroll
        for (int j = 0; j < 4; ++j) w[j] = pk2(1.f / (1.f + __expf(-lo16(w[j]))), 1.f / (1.f + __expf(-hi16(w[j]))));
        v.x = w[0]; v.y = w[1]; v.z = w[2]; v.w = w[3]; *pz = v;
    }
    for (size_t idx = gtid; idx < (size_t)T_ALL * 640; idx += gsz) {
        const int row = (int)(idx % T_ALL), j = (int)(idx / T_ALL);
        const bool lat = row < T_LAT; const int b = lat ? row / S : (row - T_LAT) / L, t = lat ? row % S : (row - T_LAT) % L, len = lat ? S : L;
        if (j < 512) { const bf16_t v = Z[(size_t)row * IN_COLS + OFF_VN + j]; bf16_t* dst = lat ? vtn : vtnc; dst[((size_t)(b * 8 + j / 64) * 64 + (j % 64)) * len + t] = v; }
        else { const int jj = j - 512; const bf16_t v = Z[(size_t)row * IN_COLS + OFF_VW + jj]; bf16_t* dst = lat ? vtw : vtwc; dst[((size_t)(b * 2 + jj / 64) * 64 + (jj % 64)) * len + t] = v; }
    }
    for (size_t idx = gtid; idx < (size_t)rows * 512; idx += gsz) {
        const int c = (int)(idx % 512), row = (int)(idx / 512);
        const int g = c / 128, w = 2 << g;
        const bool lat = row < T_LAT; const int len = lat ? S : L; const int t = lat ? row % S : (row - T_LAT) % L; const int base = row - t;
        int lo = t - w / 2; if (lo < 0) lo = 0; int hi = t - w / 2 + w; if (hi > len) hi = len;
        float sum = 0.f;
        for (int tt = lo; tt < hi; ++tt) sum += bf2f(Z[(size_t)(base + tt) * IN_COLS + OFF_A + c]);
        Pa[(size_t)row * 512 + c] = f2bf(sum / (float)(hi - lo) - bf2f(Z[(size_t)row * IN_COLS + OFF_A + c]));
    }
}

typedef short bf16x8v __attribute__((ext_vector_type(8)));
typedef float f32x4v __attribute__((ext_vector_type(4)));
constexpr float LOG2E = 1.4426950408889634f;
constexpr float QK_SCALE2 = 0.125f * LOG2E;
constexpr float MASKED = -3.0e38f;
__device__ __forceinline__ unsigned cvtpk(float lo, float hi) { unsigned r; asm volatile("v_cvt_pk_bf16_f32 %0, %1, %2" : "=v"(r) : "v"(lo), "v"(hi)); return r; }
__device__ __forceinline__ f32x4v mfma16(bf16x8v a, bf16x8v b, f32x4v c) { return __builtin_amdgcn_mfma_f32_16x16x32_bf16(a, b, c, 0, 0, 0); }
struct AttnSt { f32x4v o[4]; float m, l; };
template <class Dsc>
__device__ __forceinline__ void attn_group(const Dsc& dsc, int c0, const bf16x8v qf0, const bf16x8v qf1, AttnSt& st, int lane) {
    f32x4v s[2][2]; bool live[2];
#pragma unroll
    for (int j = 0; j < 2; ++j) {
        live[j] = dsc.live(c0 + j);
        if (live[j]) {
#pragma unroll
            for (int tt = 0; tt < 2; ++tt) {
                const bf16_t* kp = dsc.kptr(c0 + j, tt);
                const bf16x8v a0 = *(const bf16x8v*)kp, a1 = *(const bf16x8v*)(kp + 32);
                f32x4v acc = (f32x4v){0.f, 0.f, 0.f, 0.f};
                acc = mfma16(a0, qf0, acc); acc = mfma16(a1, qf1, acc);
#pragma unroll
                for (int r = 0; r < 4; ++r) acc[r] = dsc.score(c0 + j, tt, r, acc[r]);
                s[j][tt] = acc;
            }
        } else { s[j][0] = (f32x4v){MASKED, MASKED, MASKED, MASKED}; s[j][1] = s[j][0]; }
    }
    float gmax = MASKED;
#pragma unroll
    for (int j = 0; j < 2; ++j)
#pragma unroll
        for (int tt = 0; tt < 2; ++tt)
#pragma unroll
            for (int r = 0; r < 4; ++r) gmax = fmaxf(gmax, s[j][tt][r]);
    gmax = fmaxf(gmax, __shfl_xor(gmax, 16)); gmax = fmaxf(gmax, __shfl_xor(gmax, 32));
    const float mnew = fmaxf(st.m, gmax), alpha = __builtin_amdgcn_exp2f(st.m - mnew);
    st.m = mnew;
    float psum = 0.f;
#pragma unroll
    for (int j = 0; j < 2; ++j)
#pragma unroll
        for (int tt = 0; tt < 2; ++tt)
#pragma unroll
            for (int r = 0; r < 4; ++r) { const float pv = __builtin_amdgcn_exp2f(s[j][tt][r] - mnew); s[j][tt][r] = pv; psum += pv; }
    st.l = st.l * alpha + psum;
    if (!__all(alpha == 1.0f)) {
        const int gb = (lane >> 4) * 4;
#pragma unroll
        for (int r = 0; r < 4; ++r) { const float ar = __shfl(alpha, gb + r);
#pragma unroll
            for (int dt = 0; dt < 4; ++dt) st.o[dt][r] *= ar; }
    }
#pragma unroll
    for (int j = 0; j < 2; ++j) if (live[j]) {
        union { unsigned u[4]; bf16x8v v; } pf;
        pf.u[0] = cvtpk(s[j][0][0], s[j][0][1]); pf.u[1] = cvtpk(s[j][0][2], s[j][0][3]); pf.u[2] = cvtpk(s[j][1][0], s[j][1][1]); pf.u[3] = cvtpk(s[j][1][2], s[j][1][3]);
        const bf16_t* vp = dsc.vptr(c0 + j); const size_t vs = dsc.vstride16();
#pragma unroll
        for (int dt = 0; dt < 4; ++dt) { const bf16x8v vf = *(const bf16x8v*)(vp + dt * vs); st.o[dt] = mfma16(pf.v, vf, st.o[dt]); }
    }
}
__device__ __forceinline__ void attn_finish(AttnSt& st, float sink2, bool has_sink, bf16_t* orow  , int lane) {
    float l = st.l; l += __shfl_xor(l, 16); l += __shfl_xor(l, 32);
    if (has_sink) l += __builtin_amdgcn_exp2f(sink2 - st.m);
    const float inv = 1.0f / l;
    const int gb = (lane >> 4) * 4, d = lane & 15;
#pragma unroll
    for (int r = 0; r < 4; ++r) { const float ir = __shfl(inv, gb + r);
#pragma unroll
        for (int dt = 0; dt < 4; ++dt) orow[(size_t)(gb + r) * 512 + dt * 16 + d] = f2bf(st.o[dt][r] * ir); }
}
__device__ __forceinline__ void attn_init_st(AttnSt& st) {
#pragma unroll
    for (int dt = 0; dt < 4; ++dt) st.o[dt] = (f32x4v){0.f, 0.f, 0.f, 0.f};
    st.m = -1.0e30f; st.l = 0.f;
}
__device__ __forceinline__ int clampi(int v, int lo, int hi) { return v < lo ? lo : (v > hi ? hi : v); }
struct NaLocalDsc {
    const bf16_t* kbase;
    const bf16_t* vbase;
    const float* rpb;
    int kc0, qc, qs, dr0;
    __device__ __forceinline__ bool live(int) const { return true; }
    __device__ __forceinline__ const bf16_t* kptr(int c, int tt) const { return kbase + (size_t)(c * 64 + 4 * tt) * IN_COLS; }
    __device__ __forceinline__ const bf16_t* vptr(int c) const { return vbase + c * 64; }
    __device__ __forceinline__ size_t vstride16() const { return (size_t)16 * S; }
    __device__ __forceinline__ float score(int c, int tt, int r, float raw) const {
        const int kc = kc0 + 4 * tt + r; const int dc = clampi(kc - qc + 15, 0, 30);
        const float bias = rpb[(dr0 + c) * 31 + dc];
        return (kc >= qs && kc < qs + 16) ? raw * QK_SCALE2 + bias : MASKED;
    }
};
struct CtxDsc {
    const bf16_t* kbase;
    const bf16_t* vbase;
    __device__ __forceinline__ bool live(int) const { return true; }
    __device__ __forceinline__ const bf16_t* kptr(int c, int tt) const { return kbase + (size_t)(c * 32 + 4 * tt) * IN_COLS; }
    __device__ __forceinline__ const bf16_t* vptr(int c) const { return vbase + c * 32; }
    __device__ __forceinline__ size_t vstride16() const { return (size_t)16 * L; }
    __device__ __forceinline__ float score(int, int, int, float raw) const { return raw * QK_SCALE2; }
};
struct SwaLocalDsc {
    const bf16_t* zrow;
    const bf16_t* vrow;
    int p0, kslot0, g8, qpos;
    __device__ __forceinline__ bool live(int c) const { const int pos0 = p0 - 128 + 32 * c; return c < 9 && pos0 + 31 >= 0 && pos0 < S; }
    __device__ __forceinline__ const bf16_t* kptr(int c, int tt) const { const int pos = clampi(p0 - 128 + 32 * c + kslot0 + 4 * tt, 0, S - 1); return zrow + (size_t)pos * IN_COLS; }
    __device__ __forceinline__ const bf16_t* vptr(int c) const { const int pos = clampi(p0 - 128 + 32 * c + g8, 0, S - 8); return vrow + pos; }
    __device__ __forceinline__ size_t vstride16() const { return (size_t)16 * S; }
    __device__ __forceinline__ float score(int c, int tt, int r, float raw) const {
        const int pos = p0 - 128 + 32 * c + g8 + 4 * tt + r; const int dlt = qpos - pos;
        return (pos >= 0 && pos < S && dlt <= 128 && dlt >= -128) ? raw * QK_SCALE2 : MASKED;
    }
};
__device__ __forceinline__ void ph_attn(const bf16_t* __restrict__ Z, const bf16_t* __restrict__ vtn, const bf16_t* __restrict__ vtnc, const bf16_t* __restrict__ vtw, const bf16_t* __restrict__ vtwc,
                                        const float* __restrict__ rpb, const float* __restrict__ sink, bf16_t* __restrict__ Ob, bf16_t* __restrict__ Oc, bool do_ctx, float* smem) {
    const int tid = TID, lane = tid & 63, wid = tid >> 6;
    for (int i = tid; i < 8 * 465; i += NTHREADS) smem[i] = rpb[i] * LOG2E;
    __syncthreads();
    const int q = lane & 15, g = lane >> 4, kslot0 = (q >> 2) * 8 + (q & 3);
    const int vcu = (NBLK % 8 == 0) ? (BID % 8) * (NBLK / 8) + BID / 8 : BID;
    const int nunits = 8192 + 8192 + (do_ctx ? 1024 : 0);
    for (int u = vcu * 8 + wid; u < nunits; u += NBLK * 8) {
        AttnSt st; attn_init_st(st);
        if (u < 8192) {
            const int cb = u & 3, h = (u >> 2) & 7, r = (u >> 5) & 63, b = u >> 11;
            const int R0 = clampi(r - 4, 0, 56), C0 = clampi(cb * 16 - 8, 0, 32), qc = cb * 16 + q;
            const size_t t0 = (size_t)b * S + r * GW + cb * 16;
            const bf16_t* qp = Z + (t0 + q) * IN_COLS + OFF_QN + h * 64 + 8 * g;
            const bf16x8v qf0 = *(const bf16x8v*)qp, qf1 = *(const bf16x8v*)(qp + 32);
            NaLocalDsc dl; dl.kbase = Z + ((size_t)b * S + R0 * GW + C0 + kslot0) * IN_COLS + OFF_KN + h * 64 + 8 * g;
            dl.vbase = vtn + ((size_t)(b * 8 + h) * 64 + q) * S + R0 * GW + C0 + 8 * g; dl.rpb = smem + h * 465;
            dl.kc0 = C0 + 8 * g; dl.qc = qc; dl.qs = clampi(qc - 8, 0, 48); dl.dr0 = R0 - r + 7;
#pragma unroll 1
            for (int gi = 0; gi < 4; ++gi) attn_group(dl, 2 * gi, qf0, qf1, st, lane);
            CtxDsc dc; dc.kbase = Z + ((size_t)T_LAT + b * L + kslot0) * IN_COLS + OFF_KN + h * 64 + 8 * g; dc.vbase = vtnc + ((size_t)(b * 8 + h) * 64 + q) * L + 8 * g;
#pragma unroll 1
            for (int gi = 0; gi < 4; ++gi) attn_group(dc, 2 * gi, qf0, qf1, st, lane);
            attn_finish(st, 0.f, false, Ob + t0 * 512 + h * 64, lane);
        } else if (u < 16384) {
            const int v = u - 8192, rep = v & 3, qt = (v >> 2) & 255, g2 = (v >> 10) & 1, b = v >> 11, hq = g2 * 4 + rep, p0 = qt * 16;
            const size_t t0 = (size_t)b * S + p0;
            const bf16_t* qp = Z + (t0 + q) * IN_COLS + OFF_QW + hq * 64 + 8 * g;
            const bf16x8v qf0 = *(const bf16x8v*)qp, qf1 = *(const bf16x8v*)(qp + 32);
            SwaLocalDsc dl; dl.zrow = Z + (size_t)b * S * IN_COLS + OFF_KW + g2 * 64 + 8 * g; dl.vrow = vtw + ((size_t)(b * 2 + g2) * 64 + q) * S;
            dl.p0 = p0; dl.kslot0 = kslot0; dl.g8 = 8 * g; dl.qpos = p0 + q;
#pragma unroll 1
            for (int gi = 0; gi < 5; ++gi) attn_group(dl, 2 * gi, qf0, qf1, st, lane);
            CtxDsc dc; dc.kbase = Z + ((size_t)T_LAT + b * L + kslot0) * IN_COLS + OFF_KW + g2 * 64 + 8 * g; dc.vbase = vtwc + ((size_t)(b * 2 + g2) * 64 + q) * L + 8 * g;
#pragma unroll 1
            for (int gi = 0; gi < 4; ++gi) attn_group(dc, 2 * gi, qf0, qf1, st, lane);
            attn_finish(st, sink[hq] * LOG2E, true, Oc + t0 * 512 + hq * 64, lane);
        } else {
            const int v = u - 16384, qt = v & 15, h = (v >> 4) & 7, b = (v >> 7) & 3, which = v >> 9;
            const size_t t0 = (size_t)T_LAT + b * L + qt * 16;
            const int qoff = which ? OFF_QW : OFF_QN, koff = which ? OFF_KW + (h >> 2) * 64 : OFF_KN + h * 64;
            const bf16_t* qp = Z + (t0 + q) * IN_COLS + qoff + h * 64 + 8 * g;
            const bf16x8v qf0 = *(const bf16x8v*)qp, qf1 = *(const bf16x8v*)(qp + 32);
            CtxDsc dc; dc.kbase = Z + ((size_t)T_LAT + b * L + kslot0) * IN_COLS + koff + 8 * g;
            dc.vbase = which ? vtwc + ((size_t)(b * 2 + (h >> 2)) * 64 + q) * L + 8 * g : vtnc + ((size_t)(b * 8 + h) * 64 + q) * L + 8 * g;
#pragma unroll 1
            for (int gi = 0; gi < 4; ++gi) attn_group(dc, 2 * gi, qf0, qf1, st, lane);
            attn_finish(st, which ? sink[h] * LOG2E : 0.f, which != 0, (which ? Oc : Ob) + t0 * 512 + h * 64, lane);
        }
    }
}

__device__ __forceinline__ float embed(float v, unsigned mask, unsigned code) { return __uint_as_float((__float_as_uint(v) & ~mask) | code); }
__device__ __forceinline__ float gmax4(float v) { v = fmaxf(v, __shfl_xor(v, 16)); return fmaxf(v, __shfl_xor(v, 32)); }
__device__ __forceinline__ void ph_peer_topk(const bf16_t* __restrict__ Q, const bf16_t* __restrict__ keys, int* __restrict__ eidx, float* __restrict__ egate, int rows, float* smem) {
    const int tid = TID, lane = tid & 63, wid = tid >> 6, n = lane & 15, g = lane >> 4;
    int* lidx = (int*)smem + wid * 512;
    const float NEG = -3.0e38f;
    const int nunits = (rows / 16) * 8;
    for (int u = BID * 8 + wid; u < nunits; u += NBLK * 8) {
        const int h = u & 7, t0 = (u >> 3) * 16;
        float tops[2][16];
#pragma unroll
        for (int pp = 0; pp < 2; ++pp) {
            const bf16_t* qp = Q + (size_t)(t0 + n) * 2048 + h * 256 + pp * 128 + 8 * g;
            bf16x8v qf[4];
#pragma unroll
            for (int ks = 0; ks < 4; ++ks) qf[ks] = *(const bf16x8v*)(qp + ks * 32);
            const bf16_t* kp = keys + ((size_t)(h * 2 + pp) * 128 + n) * 128 + 8 * g;
            float sc[32];
#pragma unroll
            for (int T = 0; T < 8; ++T) {
                f32x4v acc = (f32x4v){0.f, 0.f, 0.f, 0.f};
#pragma unroll
                for (int ks = 0; ks < 4; ++ks) { const bf16x8v a = *(const bf16x8v*)(kp + (size_t)T * 16 * 128 + ks * 32); acc = mfma16(a, qf[ks], acc); }
#pragma unroll
                for (int r = 0; r < 4; ++r) sc[T * 4 + r] = embed(acc[r], 127u, (unsigned)(T * 16 + 4 * g + r));
            }
#pragma unroll
            for (int rd = 0; rd < 16; ++rd) {
                float mx = sc[0];
#pragma unroll
                for (int k = 1; k < 32; ++k) mx = fmaxf(mx, sc[k]);
                mx = gmax4(mx);
                tops[pp][rd] = mx;
                if (g == 0) lidx[(n * 2 + pp) * 16 + rd] = (int)(__float_as_uint(mx) & 127u);
#pragma unroll
                for (int k = 0; k < 32; ++k) sc[k] = (sc[k] == mx) ? NEG : sc[k];
            }
        }
        float bsel[4];
#pragma unroll
        for (int jj = 0; jj < 4; ++jj) bsel[jj] = g == 0 ? tops[1][4 * jj] : (g == 1 ? tops[1][4 * jj + 1] : (g == 2 ? tops[1][4 * jj + 2] : tops[1][4 * jj + 3]));
        float cd[21];
#pragma unroll
        for (int i = 0; i < 16; ++i) cd[i] = embed(tops[0][i] + bsel[0], 255u, (unsigned)((i << 4) | g));
#pragma unroll
        for (int i = 0; i < 3; ++i) cd[16 + i] = embed(tops[0][i] + bsel[1], 255u, (unsigned)((i << 4) | 4 | g));
        cd[19] = embed(tops[0][0] + bsel[2], 255u, (unsigned)(8 | g));
        cd[20] = embed(tops[0][0] + bsel[3], 255u, (unsigned)(12 | g));
        float best[16];
#pragma unroll
        for (int rd = 0; rd < 16; ++rd) {
            float mx = cd[0];
#pragma unroll
            for (int k = 1; k < 21; ++k) mx = fmaxf(mx, cd[k]);
            mx = gmax4(mx);
            best[rd] = mx;
#pragma unroll
            for (int k = 0; k < 21; ++k) cd[k] = (cd[k] == mx) ? NEG : cd[k];
        }
        float ex[16]; float sum = 0.f;
#pragma unroll
        for (int rd = 0; rd < 16; ++rd) { ex[rd] = __builtin_amdgcn_exp2f((best[rd] - best[0]) * LOG2E); sum += ex[rd]; }
        const float inv = 1.0f / sum;
        asm volatile("s_waitcnt lgkmcnt(0)" ::: "memory");
        int eo[4]; float go[4];
#pragma unroll
        for (int rr = 0; rr < 4; ++rr) {
            const float bv = g == 0 ? best[rr] : (g == 1 ? best[4 + rr] : (g == 2 ? best[8 + rr] : best[12 + rr]));
            const float ev = g == 0 ? ex[rr] : (g == 1 ? ex[4 + rr] : (g == 2 ? ex[8 + rr] : ex[12 + rr]));
            const unsigned code = __float_as_uint(bv) & 255u;
            eo[rr] = lidx[(n * 2 + 0) * 16 + (code >> 4)] * 128 + lidx[(n * 2 + 1) * 16 + (code & 15u)];
            go[rr] = ev * inv;
        }
        const size_t o = (size_t)(t0 + n) * 128 + h * 16 + 4 * g;
        *(int4*)(eidx + o) = make_int4(eo[0], eo[1], eo[2], eo[3]);
        *(float4*)(egate + o) = make_float4(go[0], go[1], go[2], go[3]);
        asm volatile("s_waitcnt lgkmcnt(0)" ::: "memory");
    }
}
__device__ __forceinline__ void ph_peer_gather(const bf16_t* __restrict__ H, const bf16_t* __restrict__ U, const bf16_t* __restrict__ V, const int* __restrict__ eidx, const float* __restrict__ egate,
                                               const float* __restrict__ modl, float* __restrict__ Xl, float* __restrict__ Xc, int rows,
                                               int mode, const float* __restrict__ gn, const float* __restrict__ modn, bf16_t* __restrict__ Hn, float* smem) {
    const int tid = TID, lane = tid & 63, wid = tid >> 6, m = lane & 15, gk = lane >> 4;
    float* wl = smem + wid * 128;
    for (int t = BID * 8 + wid; t < rows; t += NBLK * 8) {
        const int e0 = eidx[(size_t)t * 128 + lane], e1 = eidx[(size_t)t * 128 + 64 + lane];
        const bf16_t* rp[8];
#pragma unroll
        for (int T = 0; T < 8; ++T) { const int e = __shfl(T < 4 ? e0 : e1, (T & 3) * 16 + m); rp[T] = U + (size_t)e * D + 8 * gk; }
        f32x4v acc[8];
#pragma unroll
        for (int T = 0; T < 8; ++T) acc[T] = (f32x4v){0.f, 0.f, 0.f, 0.f};
        const bf16_t* hp = H + (size_t)t * D + 8 * gk;
#pragma unroll 2
        for (int ks = 0; ks < 32; ++ks) {
            const bf16x8v hb = *(const bf16x8v*)(hp + ks * 32);
#pragma unroll
            for (int T = 0; T < 8; ++T) { const bf16x8v a = *(const bf16x8v*)(rp[T] + ks * 32); acc[T] = mfma16(a, hb, acc[T]); }
        }
        const int myT = m >> 1, r0 = (m & 1) * 2;
        float va = 0.f, vb = 0.f;
#pragma unroll
        for (int T = 0; T < 8; ++T) { const float x0 = r0 ? acc[T][2] : acc[T][0], x1 = r0 ? acc[T][3] : acc[T][1]; if (myT == T) { va = x0; vb = x1; } }
        const int ee = myT * 16 + 4 * gk + r0;
        const float2 gg = *(const float2*)(egate + (size_t)t * 128 + ee);
        float2 ww; ww.x = gg.x * 0.5f * va * (1.f + erff(va * 0.70710678118654752f)); ww.y = gg.y * 0.5f * vb * (1.f + erff(vb * 0.70710678118654752f));
        *(float2*)(wl + ee) = ww;
        asm volatile("s_waitcnt lgkmcnt(0)" ::: "memory");
        const float w0 = wl[lane], w1 = wl[64 + lane];
        asm volatile("s_waitcnt lgkmcnt(0)" ::: "memory");
        float out[16];
#pragma unroll
        for (int i = 0; i < 16; ++i) out[i] = 0.f;
        const bf16_t* vb0 = V + lane * 8;
#pragma unroll
        for (int hh = 0; hh < 2; ++hh) {
            const int ev = hh ? e1 : e0; const int wbits = __float_as_int(hh ? w1 : w0);
#pragma unroll 8
            for (int k = 0; k < 64; ++k) {
                const int e = __builtin_amdgcn_readlane(ev, k); const float w = __int_as_float(__builtin_amdgcn_readlane(wbits, k));
                const bf16_t* vp = vb0 + (size_t)e * D;
                const uint4 a = *(const uint4*)vp, b = *(const uint4*)(vp + 512);
                out[0] += w * lo16(a.x); out[1] += w * hi16(a.x); out[2] += w * lo16(a.y); out[3] += w * hi16(a.y); out[4] += w * lo16(a.z); out[5] += w * hi16(a.z); out[6] += w * lo16(a.w); out[7] += w * hi16(a.w);
                out[8] += w * lo16(b.x); out[9] += w * hi16(b.x); out[10] += w * lo16(b.y); out[11] += w * hi16(b.y); out[12] += w * lo16(b.z); out[13] += w * hi16(b.z); out[14] += w * lo16(b.w); out[15] += w * hi16(b.w);
            }
        }
        const int mrow = t < T_LAT ? t / S : 4;
        float* xp = t < T_LAT ? Xl + (size_t)t * D : Xc + (size_t)(t - T_LAT) * D;
        const float* gt = modl + (size_t)mrow * 6144 + 5 * 1024;
        float xr[16]; float ss = 0.f;
#pragma unroll
        for (int q4 = 0; q4 < 4; ++q4) { const int col = (q4 >> 1) * 512 + lane * 8 + (q4 & 1) * 4;
            const float4 x = *(const float4*)(xp + col), g4 = *(const float4*)(gt + col);
            xr[q4 * 4 + 0] = x.x + g4.x * out[q4 * 4 + 0]; xr[q4 * 4 + 1] = x.y + g4.y * out[q4 * 4 + 1]; xr[q4 * 4 + 2] = x.z + g4.z * out[q4 * 4 + 2]; xr[q4 * 4 + 3] = x.w + g4.w * out[q4 * 4 + 3];
#pragma unroll
            for (int i = 0; i < 4; ++i) ss += xr[q4 * 4 + i] * xr[q4 * 4 + i]; }
        ss = wave_sum(ss);
        const float rstd = rsqrtf(ss * (1.0f / D) + EPS);
        if (mode == 0) {
            const float* shn = modn + (size_t)mrow * 6144; const float* scn = shn + 1024;
#pragma unroll
            for (int q4 = 0; q4 < 4; ++q4) { const int col = (q4 >> 1) * 512 + lane * 8 + (q4 & 1) * 4;
                *(float4*)(xp + col) = make_float4(xr[q4 * 4], xr[q4 * 4 + 1], xr[q4 * 4 + 2], xr[q4 * 4 + 3]);
                const float4 g4 = *(const float4*)(gn + col), s4 = *(const float4*)(scn + col), h4 = *(const float4*)(shn + col);
                uint2 w; w.x = pk2(xr[q4 * 4] * rstd * g4.x * (1.f + s4.x) + h4.x, xr[q4 * 4 + 1] * rstd * g4.y * (1.f + s4.y) + h4.y);
                w.y = pk2(xr[q4 * 4 + 2] * rstd * g4.z * (1.f + s4.z) + h4.z, xr[q4 * 4 + 3] * rstd * g4.w * (1.f + s4.w) + h4.w);
                *(uint2*)(Hn + (size_t)t * D + col) = w; }
        } else {
#pragma unroll
            for (int q4 = 0; q4 < 4; ++q4) { const int col = (q4 >> 1) * 512 + lane * 8 + (q4 & 1) * 4;
                const float4 g4 = *(const float4*)(gn + col);
                *(float4*)(xp + col) = make_float4(xr[q4 * 4] * rstd * g4.x, xr[q4 * 4 + 1] * rstd * g4.y, xr[q4 * 4 + 2] * rstd * g4.z, xr[q4 * 4 + 3] * rstd * g4.w); }
        }
    }
}

__device__ __forceinline__ unsigned char* launder(unsigned char* q) { asm volatile("" : "+s"(q)); return q; }
struct WsPtrs { float *mod, *rope, *XC, *X; bf16_t *H, *Z, *vtn, *vtnc, *vtw, *vtwc, *AT; int* eidx; float* egate; unsigned char* wl; const float* modl; const bf16_t *U, *V; };
__device__ __forceinline__ WsPtrs mkptrs(const Params& p, int l) {
    unsigned char* ws = launder(p.ws); WsPtrs P;
    P.mod = (float*)(ws + WS_MOD); P.rope = (float*)(ws + WS_ROPE); P.XC = (float*)(ws + WS_XC); P.X = (float*)launder((unsigned char*)p.out);
    P.H = (bf16_t*)(ws + WS_H); P.Z = (bf16_t*)(ws + WS_Z); P.vtn = (bf16_t*)(ws + WS_VTN); P.vtnc = (bf16_t*)(ws + WS_VTNC); P.vtw = (bf16_t*)(ws + WS_VTW); P.vtwc = (bf16_t*)(ws + WS_VTWC);
    P.AT = (bf16_t*)(ws + WS_AT); P.eidx = (int*)(ws + WS_EIDX); P.egate = (float*)(ws + WS_EGATE);
    P.wl = ws + WS_W + l * W_LAYER; P.modl = P.mod + (size_t)l * 5 * 6144; P.U = (const bf16_t*)(ws + WS_TAB + l * TAB_LAYER); P.V = P.U + (size_t)NEXP * D;
    return P;
}
__global__ void __launch_bounds__(NTHREADS, 2) mega_fwd(Params p) {
    extern __shared__ __attribute__((aligned(16))) unsigned char lds[];
    cg::grid_group grid = cg::this_grid();
    PG8_LAS unsigned char* ldsr = (PG8_LAS unsigned char*)lds;
    float* smem = (float*)lds;

    ph_prep(p, smem);
    grid.sync();
#pragma unroll 1
    for (int l = 0; l < 2; ++l) {
        const bool last = (l == 1);
        const int rows = last ? T_LAT : T_ALL;
        if (l == 0) { const WsPtrs P = mkptrs(p, l); ph_norm_mod(P.X, P.XC, p.norm1_g, P.modl, 0, 1, P.H, T_ALL); grid.sync(); }
        {
            const WsPtrs P = mkptrs(p, l);
            pg8::EpiStoreBf16 E{P.Z, IN_COLS, 0};
            if (!last) { pg8::Gemm g{P.H, (const bf16_t*)(P.wl + W_WIN), T_ALL, IN_COLS, D}; pg8::StaticOrder So; So.init(T_ALL, IN_COLS, NBLK, BID);
                pg8::gemm_phase<pg8::EpiStoreBf16, pg8::StaticOrder, true, true>(ldsr, g, So, E); }
            else { pg8::Gemm g{P.H, (const bf16_t*)(P.wl + W_WIN), T_LAT, IN_COLS, D}; pg8::StaticOrder So; So.init(T_LAT, IN_COLS, NBLK, BID);
                pg8::gemm_phase<pg8::EpiStoreBf16, pg8::StaticOrder, true, true>(ldsr, g, So, E);
                const WsPtrs P2 = mkptrs(p, l);
                pg8::EpiStoreBf16 E2{P2.Z + (size_t)T_LAT * IN_COLS, IN_COLS, 0};
                pg8::Gemm g2{P2.H + (size_t)T_LAT * D, (const bf16_t*)(P2.wl + W_WIN), T_CTX, CTX_KV_COLS, D}; pg8::StaticOrder S2; S2.init(T_CTX, CTX_KV_COLS, NBLK, BID);
                pg8::gemm_phase<pg8::EpiStoreBf16, pg8::StaticOrder, true, true>(ldsr, g2, S2, E2); }
        }
        grid.sync();
        { const WsPtrs P = mkptrs(p, l); ph_postz(P.Z, P.rope, P.vtn, P.vtnc, P.vtw, P.vtwc, P.AT, rows); }
        grid.sync();
        { const WsPtrs P = mkptrs(p, l); ph_attn(P.Z, P.vtn, P.vtnc, P.vtw, P.vtwc, p.na_rpb + (size_t)l * 8 * 15 * 31, p.swa_sink + l * 8, P.AT + (size_t)T_ALL * 512, P.AT + (size_t)2 * T_ALL * 512, !last, smem); }
        grid.sync();
        {
            const WsPtrs P = mkptrs(p, l);
            pg8::Gemm g{P.AT, (const bf16_t*)(P.wl + W_WA), 3 * T_ALL, 3 * D, 512}; pg8::MergeOrder Mo{(rows / 256) * 4, NBLK, BID, 0}; pg8::EpiMergeSeg E{P.Z, P.H};
            pg8::gemm_phase<pg8::EpiMergeSeg, pg8::MergeOrder, false, true>(ldsr, g, Mo, E);
        }
        grid.sync();
        {
            const WsPtrs P = mkptrs(p, l);
            pg8::Gemm g{P.H, (const bf16_t*)(P.wl + W_WO), rows, D, D}; pg8::StaticOrder So; So.init(rows, D, NBLK, BID); pg8::EpiResid E{P.X, P.XC, P.modl, 2, 0};
            pg8::gemm_phase<pg8::EpiResid, pg8::StaticOrder, true, true>(ldsr, g, So, E);
        }
        grid.sync();
        { const WsPtrs P = mkptrs(p, l); ph_norm_mod(P.X, P.XC, p.norm2_g + l * D, P.modl, 3, 4, P.H, rows); }
        grid.sync();
        {   const WsPtrs P = mkptrs(p, l);
            pg8::Gemm g{P.H, (const bf16_t*)(P.wl + W_WQ), rows, 2048, D}; pg8::StaticOrder So; So.init(rows, 2048, NBLK, BID); pg8::EpiStoreBf16 E{P.Z, 2048, 0};
            pg8::gemm_phase<pg8::EpiStoreBf16, pg8::StaticOrder, true, true>(ldsr, g, So, E);
        }
        grid.sync();
        { const WsPtrs P = mkptrs(p, l); ph_peer_topk(P.Z, (const bf16_t*)(P.wl + W_KEYS), P.eidx, P.egate, rows, smem); }
        grid.sync();
        { const WsPtrs P = mkptrs(p, l); ph_peer_gather(P.H, P.U, P.V, P.eidx, P.egate, P.modl, P.X, P.XC, rows, last ? 1 : 0, last ? p.final_g : p.norm1_g + D, P.modl + 5 * 6144, P.H, smem); }
        grid.sync();
    }
}

extern "C" void kernel_launch(void* const* d_in, const int* in_sizes, int n_in, void* d_out, int out_size, void* d_ws, size_t ws_size, hipStream_t stream) {
    static int grid_blocks = 0;
    if (grid_blocks == 0) {
        if (ws_size < WS_END || n_in != 22) { fprintf(stderr, "kernel_launch: workspace %zu < %zu or n_in %d != 22\n", ws_size, (size_t)WS_END, n_in); grid_blocks = -1; return; }
        int dev = 0, cus = 0, per_cu = 0;
        (void)hipGetDevice(&dev); (void)hipDeviceGetAttribute(&cus, hipDeviceAttributeMultiprocessorCount, dev);
        if (hipFuncSetAttribute((const void*)mega_fwd, hipFuncAttributeMaxDynamicSharedMemorySize, LDS_BYTES) != hipSuccess) { fprintf(stderr, "kernel_launch: hipFuncSetAttribute failed\n"); grid_blocks = -1; return; }
        if (hipOccupancyMaxActiveBlocksPerMultiprocessor(&per_cu, (const void*)mega_fwd, NTHREADS, LDS_BYTES) != hipSuccess || per_cu < 1) { fprintf(stderr, "kernel_launch: occupancy query says %d\n", per_cu); per_cu = 1; }
        (void)hipGetLastError();
        grid_blocks = cus * 1;
        fprintf(stderr, "kernel_launch: %d CUs, occupancy query %d per CU, grid %d\n", cus, per_cu, grid_blocks);
    }
    if (grid_blocks < 0) return;
    Params p{};
    p.x = (const float*)d_in[0]; p.c = (const float*)d_in[1]; p.ctx = (const float*)d_in[2]; p.c_ctx = (const float*)d_in[3]; p.ada_w = (const float*)d_in[4]; p.ada_b = (const float*)d_in[5];
    p.norm1_g = (const float*)d_in[6]; p.norm2_g = (const float*)d_in[7]; p.w_in = (const float*)d_in[8]; p.pool_w = (const float*)d_in[9]; p.pool_scale = (const float*)d_in[10]; p.na_rpb = (const float*)d_in[11];
    p.swa_sink = (const float*)d_in[12]; p.wba = (const float*)d_in[13]; p.wbb = (const float*)d_in[14]; p.wbc = (const float*)d_in[15]; p.w_out = (const float*)d_in[16]; p.peer_wq = (const float*)d_in[17];
    p.peer_keys = (const float*)d_in[18]; p.peer_u = (const float*)d_in[19]; p.peer_v = (const float*)d_in[20]; p.final_g = (const float*)d_in[21];
    p.out = (float*)d_out; p.ws = (unsigned char*)d_ws;
    void* args[] = {&p};
    const hipError_t e = hipLaunchCooperativeKernel((const void*)mega_fwd, dim3(grid_blocks), dim3(NTHREADS), args, LDS_BYTES, stream);
    if (e != hipSuccess) fprintf(stderr, "kernel_launch: cooperative launch failed: %s (grid %d)\n", hipGetErrorString(e), grid_blocks);
}
```

```cpp
#include <hip/hip_runtime.h>
#include <hip/hip_cooperative_groups.h>
#include <stdint.h>
#include <stdio.h>
namespace cg = cooperative_groups;

typedef unsigned short bf16_t;

constexpr int D = 1024, NB = 4, S = 4096, L = 256, GW = 64;
constexpr int T_LAT = NB * S, T_CTX = NB * L, T_ALL = T_LAT + T_CTX;
constexpr int IN_COLS = 5888;
constexpr int OFF_KN = 0, OFF_VN = 512, OFF_KW = 1024, OFF_VW = 1152, CTX_KV_COLS = 1280, OFF_QN = 1280, OFF_QW = 1792, OFF_A = 2304, OFF_G = 2816;
constexpr int NEXP = 16384;
constexpr float EPS = 1e-6f;
constexpr int NTHREADS = 512;
constexpr int LDS_BYTES = 147456;

constexpr size_t al256(size_t x) { return (x + 255) & ~(size_t)255; }
constexpr size_t WS_MOD = 0;
constexpr size_t WS_ROPE = al256(WS_MOD + 2 * 5 * 6144 * 4);
constexpr size_t WS_XC = al256(WS_ROPE + 2 * 64 * 16 * 4);
constexpr size_t WS_H = al256(WS_XC + (size_t)T_CTX * D * 4);
constexpr size_t WS_Z = al256(WS_H + (size_t)T_ALL * D * 2);
constexpr size_t WS_VTN = al256(WS_Z + (size_t)T_ALL * IN_COLS * 2);
constexpr size_t WS_VTNC = al256(WS_VTN + (size_t)NB * 8 * 64 * S * 2);
constexpr size_t WS_VTW = al256(WS_VTNC + (size_t)NB * 8 * 64 * L * 2);
constexpr size_t WS_VTWC = al256(WS_VTW + (size_t)NB * 2 * 64 * S * 2);
constexpr size_t WS_AT = al256(WS_VTWC + (size_t)NB * 2 * 64 * L * 2);
constexpr size_t WS_EIDX = al256(WS_AT + (size_t)3 * T_ALL * 512 * 2);
constexpr size_t WS_EGATE = al256(WS_EIDX + (size_t)T_ALL * 128 * 4);
constexpr size_t WS_W = al256(WS_EGATE + (size_t)T_ALL * 128 * 4);
constexpr size_t W_WIN = 0;
constexpr size_t W_WA = W_WIN + (size_t)IN_COLS * D * 2;
constexpr size_t W_WB = W_WA + (size_t)D * 512 * 2;
constexpr size_t W_WC = W_WB + (size_t)D * 512 * 2;
constexpr size_t W_WO = W_WC + (size_t)D * 512 * 2;
constexpr size_t W_WQ = W_WO + (size_t)D * D * 2;
constexpr size_t W_KEYS = W_WQ + (size_t)2048 * D * 2;
constexpr size_t W_LAYER = al256(W_KEYS + (size_t)8 * 2 * 128 * 128 * 2);
constexpr size_t WS_TAB = al256(WS_W + 2 * W_LAYER);
constexpr size_t TAB_LAYER = (size_t)2 * NEXP * D * 2;
constexpr size_t WS_END = WS_TAB + 2 * TAB_LAYER;

__device__ __forceinline__ float bf2f(bf16_t v) { return __uint_as_float((unsigned)v << 16); }
__device__ __forceinline__ bf16_t f2bf(float f) { unsigned u = __float_as_uint(f); u += 0x7fffu + ((u >> 16) & 1u); return (bf16_t)(u >> 16); }
__device__ __forceinline__ unsigned pk2(float lo, float hi) { return (unsigned)f2bf(lo) | ((unsigned)f2bf(hi) << 16); }
__device__ __forceinline__ float lo16(unsigned w) { return __uint_as_float(w << 16); }
__device__ __forceinline__ float hi16(unsigned w) { return __uint_as_float(w & 0xffff0000u); }

__device__ __forceinline__ int opaque_tid() { int t = threadIdx.x; asm volatile("" : "+v"(t)); return t; }
namespace pg8 {
#define PG8_LAS __attribute__((address_space(3)))
typedef unsigned short bf16_t;
typedef short bf16x8 __attribute__((ext_vector_type(8)));
typedef float f32x4 __attribute__((ext_vector_type(4)));
typedef unsigned u32x4 __attribute__((ext_vector_type(4)));
constexpr int BM = 256, BK = 64, HALF = 128, HTB = HALF * BK * 2  , STAGE_BYTES = 8 * HTB, NXCD = 8, WGM = 8;

__host__ __device__ __forceinline__ int lds_byte(int r, int c) { const int st = (r >> 4) * 2 + (c >> 5), rr = r & 15, cc = c & 31, ob = rr * 64 + cc * 2; return st * 1024 + (ob ^ (((ob >> 9) & 1) << 5)); }
__host__ __device__ __forceinline__ void stage_rc(int b, int& R, int& C) { const int st = b / 1024, sb = b % 1024, swz = sb ^ (((sb >> 9) & 1) << 5); R = (st >> 1) * 16 + swz / 64; C = (st & 1) * 32 + (swz % 64) / 2; }
__host__ __device__ __forceinline__ int perm32(int rho) { const int n = rho >> 4, i = rho & 15; return 8 * (i >> 2) + 4 * n + (i & 3); }

struct Unit { int pm, pn; };
struct Gemm { const bf16_t* A; const bf16_t* Bt; int M, N, K; };

struct StaticOrder {
    int nM, nN, nwg, G, c;
    __host__ __device__ void init(int M, int N, int G_, int c_) { nM = M / BM; nN = N / BM; nwg = nM * nN; G = G_; c = c_; }
    __host__ __device__ bool next(int i, Unit& u) const {
        const long L = (long)i * G + c; if (L >= nwg) return false;
        int wgid = (int)L; { const int q = nwg / NXCD, r = nwg % NXCD, xcd = wgid % NXCD, off = wgid / NXCD; wgid = (xcd < r ? xcd * (q + 1) : r * (q + 1) + (xcd - r) * q) + off; }
        const int nig = WGM * nN, gid = wgid / nig, fm = gid * WGM, gsz = (nM - fm) < WGM ? (nM - fm) : WGM;
        u.pm = fm + ((wgid % nig) % gsz); u.pn = (wgid % nig) / gsz; return true;
    }
    __device__ __forceinline__ void a_ready(const Unit&) const {}
    __device__ __forceinline__ void done(const Unit&) const {}
};
__device__ __forceinline__ unsigned cvt_pk_bf16(float lo, float hi) { unsigned r; asm volatile("v_cvt_pk_bf16_f32 %0, %1, %2" : "=v"(r) : "v"(lo), "v"(hi)); return r; }
typedef unsigned u32x4 __attribute__((ext_vector_type(4)));
struct EpiStoreBf16 {
    static constexpr bool PERM = true, AFTER_DRAIN = false;
    bf16_t* O; int ldc; int pad;
    __device__ __forceinline__ void operator()(const f32x4 (&acc)[2][2][4][2], const Unit& u, int wr, int wc, int fr, int fq) const {
        const int row0 = u.pm * BM + wr * 64 + fr, col0 = u.pn * BM + wc * 32 + 8 * fq;
#pragma unroll
        for (int ai = 0; ai < 2; ++ai)
#pragma unroll
            for (int m = 0; m < 4; ++m) { bf16_t* rowp = O + (size_t)(row0 + ai * HALF + m * 16) * ldc + col0;
#pragma unroll
                for (int bj = 0; bj < 2; ++bj) { const f32x4 v0 = acc[ai][bj][m][0], v1 = acc[ai][bj][m][1];
                    u32x4 w; w.x = cvt_pk_bf16(v0[0], v0[1]); w.y = cvt_pk_bf16(v0[2], v0[3]); w.z = cvt_pk_bf16(v1[0], v1[1]); w.w = cvt_pk_bf16(v1[2], v1[3]);
                    *(u32x4*)(rowp + bj * HALF) = w; } }
    }
};

struct EpiZ {
    static constexpr bool PERM = true, AFTER_DRAIN = false;
    bf16_t* Z; const float* rope; bf16_t *vtn, *vtnc, *vtw, *vtwc; int row_base; int pad;
    __device__ __forceinline__ void operator()(const f32x4 (&acc)[2][2][4][2], const Unit& u, int wr, int wc, int fr, int fq) const {
        const int grow0 = row_base + u.pm * BM;
        const bool lat = grow0 < 16384;
        const int b = lat ? (grow0 >> 12) : ((grow0 - 16384) >> 8), len = lat ? 4096 : 256;
        const int tpos0 = (lat ? (grow0 & 4095) : ((grow0 - 16384) & 255)) + wr * 64 + fr;
#pragma unroll
        for (int bj = 0; bj < 2; ++bj) {
            const int cb = 2 * u.pn + bj;
            const int col0 = cb * 128 + wc * 32 + 8 * fq;
            if ((cb >= 4 && cb < 8) || cb == 9) {
                const int cl = wc * 32 + 8 * fq;
                bf16_t* dst;
                if (cb == 9) dst = (lat ? vtw : vtwc) + ((size_t)(b * 2 + (cl >> 6)) * 64 + (cl & 63)) * len + tpos0;
                else dst = (lat ? vtn : vtnc) + ((size_t)(b * 8 + (cb - 4) * 2 + (cl >> 6)) * 64 + (cl & 63)) * len + tpos0;
#pragma unroll
                for (int ai = 0; ai < 2; ++ai)
#pragma unroll
                    for (int m = 0; m < 4; ++m) { bf16_t* dp = dst + ai * HALF + m * 16;
#pragma unroll
                        for (int n = 0; n < 2; ++n)
#pragma unroll
                            for (int i = 0; i < 4; ++i) { const unsigned w = cvt_pk_bf16(acc[ai][bj][m][n][i], 0.f); dp[(size_t)(4 * n + i) * len] = (bf16_t)(w & 0xffffu); } }
            } else {
                const bool is_rope = lat && (cb == 8 || (cb >= 14 && cb < 18));
                const bool is_gate = cb >= 22;
#pragma unroll
                for (int ai = 0; ai < 2; ++ai)
#pragma unroll
                    for (int m = 0; m < 4; ++m) {
                        f32x4 v0 = acc[ai][bj][m][0], v1 = acc[ai][bj][m][1];
                        if (is_gate) {
#pragma unroll
                            for (int i = 0; i < 4; ++i) { v0[i] = __builtin_amdgcn_rcpf(1.f + __builtin_amdgcn_exp2f(-1.4426950408889634f * v0[i])); v1[i] = __builtin_amdgcn_rcpf(1.f + __builtin_amdgcn_exp2f(-1.4426950408889634f * v1[i])); }
                        } else if (is_rope) {
                            const int tp = tpos0 + ai * HALF + m * 16;
                            const int pos = (wc & 1) ? (tp & 63) : (tp >> 6);
                            const float* tb = rope + pos * 16 + 8 * (fq & 1);
                            const f32x4 c0 = *(const f32x4*)tb, c1 = *(const f32x4*)(tb + 4), s0 = *(const f32x4*)(tb + 1024), s1 = *(const f32x4*)(tb + 1028);
                            f32x4 p0, p1;
#pragma unroll
                            for (int i = 0; i < 4; ++i) { p0[i] = __shfl_xor(v0[i], 32); p1[i] = __shfl_xor(v1[i], 32); }
                            if (fq < 2) { v0 = v0 * c0 - p0 * s0; v1 = v1 * c1 - p1 * s1; }
                            else { v0 = p0 * s0 + v0 * c0; v1 = p1 * s1 + v1 * c1; }
                        }
                        u32x4 w; w.x = cvt_pk_bf16(v0[0], v0[1]); w.y = cvt_pk_bf16(v0[2], v0[3]); w.z = cvt_pk_bf16(v1[0], v1[1]); w.w = cvt_pk_bf16(v1[2], v1[3]);
                        *(u32x4*)(Z + (size_t)(grow0 + ai * HALF + wr * 64 + m * 16 + fr) * 5888 + col0) = w;
                    }
            }
        }
    }
};
constexpr int NTM_STACK = 68;
struct EpiMergeSeg {
    static constexpr bool PERM = true, AFTER_DRAIN = false;
    const bf16_t* Z; bf16_t* M;
    __device__ __forceinline__ void operator()(const f32x4 (&acc)[2][2][4][2], const Unit& u, int wr, int wc, int fr, int fq) const {
        const int seg = u.pn >> 2, tn = u.pn & 3, tm = u.pm - seg * NTM_STACK;
        const int row0 = tm * BM + wr * 64 + fr, col0 = tn * BM + wc * 32 + 8 * fq;
#pragma unroll
        for (int ai = 0; ai < 2; ++ai)
#pragma unroll
            for (int m = 0; m < 4; ++m) { const int row = row0 + ai * HALF + m * 16;
#pragma unroll
                for (int bj = 0; bj < 2; ++bj) { const int col = col0 + bj * HALF;
                    const u32x4 g = *(const u32x4*)(Z + (size_t)row * 5888 + 2816 + seg * 1024 + col);
                    bf16_t* mp = M + (size_t)row * 1024 + col;
                    u32x4 o = (u32x4){0u, 0u, 0u, 0u}; if (seg) o = *(const u32x4*)mp;
                    const f32x4 v0 = acc[ai][bj][m][0], v1 = acc[ai][bj][m][1];
                    u32x4 w;
                    w.x = cvt_pk_bf16(__uint_as_float(g.x << 16) * v0[0] + __uint_as_float(o.x << 16), __uint_as_float(g.x & 0xffff0000u) * v0[1] + __uint_as_float(o.x & 0xffff0000u));
                    w.y = cvt_pk_bf16(__uint_as_float(g.y << 16) * v0[2] + __uint_as_float(o.y << 16), __uint_as_float(g.y & 0xffff0000u) * v0[3] + __uint_as_float(o.y & 0xffff0000u));
                    w.z = cvt_pk_bf16(__uint_as_float(g.z << 16) * v1[0] + __uint_as_float(o.z << 16), __uint_as_float(g.z & 0xffff0000u) * v1[1] + __uint_as_float(o.z & 0xffff0000u));
                    w.w = cvt_pk_bf16(__uint_as_float(g.w << 16) * v1[2] + __uint_as_float(o.w << 16), __uint_as_float(g.w & 0xffff0000u) * v1[3] + __uint_as_float(o.w & 0xffff0000u));
                    *(u32x4*)mp = w; } }
    }
};
struct MergeOrder {
    int ntiles, G, c, pad;
    __device__ bool next(int i, Unit& u) const { const int ti = (i / 3) * G + c, seg = i % 3; if (ti >= ntiles) return false; u.pm = seg * NTM_STACK + (ti >> 2); u.pn = seg * 4 + (ti & 3); return true; }
    __device__ __forceinline__ void a_ready(const Unit&) const {}
    __device__ __forceinline__ void done(const Unit&) const {}
};
struct EpiResid {
    static constexpr bool PERM = false, AFTER_DRAIN = false;
    float* Xl; float* Xc; const float* modl; int gate_idx; int pad;
    __device__ __forceinline__ void operator()(const f32x4 (&acc)[2][2][4][2], const Unit& u, int wr, int wc, int fr, int fq) const {
        const int mrow = u.pm < 64 ? (u.pm >> 4) : 4;
        float* base = u.pm < 64 ? Xl + (size_t)u.pm * BM * 1024 : Xc + (size_t)(u.pm - 64) * BM * 1024;
        const float* gt = modl + (size_t)mrow * 6144 + gate_idx * 1024;
        const int col0 = u.pn * BM + wc * 32 + 4 * fq;
#pragma unroll
        for (int bj = 0; bj < 2; ++bj)
#pragma unroll
            for (int n = 0; n < 2; ++n) { const int col = col0 + bj * HALF + 16 * n; const f32x4 gv = *(const f32x4*)(gt + col);
#pragma unroll
                for (int ai = 0; ai < 2; ++ai)
#pragma unroll
                    for (int m = 0; m < 4; ++m) { float* xp = base + (size_t)(ai * HALF + wr * 64 + m * 16 + fr) * 1024 + col;
                        f32x4 x = *(f32x4*)xp; x = x + gv * acc[ai][bj][m][n]; *(f32x4*)xp = x; } }
    }
};
template <class Epi, class Sched, bool ALIGN_EPI = false, bool SP2 = false>
__device__ __forceinline__ void gemm_phase(PG8_LAS unsigned char* lds, const Gemm g, const Sched& S, const Epi& E) {
    const int tid = opaque_tid(), wid = __builtin_amdgcn_readfirstlane(tid >> 6), lane = tid & 63, wr = wid >> 2, wc = wid & 3, fr = lane & 15, fq = lane >> 4;
    const int K = g.K, nt = K / BK;
    unsigned voffA[2], voffB[2];
#pragma unroll
    for (int i = 0; i < 2; ++i) { int R, C; stage_rc(tid * 16 + i * 8192, R, C); const int Rb = Epi::PERM ? ((R & ~31) + perm32(R & 31)) : R;
        voffA[i] = (unsigned)(R * K + C) * 2u; voffB[i] = (unsigned)(Rb * K + C) * 2u; }
    const size_t kstep = (size_t)(BK * 2);
    const size_t hstep = (size_t)HALF * K * 2;
    const size_t tstep = 2 * hstep;
    const unsigned ldsw = (unsigned)wid * 1024u;
    const int aoff = lds_byte(wr * 64 + fr, fq * 8), boff = lds_byte(wc * 32 + fr, fq * 8);
#define PG8_SA(b, h) (((b) * 2 + (h)) * HTB)
#define PG8_SB(b, h) ((4 + (b) * 2 + (h)) * HTB)
#define PG8_STAGE(bufoff, gbase, voff) do { _Pragma("unroll") for (int _i = 0; _i < 2; ++_i) \
        __builtin_amdgcn_global_load_lds((const unsigned*)((const char*)(gbase) + (voff)[_i]), (PG8_LAS unsigned*)(lds + (bufoff) + ldsw + _i * 8192), 16, 0, 0); } while (0)
#define PG8_LDA(dst, b, h) do { _Pragma("unroll") for (int m = 0; m < 4; ++m) _Pragma("unroll") for (int k = 0; k < 2; ++k) dst[m][k] = *(const PG8_LAS bf16x8*)(lds + PG8_SA(b, h) + aoff + m * 2048 + k * 1024); } while (0)
#define PG8_LDB(dst, b, h) do { _Pragma("unroll") for (int n = 0; n < 2; ++n) _Pragma("unroll") for (int k = 0; k < 2; ++k) dst[n][k] = *(const PG8_LAS bf16x8*)(lds + PG8_SB(b, h) + boff + n * 2048 + k * 1024); } while (0)
#define PG8_MMA(ai, bj, At, Bt) do { __builtin_amdgcn_s_setprio(1); _Pragma("unroll") for (int m = 0; m < 4; ++m) _Pragma("unroll") for (int n = 0; n < 2; ++n) _Pragma("unroll") for (int k = 0; k < 2; ++k) \
        acc[ai][bj][m][n] = __builtin_amdgcn_mfma_f32_16x16x32_bf16(Bt[n][k], At[m][k], acc[ai][bj][m][n], 0, 0, 0); __builtin_amdgcn_s_setprio(0); } while (0)
#define PG8_WAIT_V(n) asm volatile("s_waitcnt vmcnt(" #n ")" ::: "memory")
#define PG8_WAIT_L(n) asm volatile("s_waitcnt lgkmcnt(" #n ")" ::: "memory")
#define PG8_BAR __builtin_amdgcn_s_barrier()
#define PG8_SCHED __builtin_amdgcn_sched_barrier(0)
    Unit cur, nxt; int ui = 0;
    if (!S.next(0, cur)) return;
    f32x4 acc[2][2][4][2];
#pragma unroll
    for (int a = 0; a < 2; ++a)
#pragma unroll
        for (int b = 0; b < 2; ++b)
#pragma unroll
            for (int m = 0; m < 4; ++m)
#pragma unroll
                for (int n = 0; n < 2; ++n) acc[a][b][m][n] = (f32x4){0.f, 0.f, 0.f, 0.f};
    bf16x8 At[4][2], B0[2][2], B1[2][2];
    const char* cA = (const char*)g.A + (size_t)cur.pm * tstep; const char* cB = (const char*)g.Bt + (size_t)cur.pn * tstep;
    S.a_ready(cur);
    if constexpr (SP2) {
        PG8_STAGE(PG8_SB(0, 0), cB, voffB); PG8_STAGE(PG8_SB(0, 1), cB + hstep, voffB); PG8_STAGE(PG8_SA(0, 0), cA, voffA); PG8_STAGE(PG8_SA(0, 1), cA + hstep, voffA);
        if (wr == 1) PG8_BAR;
        PG8_WAIT_V(2); PG8_BAR;
        PG8_STAGE(PG8_SB(1, 0), cB + kstep, voffB); PG8_STAGE(PG8_SA(1, 0), cA + kstep, voffA); PG8_STAGE(PG8_SB(1, 1), cB + hstep + kstep, voffB);
        PG8_WAIT_V(6); PG8_BAR;
    } else {
        PG8_STAGE(PG8_SB(0, 0), cB, voffB); PG8_STAGE(PG8_SA(0, 0), cA, voffA); PG8_STAGE(PG8_SB(0, 1), cB + hstep, voffB); PG8_STAGE(PG8_SA(0, 1), cA + hstep, voffA);
        if (wr == 1) PG8_BAR;
        PG8_WAIT_V(4); PG8_BAR;
        PG8_STAGE(PG8_SB(1, 0), cB + kstep, voffB); PG8_STAGE(PG8_SA(1, 0), cA + kstep, voffA); PG8_STAGE(PG8_SB(1, 1), cB + hstep + kstep, voffB);
        PG8_WAIT_V(6); PG8_BAR;
    }
    for (;;) {
        const bool has_next = S.next(ui + 1, nxt);
        const char* nA = has_next ? (const char*)g.A + (size_t)nxt.pm * tstep : cA; const char* nB = has_next ? (const char*)g.Bt + (size_t)nxt.pn * tstep : cB;
        for (int t = 0; t < nt; t += 2) {
            const bool last = (t == nt - 2);
            const char* a1 = cA + (size_t)(t + 1) * kstep;
            const char* a2 = last ? nA : cA + (size_t)(t + 2) * kstep; const char* b2 = last ? nB : cB + (size_t)(t + 2) * kstep;
            const char* a3 = a2 + kstep; const char* b3 = b2 + kstep;
            if (last && has_next) S.a_ready(nxt);
            if constexpr (SP2) {
            PG8_LDB(B0, 0, 0); PG8_LDB(B1, 0, 1); PG8_SCHED; PG8_LDA(At, 0, 0); PG8_STAGE(PG8_SA(1, 1), a1 + hstep, voffA);
            PG8_WAIT_V(8); PG8_WAIT_L(0); PG8_BAR; PG8_MMA(0, 0, At, B0); PG8_MMA(0, 1, At, B1); PG8_BAR; PG8_SCHED;
            PG8_LDA(At, 0, 1); PG8_STAGE(PG8_SB(0, 0), b2, voffB); PG8_STAGE(PG8_SB(0, 1), b2 + hstep, voffB); PG8_STAGE(PG8_SA(0, 0), a2, voffA);
            PG8_WAIT_V(8); PG8_WAIT_L(0); PG8_BAR; PG8_MMA(1, 0, At, B0); PG8_MMA(1, 1, At, B1); PG8_BAR; PG8_SCHED;
            PG8_LDB(B0, 1, 0); PG8_LDB(B1, 1, 1); PG8_SCHED; PG8_LDA(At, 1, 0); PG8_STAGE(PG8_SA(0, 1), a2 + hstep, voffA);
            PG8_WAIT_V(8); PG8_WAIT_L(0); PG8_BAR; PG8_MMA(0, 0, At, B0); PG8_MMA(0, 1, At, B1); PG8_BAR; PG8_SCHED;
            PG8_LDA(At, 1, 1); PG8_STAGE(PG8_SB(1, 0), b3, voffB); PG8_STAGE(PG8_SB(1, 1), b3 + hstep, voffB); PG8_STAGE(PG8_SA(1, 0), a3, voffA);
            PG8_WAIT_V(8); PG8_WAIT_L(0); PG8_BAR; PG8_MMA(1, 0, At, B0); PG8_MMA(1, 1, At, B1); PG8_BAR; PG8_SCHED;
            } else {
            PG8_LDB(B0, 0, 0); PG8_SCHED; PG8_LDA(At, 0, 0); PG8_STAGE(PG8_SA(1, 1), a1 + hstep, voffA);
            PG8_WAIT_L(8); PG8_BAR; PG8_WAIT_L(0); PG8_MMA(0, 0, At, B0); PG8_BAR; PG8_SCHED;
            PG8_LDB(B1, 0, 1); PG8_STAGE(PG8_SB(0, 0), b2, voffB);
            PG8_BAR; PG8_WAIT_L(0); PG8_MMA(0, 1, At, B1); PG8_BAR;
            PG8_LDA(At, 0, 1); PG8_STAGE(PG8_SA(0, 0), a2, voffA);
            PG8_BAR; PG8_WAIT_L(0); PG8_MMA(1, 0, At, B0); PG8_BAR; PG8_SCHED;
            PG8_STAGE(PG8_SB(0, 1), b2 + hstep, voffB);
            PG8_WAIT_V(6); PG8_BAR; PG8_MMA(1, 1, At, B1); PG8_BAR;
            PG8_LDB(B0, 1, 0); PG8_SCHED; PG8_LDA(At, 1, 0); PG8_STAGE(PG8_SA(0, 1), a2 + hstep, voffA);
            PG8_WAIT_L(8); PG8_BAR; PG8_WAIT_L(0); PG8_MMA(0, 0, At, B0); PG8_BAR; PG8_SCHED;
            PG8_LDB(B1, 1, 1); PG8_STAGE(PG8_SB(1, 0), b3, voffB);
            PG8_BAR; PG8_WAIT_L(0); PG8_MMA(0, 1, At, B1); PG8_BAR;
            PG8_LDA(At, 1, 1); PG8_STAGE(PG8_SA(1, 0), a3, voffA);
            PG8_BAR; PG8_WAIT_L(0); PG8_MMA(1, 0, At, B0); PG8_BAR; PG8_SCHED;
            PG8_STAGE(PG8_SB(1, 1), b3 + hstep, voffB);
            PG8_WAIT_V(6); PG8_BAR; PG8_MMA(1, 1, At, B1); PG8_BAR;
            }
        }
        if constexpr (ALIGN_EPI) { if (wr == 0) PG8_BAR; }
        if constexpr (!Epi::AFTER_DRAIN) { E(acc, cur, wr, wc, fr, fq); S.done(cur); }
        if (!has_next) break;
#pragma unroll
        for (int a = 0; a < 2; ++a)
#pragma unroll
            for (int b = 0; b < 2; ++b)
#pragma unroll
                for (int m = 0; m < 4; ++m)
#pragma unroll
                    for (int n = 0; n < 2; ++n) acc[a][b][m][n] = (f32x4){0.f, 0.f, 0.f, 0.f};
        cur = nxt; cA = nA; cB = nB; ++ui;
        if constexpr (ALIGN_EPI) { if (wr == 1) PG8_BAR; }
    }
    PG8_WAIT_V(0);
    if constexpr (!ALIGN_EPI) { if (wr == 0) PG8_BAR; }
    PG8_BAR;
    if constexpr (Epi::AFTER_DRAIN) { E.fused(acc, cur, wr, wc, fr, fq, lds, wid, lane); S.done(cur); }
#undef PG8_SA
#undef PG8_SB
#undef PG8_STAGE
#undef PG8_LDA
#undef PG8_LDB
#undef PG8_MMA
#undef PG8_WAIT_V
#undef PG8_WAIT_L
#undef PG8_BAR
#undef PG8_SCHED
}
}

struct Params {
    const float *x, *c, *ctx, *c_ctx, *ada_w, *ada_b, *norm1_g, *norm2_g, *w_in, *pool_w, *pool_scale, *na_rpb, *swa_sink, *wba, *wbb, *wbc, *w_out, *peer_wq, *peer_keys, *peer_u, *peer_v, *final_g;
    float* out; unsigned char* ws;
};
#define TID (opaque_tid())
#define BID ((int)blockIdx.x)
#define NBLK ((int)gridDim.x)

__device__ __forceinline__ void tr_tiles(const float* __restrict__ W, bf16_t* __restrict__ Wt, int K, int N, float* tile  ) {
    const int ntn = N / 64, ntiles = (K / 64) * ntn, tid = TID, c = tid & 63, r8 = tid >> 6;
    for (int vb = BID; vb < ntiles; vb += NBLK) {
        const int k0 = (vb / ntn) * 64, n0 = (vb % ntn) * 64;
#pragma unroll
        for (int i = 0; i < 8; ++i) tile[(i * 8 + r8) * 65 + c] = W[(size_t)(k0 + i * 8 + r8) * N + n0 + c];
        __syncthreads();
#pragma unroll
        for (int i = 0; i < 8; ++i) Wt[(size_t)(n0 + i * 8 + r8) * K + k0 + c] = f2bf(tile[c * 65 + i * 8 + r8]);
        __syncthreads();
    }
}
__device__ __forceinline__ void conv_bf16(const float* __restrict__ src, bf16_t* __restrict__ dst, size_t n8) {
    for (size_t i = (size_t)BID * NTHREADS + TID; i < n8; i += (size_t)NBLK * NTHREADS) {
        const float4 a = ((const float4*)src)[2 * i], b = ((const float4*)src)[2 * i + 1];
        uint4 o; o.x = pk2(a.x, a.y); o.y = pk2(a.z, a.w); o.z = pk2(b.x, b.y); o.w = pk2(b.z, b.w);
        ((uint4*)dst)[i] = o;
    }
}
__device__ __forceinline__ void copy_f4(const float* __restrict__ src, float* __restrict__ dst, size_t n4) {
    for (size_t i = (size_t)BID * NTHREADS + TID; i < n4; i += (size_t)NBLK * NTHREADS) ((float4*)dst)[i] = ((const float4*)src)[i];
}
__device__ __forceinline__ void ph_prep(const Params& p, float* smem) {
    unsigned char* ws = p.ws;
    for (int l = 0; l < 2; ++l) {
        unsigned char* wl = ws + WS_W + l * W_LAYER;
        tr_tiles(p.w_in + (size_t)l * D * IN_COLS, (bf16_t*)(wl + W_WIN), D, IN_COLS, smem);
        tr_tiles(p.wbb + (size_t)l * 512 * D, (bf16_t*)(wl + W_WB), 512, D, smem);
        tr_tiles(p.wbc + (size_t)l * 512 * D, (bf16_t*)(wl + W_WC), 512, D, smem);
        tr_tiles(p.w_out + (size_t)l * D * D, (bf16_t*)(wl + W_WO), D, D, smem);
        tr_tiles(p.peer_wq + (size_t)l * D * 2048, (bf16_t*)(wl + W_WQ), D, 2048, smem);
        {
            const float* pw = p.pool_w + (size_t)l * 4 * 128 * 128; const float* ps = p.pool_scale + l * 512; const float* wba = p.wba + (size_t)l * 512 * D; bf16_t* WaT = (bf16_t*)(wl + W_WA);
            for (int idx = BID * NTHREADS + TID; idx < 512 * D; idx += NBLK * NTHREADS) {
                const int n = idx % D, kk = idx / D, g = kk / 128, c = kk % 128;
                float acc = 0.f;
                for (int e = 0; e < 128; ++e) acc += pw[(g * 128 + c) * 128 + e] * ps[g * 128 + e] * wba[(size_t)(g * 128 + e) * D + n];
                WaT[(size_t)n * 512 + kk] = f2bf(acc);
            }
        }
        conv_bf16(p.peer_keys + (size_t)l * 8 * 2 * 128 * 128, (bf16_t*)(wl + W_KEYS), (size_t)8 * 2 * 128 * 128 / 8);
        unsigned char* tl = ws + WS_TAB + l * TAB_LAYER;
        conv_bf16(p.peer_u + (size_t)l * NEXP * D, (bf16_t*)tl, (size_t)NEXP * D / 8);
        conv_bf16(p.peer_v + (size_t)l * NEXP * D, (bf16_t*)(tl + (size_t)NEXP * D * 2), (size_t)NEXP * D / 8);
    }
    {
        float* sv = smem; float* part = smem + 5 * 1024; float* mod = (float*)(ws + WS_MOD);
        const int tid = TID, lane = tid & 63, wid = tid >> 6;
        for (int vb = BID; vb < 2 * 96; vb += NBLK) {
            const int l = vb / 96, j0 = (vb % 96) * 64;
            for (int i = tid; i < 5 * 1024; i += NTHREADS) { const int r = i >> 10, k = i & 1023; const float v = r < 4 ? p.c[r * 1024 + k] : p.c_ctx[k]; sv[i] = v / (1.f + __expf(-v)); }
            __syncthreads();
            float a0 = 0.f, a1 = 0.f, a2 = 0.f, a3 = 0.f, a4 = 0.f;
            const float* w = p.ada_w + ((size_t)l * 1024 + wid * 128) * 6144 + j0 + lane;
            for (int k = 0; k < 128; ++k) { const float xw = w[(size_t)k * 6144]; const int kk = wid * 128 + k;
                a0 += sv[kk] * xw; a1 += sv[1024 + kk] * xw; a2 += sv[2048 + kk] * xw; a3 += sv[3072 + kk] * xw; a4 += sv[4096 + kk] * xw; }
            part[(wid * 5 + 0) * 64 + lane] = a0; part[(wid * 5 + 1) * 64 + lane] = a1; part[(wid * 5 + 2) * 64 + lane] = a2; part[(wid * 5 + 3) * 64 + lane] = a3; part[(wid * 5 + 4) * 64 + lane] = a4;
            __syncthreads();
            if (tid < 320) { const int r = tid >> 6; float s = 0.f;
#pragma unroll
                for (int w8 = 0; w8 < 8; ++w8) s += part[(w8 * 5 + r) * 64 + lane];
                mod[((size_t)l * 5 + r) * 6144 + j0 + lane] = s + p.ada_b[l * 6144 + j0 + lane]; }
            __syncthreads();
        }
    }
    {
        float* tab = (float*)(ws + WS_ROPE);
        for (int i = BID * NTHREADS + TID; i < 1024; i += NBLK * NTHREADS) { const int pos = i / 16, fi = i % 16; const float inv = powf(10000.0f, -(float)fi / 16.0f), ang = (float)pos * inv; tab[i] = cosf(ang); tab[1024 + i] = sinf(ang); }
    }
    copy_f4(p.x, p.out, (size_t)T_LAT * D / 4);
    copy_f4(p.ctx, (float*)(ws + WS_XC), (size_t)T_CTX * D / 4);
}

__device__ __forceinline__ float wave_sum(float v) {
#pragma unroll
    for (int o = 32; o > 0; o >>= 1) v += __shfl_xor(v, o);
    return v;
}
__device__ __forceinline__ void ph_norm_mod(const float* __restrict__ Xl, const float* __restrict__ Xc, const float* __restrict__ g, const float* __restrict__ modl, int shift_idx, int scale_idx, bf16_t* __restrict__ H, int nrows) {
    const int lane = TID & 63, gw = BID * 8 + (TID >> 6);
    for (int row = gw; row < nrows; row += NBLK * 8) {
        const float* src = row < T_LAT ? Xl + (size_t)row * D : Xc + (size_t)(row - T_LAT) * D;
        const int mrow = row < T_LAT ? row / S : 4;
        float4 v[4]; float ss = 0.f;
#pragma unroll
        for (int i = 0; i < 4; ++i) { v[i] = ((const float4*)src)[i * 64 + lane]; ss += v[i].x * v[i].x + v[i].y * v[i].y + v[i].z * v[i].z + v[i].w * v[i].w; }
        ss = wave_sum(ss);
        const float rstd = rsqrtf(ss * (1.0f / D) + EPS);
        const float* sh = modl + (size_t)mrow * 6144 + shift_idx * 1024; const float* sc = modl + (size_t)mrow * 6144 + scale_idx * 1024;
#pragma unroll
        for (int i = 0; i < 4; ++i) { const int k = (i * 64 + lane) * 4;
            const float4 gg = *(const float4*)(g + k), s4 = *(const float4*)(sc + k), h4 = *(const float4*)(sh + k);
            uint2 w; w.x = pk2(v[i].x * rstd * gg.x * (1.f + s4.x) + h4.x, v[i].y * rstd * gg.y * (1.f + s4.y) + h4.y);
            w.y = pk2(v[i].z * rstd * gg.z * (1.f + s4.z) + h4.z, v[i].w * rstd * gg.w * (1.f + s4.w) + h4.w);
            *(uint2*)(H + (size_t)row * D + k) = w; }
    }
}
__device__ __forceinline__ void ph_final_norm(float* __restrict__ X, const float* __restrict__ g) {
    const int lane = TID & 63, gw = BID * 8 + (TID >> 6);
    for (int row = gw; row < T_LAT; row += NBLK * 8) {
        float4* src = (float4*)(X + (size_t)row * D);
        float4 v[4]; float ss = 0.f;
#pragma unroll
        for (int i = 0; i < 4; ++i) { v[i] = src[i * 64 + lane]; ss += v[i].x * v[i].x + v[i].y * v[i].y + v[i].z * v[i].z + v[i].w * v[i].w; }
        ss = wave_sum(ss);
        const float rstd = rsqrtf(ss * (1.0f / D) + EPS);
#pragma unroll
        for (int i = 0; i < 4; ++i) { const float4 gg = ((const float4*)g)[i * 64 + lane]; float4 o = v[i]; o.x *= rstd * gg.x; o.y *= rstd * gg.y; o.z *= rstd * gg.z; o.w *= rstd * gg.w; src[i * 64 + lane] = o; }
    }
}

__device__ __forceinline__ void ph_postz(bf16_t* __restrict__ Z, const float* __restrict__ tab, bf16_t* __restrict__ vtn, bf16_t* __restrict__ vtnc, bf16_t* __restrict__ vtw, bf16_t* __restrict__ vtwc, bf16_t* __restrict__ Pa, int rows) {
    const size_t gtid = (size_t)BID * NTHREADS + TID, gsz = (size_t)NBLK * NTHREADS;
    for (size_t idx = gtid; idx < (size_t)T_LAT * 320; idx += gsz) {
        const int i = (int)(idx & 15), hh = (int)((idx >> 4) & 1), hs = (int)((idx >> 5) % 10), row = (int)(idx / 320);
        const int s = row % S, pos = hh ? (s % GW) : (s / GW);
        const int colbase = (hs < 2 ? OFF_KW + hs * 64 : OFF_QW + (hs - 2) * 64) + hh * 32 + i;
        bf16_t* pz = Z + (size_t)row * IN_COLS + colbase;
        const float x1 = bf2f(pz[0]), x2 = bf2f(pz[16]);
        const float cs = tab[pos * 16 + i], sn = tab[1024 + pos * 16 + i];
        pz[0] = f2bf(x1 * cs - x2 * sn); pz[16] = f2bf(x1 * sn + x2 * cs);
    }
    for (size_t idx = gtid; idx < (size_t)rows * 384; idx += gsz) {
        const int c8 = (int)(idx % 384); const size_t row = idx / 384;
        uint4* pz = (uint4*)(Z + row * IN_COLS + OFF_G + c8 * 8);
        uint4 v = *pz; unsigned w[4] = {v.x, v.y, v.z, v.w};
#pragma unroll
        for (int j = 0; j < 4; ++j) w[j] = pk2(1.f / (1.f + __expf(-lo16(w[j]))), 1.f / (1.f + __expf(-hi16(w[j]))));
        v.x = w[0]; v.y = w[1]; v.z = w[2]; v.w = w[3]; *pz = v;
    }
    for (size_t idx = gtid; idx < (size_t)T_ALL * 640; idx += gsz) {
        const int row = (int)(idx % T_ALL), j = (int)(idx / T_ALL);
        const bool lat = row < T_LAT; const int b = lat ? row / S : (row - T_LAT) / L, t = lat ? row % S : (row - T_LAT) % L, len = lat ? S : L;
        if (j < 512) { const bf16_t v = Z[(size_t)row * IN_COLS + OFF_VN + j]; bf16_t* dst = lat ? vtn : vtnc; dst[((size_t)(b * 8 + j / 64) * 64 + (j % 64)) * len + t] = v; }
        else { const int jj = j - 512; const bf16_t v = Z[(size_t)row * IN_COLS + OFF_VW + jj]; bf16_t* dst = lat ? vtw : vtwc; dst[((size_t)(b * 2 + jj / 64) * 64 + (jj % 64)) * len + t] = v; }
    }
    for (size_t idx = gtid; idx < (size_t)rows * 512; idx += gsz) {
        const int c = (int)(idx % 512), row = (int)(idx / 512);
        const int g = c / 128, w = 2 << g;
        const bool lat = row < T_LAT; const int len = lat ? S : L; const int t = lat ? row % S : (row - T_LAT) % L; const int base = row - t;
        int lo = t - w / 2; if (lo < 0) lo = 0; int hi = t - w / 2 + w; if (hi > len) hi = len;
        float sum = 0.f;
        for (int tt = lo; tt < hi; ++tt) sum += bf2f(Z[(size_t)(base + tt) * IN_COLS + OFF_A + c]);
        Pa[(size_t)row * 512 + c] = f2bf(sum / (float)(hi - lo) - bf2f(Z[(size_t)row * IN_COLS + OFF_A + c]));
    }
}

__device__ __forceinline__ void ph_pool(const bf16_t* __restrict__ Z, bf16_t* __restrict__ Pa, int rows, int tid) {
    for (int idx = BID * NTHREADS + tid; idx < rows * 64; idx += NBLK * NTHREADS) {
        const int c8 = idx & 63, row = idx >> 6, g = c8 >> 4, w = 2 << g;
        const bool lat = row < T_LAT; const int len = lat ? S : L; const int t = lat ? (row & (S - 1)) : ((row - T_LAT) & (L - 1)); const int base = row - t;
        int lo = t - w / 2; if (lo < 0) lo = 0; int hi = t - w / 2 + w; if (hi > len) hi = len;
        float sum[8];
#pragma unroll
        for (int i = 0; i < 8; ++i) sum[i] = 0.f;
        const bf16_t* zp = Z + (size_t)base * IN_COLS + OFF_A + c8 * 8;
        for (int tt = lo; tt < hi; ++tt) { const uint4 v = *(const uint4*)(zp + (size_t)tt * IN_COLS);
            sum[0] += lo16(v.x); sum[1] += hi16(v.x); sum[2] += lo16(v.y); sum[3] += hi16(v.y); sum[4] += lo16(v.z); sum[5] += hi16(v.z); sum[6] += lo16(v.w); sum[7] += hi16(v.w); }
        const uint4 sv = *(const uint4*)(zp + (size_t)t * IN_COLS); const float inv = 1.f / (float)(hi - lo);
        uint4 o; o.x = pk2(sum[0] * inv - lo16(sv.x), sum[1] * inv - hi16(sv.x)); o.y = pk2(sum[2] * inv - lo16(sv.y), sum[3] * inv - hi16(sv.y));
        o.z = pk2(sum[4] * inv - lo16(sv.z), sum[5] * inv - hi16(sv.z)); o.w = pk2(sum[6] * inv - lo16(sv.w), sum[7] * inv - hi16(sv.w));
        *(uint4*)(Pa + (size_t)row * 512 + c8 * 8) = o;
    }
}
typedef short bf16x8v __attribute__((ext_vector_type(8)));
typedef float f32x4v __attribute__((ext_vector_type(4)));
constexpr float LOG2E = 1.4426950408889634f;
constexpr float QK_SCALE2 = 0.125f * LOG2E;
constexpr float MASKED = -3.0e38f;
__device__ __forceinline__ unsigned cvtpk(float lo, float hi) { unsigned r; asm volatile("v_cvt_pk_bf16_f32 %0, %1, %2" : "=v"(r) : "v"(lo), "v"(hi)); return r; }
__device__ __forceinline__ f32x4v mfma16(bf16x8v a, bf16x8v b, f32x4v c) { return __builtin_amdgcn_mfma_f32_16x16x32_bf16(a, b, c, 0, 0, 0); }
struct AttnSt { f32x4v o[4]; float m, l; };
template <class Dsc>
__device__ __forceinline__ void attn_group(const Dsc& dsc, int c0, const bf16x8v qf0, const bf16x8v qf1, AttnSt& st, int lane) {
    f32x4v s[2][2]; bool live[2];
#pragma unroll
    for (int j = 0; j < 2; ++j) {
        live[j] = dsc.live(c0 + j);
        if (live[j]) {
#pragma unroll
            for (int tt = 0; tt < 2; ++tt) {
                const bf16_t* kp = dsc.kptr(c0 + j, tt);
                const bf16x8v a0 = *(const bf16x8v*)kp, a1 = *(const bf16x8v*)(kp + 32);
                f32x4v acc = (f32x4v){0.f, 0.f, 0.f, 0.f};
                acc = mfma16(a0, qf0, acc); acc = mfma16(a1, qf1, acc);
#pragma unroll
                for (int r = 0; r < 4; ++r) acc[r] = dsc.score(c0 + j, tt, r, acc[r]);
                s[j][tt] = acc;
            }
        } else { s[j][0] = (f32x4v){MASKED, MASKED, MASKED, MASKED}; s[j][1] = s[j][0]; }
    }
    float gmax = MASKED;
#pragma unroll
    for (int j = 0; j < 2; ++j)
#pragma unroll
        for (int tt = 0; tt < 2; ++tt)
#pragma unroll
            for (int r = 0; r < 4; ++r) gmax = fmaxf(gmax, s[j][tt][r]);
    gmax = fmaxf(gmax, __shfl_xor(gmax, 16)); gmax = fmaxf(gmax, __shfl_xor(gmax, 32));
    const float mnew = fmaxf(st.m, gmax), alpha = __builtin_amdgcn_exp2f(st.m - mnew);
    st.m = mnew;
    float psum = 0.f;
#pragma unroll
    for (int j = 0; j < 2; ++j)
#pragma unroll
        for (int tt = 0; tt < 2; ++tt)
#pragma unroll
            for (int r = 0; r < 4; ++r) { const float pv = __builtin_amdgcn_exp2f(s[j][tt][r] - mnew); s[j][tt][r] = pv; psum += pv; }
    st.l = st.l * alpha + psum;
    if (!__all(alpha == 1.0f)) {
        const int gb = (lane >> 4) * 4;
#pragma unroll
        for (int r = 0; r < 4; ++r) { const float ar = __shfl(alpha, gb + r);
#pragma unroll
            for (int dt = 0; dt < 4; ++dt) st.o[dt][r] *= ar; }
    }
#pragma unroll
    for (int j = 0; j < 2; ++j) if (live[j]) {
        union { unsigned u[4]; bf16x8v v; } pf;
        pf.u[0] = cvtpk(s[j][0][0], s[j][0][1]); pf.u[1] = cvtpk(s[j][0][2], s[j][0][3]); pf.u[2] = cvtpk(s[j][1][0], s[j][1][1]); pf.u[3] = cvtpk(s[j][1][2], s[j][1][3]);
        const bf16_t* vp = dsc.vptr(c0 + j); const size_t vs = dsc.vstride16();
#pragma unroll
        for (int dt = 0; dt < 4; ++dt) { const bf16x8v vf = *(const bf16x8v*)(vp + dt * vs); st.o[dt] = mfma16(pf.v, vf, st.o[dt]); }
    }
}
__device__ __forceinline__ void attn_finish(AttnSt& st, float sink2, bool has_sink, bf16_t* orow  , int lane) {
    float l = st.l; l += __shfl_xor(l, 16); l += __shfl_xor(l, 32);
    if (has_sink) l += __builtin_amdgcn_exp2f(sink2 - st.m);
    const float inv = 1.0f / l;
    const int gb = (lane >> 4) * 4, d = lane & 15;
#pragma unroll
    for (int r = 0; r < 4; ++r) { const float ir = __shfl(inv, gb + r);
#pragma unroll
        for (int dt = 0; dt < 4; ++dt) orow[(size_t)(gb + r) * 512 + dt * 16 + d] = f2bf(st.o[dt][r] * ir); }
}
__device__ __forceinline__ void attn_init_st(AttnSt& st) {
#pragma unroll
    for (int dt = 0; dt < 4; ++dt) st.o[dt] = (f32x4v){0.f, 0.f, 0.f, 0.f};
    st.m = -1.0e30f; st.l = 0.f;
}
__device__ __forceinline__ int clampi(int v, int lo, int hi) { return v < lo ? lo : (v > hi ? hi : v); }
struct NaLocalDsc {
    const bf16_t* kbase;
    const bf16_t* vbase;
    const float* rpb;
    int kc0, qc, qs, dr0;
    __device__ __forceinline__ bool live(int) const { return true; }
    __device__ __forceinline__ const bf16_t* kptr(int c, int tt) const { return kbase + (size_t)(c * 64 + 4 * tt) * IN_COLS; }
    __device__ __forceinline__ const bf16_t* vptr(int c) const { return vbase + c * 64; }
    __device__ __forceinline__ size_t vstride16() const { return (size_t)16 * S; }
    __device__ __forceinline__ float score(int c, int tt, int r, float raw) const {
        const int kc = kc0 + 4 * tt + r; const int dc = clampi(kc - qc + 15, 0, 30);
        const float bias = rpb[(dr0 + c) * 31 + dc];
        return (kc >= qs && kc < qs + 16) ? raw * QK_SCALE2 + bias : MASKED;
    }
};
struct CtxDsc {
    const bf16_t* kbase;
    const bf16_t* vbase;
    __device__ __forceinline__ bool live(int) const { return true; }
    __device__ __forceinline__ const bf16_t* kptr(int c, int tt) const { return kbase + (size_t)(c * 32 + 4 * tt) * IN_COLS; }
    __device__ __forceinline__ const bf16_t* vptr(int c) const { return vbase + c * 32; }
    __device__ __forceinline__ size_t vstride16() const { return (size_t)16 * L; }
    __device__ __forceinline__ float score(int, int, int, float raw) const { return raw * QK_SCALE2; }
};
struct SwaLocalDsc {
    const bf16_t* zrow;
    const bf16_t* vrow;
    int p0, kslot0, g8, qpos;
    __device__ __forceinline__ bool live(int c) const { const int pos0 = p0 - 128 + 32 * c; return c < 9 && pos0 + 31 >= 0 && pos0 < S; }
    __device__ __forceinline__ const bf16_t* kptr(int c, int tt) const { const int pos = clampi(p0 - 128 + 32 * c + kslot0 + 4 * tt, 0, S - 1); return zrow + (size_t)pos * IN_COLS; }
    __device__ __forceinline__ const bf16_t* vptr(int c) const { const int pos = clampi(p0 - 128 + 32 * c + g8, 0, S - 8); return vrow + pos; }
    __device__ __forceinline__ size_t vstride16() const { return (size_t)16 * S; }
    __device__ __forceinline__ float score(int c, int tt, int r, float raw) const {
        const int pos = p0 - 128 + 32 * c + g8 + 4 * tt + r; const int dlt = qpos - pos;
        return (pos >= 0 && pos < S && dlt <= 128 && dlt >= -128) ? raw * QK_SCALE2 : MASKED;
    }
};
__device__ __forceinline__ void ph_attn(const bf16_t* __restrict__ Z, const bf16_t* __restrict__ vtn, const bf16_t* __restrict__ vtnc, const bf16_t* __restrict__ vtw, const bf16_t* __restrict__ vtwc,
                                        const float* __restrict__ rpb, const float* __restrict__ sink, bf16_t* __restrict__ Ob, bf16_t* __restrict__ Oc, bool do_ctx, float* smem, bf16_t* __restrict__ Pa, int rows) {
    const int tid = TID, lane = tid & 63, wid = tid >> 6;
    for (int i = tid; i < 8 * 465; i += NTHREADS) smem[i] = rpb[i] * LOG2E;
    ph_pool(Z, Pa, rows, tid);
    __syncthreads();
    const int q = lane & 15, g = lane >> 4, kslot0 = (q >> 2) * 8 + (q & 3);
    const int vcu = (NBLK % 8 == 0) ? (BID % 8) * (NBLK / 8) + BID / 8 : BID;
    const int nunits = 8192 + 8192 + (do_ctx ? 1024 : 0);
    for (int u = vcu * 8 + wid; u < nunits; u += NBLK * 8) {
        AttnSt st; attn_init_st(st);
        if (u < 8192) {
            const int cb = u & 3, h = (u >> 2) & 7, r = (u >> 5) & 63, b = u >> 11;
            const int R0 = clampi(r - 4, 0, 56), C0 = clampi(cb * 16 - 8, 0, 32), qc = cb * 16 + q;
            const size_t t0 = (size_t)b * S + r * GW + cb * 16;
            const bf16_t* qp = Z + (t0 + q) * IN_COLS + OFF_QN + h * 64 + 8 * g;
            const bf16x8v qf0 = *(const bf16x8v*)qp, qf1 = *(const bf16x8v*)(qp + 32);
            NaLocalDsc dl; dl.kbase = Z + ((size_t)b * S + R0 * GW + C0 + kslot0) * IN_COLS + OFF_KN + h * 64 + 8 * g;
            dl.vbase = vtn + ((size_t)(b * 8 + h) * 64 + q) * S + R0 * GW + C0 + 8 * g; dl.rpb = smem + h * 465;
            dl.kc0 = C0 + 8 * g; dl.qc = qc; dl.qs = clampi(qc - 8, 0, 48); dl.dr0 = R0 - r + 7;
#pragma unroll 1
            for (int gi = 0; gi < 4; ++gi) attn_group(dl, 2 * gi, qf0, qf1, st, lane);
            CtxDsc dc; dc.kbase = Z + ((size_t)T_LAT + b * L + kslot0) * IN_COLS + OFF_KN + h * 64 + 8 * g; dc.vbase = vtnc + ((size_t)(b * 8 + h) * 64 + q) * L + 8 * g;
#pragma unroll 1
            for (int gi = 0; gi < 4; ++gi) attn_group(dc, 2 * gi, qf0, qf1, st, lane);
            attn_finish(st, 0.f, false, Ob + t0 * 512 + h * 64, lane);
        } else if (u < 16384) {
            const int v = u - 8192, rep = v & 3, qt = (v >> 2) & 255, g2 = (v >> 10) & 1, b = v >> 11, hq = g2 * 4 + rep, p0 = qt * 16;
            const size_t t0 = (size_t)b * S + p0;
            const bf16_t* qp = Z + (t0 + q) * IN_COLS + OFF_QW + hq * 64 + 8 * g;
            const bf16x8v qf0 = *(const bf16x8v*)qp, qf1 = *(const bf16x8v*)(qp + 32);
            SwaLocalDsc dl; dl.zrow = Z + (size_t)b * S * IN_COLS + OFF_KW + g2 * 64 + 8 * g; dl.vrow = vtw + ((size_t)(b * 2 + g2) * 64 + q) * S;
            dl.p0 = p0; dl.kslot0 = kslot0; dl.g8 = 8 * g; dl.qpos = p0 + q;
#pragma unroll 1
            for (int gi = 0; gi < 5; ++gi) attn_group(dl, 2 * gi, qf0, qf1, st, lane);
            CtxDsc dc; dc.kbase = Z + ((size_t)T_LAT + b * L + kslot0) * IN_COLS + OFF_KW + g2 * 64 + 8 * g; dc.vbase = vtwc + ((size_t)(b * 2 + g2) * 64 + q) * L + 8 * g;
#pragma unroll 1
            for (int gi = 0; gi < 4; ++gi) attn_group(dc, 2 * gi, qf0, qf1, st, lane);
            attn_finish(st, sink[hq] * LOG2E, true, Oc + t0 * 512 + hq * 64, lane);
        } else {
            const int v = u - 16384, qt = v & 15, h = (v >> 4) & 7, b = (v >> 7) & 3, which = v >> 9;
            const size_t t0 = (size_t)T_LAT + b * L + qt * 16;
            const int qoff = which ? OFF_QW : OFF_QN, koff = which ? OFF_KW + (h >> 2) * 64 : OFF_KN + h * 64;
            const bf16_t* qp = Z + (t0 + q) * IN_COLS + qoff + h * 64 + 8 * g;
            const bf16x8v qf0 = *(const bf16x8v*)qp, qf1 = *(const bf16x8v*)(qp + 32);
            CtxDsc dc; dc.kbase = Z + ((size_t)T_LAT + b * L + kslot0) * IN_COLS + koff + 8 * g;
            dc.vbase = which ? vtwc + ((size_t)(b * 2 + (h >> 2)) * 64 + q) * L + 8 * g : vtnc + ((size_t)(b * 8 + h) * 64 + q) * L + 8 * g;
#pragma unroll 1
            for (int gi = 0; gi < 4; ++gi) attn_group(dc, 2 * gi, qf0, qf1, st, lane);
            attn_finish(st, which ? sink[h] * LOG2E : 0.f, which != 0, (which ? Oc : Ob) + t0 * 512 + h * 64, lane);
        }
    }
}

__device__ __forceinline__ float embed(float v, unsigned mask, unsigned code) { return __uint_as_float((__float_as_uint(v) & ~mask) | code); }
__device__ __forceinline__ float gmax4(float v) { v = fmaxf(v, __shfl_xor(v, 16)); return fmaxf(v, __shfl_xor(v, 32)); }
__device__ __forceinline__ void ph_peer_topk(const bf16_t* __restrict__ Q, const bf16_t* __restrict__ keys, int* __restrict__ eidx, float* __restrict__ egate, int rows, float* smem) {
    const int tid = TID, lane = tid & 63, wid = tid >> 6, n = lane & 15, g = lane >> 4;
    int* lidx = (int*)smem + wid * 512;
    const float NEG = -3.0e38f;
    const int nunits = (rows / 16) * 8;
    for (int u = BID * 8 + wid; u < nunits; u += NBLK * 8) {
        const int h = u & 7, t0 = (u >> 3) * 16;
        float tops[2][16];
#pragma unroll
        for (int pp = 0; pp < 2; ++pp) {
            const bf16_t* qp = Q + (size_t)(t0 + n) * 2048 + h * 256 + pp * 128 + 8 * g;
            bf16x8v qf[4];
#pragma unroll
            for (int ks = 0; ks < 4; ++ks) qf[ks] = *(const bf16x8v*)(qp + ks * 32);
            const bf16_t* kp = keys + ((size_t)(h * 2 + pp) * 128 + n) * 128 + 8 * g;
            float sc[32];
#pragma unroll
            for (int T = 0; T < 8; ++T) {
                f32x4v acc = (f32x4v){0.f, 0.f, 0.f, 0.f};
#pragma unroll
                for (int ks = 0; ks < 4; ++ks) { const bf16x8v a = *(const bf16x8v*)(kp + (size_t)T * 16 * 128 + ks * 32); acc = mfma16(a, qf[ks], acc); }
#pragma unroll
                for (int r = 0; r < 4; ++r) sc[T * 4 + r] = embed(acc[r], 127u, (unsigned)(T * 16 + 4 * g + r));
            }
#pragma unroll
            for (int rd = 0; rd < 16; ++rd) {
                float mx = sc[0];
#pragma unroll
                for (int k = 1; k < 32; ++k) mx = fmaxf(mx, sc[k]);
                mx = gmax4(mx);
                tops[pp][rd] = mx;
                if (g == 0) lidx[(n * 2 + pp) * 16 + rd] = (int)(__float_as_uint(mx) & 127u);
#pragma unroll
                for (int k = 0; k < 32; ++k) sc[k] = (sc[k] == mx) ? NEG : sc[k];
            }
        }
        float bsel[4];
#pragma unroll
        for (int jj = 0; jj < 4; ++jj) bsel[jj] = g == 0 ? tops[1][4 * jj] : (g == 1 ? tops[1][4 * jj + 1] : (g == 2 ? tops[1][4 * jj + 2] : tops[1][4 * jj + 3]));
        float cd[21];
#pragma unroll
        for (int i = 0; i < 16; ++i) cd[i] = embed(tops[0][i] + bsel[0], 255u, (unsigned)((i << 4) | g));
#pragma unroll
        for (int i = 0; i < 3; ++i) cd[16 + i] = embed(tops[0][i] + bsel[1], 255u, (unsigned)((i << 4) | 4 | g));
        cd[19] = embed(tops[0][0] + bsel[2], 255u, (unsigned)(8 | g));
        cd[20] = embed(tops[0][0] + bsel[3], 255u, (unsigned)(12 | g));
        float best[16];
#pragma unroll
        for (int rd = 0; rd < 16; ++rd) {
            float mx = cd[0];
#pragma unroll
            for (int k = 1; k < 21; ++k) mx = fmaxf(mx, cd[k]);
            mx = gmax4(mx);
            best[rd] = mx;
#pragma unroll
            for (int k = 0; k < 21; ++k) cd[k] = (cd[k] == mx) ? NEG : cd[k];
        }
        float ex[16]; float sum = 0.f;
#pragma unroll
        for (int rd = 0; rd < 16; ++rd) { ex[rd] = __builtin_amdgcn_exp2f((best[rd] - best[0]) * LOG2E); sum += ex[rd]; }
        const float inv = 1.0f / sum;
        asm volatile("s_waitcnt lgkmcnt(0)" ::: "memory");
        int eo[4]; float go[4];
#pragma unroll
        for (int rr = 0; rr < 4; ++rr) {
            const float bv = g == 0 ? best[rr] : (g == 1 ? best[4 + rr] : (g == 2 ? best[8 + rr] : best[12 + rr]));
            const float ev = g == 0 ? ex[rr] : (g == 1 ? ex[4 + rr] : (g == 2 ? ex[8 + rr] : ex[12 + rr]));
            const unsigned code = __float_as_uint(bv) & 255u;
            eo[rr] = lidx[(n * 2 + 0) * 16 + (code >> 4)] * 128 + lidx[(n * 2 + 1) * 16 + (code & 15u)];
            go[rr] = ev * inv;
        }
        const size_t o = (size_t)(t0 + n) * 128 + h * 16 + 4 * g;
        *(int4*)(eidx + o) = make_int4(eo[0], eo[1], eo[2], eo[3]);
        *(float4*)(egate + o) = make_float4(go[0], go[1], go[2], go[3]);
        asm volatile("s_waitcnt lgkmcnt(0)" ::: "memory");
    }
}
__device__ __forceinline__ void ph_peer_gather(const bf16_t* __restrict__ H, const bf16_t* __restrict__ U, const bf16_t* __restrict__ V, const int* __restrict__ eidx, const float* __restrict__ egate,
                                               const float* __restrict__ modl, float* __restrict__ Xl, float* __restrict__ Xc, int rows,
                                               int mode, const float* __restrict__ gn, const float* __restrict__ modn, bf16_t* __restrict__ Hn, float* smem, bool dry = false) {
    const int tid = TID, lane = tid & 63, wid = tid >> 6, m = lane & 15, gk = lane >> 4;
    float* wl = smem + wid * 128;
    for (int t = BID * 8 + wid; t < rows; t += NBLK * 8) {
        const int e0 = eidx[(size_t)t * 128 + lane], e1 = eidx[(size_t)t * 128 + 64 + lane];
        const bf16_t* rp[8];
#pragma unroll
        for (int T = 0; T < 8; ++T) { const int e = __shfl(T < 4 ? e0 : e1, (T & 3) * 16 + m); rp[T] = U + (size_t)e * D + 8 * gk; }
        f32x4v acc[8];
#pragma unroll
        for (int T = 0; T < 8; ++T) acc[T] = (f32x4v){0.f, 0.f, 0.f, 0.f};
        const bf16_t* hp = H + (size_t)t * D + 8 * gk;
#pragma unroll 2
        for (int ks = 0; ks < 32; ++ks) {
            const bf16x8v hb = *(const bf16x8v*)(hp + ks * 32);
#pragma unroll
            for (int T = 0; T < 8; ++T) { const bf16x8v a = *(const bf16x8v*)(rp[T] + ks * 32); acc[T] = mfma16(a, hb, acc[T]); }
        }
        const int myT = m >> 1, r0 = (m & 1) * 2;
        float va = 0.f, vb = 0.f;
#pragma unroll
        for (int T = 0; T < 8; ++T) { const float x0 = r0 ? acc[T][2] : acc[T][0], x1 = r0 ? acc[T][3] : acc[T][1]; if (myT == T) { va = x0; vb = x1; } }
        const int ee = myT * 16 + 4 * gk + r0;
        const float2 gg = *(const float2*)(egate + (size_t)t * 128 + ee);
        float2 ww; ww.x = gg.x * 0.5f * va * (1.f + erff(va * 0.70710678118654752f)); ww.y = gg.y * 0.5f * vb * (1.f + erff(vb * 0.70710678118654752f));
        *(float2*)(wl + ee) = ww;
        asm volatile("s_waitcnt lgkmcnt(0)" ::: "memory");
        const float w0 = wl[lane], w1 = wl[64 + lane];
        asm volatile("s_waitcnt lgkmcnt(0)" ::: "memory");
        float out[16];
#pragma unroll
        for (int i = 0; i < 16; ++i) out[i] = 0.f;
        const bf16_t* vb0 = V + lane * 8;
#pragma unroll
        for (int hh = 0; hh < 2; ++hh) {
            const int ev = hh ? e1 : e0; const int wbits = __float_as_int(hh ? w1 : w0);
#pragma unroll 8
            for (int k = 0; k < 64; ++k) {
                const int e = __builtin_amdgcn_readlane(ev, k); const float w = __int_as_float(__builtin_amdgcn_readlane(wbits, k));
                const bf16_t* vp = vb0 + (size_t)e * D;
                const uint4 a = *(const uint4*)vp, b = *(const uint4*)(vp + 512);
                out[0] += w * lo16(a.x); out[1] += w * hi16(a.x); out[2] += w * lo16(a.y); out[3] += w * hi16(a.y); out[4] += w * lo16(a.z); out[5] += w * hi16(a.z); out[6] += w * lo16(a.w); out[7] += w * hi16(a.w);
                out[8] += w * lo16(b.x); out[9] += w * hi16(b.x); out[10] += w * lo16(b.y); out[11] += w * hi16(b.y); out[12] += w * lo16(b.z); out[13] += w * hi16(b.z); out[14] += w * lo16(b.w); out[15] += w * hi16(b.w);
            }
        }
        const int mrow = t < T_LAT ? t / S : 4;
        float* xp = t < T_LAT ? Xl + (size_t)t * D : Xc + (size_t)(t - T_LAT) * D;
        const float* gt = modl + (size_t)mrow * 6144 + 5 * 1024;
        float xr[16]; float ss = 0.f;
#pragma unroll
        for (int q4 = 0; q4 < 4; ++q4) { const int col = (q4 >> 1) * 512 + lane * 8 + (q4 & 1) * 4;
            const float4 x = *(const float4*)(xp + col), g4 = *(const float4*)(gt + col);
            xr[q4 * 4 + 0] = x.x + g4.x * out[q4 * 4 + 0]; xr[q4 * 4 + 1] = x.y + g4.y * out[q4 * 4 + 1]; xr[q4 * 4 + 2] = x.z + g4.z * out[q4 * 4 + 2]; xr[q4 * 4 + 3] = x.w + g4.w * out[q4 * 4 + 3];
#pragma unroll
            for (int i = 0; i < 4; ++i) ss += xr[q4 * 4 + i] * xr[q4 * 4 + i]; }
        ss = wave_sum(ss);
        const float rstd = rsqrtf(ss * (1.0f / D) + EPS);
        if (dry && rstd != 12345.678f) continue;
        if (mode == 0) {
            const float* shn = modn + (size_t)mrow * 6144; const float* scn = shn + 1024;
#pragma unroll
            for (int q4 = 0; q4 < 4; ++q4) { const int col = (q4 >> 1) * 512 + lane * 8 + (q4 & 1) * 4;
                *(float4*)(xp + col) = make_float4(xr[q4 * 4], xr[q4 * 4 + 1], xr[q4 * 4 + 2], xr[q4 * 4 + 3]);
                const float4 g4 = *(const float4*)(gn + col), s4 = *(const float4*)(scn + col), h4 = *(const float4*)(shn + col);
                uint2 w; w.x = pk2(xr[q4 * 4] * rstd * g4.x * (1.f + s4.x) + h4.x, xr[q4 * 4 + 1] * rstd * g4.y * (1.f + s4.y) + h4.y);
                w.y = pk2(xr[q4 * 4 + 2] * rstd * g4.z * (1.f + s4.z) + h4.z, xr[q4 * 4 + 3] * rstd * g4.w * (1.f + s4.w) + h4.w);
                *(uint2*)(Hn + (size_t)t * D + col) = w; }
        } else {
#pragma unroll
            for (int q4 = 0; q4 < 4; ++q4) { const int col = (q4 >> 1) * 512 + lane * 8 + (q4 & 1) * 4;
                const float4 g4 = *(const float4*)(gn + col);
                *(float4*)(xp + col) = make_float4(xr[q4 * 4] * rstd * g4.x, xr[q4 * 4 + 1] * rstd * g4.y, xr[q4 * 4 + 2] * rstd * g4.z, xr[q4 * 4 + 3] * rstd * g4.w); }
        }
    }
}

__device__ __forceinline__ unsigned char* launder(unsigned char* q) { asm volatile("" : "+s"(q)); return q; }
struct WsPtrs { float *mod, *rope, *XC, *X; bf16_t *H, *Z, *vtn, *vtnc, *vtw, *vtwc, *AT; int* eidx; float* egate; unsigned char* wl; const float* modl; const bf16_t *U, *V; };
__device__ __forceinline__ WsPtrs mkptrs(const Params& p, int l) {
    unsigned char* ws = launder(p.ws); WsPtrs P;
    P.mod = (float*)(ws + WS_MOD); P.rope = (float*)(ws + WS_ROPE); P.XC = (float*)(ws + WS_XC); P.X = (float*)launder((unsigned char*)p.out);
    P.H = (bf16_t*)(ws + WS_H); P.Z = (bf16_t*)(ws + WS_Z); P.vtn = (bf16_t*)(ws + WS_VTN); P.vtnc = (bf16_t*)(ws + WS_VTNC); P.vtw = (bf16_t*)(ws + WS_VTW); P.vtwc = (bf16_t*)(ws + WS_VTWC);
    P.AT = (bf16_t*)(ws + WS_AT); P.eidx = (int*)(ws + WS_EIDX); P.egate = (float*)(ws + WS_EGATE);
    P.wl = ws + WS_W + l * W_LAYER; P.modl = P.mod + (size_t)l * 5 * 6144; P.U = (const bf16_t*)(ws + WS_TAB + l * TAB_LAYER); P.V = P.U + (size_t)NEXP * D;
    return P;
}
__global__ void __launch_bounds__(NTHREADS, 2) mega_fwd(Params p) {
    extern __shared__ __attribute__((aligned(16))) unsigned char lds[];
    cg::grid_group grid = cg::this_grid();
    PG8_LAS unsigned char* ldsr = (PG8_LAS unsigned char*)lds;
    float* smem = (float*)lds;

#ifndef PROBE_DUP
#define PROBE_DUP 0
#endif
#define SYNC() grid.sync()
#define DUP(k, PH) do { PH; SYNC(); if (PROBE_DUP == (k)) { PH; SYNC(); } } while (0)
#define PH_NORM1() { const WsPtrs P = mkptrs(p, l); ph_norm_mod(P.X, P.XC, p.norm1_g, P.modl, 0, 1, P.H, T_ALL); }
#define PH_ZGEMM() {     \
            const WsPtrs P = mkptrs(p, l); \
            pg8::EpiZ E{P.Z, P.rope, P.vtn, P.vtnc, P.vtw, P.vtwc, 0, 0}; \
            if (!last) { pg8::Gemm g{P.H, (const bf16_t*)(P.wl + W_WIN), T_ALL, IN_COLS, D}; pg8::StaticOrder So; So.init(T_ALL, IN_COLS, NBLK, BID); \
                pg8::gemm_phase<pg8::EpiZ, pg8::StaticOrder, true, true>(ldsr, g, So, E); } \
            else { pg8::Gemm g{P.H, (const bf16_t*)(P.wl + W_WIN), T_LAT, IN_COLS, D}; pg8::StaticOrder So; So.init(T_LAT, IN_COLS, NBLK, BID); \
                pg8::gemm_phase<pg8::EpiZ, pg8::StaticOrder, true, true>(ldsr, g, So, E); \
                const WsPtrs P2 = mkptrs(p, l); \
                pg8::EpiZ E2{P2.Z, P2.rope, P2.vtn, P2.vtnc, P2.vtw, P2.vtwc, T_LAT, 0}; \
                pg8::Gemm g2{P2.H + (size_t)T_LAT * D, (const bf16_t*)(P2.wl + W_WIN), T_CTX, CTX_KV_COLS, D}; pg8::StaticOrder S2; S2.init(T_CTX, CTX_KV_COLS, NBLK, BID); \
                pg8::gemm_phase<pg8::EpiZ, pg8::StaticOrder, true, true>(ldsr, g2, S2, E2); } }
#define PH_ATTN() { const WsPtrs P = mkptrs(p, l); ph_attn(P.Z, P.vtn, P.vtnc, P.vtw, P.vtwc, p.na_rpb + (size_t)l * 8 * 15 * 31, p.swa_sink + l * 8, P.AT + (size_t)T_ALL * 512, P.AT + (size_t)2 * T_ALL * 512, !last, smem, P.AT, rows); }
#define PH_MERGE() {     \
            const WsPtrs P = mkptrs(p, l); \
            pg8::Gemm g{P.AT, (const bf16_t*)(P.wl + W_WA), 3 * T_ALL, 3 * D, 512}; pg8::MergeOrder Mo{(rows / 256) * 4, NBLK, BID, 0}; pg8::EpiMergeSeg E{P.Z, P.H}; \
            pg8::gemm_phase<pg8::EpiMergeSeg, pg8::MergeOrder, false, true>(ldsr, g, Mo, E); }
#define PH_OUT(GIDX) {     \
            const WsPtrs P = mkptrs(p, l); \
            pg8::Gemm g{P.H, (const bf16_t*)(P.wl + W_WO), rows, D, D}; pg8::StaticOrder So; So.init(rows, D, NBLK, BID); pg8::EpiResid E{P.X, P.XC, P.modl, GIDX, 0}; \
            pg8::gemm_phase<pg8::EpiResid, pg8::StaticOrder, true, true>(ldsr, g, So, E); }
#define PH_NORM2() { const WsPtrs P = mkptrs(p, l); ph_norm_mod(P.X, P.XC, p.norm2_g + l * D, P.modl, 3, 4, P.H, rows); }
#define PH_QGEMM() { const WsPtrs P = mkptrs(p, l); \
            pg8::Gemm g{P.H, (const bf16_t*)(P.wl + W_WQ), rows, 2048, D}; pg8::StaticOrder So; So.init(rows, 2048, NBLK, BID); pg8::EpiStoreBf16 E{P.Z, 2048, 0}; \
            pg8::gemm_phase<pg8::EpiStoreBf16, pg8::StaticOrder, true, true>(ldsr, g, So, E); }
#define PH_TOPK() { const WsPtrs P = mkptrs(p, l); ph_peer_topk(P.Z, (const bf16_t*)(P.wl + W_KEYS), P.eidx, P.egate, rows, smem); }
#define PH_GATHER(DRY) { const WsPtrs P = mkptrs(p, l); ph_peer_gather(P.H, P.U, P.V, P.eidx, P.egate, P.modl, P.X, P.XC, rows, last ? 1 : 0, last ? p.final_g : p.norm1_g + D, P.modl + 5 * 6144, P.H, smem, DRY); }

    DUP(1, ph_prep(p, smem));
#pragma unroll 1
    for (int l = 0; l < 2; ++l) {
        const bool last = (l == 1);
        const int rows = last ? T_LAT : T_ALL;
        if (l == 0) { PH_NORM1(); SYNC(); }
        DUP(2, PH_ZGEMM());
        DUP(3, PH_ATTN());
        DUP(4, PH_MERGE());
        PH_OUT(2); SYNC();
        DUP(5, PH_NORM2());
        DUP(6, PH_QGEMM());
        DUP(7, PH_TOPK());
        if (PROBE_DUP == 8) { PH_GATHER(true); SYNC(); }
        PH_GATHER(false); SYNC();
    }
}

extern "C" void kernel_launch(void* const* d_in, const int* in_sizes, int n_in, void* d_out, int out_size, void* d_ws, size_t ws_size, hipStream_t stream) {
    static int grid_blocks = 0;
    if (grid_blocks == 0) {
        if (ws_size < WS_END || n_in != 22) { fprintf(stderr, "kernel_launch: workspace %zu < %zu or n_in %d != 22\n", ws_size, (size_t)WS_END, n_in); grid_blocks = -1; return; }
        int dev = 0, cus = 0, per_cu = 0;
        (void)hipGetDevice(&dev); (void)hipDeviceGetAttribute(&cus, hipDeviceAttributeMultiprocessorCount, dev);
        if (hipFuncSetAttribute((const void*)mega_fwd, hipFuncAttributeMaxDynamicSharedMemorySize, LDS_BYTES) != hipSuccess) { fprintf(stderr, "kernel_launch: hipFuncSetAttribute failed\n"); grid_blocks = -1; return; }
        if (hipOccupancyMaxActiveBlocksPerMultiprocessor(&per_cu, (const void*)mega_fwd, NTHREADS, LDS_BYTES) != hipSuccess || per_cu < 1) { fprintf(stderr, "kernel_launch: occupancy query says %d\n", per_cu); per_cu = 1; }
        (void)hipGetLastError();
        grid_blocks = cus * 1;
        fprintf(stderr, "kernel_launch: %d CUs, occupancy query %d per CU, grid %d\n", cus, per_cu, grid_blocks);
    }
    if (grid_blocks < 0) return;
    Params p{};
    p.x = (const float*)d_in[0]; p.c = (const float*)d_in[1]; p.ctx = (const float*)d_in[2]; p.c_ctx = (const float*)d_in[3]; p.ada_w = (const float*)d_in[4]; p.ada_b = (const float*)d_in[5];
    p.norm1_g = (const float*)d_in[6]; p.norm2_g = (const float*)d_in[7]; p.w_in = (const float*)d_in[8]; p.pool_w = (const float*)d_in[9]; p.pool_scale = (const float*)d_in[10]; p.na_rpb = (const float*)d_in[11];
    p.swa_sink = (const float*)d_in[12]; p.wba = (const float*)d_in[13]; p.wbb = (const float*)d_in[14]; p.wbc = (const float*)d_in[15]; p.w_out = (const float*)d_in[16]; p.peer_wq = (const float*)d_in[17];
    p.peer_keys = (const float*)d_in[18]; p.peer_u = (const float*)d_in[19]; p.peer_v = (const float*)d_in[20]; p.final_g = (const float*)d_in[21];
    p.out = (float*)d_out; p.ws = (unsigned char*)d_ws;
    void* args[] = {&p};
    const hipError_t e = hipLaunchCooperativeKernel((const void*)mega_fwd, dim3(grid_blocks), dim3(NTHREADS), args, LDS_BYTES, stream);
    if (e != hipSuccess) fprintf(stderr, "kernel_launch: cooperative launch failed: %s (grid %d)\n", hipGetErrorString(e), grid_blocks);
}
```

```cpp
#include <hip/hip_runtime.h>
#include <hip/hip_cooperative_groups.h>
#include <stdint.h>
#include <stdio.h>
namespace cg = cooperative_groups;

typedef unsigned short bf16_t;

constexpr int D = 1024, NB = 4, S = 4096, L = 256, GW = 64;
constexpr int T_LAT = NB * S, T_CTX = NB * L, T_ALL = T_LAT + T_CTX;
constexpr int IN_COLS = 5888;
constexpr int OFF_KN = 0, OFF_VN = 512, OFF_KW = 1024, OFF_VW = 1152, CTX_KV_COLS = 1280, OFF_QN = 1280, OFF_QW = 1792, OFF_A = 2304, OFF_G = 2816;
constexpr int NEXP = 16384;
constexpr float EPS = 1e-6f;
#ifndef FP8_L0
#define FP8_L0 1
#endif
#ifndef RING_U
#define RING_U 1
#endif
#ifndef RING_V
#define RING_V 1
#endif
constexpr int NTHREADS = 512;
constexpr int LDS_BYTES = 147456;

constexpr size_t al256(size_t x) { return (x + 255) & ~(size_t)255; }
constexpr size_t WS_CTL = 0, CTL_BYTES = 16384;
constexpr size_t WS_MOD = WS_CTL + CTL_BYTES;
constexpr size_t WS_ROPE = al256(WS_MOD + 2 * 5 * 6144 * 4);
constexpr size_t WS_XC = al256(WS_ROPE + 2 * 64 * 16 * 4);
constexpr size_t WS_H = al256(WS_XC + (size_t)T_CTX * D * 4);
constexpr size_t WS_Z = al256(WS_H + (size_t)T_ALL * D * 2);
constexpr size_t WS_VTN = al256(WS_Z + (size_t)T_ALL * IN_COLS * 2);
constexpr size_t WS_VTNC = al256(WS_VTN + (size_t)NB * 8 * 64 * S * 2);
constexpr size_t WS_VTW = al256(WS_VTNC + (size_t)NB * 8 * 64 * L * 2);
constexpr size_t WS_VTWC = al256(WS_VTW + (size_t)NB * 2 * 64 * S * 2);
constexpr size_t WS_AT = al256(WS_VTWC + (size_t)NB * 2 * 64 * L * 2);
constexpr size_t WS_EIDX = al256(WS_AT + (size_t)3 * T_ALL * 512 * 2);
constexpr size_t WS_EGATE = al256(WS_EIDX + (size_t)T_ALL * 128 * 4);
constexpr size_t WS_W = al256(WS_EGATE + (size_t)T_ALL * 128 * 4);
constexpr size_t W_WIN = 0;
constexpr size_t W_WA = W_WIN + (size_t)IN_COLS * D * 2;
constexpr size_t W_WB = W_WA + (size_t)D * 512 * 2;
constexpr size_t W_WC = W_WB + (size_t)D * 512 * 2;
constexpr size_t W_WO = W_WC + (size_t)D * 512 * 2;
constexpr size_t W_WQ = W_WO + (size_t)D * D * 2;
constexpr size_t W_KEYS = W_WQ + (size_t)2048 * D * 2;
constexpr size_t W_LAYER = al256(W_KEYS + (size_t)8 * 2 * 128 * 128 * 2);
constexpr size_t WS_H8 = al256(WS_W + 2 * W_LAYER);
constexpr size_t WS_TAB0 = al256(WS_H8 + (size_t)2 * T_ALL * D);
constexpr size_t WS_TAB1 = al256(WS_TAB0 + (size_t)2 * NEXP * D * 2);
constexpr size_t WS_END = WS_TAB1 + (size_t)2 * NEXP * D + (size_t)2 * NEXP * 4;

__device__ __forceinline__ float bf2f(bf16_t v) { return __uint_as_float((unsigned)v << 16); }
__device__ __forceinline__ bf16_t f2bf(float f) { unsigned u = __float_as_uint(f); u += 0x7fffu + ((u >> 16) & 1u); return (bf16_t)(u >> 16); }
__device__ __forceinline__ unsigned pk2(float lo, float hi) { return (unsigned)f2bf(lo) | ((unsigned)f2bf(hi) << 16); }
__device__ __forceinline__ float lo16(unsigned w) { return __uint_as_float(w << 16); }
__device__ __forceinline__ float hi16(unsigned w) { return __uint_as_float(w & 0xffff0000u); }

__device__ __forceinline__ int opaque_tid() { int t = threadIdx.x; asm volatile("" : "+v"(t)); return t; }
namespace pg8 {
#define PG8_LAS __attribute__((address_space(3)))
typedef unsigned short bf16_t;
typedef short bf16x8 __attribute__((ext_vector_type(8)));
typedef float f32x4 __attribute__((ext_vector_type(4)));
typedef unsigned u32x4 __attribute__((ext_vector_type(4)));
constexpr int BM = 256, BK = 64, HALF = 128, HTB = HALF * BK * 2  , STAGE_BYTES = 8 * HTB, NXCD = 8, WGM = 8;

__host__ __device__ __forceinline__ int lds_byte(int r, int c) { const int st = (r >> 4) * 2 + (c >> 5), rr = r & 15, cc = c & 31, ob = rr * 64 + cc * 2; return st * 1024 + (ob ^ (((ob >> 9) & 1) << 5)); }
__host__ __device__ __forceinline__ void stage_rc(int b, int& R, int& C) { const int st = b / 1024, sb = b % 1024, swz = sb ^ (((sb >> 9) & 1) << 5); R = (st >> 1) * 16 + swz / 64; C = (st & 1) * 32 + (swz % 64) / 2; }
__host__ __device__ __forceinline__ int perm32(int rho) { const int n = rho >> 4, i = rho & 15; return 8 * (i >> 2) + 4 * n + (i & 3); }

struct Unit { int pm, pn; };
struct Gemm { const bf16_t* A; const bf16_t* Bt; int M, N, K; };

struct StaticOrder {
    int nM, nN, nwg, G, c;
    __host__ __device__ void init(int M, int N, int G_, int c_) { nM = M / BM; nN = N / BM; nwg = nM * nN; G = G_; c = c_; }
    __host__ __device__ bool next(int i, Unit& u) const {
        const long L = (long)i * G + c; if (L >= nwg) return false;
        int wgid = (int)L; { const int q = nwg / NXCD, r = nwg % NXCD, xcd = wgid % NXCD, off = wgid / NXCD; wgid = (xcd < r ? xcd * (q + 1) : r * (q + 1) + (xcd - r) * q) + off; }
        const int nig = WGM * nN, gid = wgid / nig, fm = gid * WGM, gsz = (nM - fm) < WGM ? (nM - fm) : WGM;
        u.pm = fm + ((wgid % nig) % gsz); u.pn = (wgid % nig) / gsz; return true;
    }
    __device__ __forceinline__ void a_ready(const Unit&) const {}
    __device__ __forceinline__ void done(const Unit&) const {}
};
__device__ __forceinline__ unsigned cvt_pk_bf16(float lo, float hi) { unsigned r; asm volatile("v_cvt_pk_bf16_f32 %0, %1, %2" : "=v"(r) : "v"(lo), "v"(hi)); return r; }
typedef unsigned u32x4 __attribute__((ext_vector_type(4)));
struct EpiStoreBf16 {
    static constexpr bool PERM = true, AFTER_DRAIN = false;
    bf16_t* O; int ldc; int pad;
    __device__ __forceinline__ void operator()(const f32x4 (&acc)[2][2][4][2], const Unit& u, int wr, int wc, int fr, int fq) const {
        const int row0 = u.pm * BM + wr * 64 + fr, col0 = u.pn * BM + wc * 32 + 8 * fq;
#pragma unroll
        for (int ai = 0; ai < 2; ++ai)
#pragma unroll
            for (int m = 0; m < 4; ++m) { bf16_t* rowp = O + (size_t)(row0 + ai * HALF + m * 16) * ldc + col0;
#pragma unroll
                for (int bj = 0; bj < 2; ++bj) { const f32x4 v0 = acc[ai][bj][m][0], v1 = acc[ai][bj][m][1];
                    u32x4 w; w.x = cvt_pk_bf16(v0[0], v0[1]); w.y = cvt_pk_bf16(v0[2], v0[3]); w.z = cvt_pk_bf16(v1[0], v1[1]); w.w = cvt_pk_bf16(v1[2], v1[3]);
                    *(u32x4*)(rowp + bj * HALF) = w; } }
    }
};

struct EpiZ {
    static constexpr bool PERM = true, AFTER_DRAIN = false;
    bf16_t* Z; const float* rope; bf16_t *vtn, *vtnc, *vtw, *vtwc; int row_base; int pad;
    __device__ __forceinline__ void operator()(const f32x4 (&acc)[2][2][4][2], const Unit& u, int wr, int wc, int fr, int fq) const {
        const int grow0 = row_base + u.pm * BM;
        const bool lat = grow0 < 16384;
        const int b = lat ? (grow0 >> 12) : ((grow0 - 16384) >> 8), len = lat ? 4096 : 256;
        const int tpos0 = (lat ? (grow0 & 4095) : ((grow0 - 16384) & 255)) + wr * 64 + fr;
#pragma unroll
        for (int bj = 0; bj < 2; ++bj) {
            const int cb = 2 * u.pn + bj;
            const int col0 = cb * 128 + wc * 32 + 8 * fq;
            if ((cb >= 4 && cb < 8) || cb == 9) {
                const int cl = wc * 32 + 8 * fq;
                bf16_t* dst;
                if (cb == 9) dst = (lat ? vtw : vtwc) + ((size_t)(b * 2 + (cl >> 6)) * 64 + (cl & 63)) * len + tpos0;
                else dst = (lat ? vtn : vtnc) + ((size_t)(b * 8 + (cb - 4) * 2 + (cl >> 6)) * 64 + (cl & 63)) * len + tpos0;
#pragma unroll
                for (int ai = 0; ai < 2; ++ai)
#pragma unroll
                    for (int m = 0; m < 4; ++m) { bf16_t* dp = dst + ai * HALF + m * 16;
#pragma unroll
                        for (int n = 0; n < 2; ++n)
#pragma unroll
                            for (int i = 0; i < 4; ++i) { const unsigned w = cvt_pk_bf16(acc[ai][bj][m][n][i], 0.f); dp[(size_t)(4 * n + i) * len] = (bf16_t)(w & 0xffffu); } }
            } else {
                const bool is_rope = lat && (cb == 8 || (cb >= 14 && cb < 18));
                const bool is_gate = cb >= 22;
#pragma unroll
                for (int ai = 0; ai < 2; ++ai)
#pragma unroll
                    for (int m = 0; m < 4; ++m) {
                        f32x4 v0 = acc[ai][bj][m][0], v1 = acc[ai][bj][m][1];
                        if (is_gate) {
#pragma unroll
                            for (int i = 0; i < 4; ++i) { v0[i] = __builtin_amdgcn_rcpf(1.f + __builtin_amdgcn_exp2f(-1.4426950408889634f * v0[i])); v1[i] = __builtin_amdgcn_rcpf(1.f + __builtin_amdgcn_exp2f(-1.4426950408889634f * v1[i])); }
                        } else if (is_rope) {
                            const int tp = tpos0 + ai * HALF + m * 16;
                            const int pos = (wc & 1) ? (tp & 63) : (tp >> 6);
                            const float* tb = rope + pos * 16 + 8 * (fq & 1);
                            const f32x4 c0 = *(const f32x4*)tb, c1 = *(const f32x4*)(tb + 4), s0 = *(const f32x4*)(tb + 1024), s1 = *(const f32x4*)(tb + 1028);
                            f32x4 p0, p1;
#pragma unroll
                            for (int i = 0; i < 4; ++i) { p0[i] = __shfl_xor(v0[i], 32); p1[i] = __shfl_xor(v1[i], 32); }
                            if (fq < 2) { v0 = v0 * c0 - p0 * s0; v1 = v1 * c1 - p1 * s1; }
                            else { v0 = p0 * s0 + v0 * c0; v1 = p1 * s1 + v1 * c1; }
                        }
                        u32x4 w; w.x = cvt_pk_bf16(v0[0], v0[1]); w.y = cvt_pk_bf16(v0[2], v0[3]); w.z = cvt_pk_bf16(v1[0], v1[1]); w.w = cvt_pk_bf16(v1[2], v1[3]);
                        *(u32x4*)(Z + (size_t)(grow0 + ai * HALF + wr * 64 + m * 16 + fr) * 5888 + col0) = w;
                    }
            }
        }
    }
};
constexpr int NTM_STACK = 68;
struct EpiMergeSeg {
    static constexpr bool PERM = true, AFTER_DRAIN = false;
    const bf16_t* Z; bf16_t* M;
    __device__ __forceinline__ void operator()(const f32x4 (&acc)[2][2][4][2], const Unit& u, int wr, int wc, int fr, int fq) const {
        const int seg = u.pn >> 2, tn = u.pn & 3, tm = u.pm - seg * NTM_STACK;
        const int row0 = tm * BM + wr * 64 + fr, col0 = tn * BM + wc * 32 + 8 * fq;
#pragma unroll
        for (int ai = 0; ai < 2; ++ai)
#pragma unroll
            for (int m = 0; m < 4; ++m) { const int row = row0 + ai * HALF + m * 16;
#pragma unroll
                for (int bj = 0; bj < 2; ++bj) { const int col = col0 + bj * HALF;
                    const u32x4 g = *(const u32x4*)(Z + (size_t)row * 5888 + 2816 + seg * 1024 + col);
                    bf16_t* mp = M + (size_t)row * 1024 + col;
                    u32x4 o = (u32x4){0u, 0u, 0u, 0u}; if (seg) o = *(const u32x4*)mp;
                    const f32x4 v0 = acc[ai][bj][m][0], v1 = acc[ai][bj][m][1];
                    u32x4 w;
                    w.x = cvt_pk_bf16(__uint_as_float(g.x << 16) * v0[0] + __uint_as_float(o.x << 16), __uint_as_float(g.x & 0xffff0000u) * v0[1] + __uint_as_float(o.x & 0xffff0000u));
                    w.y = cvt_pk_bf16(__uint_as_float(g.y << 16) * v0[2] + __uint_as_float(o.y << 16), __uint_as_float(g.y & 0xffff0000u) * v0[3] + __uint_as_float(o.y & 0xffff0000u));
                    w.z = cvt_pk_bf16(__uint_as_float(g.z << 16) * v1[0] + __uint_as_float(o.z << 16), __uint_as_float(g.z & 0xffff0000u) * v1[1] + __uint_as_float(o.z & 0xffff0000u));
                    w.w = cvt_pk_bf16(__uint_as_float(g.w << 16) * v1[2] + __uint_as_float(o.w << 16), __uint_as_float(g.w & 0xffff0000u) * v1[3] + __uint_as_float(o.w & 0xffff0000u));
                    *(u32x4*)mp = w; } }
    }
};
struct MergeOrder {
    int ntiles, G, c, pad;
    __device__ bool next(int i, Unit& u) const { const int ti = (i / 3) * G + c, seg = i % 3; if (ti >= ntiles) return false; u.pm = seg * NTM_STACK + (ti >> 2); u.pn = seg * 4 + (ti & 3); return true; }
    __device__ __forceinline__ void a_ready(const Unit&) const {}
    __device__ __forceinline__ void done(const Unit&) const {}
};
struct EpiResid {
    static constexpr bool PERM = false, AFTER_DRAIN = false;
    float* Xl; float* Xc; const float* modl; int gate_idx; int pad;
    __device__ __forceinline__ void operator()(const f32x4 (&acc)[2][2][4][2], const Unit& u, int wr, int wc, int fr, int fq) const {
        const int mrow = u.pm < 64 ? (u.pm >> 4) : 4;
        float* base = u.pm < 64 ? Xl + (size_t)u.pm * BM * 1024 : Xc + (size_t)(u.pm - 64) * BM * 1024;
        const float* gt = modl + (size_t)mrow * 6144 + gate_idx * 1024;
        const int col0 = u.pn * BM + wc * 32 + 4 * fq;
#pragma unroll
        for (int bj = 0; bj < 2; ++bj)
#pragma unroll
            for (int n = 0; n < 2; ++n) { const int col = col0 + bj * HALF + 16 * n; const f32x4 gv = *(const f32x4*)(gt + col);
#pragma unroll
                for (int ai = 0; ai < 2; ++ai)
#pragma unroll
                    for (int m = 0; m < 4; ++m) { float* xp = base + (size_t)(ai * HALF + wr * 64 + m * 16 + fr) * 1024 + col;
                        f32x4 x = *(f32x4*)xp; x = x + gv * acc[ai][bj][m][n]; *(f32x4*)xp = x; } }
    }
};
template <class Epi, class Sched, bool ALIGN_EPI = false, bool SP2 = false>
__device__ __forceinline__ void gemm_phase(PG8_LAS unsigned char* lds, const Gemm g, const Sched& S, const Epi& E) {
    const int tid = opaque_tid(), wid = __builtin_amdgcn_readfirstlane(tid >> 6), lane = tid & 63, wr = wid >> 2, wc = wid & 3, fr = lane & 15, fq = lane >> 4;
    const int K = g.K, nt = K / BK;
    unsigned voffA[2], voffB[2];
#pragma unroll
    for (int i = 0; i < 2; ++i) { int R, C; stage_rc(tid * 16 + i * 8192, R, C); const int Rb = Epi::PERM ? ((R & ~31) + perm32(R & 31)) : R;
        voffA[i] = (unsigned)(R * K + C) * 2u; voffB[i] = (unsigned)(Rb * K + C) * 2u; }
    const size_t kstep = (size_t)(BK * 2);
    const size_t hstep = (size_t)HALF * K * 2;
    const size_t tstep = 2 * hstep;
    const unsigned ldsw = (unsigned)wid * 1024u;
    const int aoff = lds_byte(wr * 64 + fr, fq * 8), boff = lds_byte(wc * 32 + fr, fq * 8);
#define PG8_SA(b, h) (((b) * 2 + (h)) * HTB)
#define PG8_SB(b, h) ((4 + (b) * 2 + (h)) * HTB)
#define PG8_STAGE(bufoff, gbase, voff) do { _Pragma("unroll") for (int _i = 0; _i < 2; ++_i) \
        __builtin_amdgcn_global_load_lds((const unsigned*)((const char*)(gbase) + (voff)[_i]), (PG8_LAS unsigned*)(lds + (bufoff) + ldsw + _i * 8192), 16, 0, 0); } while (0)
#define PG8_LDA(dst, b, h) do { _Pragma("unroll") for (int m = 0; m < 4; ++m) _Pragma("unroll") for (int k = 0; k < 2; ++k) dst[m][k] = *(const PG8_LAS bf16x8*)(lds + PG8_SA(b, h) + aoff + m * 2048 + k * 1024); } while (0)
#define PG8_LDB(dst, b, h) do { _Pragma("unroll") for (int n = 0; n < 2; ++n) _Pragma("unroll") for (int k = 0; k < 2; ++k) dst[n][k] = *(const PG8_LAS bf16x8*)(lds + PG8_SB(b, h) + boff + n * 2048 + k * 1024); } while (0)
#define PG8_MMA(ai, bj, At, Bt) do { __builtin_amdgcn_s_setprio(1); _Pragma("unroll") for (int m = 0; m < 4; ++m) _Pragma("unroll") for (int n = 0; n < 2; ++n) _Pragma("unroll") for (int k = 0; k < 2; ++k) \
        acc[ai][bj][m][n] = __builtin_amdgcn_mfma_f32_16x16x32_bf16(Bt[n][k], At[m][k], acc[ai][bj][m][n], 0, 0, 0); __builtin_amdgcn_s_setprio(0); } while (0)
#define PG8_WAIT_V(n) asm volatile("s_waitcnt vmcnt(" #n ")" ::: "memory")
#define PG8_WAIT_L(n) asm volatile("s_waitcnt lgkmcnt(" #n ")" ::: "memory")
#define PG8_BAR __builtin_amdgcn_s_barrier()
#define PG8_SCHED __builtin_amdgcn_sched_barrier(0)
    Unit cur, nxt; int ui = 0;
    if (!S.next(0, cur)) return;
    f32x4 acc[2][2][4][2];
#pragma unroll
    for (int a = 0; a < 2; ++a)
#pragma unroll
        for (int b = 0; b < 2; ++b)
#pragma unroll
            for (int m = 0; m < 4; ++m)
#pragma unroll
                for (int n = 0; n < 2; ++n) acc[a][b][m][n] = (f32x4){0.f, 0.f, 0.f, 0.f};
    bf16x8 At[4][2], B0[2][2], B1[2][2];
    const char* cA = (const char*)g.A + (size_t)cur.pm * tstep; const char* cB = (const char*)g.Bt + (size_t)cur.pn * tstep;
    S.a_ready(cur);
    if constexpr (SP2) {
        PG8_STAGE(PG8_SB(0, 0), cB, voffB); PG8_STAGE(PG8_SB(0, 1), cB + hstep, voffB); PG8_STAGE(PG8_SA(0, 0), cA, voffA); PG8_STAGE(PG8_SA(0, 1), cA + hstep, voffA);
        if (wr == 1) PG8_BAR;
        PG8_WAIT_V(2); PG8_BAR;
        PG8_STAGE(PG8_SB(1, 0), cB + kstep, voffB); PG8_STAGE(PG8_SA(1, 0), cA + kstep, voffA); PG8_STAGE(PG8_SB(1, 1), cB + hstep + kstep, voffB);
        PG8_WAIT_V(6); PG8_BAR;
    } else {
        PG8_STAGE(PG8_SB(0, 0), cB, voffB); PG8_STAGE(PG8_SA(0, 0), cA, voffA); PG8_STAGE(PG8_SB(0, 1), cB + hstep, voffB); PG8_STAGE(PG8_SA(0, 1), cA + hstep, voffA);
        if (wr == 1) PG8_BAR;
        PG8_WAIT_V(4); PG8_BAR;
        PG8_STAGE(PG8_SB(1, 0), cB + kstep, voffB); PG8_STAGE(PG8_SA(1, 0), cA + kstep, voffA); PG8_STAGE(PG8_SB(1, 1), cB + hstep + kstep, voffB);
        PG8_WAIT_V(6); PG8_BAR;
    }
    for (;;) {
        const bool has_next = S.next(ui + 1, nxt);
        const char* nA = has_next ? (const char*)g.A + (size_t)nxt.pm * tstep : cA; const char* nB = has_next ? (const char*)g.Bt + (size_t)nxt.pn * tstep : cB;
        for (int t = 0; t < nt; t += 2) {
            const bool last = (t == nt - 2);
            const char* a1 = cA + (size_t)(t + 1) * kstep;
            const char* a2 = last ? nA : cA + (size_t)(t + 2) * kstep; const char* b2 = last ? nB : cB + (size_t)(t + 2) * kstep;
            const char* a3 = a2 + kstep; const char* b3 = b2 + kstep;
            if (last && has_next) S.a_ready(nxt);
            if constexpr (SP2) {
            PG8_LDB(B0, 0, 0); PG8_LDB(B1, 0, 1); PG8_SCHED; PG8_LDA(At, 0, 0); PG8_STAGE(PG8_SA(1, 1), a1 + hstep, voffA);
            PG8_WAIT_V(8); PG8_WAIT_L(0); PG8_BAR; PG8_MMA(0, 0, At, B0); PG8_MMA(0, 1, At, B1); PG8_BAR; PG8_SCHED;
            PG8_LDA(At, 0, 1); PG8_STAGE(PG8_SB(0, 0), b2, voffB); PG8_STAGE(PG8_SB(0, 1), b2 + hstep, voffB); PG8_STAGE(PG8_SA(0, 0), a2, voffA);
            PG8_WAIT_V(8); PG8_WAIT_L(0); PG8_BAR; PG8_MMA(1, 0, At, B0); PG8_MMA(1, 1, At, B1); PG8_BAR; PG8_SCHED;
            PG8_LDB(B0, 1, 0); PG8_LDB(B1, 1, 1); PG8_SCHED; PG8_LDA(At, 1, 0); PG8_STAGE(PG8_SA(0, 1), a2 + hstep, voffA);
            PG8_WAIT_V(8); PG8_WAIT_L(0); PG8_BAR; PG8_MMA(0, 0, At, B0); PG8_MMA(0, 1, At, B1); PG8_BAR; PG8_SCHED;
            PG8_LDA(At, 1, 1); PG8_STAGE(PG8_SB(1, 0), b3, voffB); PG8_STAGE(PG8_SB(1, 1), b3 + hstep, voffB); PG8_STAGE(PG8_SA(1, 0), a3, voffA);
            PG8_WAIT_V(8); PG8_WAIT_L(0); PG8_BAR; PG8_MMA(1, 0, At, B0); PG8_MMA(1, 1, At, B1); PG8_BAR; PG8_SCHED;
            } else {
            PG8_LDB(B0, 0, 0); PG8_SCHED; PG8_LDA(At, 0, 0); PG8_STAGE(PG8_SA(1, 1), a1 + hstep, voffA);
            PG8_WAIT_L(8); PG8_BAR; PG8_WAIT_L(0); PG8_MMA(0, 0, At, B0); PG8_BAR; PG8_SCHED;
            PG8_LDB(B1, 0, 1); PG8_STAGE(PG8_SB(0, 0), b2, voffB);
            PG8_BAR; PG8_WAIT_L(0); PG8_MMA(0, 1, At, B1); PG8_BAR;
            PG8_LDA(At, 0, 1); PG8_STAGE(PG8_SA(0, 0), a2, voffA);
            PG8_BAR; PG8_WAIT_L(0); PG8_MMA(1, 0, At, B0); PG8_BAR; PG8_SCHED;
            PG8_STAGE(PG8_SB(0, 1), b2 + hstep, voffB);
            PG8_WAIT_V(6); PG8_BAR; PG8_MMA(1, 1, At, B1); PG8_BAR;
            PG8_LDB(B0, 1, 0); PG8_SCHED; PG8_LDA(At, 1, 0); PG8_STAGE(PG8_SA(0, 1), a2 + hstep, voffA);
            PG8_WAIT_L(8); PG8_BAR; PG8_WAIT_L(0); PG8_MMA(0, 0, At, B0); PG8_BAR; PG8_SCHED;
            PG8_LDB(B1, 1, 1); PG8_STAGE(PG8_SB(1, 0), b3, voffB);
            PG8_BAR; PG8_WAIT_L(0); PG8_MMA(0, 1, At, B1); PG8_BAR;
            PG8_LDA(At, 1, 1); PG8_STAGE(PG8_SA(1, 0), a3, voffA);
            PG8_BAR; PG8_WAIT_L(0); PG8_MMA(1, 0, At, B0); PG8_BAR; PG8_SCHED;
            PG8_STAGE(PG8_SB(1, 1), b3 + hstep, voffB);
            PG8_WAIT_V(6); PG8_BAR; PG8_MMA(1, 1, At, B1); PG8_BAR;
            }
        }
        if constexpr (ALIGN_EPI) { if (wr == 0) PG8_BAR; }
        if constexpr (!Epi::AFTER_DRAIN) { E(acc, cur, wr, wc, fr, fq); S.done(cur); }
        if (!has_next) break;
#pragma unroll
        for (int a = 0; a < 2; ++a)
#pragma unroll
            for (int b = 0; b < 2; ++b)
#pragma unroll
                for (int m = 0; m < 4; ++m)
#pragma unroll
                    for (int n = 0; n < 2; ++n) acc[a][b][m][n] = (f32x4){0.f, 0.f, 0.f, 0.f};
        cur = nxt; cA = nA; cB = nB; ++ui;
        if constexpr (ALIGN_EPI) { if (wr == 1) PG8_BAR; }
    }
    PG8_WAIT_V(0);
    if constexpr (!ALIGN_EPI) { if (wr == 0) PG8_BAR; }
    PG8_BAR;
    if constexpr (Epi::AFTER_DRAIN) { E.fused(acc, cur, wr, wc, fr, fq, lds, wid, lane); S.done(cur); }
#undef PG8_SA
#undef PG8_SB
#undef PG8_STAGE
#undef PG8_LDA
#undef PG8_LDB
#undef PG8_MMA
#undef PG8_WAIT_V
#undef PG8_WAIT_L
#undef PG8_BAR
#undef PG8_SCHED
}
}

struct Params {
    const float *x, *c, *ctx, *c_ctx, *ada_w, *ada_b, *norm1_g, *norm2_g, *w_in, *pool_w, *pool_scale, *na_rpb, *swa_sink, *wba, *wbb, *wbc, *w_out, *peer_wq, *peer_keys, *peer_u, *peer_v, *final_g;
    float* out; unsigned char* ws;
};
#define TID (opaque_tid())
#define BID ((int)blockIdx.x)
#define NBLK ((int)gridDim.x)

__device__ __forceinline__ void tr_tiles(const float* __restrict__ W, bf16_t* __restrict__ Wt, int K, int N, float* tile  ) {
    const int ntn = N / 64, ntiles = (K / 64) * ntn, tid = TID, c = tid & 63, r8 = tid >> 6;
    for (int vb = BID; vb < ntiles; vb += NBLK) {
        const int k0 = (vb / ntn) * 64, n0 = (vb % ntn) * 64;
#pragma unroll
        for (int i = 0; i < 8; ++i) tile[(i * 8 + r8) * 65 + c] = W[(size_t)(k0 + i * 8 + r8) * N + n0 + c];
        __syncthreads();
#pragma unroll
        for (int i = 0; i < 8; ++i) Wt[(size_t)(n0 + i * 8 + r8) * K + k0 + c] = f2bf(tile[c * 65 + i * 8 + r8]);
        __syncthreads();
    }
}
__device__ __forceinline__ void conv_bf16(const float* __restrict__ src, bf16_t* __restrict__ dst, size_t n8) {
    for (size_t i = (size_t)BID * NTHREADS + TID; i < n8; i += (size_t)NBLK * NTHREADS) {
        const float4 a = ((const float4*)src)[2 * i], b = ((const float4*)src)[2 * i + 1];
        uint4 o; o.x = pk2(a.x, a.y); o.y = pk2(a.z, a.w); o.z = pk2(b.x, b.y); o.w = pk2(b.z, b.w);
        ((uint4*)dst)[i] = o;
    }
}
__device__ __forceinline__ void conv_fp8_rows(const float* __restrict__ src, unsigned* __restrict__ dst, float* __restrict__ inv, int nrows) {
    const int tid = TID, lane = tid & 63, gw = BID * 8 + (tid >> 6);
    for (int row = gw; row < nrows; row += NBLK * 8) {
        const float4* sp = (const float4*)(src + (size_t)row * D);
        float4 v[4]; float amax = 0.f;
#pragma unroll
        for (int i = 0; i < 4; ++i) { v[i] = sp[i * 64 + lane]; amax = fmaxf(amax, fmaxf(fmaxf(fabsf(v[i].x), fabsf(v[i].y)), fmaxf(fabsf(v[i].z), fabsf(v[i].w)))); }
#pragma unroll
        for (int o = 32; o > 0; o >>= 1) amax = fmaxf(amax, __shfl_xor(amax, o));
        const int k = (int)((__float_as_uint(amax) >> 23) & 255u) - 127;
        const bool ok = amax > 1e-30f;
        const float s = ok ? __uint_as_float((unsigned)(127 + 7 - k) << 23) : 1.f;
#pragma unroll
        for (int i = 0; i < 4; ++i) { int w = __builtin_amdgcn_cvt_pk_fp8_f32(v[i].x * s, v[i].y * s, 0, false); w = __builtin_amdgcn_cvt_pk_fp8_f32(v[i].z * s, v[i].w * s, w, true);
            dst[(size_t)row * 256 + i * 64 + lane] = (unsigned)w; }
        if (lane == 0) inv[row] = ok ? __uint_as_float((unsigned)(127 - 7 + k) << 23) : 1.f;
    }
}
__device__ __forceinline__ void copy_f4(const float* __restrict__ src, float* __restrict__ dst, size_t n4) {
    for (size_t i = (size_t)BID * NTHREADS + TID; i < n4; i += (size_t)NBLK * NTHREADS) ((float4*)dst)[i] = ((const float4*)src)[i];
}
__device__ __forceinline__ void ph_prep(const Params& p, float* smem) {
    unsigned char* ws = p.ws;
    for (int l = 0; l < 2; ++l) {
        unsigned char* wl = ws + WS_W + l * W_LAYER;
        tr_tiles(p.w_in + (size_t)l * D * IN_COLS, (bf16_t*)(wl + W_WIN), D, IN_COLS, smem);
        tr_tiles(p.wbb + (size_t)l * 512 * D, (bf16_t*)(wl + W_WB), 512, D, smem);
        tr_tiles(p.wbc + (size_t)l * 512 * D, (bf16_t*)(wl + W_WC), 512, D, smem);
        tr_tiles(p.w_out + (size_t)l * D * D, (bf16_t*)(wl + W_WO), D, D, smem);
        tr_tiles(p.peer_wq + (size_t)l * D * 2048, (bf16_t*)(wl + W_WQ), D, 2048, smem);
        {
            const float* pw = p.pool_w + (size_t)l * 4 * 128 * 128; const float* ps = p.pool_scale + l * 512; const float* wba = p.wba + (size_t)l * 512 * D; bf16_t* WaT = (bf16_t*)(wl + W_WA);
            for (int idx = BID * NTHREADS + TID; idx < 512 * D; idx += NBLK * NTHREADS) {
                const int n = idx % D, kk = idx / D, g = kk / 128, c = kk % 128;
                float acc = 0.f;
                for (int e = 0; e < 128; ++e) acc += pw[(g * 128 + c) * 128 + e] * ps[g * 128 + e] * wba[(size_t)(g * 128 + e) * D + n];
                WaT[(size_t)n * 512 + kk] = f2bf(acc);
            }
        }
        conv_bf16(p.peer_keys + (size_t)l * 8 * 2 * 128 * 128, (bf16_t*)(wl + W_KEYS), (size_t)8 * 2 * 128 * 128 / 8);
        if (l == 0 && !FP8_L0) {
            conv_bf16(p.peer_u, (bf16_t*)(ws + WS_TAB0), (size_t)NEXP * D / 8);
            conv_bf16(p.peer_v, (bf16_t*)(ws + WS_TAB0) + (size_t)NEXP * D, (size_t)NEXP * D / 8);
        } else {
            unsigned char* tl = ws + (l == 0 ? WS_TAB0 : WS_TAB1);
            conv_fp8_rows(p.peer_u + (size_t)l * NEXP * D, (unsigned*)tl, (float*)(tl + (size_t)2 * NEXP * D), NEXP);
            conv_fp8_rows(p.peer_v + (size_t)l * NEXP * D, (unsigned*)(tl + (size_t)NEXP * D), (float*)(tl + (size_t)2 * NEXP * D) + NEXP, NEXP);
        }
    }
    {
        float* sv = smem; float* part = smem + 5 * 1024; float* mod = (float*)(ws + WS_MOD);
        const int tid = TID, lane = tid & 63, wid = tid >> 6;
        for (int vb = BID; vb < 2 * 96; vb += NBLK) {
            const int l = vb / 96, j0 = (vb % 96) * 64;
            for (int i = tid; i < 5 * 1024; i += NTHREADS) { const int r = i >> 10, k = i & 1023; const float v = r < 4 ? p.c[r * 1024 + k] : p.c_ctx[k]; sv[i] = v / (1.f + __expf(-v)); }
            __syncthreads();
            float a0 = 0.f, a1 = 0.f, a2 = 0.f, a3 = 0.f, a4 = 0.f;
            const float* w = p.ada_w + ((size_t)l * 1024 + wid * 128) * 6144 + j0 + lane;
            for (int k = 0; k < 128; ++k) { const float xw = w[(size_t)k * 6144]; const int kk = wid * 128 + k;
                a0 += sv[kk] * xw; a1 += sv[1024 + kk] * xw; a2 += sv[2048 + kk] * xw; a3 += sv[3072 + kk] * xw; a4 += sv[4096 + kk] * xw; }
            part[(wid * 5 + 0) * 64 + lane] = a0; part[(wid * 5 + 1) * 64 + lane] = a1; part[(wid * 5 + 2) * 64 + lane] = a2; part[(wid * 5 + 3) * 64 + lane] = a3; part[(wid * 5 + 4) * 64 + lane] = a4;
            __syncthreads();
            if (tid < 320) { const int r = tid >> 6; float s = 0.f;
#pragma unroll
                for (int w8 = 0; w8 < 8; ++w8) s += part[(w8 * 5 + r) * 64 + lane];
                mod[((size_t)l * 5 + r) * 6144 + j0 + lane] = s + p.ada_b[l * 6144 + j0 + lane]; }
            __syncthreads();
        }
    }
    {
        float* tab = (float*)(ws + WS_ROPE);
        for (int i = BID * NTHREADS + TID; i < 1024; i += NBLK * NTHREADS) { const int pos = i / 16, fi = i % 16; const float inv = powf(10000.0f, -(float)fi / 16.0f), ang = (float)pos * inv; tab[i] = cosf(ang); tab[1024 + i] = sinf(ang); }
    }
    copy_f4(p.x, p.out, (size_t)T_LAT * D / 4);
    copy_f4(p.ctx, (float*)(ws + WS_XC), (size_t)T_CTX * D / 4);
}

typedef float f32x2v __attribute__((ext_vector_type(2)));
__device__ __forceinline__ float wave_sum(float v) {
#pragma unroll
    for (int o = 32; o > 0; o >>= 1) v += __shfl_xor(v, o);
    return v;
}
__device__ __forceinline__ void ph_norm_mod(const float* __restrict__ Xl, const float* __restrict__ Xc, const float* __restrict__ g, const float* __restrict__ modl, int shift_idx, int scale_idx, bf16_t* __restrict__ H, int nrows, unsigned* __restrict__ H8 = nullptr) {
    const int lane = TID & 63, gw = BID * 8 + (TID >> 6);
    for (int row = gw; row < nrows; row += NBLK * 8) {
        const float* src = row < T_LAT ? Xl + (size_t)row * D : Xc + (size_t)(row - T_LAT) * D;
        const int mrow = row < T_LAT ? row / S : 4;
        float4 v[4]; float ss = 0.f;
#pragma unroll
        for (int i = 0; i < 4; ++i) { v[i] = ((const float4*)src)[i * 64 + lane]; ss += v[i].x * v[i].x + v[i].y * v[i].y + v[i].z * v[i].z + v[i].w * v[i].w; }
        ss = wave_sum(ss);
        const float rstd = rsqrtf(ss * (1.0f / D) + EPS);
        const float* sh = modl + (size_t)mrow * 6144 + shift_idx * 1024; const float* sc = modl + (size_t)mrow * 6144 + scale_idx * 1024;
#pragma unroll
        for (int i = 0; i < 4; ++i) { const int k = (i * 64 + lane) * 4;
            const float4 gg = *(const float4*)(g + k), s4 = *(const float4*)(sc + k), h4 = *(const float4*)(sh + k);
            uint2 w; w.x = pk2(v[i].x * rstd * gg.x * (1.f + s4.x) + h4.x, v[i].y * rstd * gg.y * (1.f + s4.y) + h4.y);
            w.y = pk2(v[i].z * rstd * gg.z * (1.f + s4.z) + h4.z, v[i].w * rstd * gg.w * (1.f + s4.w) + h4.w);
            *(uint2*)(H + (size_t)row * D + k) = w;
            if (H8) {
                const float h0 = 8.f * lo16(w.x), h1 = 8.f * hi16(w.x), h2 = 8.f * lo16(w.y), h3 = 8.f * hi16(w.y);
                int hi = __builtin_amdgcn_cvt_pk_fp8_f32(h0, h1, 0, false); hi = __builtin_amdgcn_cvt_pk_fp8_f32(h2, h3, hi, true);
                const f32x2v d0 = __builtin_amdgcn_cvt_pk_f32_fp8(hi, false), d1 = __builtin_amdgcn_cvt_pk_f32_fp8(hi, true);
                int lo = __builtin_amdgcn_cvt_pk_fp8_f32(h0 - d0[0], h1 - d0[1], 0, false); lo = __builtin_amdgcn_cvt_pk_fp8_f32(h2 - d1[0], h3 - d1[1], lo, true);
                H8[(size_t)row * 256 + i * 64 + lane] = (unsigned)hi; H8[(size_t)T_ALL * 256 + (size_t)row * 256 + i * 64 + lane] = (unsigned)lo; } }
    }
}
__device__ __forceinline__ void ph_final_norm(float* __restrict__ X, const float* __restrict__ g) {
    const int lane = TID & 63, gw = BID * 8 + (TID >> 6);
    for (int row = gw; row < T_LAT; row += NBLK * 8) {
        float4* src = (float4*)(X + (size_t)row * D);
        float4 v[4]; float ss = 0.f;
#pragma unroll
        for (int i = 0; i < 4; ++i) { v[i] = src[i * 64 + lane]; ss += v[i].x * v[i].x + v[i].y * v[i].y + v[i].z * v[i].z + v[i].w * v[i].w; }
        ss = wave_sum(ss);
        const float rstd = rsqrtf(ss * (1.0f / D) + EPS);
#pragma unroll
        for (int i = 0; i < 4; ++i) { const float4 gg = ((const float4*)g)[i * 64 + lane]; float4 o = v[i]; o.x *= rstd * gg.x; o.y *= rstd * gg.y; o.z *= rstd * gg.z; o.w *= rstd * gg.w; src[i * 64 + lane] = o; }
    }
}

__device__ __forceinline__ void ph_postz(bf16_t* __restrict__ Z, const float* __restrict__ tab, bf16_t* __restrict__ vtn, bf16_t* __restrict__ vtnc, bf16_t* __restrict__ vtw, bf16_t* __restrict__ vtwc, bf16_t* __restrict__ Pa, int rows) {
    const size_t gtid = (size_t)BID * NTHREADS + TID, gsz = (size_t)NBLK * NTHREADS;
    for (size_t idx = gtid; idx < (size_t)T_LAT * 320; idx += gsz) {
        const int i = (int)(idx & 15), hh = (int)((idx >> 4) & 1), hs = (int)((idx >> 5) % 10), row = (int)(idx / 320);
        const int s = row % S, pos = hh ? (s % GW) : (s / GW);
        const int colbase = (hs < 2 ? OFF_KW + hs * 64 : OFF_QW + (hs - 2) * 64) + hh * 32 + i;
        bf16_t* pz = Z + (size_t)row * IN_COLS + colbase;
        const float x1 = bf2f(pz[0]), x2 = bf2f(pz[16]);
        const float cs = tab[pos * 16 + i], sn = tab[1024 + pos * 16 + i];
        pz[0] = f2bf(x1 * cs - x2 * sn); pz[16] = f2bf(x1 * sn + x2 * cs);
    }
    for (size_t idx = gtid; idx < (size_t)rows * 384; idx += gsz) {
        const int c8 = (int)(idx % 384); const size_t row = idx / 384;
        uint4* pz = (uint4*)(Z + row * IN_COLS + OFF_G + c8 * 8);
        uint4 v = *pz; unsigned w[4] = {v.x, v.y, v.z, v.w};
#pragma unroll
        for (int j = 0; j < 4; ++j) w[j] = pk2(1.f / (1.f + __expf(-lo16(w[j]))), 1.f / (1.f + __expf(-hi16(w[j]))));
        v.x = w[0]; v.y = w[1]; v.z = w[2]; v.w = w[3]; *pz = v;
    }
    for (size_t idx = gtid; idx < (size_t)T_ALL * 640; idx += gsz) {
        const int row = (int)(idx % T_ALL), j = (int)(idx / T_ALL);
        const bool lat = row < T_LAT; const int b = lat ? row / S : (row - T_LAT) / L, t = lat ? row % S : (row - T_LAT) % L, len = lat ? S : L;
        if (j < 512) { const bf16_t v = Z[(size_t)row * IN_COLS + OFF_VN + j]; bf16_t* dst = lat ? vtn : vtnc; dst[((size_t)(b * 8 + j / 64) * 64 + (j % 64)) * len + t] = v; }
        else { const int jj = j - 512; const bf16_t v = Z[(size_t)row * IN_COLS + OFF_VW + jj]; bf16_t* dst = lat ? vtw : vtwc; dst[((size_t)(b * 2 + jj / 64) * 64 + (jj % 64)) * len + t] = v; }
    }
    for (size_t idx = gtid; idx < (size_t)rows * 512; idx += gsz) {
        const int c = (int)(idx % 512), row = (int)(idx / 512);
        const int g = c / 128, w = 2 << g;
        const bool lat = row < T_LAT; const int len = lat ? S : L; const int t = lat ? row % S : (row - T_LAT) % L; const int base = row - t;
        int lo = t - w / 2; if (lo < 0) lo = 0; int hi = t - w / 2 + w; if (hi > len) hi = len;
        float sum = 0.f;
        for (int tt = lo; tt < hi; ++tt) sum += bf2f(Z[(size_t)(base + tt) * IN_COLS + OFF_A + c]);
        Pa[(size_t)row * 512 + c] = f2bf(sum / (float)(hi - lo) - bf2f(Z[(size_t)row * IN_COLS + OFF_A + c]));
    }
}

__device__ __forceinline__ void ph_pool(const bf16_t* __restrict__ Z, bf16_t* __restrict__ Pa, int rows, int tid) {
    for (int idx = BID * NTHREADS + tid; idx < rows * 64; idx += NBLK * NTHREADS) {
        const int c8 = idx & 63, row = idx >> 6, g = c8 >> 4, w = 2 << g;
        const bool lat = row < T_LAT; const int len = lat ? S : L; const int t = lat ? (row & (S - 1)) : ((row - T_LAT) & (L - 1)); const int base = row - t;
        int lo = t - w / 2; if (lo < 0) lo = 0; int hi = t - w / 2 + w; if (hi > len) hi = len;
        float sum[8];
#pragma unroll
        for (int i = 0; i < 8; ++i) sum[i] = 0.f;
        const bf16_t* zp = Z + (size_t)base * IN_COLS + OFF_A + c8 * 8;
        for (int tt = lo; tt < hi; ++tt) { const uint4 v = *(const uint4*)(zp + (size_t)tt * IN_COLS);
            sum[0] += lo16(v.x); sum[1] += hi16(v.x); sum[2] += lo16(v.y); sum[3] += hi16(v.y); sum[4] += lo16(v.z); sum[5] += hi16(v.z); sum[6] += lo16(v.w); sum[7] += hi16(v.w); }
        const uint4 sv = *(const uint4*)(zp + (size_t)t * IN_COLS); const float inv = 1.f / (float)(hi - lo);
        uint4 o; o.x = pk2(sum[0] * inv - lo16(sv.x), sum[1] * inv - hi16(sv.x)); o.y = pk2(sum[2] * inv - lo16(sv.y), sum[3] * inv - hi16(sv.y));
        o.z = pk2(sum[4] * inv - lo16(sv.z), sum[5] * inv - hi16(sv.z)); o.w = pk2(sum[6] * inv - lo16(sv.w), sum[7] * inv - hi16(sv.w));
        *(uint4*)(Pa + (size_t)row * 512 + c8 * 8) = o;
    }
}
typedef short bf16x8v __attribute__((ext_vector_type(8)));
typedef float f32x4v __attribute__((ext_vector_type(4)));
constexpr float LOG2E = 1.4426950408889634f;
constexpr float QK_SCALE2 = 0.125f * LOG2E;
constexpr float MASKED = -3.0e38f;
__device__ __forceinline__ unsigned cvtpk(float lo, float hi) { unsigned r; asm volatile("v_cvt_pk_bf16_f32 %0, %1, %2" : "=v"(r) : "v"(lo), "v"(hi)); return r; }
__device__ __forceinline__ f32x4v mfma16(bf16x8v a, bf16x8v b, f32x4v c) { return __builtin_amdgcn_mfma_f32_16x16x32_bf16(a, b, c, 0, 0, 0); }
struct AttnSt { f32x4v o[4]; float m, l; };
template <class Dsc>
__device__ __forceinline__ void attn_group(const Dsc& dsc, int c0, const bf16x8v qf0, const bf16x8v qf1, AttnSt& st, int lane) {
    f32x4v s[2][2]; bool live[2];
#pragma unroll
    for (int j = 0; j < 2; ++j) {
        live[j] = dsc.live(c0 + j);
        if (live[j]) {
#pragma unroll
            for (int tt = 0; tt < 2; ++tt) {
                const bf16_t* kp = dsc.kptr(c0 + j, tt);
                const bf16x8v a0 = *(const bf16x8v*)kp, a1 = *(const bf16x8v*)(kp + 32);
                f32x4v acc = (f32x4v){0.f, 0.f, 0.f, 0.f};
                acc = mfma16(a0, qf0, acc); acc = mfma16(a1, qf1, acc);
#pragma unroll
                for (int r = 0; r < 4; ++r) acc[r] = dsc.score(c0 + j, tt, r, acc[r]);
                s[j][tt] = acc;
            }
        } else { s[j][0] = (f32x4v){MASKED, MASKED, MASKED, MASKED}; s[j][1] = s[j][0]; }
    }
    float gmax = MASKED;
#pragma unroll
    for (int j = 0; j < 2; ++j)
#pragma unroll
        for (int tt = 0; tt < 2; ++tt)
#pragma unroll
            for (int r = 0; r < 4; ++r) gmax = fmaxf(gmax, s[j][tt][r]);
    gmax = fmaxf(gmax, __shfl_xor(gmax, 16)); gmax = fmaxf(gmax, __shfl_xor(gmax, 32));
    const float mnew = fmaxf(st.m, gmax), alpha = __builtin_amdgcn_exp2f(st.m - mnew);
    st.m = mnew;
    float psum = 0.f;
#pragma unroll
    for (int j = 0; j < 2; ++j)
#pragma unroll
        for (int tt = 0; tt < 2; ++tt)
#pragma unroll
            for (int r = 0; r < 4; ++r) { const float pv = __builtin_amdgcn_exp2f(s[j][tt][r] - mnew); s[j][tt][r] = pv; psum += pv; }
    st.l = st.l * alpha + psum;
    if (!__all(alpha == 1.0f)) {
        const int gb = (lane >> 4) * 4;
#pragma unroll
        for (int r = 0; r < 4; ++r) { const float ar = __shfl(alpha, gb + r);
#pragma unroll
            for (int dt = 0; dt < 4; ++dt) st.o[dt][r] *= ar; }
    }
#pragma unroll
    for (int j = 0; j < 2; ++j) if (live[j]) {
        union { unsigned u[4]; bf16x8v v; } pf;
        pf.u[0] = cvtpk(s[j][0][0], s[j][0][1]); pf.u[1] = cvtpk(s[j][0][2], s[j][0][3]); pf.u[2] = cvtpk(s[j][1][0], s[j][1][1]); pf.u[3] = cvtpk(s[j][1][2], s[j][1][3]);
        const bf16_t* vp = dsc.vptr(c0 + j); const size_t vs = dsc.vstride16();
#pragma unroll
        for (int dt = 0; dt < 4; ++dt) { const bf16x8v vf = *(const bf16x8v*)(vp + dt * vs); st.o[dt] = mfma16(pf.v, vf, st.o[dt]); }
    }
}
__device__ __forceinline__ void attn_finish(AttnSt& st, float sink2, bool has_sink, bf16_t* orow  , int lane) {
    float l = st.l; l += __shfl_xor(l, 16); l += __shfl_xor(l, 32);
    if (has_sink) l += __builtin_amdgcn_exp2f(sink2 - st.m);
    const float inv = 1.0f / l;
    const int gb = (lane >> 4) * 4, d = lane & 15;
#pragma unroll
    for (int r = 0; r < 4; ++r) { const float ir = __shfl(inv, gb + r);
#pragma unroll
        for (int dt = 0; dt < 4; ++dt) orow[(size_t)(gb + r) * 512 + dt * 16 + d] = f2bf(st.o[dt][r] * ir); }
}
__device__ __forceinline__ void attn_init_st(AttnSt& st) {
#pragma unroll
    for (int dt = 0; dt < 4; ++dt) st.o[dt] = (f32x4v){0.f, 0.f, 0.f, 0.f};
    st.m = -1.0e30f; st.l = 0.f;
}
__device__ __forceinline__ int clampi(int v, int lo, int hi) { return v < lo ? lo : (v > hi ? hi : v); }
struct NaLocalDsc {
    const bf16_t* kbase;
    const bf16_t* vbase;
    const float* rpb;
    int kc0, qc, qs, dr0;
    __device__ __forceinline__ bool live(int) const { return true; }
    __device__ __forceinline__ const bf16_t* kptr(int c, int tt) const { return kbase + (size_t)(c * 64 + 4 * tt) * IN_COLS; }
    __device__ __forceinline__ const bf16_t* vptr(int c) const { return vbase + c * 64; }
    __device__ __forceinline__ size_t vstride16() const { return (size_t)16 * S; }
    __device__ __forceinline__ float score(int c, int tt, int r, float raw) const {
        const int kc = kc0 + 4 * tt + r; const int dc = clampi(kc - qc + 15, 0, 30);
        const float bias = rpb[(dr0 + c) * 31 + dc];
        return (kc >= qs && kc < qs + 16) ? raw * QK_SCALE2 + bias : MASKED;
    }
};
struct CtxDsc {
    const bf16_t* kbase;
    const bf16_t* vbase;
    __device__ __forceinline__ bool live(int) const { return true; }
    __device__ __forceinline__ const bf16_t* kptr(int c, int tt) const { return kbase + (size_t)(c * 32 + 4 * tt) * IN_COLS; }
    __device__ __forceinline__ const bf16_t* vptr(int c) const { return vbase + c * 32; }
    __device__ __forceinline__ size_t vstride16() const { return (size_t)16 * L; }
    __device__ __forceinline__ float score(int, int, int, float raw) const { return raw * QK_SCALE2; }
};
struct SwaLocalDsc {
    const bf16_t* zrow;
    const bf16_t* vrow;
    int p0, kslot0, g8, qpos;
    __device__ __forceinline__ bool live(int c) const { const int pos0 = p0 - 128 + 32 * c; return c < 9 && pos0 + 31 >= 0 && pos0 < S; }
    __device__ __forceinline__ const bf16_t* kptr(int c, int tt) const { const int pos = clampi(p0 - 128 + 32 * c + kslot0 + 4 * tt, 0, S - 1); return zrow + (size_t)pos * IN_COLS; }
    __device__ __forceinline__ const bf16_t* vptr(int c) const { const int pos = clampi(p0 - 128 + 32 * c + g8, 0, S - 8); return vrow + pos; }
    __device__ __forceinline__ size_t vstride16() const { return (size_t)16 * S; }
    __device__ __forceinline__ float score(int c, int tt, int r, float raw) const {
        const int pos = p0 - 128 + 32 * c + g8 + 4 * tt + r; const int dlt = qpos - pos;
        return (pos >= 0 && pos < S && dlt <= 128 && dlt >= -128) ? raw * QK_SCALE2 : MASKED;
    }
};
__device__ __forceinline__ void ph_attn(const bf16_t* __restrict__ Z, const bf16_t* __restrict__ vtn, const bf16_t* __restrict__ vtnc, const bf16_t* __restrict__ vtw, const bf16_t* __restrict__ vtwc,
                                        const float* __restrict__ rpb, const float* __restrict__ sink, bf16_t* __restrict__ Ob, bf16_t* __restrict__ Oc, bool do_ctx, float* smem, bf16_t* __restrict__ Pa, int rows) {
    const int tid = TID, lane = tid & 63, wid = tid >> 6;
    for (int i = tid; i < 8 * 465; i += NTHREADS) smem[i] = rpb[i] * LOG2E;
    ph_pool(Z, Pa, rows, tid);
    __syncthreads();
    const int q = lane & 15, g = lane >> 4, kslot0 = (q >> 2) * 8 + (q & 3);
    const int vcu = (NBLK % 8 == 0) ? (BID % 8) * (NBLK / 8) + BID / 8 : BID;
    const int nunits = 8192 + 8192 + (do_ctx ? 1024 : 0);
    for (int u = vcu * 8 + wid; u < nunits; u += NBLK * 8) {
        AttnSt st; attn_init_st(st);
        if (u < 8192) {
            const int cb = u & 3, h = (u >> 2) & 7, r = (u >> 5) & 63, b = u >> 11;
            const int R0 = clampi(r - 4, 0, 56), C0 = clampi(cb * 16 - 8, 0, 32), qc = cb * 16 + q;
            const size_t t0 = (size_t)b * S + r * GW + cb * 16;
            const bf16_t* qp = Z + (t0 + q) * IN_COLS + OFF_QN + h * 64 + 8 * g;
            const bf16x8v qf0 = *(const bf16x8v*)qp, qf1 = *(const bf16x8v*)(qp + 32);
            NaLocalDsc dl; dl.kbase = Z + ((size_t)b * S + R0 * GW + C0 + kslot0) * IN_COLS + OFF_KN + h * 64 + 8 * g;
            dl.vbase = vtn + ((size_t)(b * 8 + h) * 64 + q) * S + R0 * GW + C0 + 8 * g; dl.rpb = smem + h * 465;
            dl.kc0 = C0 + 8 * g; dl.qc = qc; dl.qs = clampi(qc - 8, 0, 48); dl.dr0 = R0 - r + 7;
#pragma unroll 1
            for (int gi = 0; gi < 4; ++gi) attn_group(dl, 2 * gi, qf0, qf1, st, lane);
            CtxDsc dc; dc.kbase = Z + ((size_t)T_LAT + b * L + kslot0) * IN_COLS + OFF_KN + h * 64 + 8 * g; dc.vbase = vtnc + ((size_t)(b * 8 + h) * 64 + q) * L + 8 * g;
#pragma unroll 1
            for (int gi = 0; gi < 4; ++gi) attn_group(dc, 2 * gi, qf0, qf1, st, lane);
            attn_finish(st, 0.f, false, Ob + t0 * 512 + h * 64, lane);
        } else if (u < 16384) {
            const int v = u - 8192, rep = v & 3, qt = (v >> 2) & 255, g2 = (v >> 10) & 1, b = v >> 11, hq = g2 * 4 + rep, p0 = qt * 16;
            const size_t t0 = (size_t)b * S + p0;
            const bf16_t* qp = Z + (t0 + q) * IN_COLS + OFF_QW + hq * 64 + 8 * g;
            const bf16x8v qf0 = *(const bf16x8v*)qp, qf1 = *(const bf16x8v*)(qp + 32);
            SwaLocalDsc dl; dl.zrow = Z + (size_t)b * S * IN_COLS + OFF_KW + g2 * 64 + 8 * g; dl.vrow = vtw + ((size_t)(b * 2 + g2) * 64 + q) * S;
            dl.p0 = p0; dl.kslot0 = kslot0; dl.g8 = 8 * g; dl.qpos = p0 + q;
#pragma unroll 1
            for (int gi = 0; gi < 5; ++gi) attn_group(dl, 2 * gi, qf0, qf1, st, lane);
            CtxDsc dc; dc.kbase = Z + ((size_t)T_LAT + b * L + kslot0) * IN_COLS + OFF_KW + g2 * 64 + 8 * g; dc.vbase = vtwc + ((size_t)(b * 2 + g2) * 64 + q) * L + 8 * g;
#pragma unroll 1
            for (int gi = 0; gi < 4; ++gi) attn_group(dc, 2 * gi, qf0, qf1, st, lane);
            attn_finish(st, sink[hq] * LOG2E, true, Oc + t0 * 512 + hq * 64, lane);
        } else {
            const int v = u - 16384, qt = v & 15, h = (v >> 4) & 7, b = (v >> 7) & 3, which = v >> 9;
            const size_t t0 = (size_t)T_LAT + b * L + qt * 16;
            const int qoff = which ? OFF_QW : OFF_QN, koff = which ? OFF_KW + (h >> 2) * 64 : OFF_KN + h * 64;
            const bf16_t* qp = Z + (t0 + q) * IN_COLS + qoff + h * 64 + 8 * g;
            const bf16x8v qf0 = *(const bf16x8v*)qp, qf1 = *(const bf16x8v*)(qp + 32);
            CtxDsc dc; dc.kbase = Z + ((size_t)T_LAT + b * L + kslot0) * IN_COLS + koff + 8 * g;
            dc.vbase = which ? vtwc + ((size_t)(b * 2 + (h >> 2)) * 64 + q) * L + 8 * g : vtnc + ((size_t)(b * 8 + h) * 64 + q) * L + 8 * g;
#pragma unroll 1
            for (int gi = 0; gi < 4; ++gi) attn_group(dc, 2 * gi, qf0, qf1, st, lane);
            attn_finish(st, which ? sink[h] * LOG2E : 0.f, which != 0, (which ? Oc : Ob) + t0 * 512 + h * 64, lane);
        }
    }
}

__device__ __forceinline__ float embed(float v, unsigned mask, unsigned code) { return __uint_as_float((__float_as_uint(v) & ~mask) | code); }
__device__ __forceinline__ float gmax4(float v) { v = fmaxf(v, __shfl_xor(v, 16)); return fmaxf(v, __shfl_xor(v, 32)); }
__device__ __forceinline__ void ph_peer_topk(const bf16_t* __restrict__ Q, const bf16_t* __restrict__ keys, int* __restrict__ eidx, float* __restrict__ egate, int rows, float* smem) {
    const int tid = TID, lane = tid & 63, wid = tid >> 6, n = lane & 15, g = lane >> 4;
    int* lidx = (int*)smem + wid * 512;
    const float NEG = -3.0e38f;
    const int nunits = (rows / 16) * 8;
    for (int u = BID * 8 + wid; u < nunits; u += NBLK * 8) {
        const int h = u & 7, t0 = (u >> 3) * 16;
        float tops[2][16];
#pragma unroll
        for (int pp = 0; pp < 2; ++pp) {
            const bf16_t* qp = Q + (size_t)(t0 + n) * 2048 + h * 256 + pp * 128 + 8 * g;
            bf16x8v qf[4];
#pragma unroll
            for (int ks = 0; ks < 4; ++ks) qf[ks] = *(const bf16x8v*)(qp + ks * 32);
            const bf16_t* kp = keys + ((size_t)(h * 2 + pp) * 128 + n) * 128 + 8 * g;
            float sc[32];
#pragma unroll
            for (int T = 0; T < 8; ++T) {
                f32x4v acc = (f32x4v){0.f, 0.f, 0.f, 0.f};
#pragma unroll
                for (int ks = 0; ks < 4; ++ks) { const bf16x8v a = *(const bf16x8v*)(kp + (size_t)T * 16 * 128 + ks * 32); acc = mfma16(a, qf[ks], acc); }
#pragma unroll
                for (int r = 0; r < 4; ++r) sc[T * 4 + r] = embed(acc[r], 127u, (unsigned)(T * 16 + 4 * g + r));
            }
#pragma unroll
            for (int rd = 0; rd < 16; ++rd) {
                float mx = sc[0];
#pragma unroll
                for (int k = 1; k < 32; ++k) mx = fmaxf(mx, sc[k]);
                mx = gmax4(mx);
                tops[pp][rd] = mx;
                if (g == 0) lidx[(n * 2 + pp) * 16 + rd] = (int)(__float_as_uint(mx) & 127u);
#pragma unroll
                for (int k = 0; k < 32; ++k) sc[k] = (sc[k] == mx) ? NEG : sc[k];
            }
        }
        float bsel[4];
#pragma unroll
        for (int jj = 0; jj < 4; ++jj) bsel[jj] = g == 0 ? tops[1][4 * jj] : (g == 1 ? tops[1][4 * jj + 1] : (g == 2 ? tops[1][4 * jj + 2] : tops[1][4 * jj + 3]));
        float cd[21];
#pragma unroll
        for (int i = 0; i < 16; ++i) cd[i] = embed(tops[0][i] + bsel[0], 255u, (unsigned)((i << 4) | g));
#pragma unroll
        for (int i = 0; i < 3; ++i) cd[16 + i] = embed(tops[0][i] + bsel[1], 255u, (unsigned)((i << 4) | 4 | g));
        cd[19] = embed(tops[0][0] + bsel[2], 255u, (unsigned)(8 | g));
        cd[20] = embed(tops[0][0] + bsel[3], 255u, (unsigned)(12 | g));
        float best[16];
#pragma unroll
        for (int rd = 0; rd < 16; ++rd) {
            float mx = cd[0];
#pragma unroll
            for (int k = 1; k < 21; ++k) mx = fmaxf(mx, cd[k]);
            mx = gmax4(mx);
            best[rd] = mx;
#pragma unroll
            for (int k = 0; k < 21; ++k) cd[k] = (cd[k] == mx) ? NEG : cd[k];
        }
        float ex[16]; float sum = 0.f;
#pragma unroll
        for (int rd = 0; rd < 16; ++rd) { ex[rd] = __builtin_amdgcn_exp2f((best[rd] - best[0]) * LOG2E); sum += ex[rd]; }
        const float inv = 1.0f / sum;
        asm volatile("s_waitcnt lgkmcnt(0)" ::: "memory");
        int eo[4]; float go[4];
#pragma unroll
        for (int rr = 0; rr < 4; ++rr) {
            const float bv = g == 0 ? best[rr] : (g == 1 ? best[4 + rr] : (g == 2 ? best[8 + rr] : best[12 + rr]));
            const float ev = g == 0 ? ex[rr] : (g == 1 ? ex[4 + rr] : (g == 2 ? ex[8 + rr] : ex[12 + rr]));
            const unsigned code = __float_as_uint(bv) & 255u;
            eo[rr] = lidx[(n * 2 + 0) * 16 + (code >> 4)] * 128 + lidx[(n * 2 + 1) * 16 + (code & 15u)];
            go[rr] = ev * inv;
        }
        const size_t o = (size_t)(t0 + n) * 128 + h * 16 + 4 * g;
        *(int4*)(eidx + o) = make_int4(eo[0], eo[1], eo[2], eo[3]);
        *(float4*)(egate + o) = make_float4(go[0], go[1], go[2], go[3]);
        asm volatile("s_waitcnt lgkmcnt(0)" ::: "memory");
    }
}
__device__ __forceinline__ void ph_peer_gather_bf16(const bf16_t* __restrict__ H, const bf16_t* __restrict__ U, const bf16_t* __restrict__ V, const int* __restrict__ eidx, const float* __restrict__ egate,
                                               const float* __restrict__ modl, float* __restrict__ Xl, float* __restrict__ Xc, int rows,
                                               int mode, const float* __restrict__ gn, const float* __restrict__ modn, bf16_t* __restrict__ Hn, float* smem, bool dry = false) {
    const int tid = TID, lane = tid & 63, wid = tid >> 6, m = lane & 15, gk = lane >> 4;
    float* wl = smem + wid * 128;
    for (int t = BID * 8 + wid; t < rows; t += NBLK * 8) {
        const int e0 = eidx[(size_t)t * 128 + lane], e1 = eidx[(size_t)t * 128 + 64 + lane];
        const bf16_t* rp[8];
#pragma unroll
        for (int T = 0; T < 8; ++T) { const int e = __shfl(T < 4 ? e0 : e1, (T & 3) * 16 + m); rp[T] = U + (size_t)e * D + 8 * gk; }
        f32x4v acc[8];
#pragma unroll
        for (int T = 0; T < 8; ++T) acc[T] = (f32x4v){0.f, 0.f, 0.f, 0.f};
        const bf16_t* hp = H + (size_t)t * D + 8 * gk;
#pragma unroll 2
        for (int ks = 0; ks < 32; ++ks) {
            const bf16x8v hb = *(const bf16x8v*)(hp + ks * 32);
#pragma unroll
            for (int T = 0; T < 8; ++T) { const bf16x8v a = *(const bf16x8v*)(rp[T] + ks * 32); acc[T] = mfma16(a, hb, acc[T]); }
        }
        const int myT = m >> 1, r0 = (m & 1) * 2;
        float va = 0.f, vb = 0.f;
#pragma unroll
        for (int T = 0; T < 8; ++T) { const float x0 = r0 ? acc[T][2] : acc[T][0], x1 = r0 ? acc[T][3] : acc[T][1]; if (myT == T) { va = x0; vb = x1; } }
        const int ee = myT * 16 + 4 * gk + r0;
        const float2 gg = *(const float2*)(egate + (size_t)t * 128 + ee);
        float2 ww; ww.x = gg.x * 0.5f * va * (1.f + erff(va * 0.70710678118654752f)); ww.y = gg.y * 0.5f * vb * (1.f + erff(vb * 0.70710678118654752f));
        *(float2*)(wl + ee) = ww;
        asm volatile("s_waitcnt lgkmcnt(0)" ::: "memory");
        const float w0 = wl[lane], w1 = wl[64 + lane];
        asm volatile("s_waitcnt lgkmcnt(0)" ::: "memory");
        float out[16];
#pragma unroll
        for (int i = 0; i < 16; ++i) out[i] = 0.f;
        const bf16_t* vb0 = V + lane * 8;
#pragma unroll
        for (int hh = 0; hh < 2; ++hh) {
            const int ev = hh ? e1 : e0; const int wbits = __float_as_int(hh ? w1 : w0);
#pragma unroll 8
            for (int k = 0; k < 64; ++k) {
                const int e = __builtin_amdgcn_readlane(ev, k); const float w = __int_as_float(__builtin_amdgcn_readlane(wbits, k));
                const bf16_t* vp = vb0 + (size_t)e * D;
                const uint4 a = *(const uint4*)vp, b = *(const uint4*)(vp + 512);
                out[0] += w * lo16(a.x); out[1] += w * hi16(a.x); out[2] += w * lo16(a.y); out[3] += w * hi16(a.y); out[4] += w * lo16(a.z); out[5] += w * hi16(a.z); out[6] += w * lo16(a.w); out[7] += w * hi16(a.w);
                out[8] += w * lo16(b.x); out[9] += w * hi16(b.x); out[10] += w * lo16(b.y); out[11] += w * hi16(b.y); out[12] += w * lo16(b.z); out[13] += w * hi16(b.z); out[14] += w * lo16(b.w); out[15] += w * hi16(b.w);
            }
        }
        const int mrow = t < T_LAT ? t / S : 4;
        float* xp = t < T_LAT ? Xl + (size_t)t * D : Xc + (size_t)(t - T_LAT) * D;
        const float* gt = modl + (size_t)mrow * 6144 + 5 * 1024;
        float xr[16]; float ss = 0.f;
#pragma unroll
        for (int q4 = 0; q4 < 4; ++q4) { const int col = (q4 >> 1) * 512 + lane * 8 + (q4 & 1) * 4;
            const float4 x = *(const float4*)(xp + col), g4 = *(const float4*)(gt + col);
            xr[q4 * 4 + 0] = x.x + g4.x * out[q4 * 4 + 0]; xr[q4 * 4 + 1] = x.y + g4.y * out[q4 * 4 + 1]; xr[q4 * 4 + 2] = x.z + g4.z * out[q4 * 4 + 2]; xr[q4 * 4 + 3] = x.w + g4.w * out[q4 * 4 + 3];
#pragma unroll
            for (int i = 0; i < 4; ++i) ss += xr[q4 * 4 + i] * xr[q4 * 4 + i]; }
        ss = wave_sum(ss);
        const float rstd = rsqrtf(ss * (1.0f / D) + EPS);
        if (dry && rstd != 12345.678f) continue;
        if (mode == 0) {
            const float* shn = modn + (size_t)mrow * 6144; const float* scn = shn + 1024;
#pragma unroll
            for (int q4 = 0; q4 < 4; ++q4) { const int col = (q4 >> 1) * 512 + lane * 8 + (q4 & 1) * 4;
                *(float4*)(xp + col) = make_float4(xr[q4 * 4], xr[q4 * 4 + 1], xr[q4 * 4 + 2], xr[q4 * 4 + 3]);
                const float4 g4 = *(const float4*)(gn + col), s4 = *(const float4*)(scn + col), h4 = *(const float4*)(shn + col);
                uint2 w; w.x = pk2(xr[q4 * 4] * rstd * g4.x * (1.f + s4.x) + h4.x, xr[q4 * 4 + 1] * rstd * g4.y * (1.f + s4.y) + h4.y);
                w.y = pk2(xr[q4 * 4 + 2] * rstd * g4.z * (1.f + s4.z) + h4.z, xr[q4 * 4 + 3] * rstd * g4.w * (1.f + s4.w) + h4.w);
                *(uint2*)(Hn + (size_t)t * D + col) = w; }
        } else {
#pragma unroll
            for (int q4 = 0; q4 < 4; ++q4) { const int col = (q4 >> 1) * 512 + lane * 8 + (q4 & 1) * 4;
                const float4 g4 = *(const float4*)(gn + col);
                *(float4*)(xp + col) = make_float4(xr[q4 * 4] * rstd * g4.x, xr[q4 * 4 + 1] * rstd * g4.y, xr[q4 * 4 + 2] * rstd * g4.z, xr[q4 * 4 + 3] * rstd * g4.w); }
        }
    }
}

typedef long i64v;
typedef long i64x2v __attribute__((ext_vector_type(2)));
__device__ __forceinline__ f32x4v mfma8(i64v a, i64v b, f32x4v c) { return __builtin_amdgcn_mfma_f32_16x16x32_fp8_fp8(a, b, c, 0, 0, 0); }
__device__ __forceinline__ void ph_peer_gather_fp8(const unsigned char* __restrict__ H8, const unsigned char* __restrict__ U8, const unsigned char* __restrict__ V8, const float* __restrict__ isu, const float* __restrict__ isv,
                                               const int* __restrict__ eidx, const float* __restrict__ egate,
                                               const float* __restrict__ modl, float* __restrict__ Xl, float* __restrict__ Xc, int rows,
                                               int mode, const float* __restrict__ gn, const float* __restrict__ modn, bf16_t* Hn, float* smem, bool dry = false) {
    const int tid = TID, lane = tid & 63, wid = tid >> 6, m = lane & 15, gk = lane >> 4;
    float* wl = smem + wid * 128;
    for (int t = BID * 8 + wid; t < rows; t += NBLK * 8) {
        const int e0 = eidx[(size_t)t * 128 + lane], e1 = eidx[(size_t)t * 128 + 64 + lane];
        unsigned rp[8];
#pragma unroll
        for (int T = 0; T < 8; ++T) { const int e = __shfl(T < 4 ? e0 : e1, (T & 3) * 16 + m); rp[T] = (unsigned)e * (unsigned)D + 16u * (unsigned)gk; }
        f32x4v acc[8];
#pragma unroll
        for (int T = 0; T < 8; ++T) acc[T] = (f32x4v){0.f, 0.f, 0.f, 0.f};
        const unsigned char* hp = H8 + (size_t)t * D + 16 * gk;
#if RING_U
        i64x2v A[3][8], Bh[3], Bl[3];
#define GLOADK(ks) do { _Pragma("unroll") for (int T = 0; T < 8; ++T) A[(ks) % 3][T] = *(const i64x2v*)(U8 + (rp[T] + (unsigned)((ks) * 64))); \
                        Bh[(ks) % 3] = *(const i64x2v*)(hp + (ks) * 64); Bl[(ks) % 3] = *(const i64x2v*)(hp + (size_t)T_ALL * D + (ks) * 64); } while (0)
        GLOADK(0); GLOADK(1);
#pragma unroll
        for (int ks = 0; ks < 16; ++ks) {
            if (ks + 2 < 16) GLOADK(ks + 2);
            __builtin_amdgcn_sched_barrier(0);
#pragma unroll
            for (int T = 0; T < 8; ++T) { const i64x2v a = A[ks % 3][T];
                acc[T] = mfma8(a[0], Bh[ks % 3][0], acc[T]); acc[T] = mfma8(a[0], Bl[ks % 3][0], acc[T]); acc[T] = mfma8(a[1], Bh[ks % 3][1], acc[T]); acc[T] = mfma8(a[1], Bl[ks % 3][1], acc[T]); }
            __builtin_amdgcn_sched_barrier(0);
        }
#undef GLOADK
#else
#pragma unroll 2
        for (int ks = 0; ks < 16; ++ks) {
            const i64x2v bh = *(const i64x2v*)(hp + ks * 64), bl = *(const i64x2v*)(hp + (size_t)T_ALL * D + ks * 64);
            i64x2v a[8];
#pragma unroll
            for (int T = 0; T < 8; ++T) a[T] = *(const i64x2v*)(U8 + (rp[T] + (unsigned)(ks * 64)));
#pragma unroll
            for (int T = 0; T < 8; ++T) { acc[T] = mfma8(a[T][0], bh[0], acc[T]); acc[T] = mfma8(a[T][0], bl[0], acc[T]); acc[T] = mfma8(a[T][1], bh[1], acc[T]); acc[T] = mfma8(a[T][1], bl[1], acc[T]); }
        }
#endif
        const int myT = m >> 1, r0 = (m & 1) * 2;
        float va = 0.f, vb = 0.f;
#pragma unroll
        for (int T = 0; T < 8; ++T) { const float x0 = r0 ? acc[T][2] : acc[T][0], x1 = r0 ? acc[T][3] : acc[T][1]; if (myT == T) { va = x0; vb = x1; } }
        const int ee = myT * 16 + 4 * gk + r0;
        const int ida0 = __shfl(e0, ee & 63), ida1 = __shfl(e1, ee & 63), idb0 = __shfl(e0, (ee + 1) & 63), idb1 = __shfl(e1, (ee + 1) & 63);
        const int ida = ee < 64 ? ida0 : ida1, idb = ee < 64 ? idb0 : idb1;
        va *= 0.125f * isu[ida]; vb *= 0.125f * isu[idb];
        const float2 gg = *(const float2*)(egate + (size_t)t * 128 + ee);
        float2 ww; ww.x = gg.x * 0.5f * va * (1.f + erff(va * 0.70710678118654752f)); ww.y = gg.y * 0.5f * vb * (1.f + erff(vb * 0.70710678118654752f));
        *(float2*)(wl + ee) = ww;
        asm volatile("s_waitcnt lgkmcnt(0)" ::: "memory");
        const float w0 = wl[lane] * isv[e0], w1 = wl[64 + lane] * isv[e1];
        asm volatile("s_waitcnt lgkmcnt(0)" ::: "memory");
        float out[16];
#pragma unroll
        for (int i = 0; i < 16; ++i) out[i] = 0.f;
        const unsigned voff = 16u * (unsigned)lane;
#if RING_V
        uint4 VR[2][8];
#define VLOADC(c, slot) do { const int ev_ = ((c) & 8) ? e1 : e0; _Pragma("unroll") for (int j = 0; j < 8; ++j) { const int e = __builtin_amdgcn_readlane(ev_, ((c) & 7) * 8 + j); VR[slot][j] = *(const uint4*)(V8 + ((unsigned)e * (unsigned)D + voff)); } } while (0)
#define VCOMPC(c, slot) do { const int wb_ = __float_as_int(((c) & 8) ? w1 : w0); _Pragma("unroll") for (int j = 0; j < 8; ++j) { const float w = __int_as_float(__builtin_amdgcn_readlane(wb_, ((c) & 7) * 8 + j)); \
            const unsigned aw[4] = {VR[slot][j].x, VR[slot][j].y, VR[slot][j].z, VR[slot][j].w}; \
            _Pragma("unroll") for (int q = 0; q < 4; ++q) { const f32x2v d0 = __builtin_amdgcn_cvt_pk_f32_fp8((int)aw[q], false), d1 = __builtin_amdgcn_cvt_pk_f32_fp8((int)aw[q], true); \
                out[4 * q] += w * d0[0]; out[4 * q + 1] += w * d0[1]; out[4 * q + 2] += w * d1[0]; out[4 * q + 3] += w * d1[1]; } } } while (0)
        VLOADC(0, 0);
#pragma unroll 1
        for (int c2 = 0; c2 < 16; c2 += 2) {
            VLOADC(c2 + 1, 1); __builtin_amdgcn_sched_barrier(0); VCOMPC(c2, 0); __builtin_amdgcn_sched_barrier(0);
            if (c2 + 2 < 16) VLOADC(c2 + 2, 0); __builtin_amdgcn_sched_barrier(0); VCOMPC(c2 + 1, 1); __builtin_amdgcn_sched_barrier(0);
        }
#undef VLOADC
#undef VCOMPC
#else
#pragma unroll
        for (int hh = 0; hh < 2; ++hh) {
            const int ev = hh ? e1 : e0; const int wbits = __float_as_int(hh ? w1 : w0);
#pragma unroll 16
            for (int k = 0; k < 64; ++k) {
                const int e = __builtin_amdgcn_readlane(ev, k); const float w = __int_as_float(__builtin_amdgcn_readlane(wbits, k));
                const uint4 a = *(const uint4*)(V8 + ((unsigned)e * (unsigned)D + voff));
                const unsigned aw[4] = {a.x, a.y, a.z, a.w};
#pragma unroll
                for (int q = 0; q < 4; ++q) { const f32x2v d0 = __builtin_amdgcn_cvt_pk_f32_fp8((int)aw[q], false), d1 = __builtin_amdgcn_cvt_pk_f32_fp8((int)aw[q], true);
                    out[4 * q] += w * d0[0]; out[4 * q + 1] += w * d0[1]; out[4 * q + 2] += w * d1[0]; out[4 * q + 3] += w * d1[1]; }
            }
        }
#endif
        const int mrow = t < T_LAT ? t / S : 4;
        float* xp = (t < T_LAT ? Xl + (size_t)t * D : Xc + (size_t)(t - T_LAT) * D) + lane * 16;
        const float* gt = modl + (size_t)mrow * 6144 + 5 * 1024 + lane * 16;
        float xr[16]; float ss = 0.f;
#pragma unroll
        for (int q4 = 0; q4 < 4; ++q4) {
            const float4 x = *(const float4*)(xp + q4 * 4), g4 = *(const float4*)(gt + q4 * 4);
            xr[q4 * 4 + 0] = x.x + g4.x * out[q4 * 4 + 0]; xr[q4 * 4 + 1] = x.y + g4.y * out[q4 * 4 + 1]; xr[q4 * 4 + 2] = x.z + g4.z * out[q4 * 4 + 2]; xr[q4 * 4 + 3] = x.w + g4.w * out[q4 * 4 + 3];
#pragma unroll
            for (int i = 0; i < 4; ++i) ss += xr[q4 * 4 + i] * xr[q4 * 4 + i]; }
        ss = wave_sum(ss);
        const float rstd = rsqrtf(ss * (1.0f / D) + EPS);
        if (dry && rstd != 12345.678f) continue;
        if (mode == 0) {
            const float* shn = modn + (size_t)mrow * 6144 + lane * 16; const float* scn = shn + 1024; const float* gp = gn + lane * 16;
#pragma unroll
            for (int q4 = 0; q4 < 4; ++q4) {
                *(float4*)(xp + q4 * 4) = make_float4(xr[q4 * 4], xr[q4 * 4 + 1], xr[q4 * 4 + 2], xr[q4 * 4 + 3]);
                const float4 g4 = *(const float4*)(gp + q4 * 4), s4 = *(const float4*)(scn + q4 * 4), h4 = *(const float4*)(shn + q4 * 4);
                uint2 w; w.x = pk2(xr[q4 * 4] * rstd * g4.x * (1.f + s4.x) + h4.x, xr[q4 * 4 + 1] * rstd * g4.y * (1.f + s4.y) + h4.y);
                w.y = pk2(xr[q4 * 4 + 2] * rstd * g4.z * (1.f + s4.z) + h4.z, xr[q4 * 4 + 3] * rstd * g4.w * (1.f + s4.w) + h4.w);
                *(uint2*)(Hn + (size_t)t * D + lane * 16 + q4 * 4) = w; }
        } else {
            const float* gp = gn + lane * 16;
#pragma unroll
            for (int q4 = 0; q4 < 4; ++q4) { const float4 g4 = *(const float4*)(gp + q4 * 4);
                *(float4*)(xp + q4 * 4) = make_float4(xr[q4 * 4] * rstd * g4.x, xr[q4 * 4 + 1] * rstd * g4.y, xr[q4 * 4 + 2] * rstd * g4.z, xr[q4 * 4 + 3] * rstd * g4.w); }
        }
    }
}

#define LAS __attribute__((address_space(3)))
#define XB_TMO      128
#define XB_XCNT(j)  (256  + 64 * (j))
#define XB_XSUB(j)  (1280 + 64 * (j))
#define XB_XGEN(j)  (2304 + 64 * (j))
#define XB_TOP      3328
#define XB_TOPGEN   3392
#define XCD_BAR_WORDS 3456
#define XB_SPIN_CAP (1u << 18)

__device__ __forceinline__ unsigned xb_ld(unsigned* p)              { return __hip_atomic_load(p, __ATOMIC_RELAXED, __HIP_MEMORY_SCOPE_AGENT); }
__device__ __forceinline__ unsigned xb_add(unsigned* p, unsigned v) { return __hip_atomic_fetch_add(p, v, __ATOMIC_RELAXED, __HIP_MEMORY_SCOPE_AGENT); }
__device__ __forceinline__ unsigned xb_xcc_id() { return (unsigned)__builtin_amdgcn_s_getreg((3 << 11) | 20) & 0xFu; }
#define XB_SPIN(cond, bar) do { unsigned _sp = 0; while (cond) { __builtin_amdgcn_s_sleep(1); \
    if ((++_sp & 255u) == 0u) { if (xb_ld(&(bar)[XB_TMO])) break; if (_sp > XB_SPIN_CAP) { atomicAdd(&(bar)[XB_TMO], 1u); break; } } } } while (0)

struct XcdBarrier {
    unsigned* bar; unsigned x;
    volatile LAS unsigned* st;
};

__device__ __forceinline__ XcdBarrier xcd_barrier_post(unsigned* bar, volatile LAS unsigned* st) {
    XcdBarrier b; b.bar = bar; b.x = xb_xcc_id(); b.st = st;
    if (threadIdx.x == 0) (void)xb_add(&bar[XB_XCNT(b.x)], 1u);
    return b;
}
__device__ __forceinline__ void xcd_barrier_complete(unsigned* bar, unsigned x, unsigned& nloc, unsigned& nx) {
    const unsigned G = gridDim.x * gridDim.y * gridDim.z;
    unsigned sum, cnt, mine, sp = 0u;
    for (;;) {
        sum = 0u; cnt = 0u; mine = 0u;
#pragma unroll
        for (unsigned j = 0; j < 16; ++j) { const unsigned c = xb_ld(&bar[XB_XCNT(j)]); sum += c; cnt += (c > 0u) ? 1u : 0u; mine = (j == x) ? c : mine; }
        if (sum == G) break;
        __builtin_amdgcn_s_sleep(1);
        if ((++sp & 255u) == 0u) { if (xb_ld(&bar[XB_TMO])) break; if (sp > XB_SPIN_CAP) { atomicAdd(&bar[XB_TMO], 1u); break; } }
    }
    nloc = mine > 0u ? mine : 1u; nx = cnt > 0u ? cnt : 1u;
}

__device__ __forceinline__ void xcd_barrier(const XcdBarrier& b) {
    asm volatile("s_waitcnt vmcnt(0)" ::: "memory");
    __syncthreads();
    if (threadIdx.x == 0) {
        unsigned* bar = b.bar;
        __builtin_amdgcn_s_waitcnt(0);
        unsigned nloc = b.st[0], nx = b.st[1];
        if (nloc == 0u) { xcd_barrier_complete(bar, b.x, nloc, nx); b.st[0] = nloc; b.st[1] = nx; }
        const unsigned old = xb_add(&bar[XB_XSUB(b.x)], 1u);
        const unsigned gen = old / nloc;
        if (old + 1u == (gen + 1u) * nloc) {
            __builtin_amdgcn_fence(__ATOMIC_RELEASE, "agent");
            asm volatile("s_waitcnt vmcnt(0)" ::: "memory");
            const unsigned og = xb_add(&bar[XB_TOP], 1u);
            const unsigned tg = og / nx;
            if (og + 1u == (tg + 1u) * nx) xb_add(&bar[XB_TOPGEN], 1u);
            else XB_SPIN(xb_ld(&bar[XB_TOPGEN]) == tg, bar);
            __builtin_amdgcn_fence(__ATOMIC_ACQUIRE, "agent");
            xb_add(&bar[XB_XGEN(b.x)], 1u);
            asm volatile("s_waitcnt vmcnt(0)" ::: "memory");
        } else {
            XB_SPIN(xb_ld(&bar[XB_XGEN(b.x)]) == gen, bar);
            __builtin_amdgcn_fence(__ATOMIC_ACQUIRE, "agent");
            asm volatile("s_waitcnt vmcnt(0)" ::: "memory");
        }
    }
    __syncthreads();
}

__device__ __forceinline__ unsigned char* launder(unsigned char* q) { size_t z = 0; asm volatile("" : "+s"(z)); return q + z; }
struct WsPtrs { float *mod, *rope, *XC, *X; bf16_t *H, *Z, *vtn, *vtnc, *vtw, *vtwc, *AT; int* eidx; float* egate; unsigned char* wl; const float* modl; const unsigned char *U8, *V8, *H8; const float *isu, *isv; const bf16_t *U, *V; };
__device__ __forceinline__ WsPtrs mkptrs(const Params& p, int l) {
    unsigned char* ws = launder(p.ws); WsPtrs P;
    P.mod = (float*)(ws + WS_MOD); P.rope = (float*)(ws + WS_ROPE); P.XC = (float*)(ws + WS_XC); P.X = (float*)launder((unsigned char*)p.out);
    P.H = (bf16_t*)(ws + WS_H); P.Z = (bf16_t*)(ws + WS_Z); P.vtn = (bf16_t*)(ws + WS_VTN); P.vtnc = (bf16_t*)(ws + WS_VTNC); P.vtw = (bf16_t*)(ws + WS_VTW); P.vtwc = (bf16_t*)(ws + WS_VTWC);
    P.AT = (bf16_t*)(ws + WS_AT); P.eidx = (int*)(ws + WS_EIDX); P.egate = (float*)(ws + WS_EGATE);
    P.wl = ws + WS_W + l * W_LAYER; P.modl = P.mod + (size_t)l * 5 * 6144; P.U = (const bf16_t*)(ws + WS_TAB0); P.V = P.U + (size_t)NEXP * D; P.U8 = ws + ((l == 0) ? WS_TAB0 : WS_TAB1); P.V8 = P.U8 + (size_t)NEXP * D; P.isu = (const float*)(P.U8 + (size_t)2 * NEXP * D); P.isv = P.isu + NEXP; P.H8 = ws + WS_H8;
    return P;
}
__global__ void __launch_bounds__(NTHREADS, 2) mega_fwd(Params p) {
    extern __shared__ __attribute__((aligned(16))) unsigned char lds[];
    cg::grid_group grid = cg::this_grid();
    PG8_LAS unsigned char* ldsr = (PG8_LAS unsigned char*)lds;
    float* smem = (float*)lds;
    volatile LAS unsigned* bst = (volatile LAS unsigned*)((LAS unsigned char*)lds + 131072 + 256);
    if (threadIdx.x < 2) bst[threadIdx.x] = 0u;
    __syncthreads();
    const XcdBarrier xbar = xcd_barrier_post((unsigned*)(p.ws + WS_CTL), bst);

#ifndef PROBE_DUP
#define PROBE_DUP 0
#endif

#define SYNC() xcd_barrier(xbar)
#define DUP(k, PH) do { PH; SYNC(); if (PROBE_DUP == (k)) { PH; SYNC(); } } while (0)
#define PH_NORM1() { const WsPtrs P = mkptrs(p, l); ph_norm_mod(P.X, P.XC, p.norm1_g, P.modl, 0, 1, P.H, T_ALL); }
#define PH_ZGEMM() {     \
            const WsPtrs P = mkptrs(p, l); \
            pg8::EpiZ E{P.Z, P.rope, P.vtn, P.vtnc, P.vtw, P.vtwc, 0, 0}; \
            if (!last) { pg8::Gemm g{P.H, (const bf16_t*)(P.wl + W_WIN), T_ALL, IN_COLS, D}; pg8::StaticOrder So; So.init(T_ALL, IN_COLS, NBLK, BID); \
                pg8::gemm_phase<pg8::EpiZ, pg8::StaticOrder, true, true>(ldsr, g, So, E); } \
            else { pg8::Gemm g{P.H, (const bf16_t*)(P.wl + W_WIN), T_LAT, IN_COLS, D}; pg8::StaticOrder So; So.init(T_LAT, IN_COLS, NBLK, BID); \
                pg8::gemm_phase<pg8::EpiZ, pg8::StaticOrder, true, true>(ldsr, g, So, E); \
                const WsPtrs P2 = mkptrs(p, l); \
                pg8::EpiZ E2{P2.Z, P2.rope, P2.vtn, P2.vtnc, P2.vtw, P2.vtwc, T_LAT, 0}; \
                pg8::Gemm g2{P2.H + (size_t)T_LAT * D, (const bf16_t*)(P2.wl + W_WIN), T_CTX, CTX_KV_COLS, D}; pg8::StaticOrder S2; S2.init(T_CTX, CTX_KV_COLS, NBLK, BID); \
                pg8::gemm_phase<pg8::EpiZ, pg8::StaticOrder, true, true>(ldsr, g2, S2, E2); } }
#define PH_ATTN() { const WsPtrs P = mkptrs(p, l); ph_attn(P.Z, P.vtn, P.vtnc, P.vtw, P.vtwc, p.na_rpb + (size_t)l * 8 * 15 * 31, p.swa_sink + l * 8, P.AT + (size_t)T_ALL * 512, P.AT + (size_t)2 * T_ALL * 512, !last, smem, P.AT, rows); }
#define PH_MERGE() {     \
            const WsPtrs P = mkptrs(p, l); \
            pg8::Gemm g{P.AT, (const bf16_t*)(P.wl + W_WA), 3 * T_ALL, 3 * D, 512}; pg8::MergeOrder Mo{(rows / 256) * 4, NBLK, BID, 0}; pg8::EpiMergeSeg E{P.Z, P.H}; \
            pg8::gemm_phase<pg8::EpiMergeSeg, pg8::MergeOrder, false, true>(ldsr, g, Mo, E); }
#define PH_OUT(GIDX) {     \
            const WsPtrs P = mkptrs(p, l); \
            pg8::Gemm g{P.H, (const bf16_t*)(P.wl + W_WO), rows, D, D}; pg8::StaticOrder So; So.init(rows, D, NBLK, BID); pg8::EpiResid E{P.X, P.XC, P.modl, GIDX, 0}; \
            pg8::gemm_phase<pg8::EpiResid, pg8::StaticOrder, true, true>(ldsr, g, So, E); }
#define PH_NORM2() { const WsPtrs P = mkptrs(p, l); ph_norm_mod(P.X, P.XC, p.norm2_g + l * D, P.modl, 3, 4, P.H, rows, (last || FP8_L0) ? (unsigned*)P.H8 : nullptr); }
#define PH_QGEMM() { const WsPtrs P = mkptrs(p, l); \
            pg8::Gemm g{P.H, (const bf16_t*)(P.wl + W_WQ), rows, 2048, D}; pg8::StaticOrder So; So.init(rows, 2048, NBLK, BID); pg8::EpiStoreBf16 E{P.Z, 2048, 0}; \
            pg8::gemm_phase<pg8::EpiStoreBf16, pg8::StaticOrder, true, true>(ldsr, g, So, E); }
#define PH_TOPK() { const WsPtrs P = mkptrs(p, l); ph_peer_topk(P.Z, (const bf16_t*)(P.wl + W_KEYS), P.eidx, P.egate, rows, smem); }
#define PH_GATHER(DRY) { const WsPtrs P = mkptrs(p, l); \
            if (!last && !FP8_L0) ph_peer_gather_bf16(P.H, P.U, P.V, P.eidx, P.egate, P.modl, P.X, P.XC, rows, 0, p.norm1_g + D, P.modl + 5 * 6144, P.H, smem, DRY); \
            else ph_peer_gather_fp8(P.H8, P.U8, P.V8, P.isu, P.isv, P.eidx, P.egate, P.modl, P.X, P.XC, rows, last ? 1 : 0, last ? p.final_g : p.norm1_g + D, P.modl + 5 * 6144, P.H, smem, DRY); }

    ph_prep(p, smem);
    grid.sync();
    if (PROBE_DUP == 1) { ph_prep(p, smem); SYNC(); }
#pragma unroll 1
    for (int l = 0; l < 2; ++l) {
        const bool last = (l == 1);
        const int rows = last ? T_LAT : T_ALL;
        if (l == 0) { PH_NORM1(); SYNC(); }
        DUP(2, PH_ZGEMM());
        DUP(3, PH_ATTN());
        DUP(4, PH_MERGE());
        PH_OUT(2); SYNC();
        DUP(5, PH_NORM2());
        DUP(6, PH_QGEMM());
        DUP(7, PH_TOPK());
        if (PROBE_DUP == 8) { PH_GATHER(true); SYNC(); }
        PH_GATHER(false); SYNC();
    }
}

extern "C" void kernel_launch(void* const* d_in, const int* in_sizes, int n_in, void* d_out, int out_size, void* d_ws, size_t ws_size, hipStream_t stream) {
    static int grid_blocks = 0;
    if (grid_blocks == 0) {
        if (ws_size < WS_END || n_in != 22) { fprintf(stderr, "kernel_launch: workspace %zu < %zu or n_in %d != 22\n", ws_size, (size_t)WS_END, n_in); grid_blocks = -1; return; }
        int dev = 0, cus = 0, per_cu = 0;
        (void)hipGetDevice(&dev); (void)hipDeviceGetAttribute(&cus, hipDeviceAttributeMultiprocessorCount, dev);
        if (hipFuncSetAttribute((const void*)mega_fwd, hipFuncAttributeMaxDynamicSharedMemorySize, LDS_BYTES) != hipSuccess) { fprintf(stderr, "kernel_launch: hipFuncSetAttribute failed\n"); grid_blocks = -1; return; }
        if (hipOccupancyMaxActiveBlocksPerMultiprocessor(&per_cu, (const void*)mega_fwd, NTHREADS, LDS_BYTES) != hipSuccess || per_cu < 1) { fprintf(stderr, "kernel_launch: occupancy query says %d\n", per_cu); per_cu = 1; }
        (void)hipGetLastError();
        grid_blocks = cus * 1;
        fprintf(stderr, "kernel_launch: %d CUs, occupancy query %d per CU, grid %d\n", cus, per_cu, grid_blocks);
    }
    if (grid_blocks < 0) return;
    (void)hipMemsetAsync((char*)d_ws + WS_CTL, 0, CTL_BYTES, stream);
    Params p{};
    p.x = (const float*)d_in[0]; p.c = (const float*)d_in[1]; p.ctx = (const float*)d_in[2]; p.c_ctx = (const float*)d_in[3]; p.ada_w = (const float*)d_in[4]; p.ada_b = (const float*)d_in[5];
    p.norm1_g = (const float*)d_in[6]; p.norm2_g = (const float*)d_in[7]; p.w_in = (const float*)d_in[8]; p.pool_w = (const float*)d_in[9]; p.pool_scale = (const float*)d_in[10]; p.na_rpb = (const float*)d_in[11];
    p.swa_sink = (const float*)d_in[12]; p.wba = (const float*)d_in[13]; p.wbb = (const float*)d_in[14]; p.wbc = (const float*)d_in[15]; p.w_out = (const float*)d_in[16]; p.peer_wq = (const float*)d_in[17];
    p.peer_keys = (const float*)d_in[18]; p.peer_u = (const float*)d_in[19]; p.peer_v = (const float*)d_in[20]; p.final_g = (const float*)d_in[21];
    p.out = (float*)d_out; p.ws = (unsigned char*)d_ws;
    void* args[] = {&p};
    const hipError_t e = hipLaunchCooperativeKernel((const void*)mega_fwd, dim3(grid_blocks), dim3(NTHREADS), args, LDS_BYTES, stream);
    if (e != hipSuccess) fprintf(stderr, "kernel_launch: cooperative launch failed: %s (grid %d)\n", hipGetErrorString(e), grid_blocks);
}
```

```cpp
#include <hip/hip_runtime.h>
#include <hip/hip_cooperative_groups.h>
#include <stdint.h>
#include <stdio.h>
namespace cg = cooperative_groups;

typedef unsigned short bf16_t;

constexpr int D = 1024, NB = 4, S = 4096, L = 256, GW = 64;
constexpr int T_LAT = NB * S, T_CTX = NB * L, T_ALL = T_LAT + T_CTX;
constexpr int IN_COLS = 5888;
constexpr int OFF_KN = 0, OFF_VN = 512, OFF_KW = 1024, OFF_VW = 1152, CTX_KV_COLS = 1280, OFF_QN = 1280, OFF_QW = 1792, OFF_A = 2304, OFF_G = 2816;
constexpr int NEXP = 16384;
constexpr float EPS = 1e-6f;
#ifndef FP8_L0
#define FP8_L0 1
#endif
#ifndef RING_U
#define RING_U 1
#endif
#ifndef RING_V
#define RING_V 1
#endif
constexpr int NTHREADS = 512;
constexpr int LDS_BYTES = 147456;

constexpr size_t al256(size_t x) { return (x + 255) & ~(size_t)255; }
constexpr size_t WS_CTL = 0, CTL_BYTES = 16384;
constexpr size_t WS_MOD = WS_CTL + CTL_BYTES;
constexpr size_t WS_ROPE = al256(WS_MOD + 2 * 5 * 6144 * 4);
constexpr size_t WS_XC = al256(WS_ROPE + 2 * 64 * 16 * 4);
constexpr size_t WS_H = al256(WS_XC + (size_t)T_CTX * D * 4);
constexpr size_t WS_Z = al256(WS_H + (size_t)T_ALL * D * 2);
constexpr size_t WS_VTN = al256(WS_Z + (size_t)T_ALL * IN_COLS * 2);
constexpr size_t WS_VTNC = al256(WS_VTN + (size_t)NB * 8 * 64 * S * 2);
constexpr size_t WS_VTW = al256(WS_VTNC + (size_t)NB * 8 * 64 * L * 2);
constexpr size_t WS_VTWC = al256(WS_VTW + (size_t)NB * 2 * 64 * S * 2);
constexpr size_t WS_AT = al256(WS_VTWC + (size_t)NB * 2 * 64 * L * 2);
constexpr size_t WS_EIDX = al256(WS_AT + (size_t)3 * T_ALL * 512 * 2);
constexpr size_t WS_EGATE = al256(WS_EIDX + (size_t)T_ALL * 128 * 4);
constexpr size_t WS_W = al256(WS_EGATE + (size_t)T_ALL * 128 * 4);
constexpr size_t W_WIN = 0;
constexpr size_t W_WA = W_WIN + (size_t)IN_COLS * D * 2;
constexpr size_t W_WB = W_WA + (size_t)D * 512 * 2;
constexpr size_t W_WC = W_WB + (size_t)D * 512 * 2;
constexpr size_t W_WO = W_WC + (size_t)D * 512 * 2;
constexpr size_t W_WQ = W_WO + (size_t)D * D * 2;
constexpr size_t W_KEYS = W_WQ + (size_t)2048 * D * 2;
constexpr size_t W_LAYER = al256(W_KEYS + (size_t)8 * 2 * 128 * 128 * 2);
constexpr size_t WS_H8 = al256(WS_W + 2 * W_LAYER);
constexpr size_t WS_TAB0 = al256(WS_H8 + (size_t)2 * T_ALL * D);
constexpr size_t WS_TAB1 = al256(WS_TAB0 + (size_t)2 * NEXP * D * 2);
constexpr size_t WS_END = WS_TAB1 + (size_t)2 * NEXP * D + (size_t)2 * NEXP * 4;

__device__ __forceinline__ float bf2f(bf16_t v) { return __uint_as_float((unsigned)v << 16); }
__device__ __forceinline__ bf16_t f2bf(float f) { unsigned u = __float_as_uint(f); u += 0x7fffu + ((u >> 16) & 1u); return (bf16_t)(u >> 16); }
__device__ __forceinline__ unsigned pk2(float lo, float hi) { return (unsigned)f2bf(lo) | ((unsigned)f2bf(hi) << 16); }
__device__ __forceinline__ float lo16(unsigned w) { return __uint_as_float(w << 16); }
__device__ __forceinline__ float hi16(unsigned w) { return __uint_as_float(w & 0xffff0000u); }

__device__ __forceinline__ int lane_id() { int l; asm volatile("v_mbcnt_lo_u32_b32 %0, -1, 0\n\tv_mbcnt_hi_u32_b32 %0, -1, %0" : "=&v"(l)); return l; }
__device__ __forceinline__ int opaque_tid(int wv) { int t = (wv << 6) | lane_id(); asm volatile("" : "+v"(t)); return t; }
namespace pg8 {
#define PG8_LAS __attribute__((address_space(3)))
typedef unsigned short bf16_t;
typedef short bf16x8 __attribute__((ext_vector_type(8)));
typedef float f32x4 __attribute__((ext_vector_type(4)));
typedef unsigned u32x4 __attribute__((ext_vector_type(4)));
constexpr int BM = 256, BK = 64, HALF = 128, HTB = HALF * BK * 2  , STAGE_BYTES = 8 * HTB, NXCD = 8, WGM = 8;

__host__ __device__ __forceinline__ int lds_byte(int r, int c) { const int st = (r >> 4) * 2 + (c >> 5), rr = r & 15, cc = c & 31, ob = rr * 64 + cc * 2; return st * 1024 + (ob ^ (((ob >> 9) & 1) << 5)); }
__host__ __device__ __forceinline__ void stage_rc(int b, int& R, int& C) { const int st = b / 1024, sb = b % 1024, swz = sb ^ (((sb >> 9) & 1) << 5); R = (st >> 1) * 16 + swz / 64; C = (st & 1) * 32 + (swz % 64) / 2; }
__host__ __device__ __forceinline__ int perm32(int rho) { const int n = rho >> 4, i = rho & 15; return 8 * (i >> 2) + 4 * n + (i & 3); }

struct Unit { int pm, pn; };
struct Gemm { const bf16_t* A; const bf16_t* Bt; int M, N, K; };

struct StaticOrder {
    int nM, nN, nwg, G, c;
    __host__ __device__ void init(int M, int N, int G_, int c_) { nM = M / BM; nN = N / BM; nwg = nM * nN; G = G_; c = c_; }
    __host__ __device__ bool next(int i, Unit& u) const {
        const long L = (long)i * G + c; if (L >= nwg) return false;
        int wgid = (int)L; { const int q = nwg / NXCD, r = nwg % NXCD, xcd = wgid % NXCD, off = wgid / NXCD; wgid = (xcd < r ? xcd * (q + 1) : r * (q + 1) + (xcd - r) * q) + off; }
        const int nig = WGM * nN, gid = wgid / nig, fm = gid * WGM, gsz = (nM - fm) < WGM ? (nM - fm) : WGM;
        u.pm = fm + ((wgid % nig) % gsz); u.pn = (wgid % nig) / gsz; return true;
    }
    __device__ __forceinline__ void a_ready(const Unit&) const {}
    __device__ __forceinline__ void done(const Unit&) const {}
};
__device__ __forceinline__ unsigned cvt_pk_bf16(float lo, float hi) { unsigned r; asm volatile("v_cvt_pk_bf16_f32 %0, %1, %2" : "=v"(r) : "v"(lo), "v"(hi)); return r; }
typedef unsigned u32x4 __attribute__((ext_vector_type(4)));
struct EpiStoreBf16 {
    static constexpr bool PERM = true, AFTER_DRAIN = false;
    bf16_t* O; int ldc; int pad;
    __device__ __forceinline__ void operator()(const f32x4 (&acc)[2][2][4][2], const Unit& u, int wr, int wc, int fr, int fq) const {
        const int row0 = u.pm * BM + wr * 64 + fr, col0 = u.pn * BM + wc * 32 + 8 * fq;
#pragma unroll
        for (int ai = 0; ai < 2; ++ai)
#pragma unroll
            for (int m = 0; m < 4; ++m) { bf16_t* rowp = O + (size_t)(row0 + ai * HALF + m * 16) * ldc + col0;
#pragma unroll
                for (int bj = 0; bj < 2; ++bj) { const f32x4 v0 = acc[ai][bj][m][0], v1 = acc[ai][bj][m][1];
                    u32x4 w; w.x = cvt_pk_bf16(v0[0], v0[1]); w.y = cvt_pk_bf16(v0[2], v0[3]); w.z = cvt_pk_bf16(v1[0], v1[1]); w.w = cvt_pk_bf16(v1[2], v1[3]);
                    *(u32x4*)(rowp + bj * HALF) = w; } }
    }
};

struct EpiZ {
    static constexpr bool PERM = true, AFTER_DRAIN = false;
    bf16_t* Z; const float* rope; bf16_t *vtn, *vtnc, *vtw, *vtwc; int row_base; int pad;
    __device__ __forceinline__ void operator()(const f32x4 (&acc)[2][2][4][2], const Unit& u, int wr, int wc, int fr, int fq) const {
        const int grow0 = row_base + u.pm * BM;
        const bool lat = grow0 < 16384;
        const int b = lat ? (grow0 >> 12) : ((grow0 - 16384) >> 8), len = lat ? 4096 : 256;
        const int tpos0 = (lat ? (grow0 & 4095) : ((grow0 - 16384) & 255)) + wr * 64 + fr;
#pragma unroll
        for (int bj = 0; bj < 2; ++bj) {
            const int cb = 2 * u.pn + bj;
            const int col0 = cb * 128 + wc * 32 + 8 * fq;
            if ((cb >= 4 && cb < 8) || cb == 9) {
                const int cl = wc * 32 + 8 * fq;
                bf16_t* dst;
                if (cb == 9) dst = (lat ? vtw : vtwc) + ((size_t)(b * 2 + (cl >> 6)) * 64 + (cl & 63)) * len + tpos0;
                else dst = (lat ? vtn : vtnc) + ((size_t)(b * 8 + (cb - 4) * 2 + (cl >> 6)) * 64 + (cl & 63)) * len + tpos0;
#pragma unroll
                for (int ai = 0; ai < 2; ++ai)
#pragma unroll
                    for (int m = 0; m < 4; ++m) { bf16_t* dp = dst + ai * HALF + m * 16;
#pragma unroll
                        for (int n = 0; n < 2; ++n)
#pragma unroll
                            for (int i = 0; i < 4; ++i) { const unsigned w = cvt_pk_bf16(acc[ai][bj][m][n][i], 0.f); dp[(size_t)(4 * n + i) * len] = (bf16_t)(w & 0xffffu); } }
            } else {
                const bool is_rope = lat && (cb == 8 || (cb >= 14 && cb < 18));
                const bool is_gate = cb >= 22;
#pragma unroll
                for (int ai = 0; ai < 2; ++ai)
#pragma unroll
                    for (int m = 0; m < 4; ++m) {
                        f32x4 v0 = acc[ai][bj][m][0], v1 = acc[ai][bj][m][1];
                        if (is_gate) {
#pragma unroll
                            for (int i = 0; i < 4; ++i) { v0[i] = __builtin_amdgcn_rcpf(1.f + __builtin_amdgcn_exp2f(-1.4426950408889634f * v0[i])); v1[i] = __builtin_amdgcn_rcpf(1.f + __builtin_amdgcn_exp2f(-1.4426950408889634f * v1[i])); }
                        } else if (is_rope) {
                            const int tp = tpos0 + ai * HALF + m * 16;
                            const int pos = (wc & 1) ? (tp & 63) : (tp >> 6);
                            const float* tb = rope + pos * 16 + 8 * (fq & 1);
                            const f32x4 c0 = *(const f32x4*)tb, c1 = *(const f32x4*)(tb + 4), s0 = *(const f32x4*)(tb + 1024), s1 = *(const f32x4*)(tb + 1028);
                            f32x4 p0, p1;
#pragma unroll
                            for (int i = 0; i < 4; ++i) { p0[i] = __shfl_xor(v0[i], 32); p1[i] = __shfl_xor(v1[i], 32); }
                            if (fq < 2) { v0 = v0 * c0 - p0 * s0; v1 = v1 * c1 - p1 * s1; }
                            else { v0 = p0 * s0 + v0 * c0; v1 = p1 * s1 + v1 * c1; }
                        }
                        u32x4 w; w.x = cvt_pk_bf16(v0[0], v0[1]); w.y = cvt_pk_bf16(v0[2], v0[3]); w.z = cvt_pk_bf16(v1[0], v1[1]); w.w = cvt_pk_bf16(v1[2], v1[3]);
                        *(u32x4*)(Z + (size_t)(grow0 + ai * HALF + wr * 64 + m * 16 + fr) * 5888 + col0) = w;
                    }
            }
        }
    }
};
constexpr int NTM_STACK = 68;
struct EpiMergeSeg {
    static constexpr bool PERM = true, AFTER_DRAIN = false;
    const bf16_t* Z; bf16_t* M;
    __device__ __forceinline__ void operator()(const f32x4 (&acc)[2][2][4][2], const Unit& u, int wr, int wc, int fr, int fq) const {
        const int seg = u.pn >> 2, tn = u.pn & 3, tm = u.pm - seg * NTM_STACK;
        const int row0 = tm * BM + wr * 64 + fr, col0 = tn * BM + wc * 32 + 8 * fq;
#pragma unroll
        for (int ai = 0; ai < 2; ++ai)
#pragma unroll
            for (int m = 0; m < 4; ++m) { const int row = row0 + ai * HALF + m * 16;
#pragma unroll
                for (int bj = 0; bj < 2; ++bj) { const int col = col0 + bj * HALF;
                    const u32x4 g = *(const u32x4*)(Z + (size_t)row * 5888 + 2816 + seg * 1024 + col);
                    bf16_t* mp = M + (size_t)row * 1024 + col;
                    u32x4 o = (u32x4){0u, 0u, 0u, 0u}; if (seg) o = *(const u32x4*)mp;
                    const f32x4 v0 = acc[ai][bj][m][0], v1 = acc[ai][bj][m][1];
                    u32x4 w;
                    w.x = cvt_pk_bf16(__uint_as_float(g.x << 16) * v0[0] + __uint_as_float(o.x << 16), __uint_as_float(g.x & 0xffff0000u) * v0[1] + __uint_as_float(o.x & 0xffff0000u));
                    w.y = cvt_pk_bf16(__uint_as_float(g.y << 16) * v0[2] + __uint_as_float(o.y << 16), __uint_as_float(g.y & 0xffff0000u) * v0[3] + __uint_as_float(o.y & 0xffff0000u));
                    w.z = cvt_pk_bf16(__uint_as_float(g.z << 16) * v1[0] + __uint_as_float(o.z << 16), __uint_as_float(g.z & 0xffff0000u) * v1[1] + __uint_as_float(o.z & 0xffff0000u));
                    w.w = cvt_pk_bf16(__uint_as_float(g.w << 16) * v1[2] + __uint_as_float(o.w << 16), __uint_as_float(g.w & 0xffff0000u) * v1[3] + __uint_as_float(o.w & 0xffff0000u));
                    *(u32x4*)mp = w; } }
    }
};
struct MergeOrder {
    int ntiles, G, c, pad;
    __device__ bool next(int i, Unit& u) const { const int ti = (i / 3) * G + c, seg = i % 3; if (ti >= ntiles) return false; u.pm = seg * NTM_STACK + (ti >> 2); u.pn = seg * 4 + (ti & 3); return true; }
    __device__ __forceinline__ void a_ready(const Unit&) const {}
    __device__ __forceinline__ void done(const Unit&) const {}
};
struct EpiResid {
    static constexpr bool PERM = false, AFTER_DRAIN = false;
    float* Xl; float* Xc; const float* modl; int gate_idx; int pad;
    __device__ __forceinline__ void operator()(const f32x4 (&acc)[2][2][4][2], const Unit& u, int wr, int wc, int fr, int fq) const {
        const int mrow = u.pm < 64 ? (u.pm >> 4) : 4;
        float* base = u.pm < 64 ? Xl + (size_t)u.pm * BM * 1024 : Xc + (size_t)(u.pm - 64) * BM * 1024;
        const float* gt = modl + (size_t)mrow * 6144 + gate_idx * 1024;
        const int col0 = u.pn * BM + wc * 32 + 4 * fq;
#pragma unroll
        for (int bj = 0; bj < 2; ++bj)
#pragma unroll
            for (int n = 0; n < 2; ++n) { const int col = col0 + bj * HALF + 16 * n; const f32x4 gv = *(const f32x4*)(gt + col);
#pragma unroll
                for (int ai = 0; ai < 2; ++ai)
#pragma unroll
                    for (int m = 0; m < 4; ++m) { float* xp = base + (size_t)(ai * HALF + wr * 64 + m * 16 + fr) * 1024 + col;
                        f32x4 x = *(f32x4*)xp; x = x + gv * acc[ai][bj][m][n]; *(f32x4*)xp = x; } }
    }
};
template <class Epi, class Sched, bool ALIGN_EPI = false, bool SP2 = false>
__device__ __forceinline__ void gemm_phase(PG8_LAS unsigned char* lds, const Gemm g, const Sched& S, const Epi& E, const int WV) {
    const int tid = opaque_tid(WV), wid = __builtin_amdgcn_readfirstlane(tid >> 6), lane = tid & 63, wr = wid >> 2, wc = wid & 3, fr = lane & 15, fq = lane >> 4;
    const int K = g.K, nt = K / BK;
    unsigned voffA[2], voffB[2];
#pragma unroll
    for (int i = 0; i < 2; ++i) { int R, C; stage_rc(tid * 16 + i * 8192, R, C); const int Rb = Epi::PERM ? ((R & ~31) + perm32(R & 31)) : R;
        voffA[i] = (unsigned)(R * K + C) * 2u; voffB[i] = (unsigned)(Rb * K + C) * 2u; }
    const size_t kstep = (size_t)(BK * 2);
    const size_t hstep = (size_t)HALF * K * 2;
    const size_t tstep = 2 * hstep;
    const unsigned ldsw = (unsigned)wid * 1024u;
    const int aoff = lds_byte(wr * 64 + fr, fq * 8), boff = lds_byte(wc * 32 + fr, fq * 8);
#define PG8_SA(b, h) (((b) * 2 + (h)) * HTB)
#define PG8_SB(b, h) ((4 + (b) * 2 + (h)) * HTB)
#define PG8_STAGE(bufoff, gbase, voff) do { _Pragma("unroll") for (int _i = 0; _i < 2; ++_i) \
        __builtin_amdgcn_global_load_lds((const unsigned*)((const char*)(gbase) + (voff)[_i]), (PG8_LAS unsigned*)(lds + (bufoff) + ldsw + _i * 8192), 16, 0, 0); } while (0)
#define PG8_LDA(dst, b, h) do { _Pragma("unroll") for (int m = 0; m < 4; ++m) _Pragma("unroll") for (int k = 0; k < 2; ++k) dst[m][k] = *(const PG8_LAS bf16x8*)(lds + PG8_SA(b, h) + aoff + m * 2048 + k * 1024); } while (0)
#define PG8_LDB(dst, b, h) do { _Pragma("unroll") for (int n = 0; n < 2; ++n) _Pragma("unroll") for (int k = 0; k < 2; ++k) dst[n][k] = *(const PG8_LAS bf16x8*)(lds + PG8_SB(b, h) + boff + n * 2048 + k * 1024); } while (0)
#define PG8_MMA(ai, bj, At, Bt) do { __builtin_amdgcn_s_setprio(1); _Pragma("unroll") for (int m = 0; m < 4; ++m) _Pragma("unroll") for (int n = 0; n < 2; ++n) _Pragma("unroll") for (int k = 0; k < 2; ++k) \
        acc[ai][bj][m][n] = __builtin_amdgcn_mfma_f32_16x16x32_bf16(Bt[n][k], At[m][k], acc[ai][bj][m][n], 0, 0, 0); __builtin_amdgcn_s_setprio(0); } while (0)
#define PG8_WAIT_V(n) asm volatile("s_waitcnt vmcnt(" #n ")" ::: "memory")
#define PG8_WAIT_L(n) asm volatile("s_waitcnt lgkmcnt(" #n ")" ::: "memory")
#define PG8_BAR __builtin_amdgcn_s_barrier()
#define PG8_SCHED __builtin_amdgcn_sched_barrier(0)
    Unit cur, nxt; int ui = 0;
    if (!S.next(0, cur)) return;
    f32x4 acc[2][2][4][2];
#pragma unroll
    for (int a = 0; a < 2; ++a)
#pragma unroll
        for (int b = 0; b < 2; ++b)
#pragma unroll
            for (int m = 0; m < 4; ++m)
#pragma unroll
                for (int n = 0; n < 2; ++n) acc[a][b][m][n] = (f32x4){0.f, 0.f, 0.f, 0.f};
    bf16x8 At[4][2], B0[2][2], B1[2][2];
    const char* cA = (const char*)g.A + (size_t)cur.pm * tstep; const char* cB = (const char*)g.Bt + (size_t)cur.pn * tstep;
    S.a_ready(cur);
    if constexpr (SP2) {
        PG8_STAGE(PG8_SB(0, 0), cB, voffB); PG8_STAGE(PG8_SB(0, 1), cB + hstep, voffB); PG8_STAGE(PG8_SA(0, 0), cA, voffA); PG8_STAGE(PG8_SA(0, 1), cA + hstep, voffA);
        if (wr == 1) PG8_BAR;
        PG8_WAIT_V(2); PG8_BAR;
        PG8_STAGE(PG8_SB(1, 0), cB + kstep, voffB); PG8_STAGE(PG8_SA(1, 0), cA + kstep, voffA); PG8_STAGE(PG8_SB(1, 1), cB + hstep + kstep, voffB);
        PG8_WAIT_V(6); PG8_BAR;
    } else {
        PG8_STAGE(PG8_SB(0, 0), cB, voffB); PG8_STAGE(PG8_SA(0, 0), cA, voffA); PG8_STAGE(PG8_SB(0, 1), cB + hstep, voffB); PG8_STAGE(PG8_SA(0, 1), cA + hstep, voffA);
        if (wr == 1) PG8_BAR;
        PG8_WAIT_V(4); PG8_BAR;
        PG8_STAGE(PG8_SB(1, 0), cB + kstep, voffB); PG8_STAGE(PG8_SA(1, 0), cA + kstep, voffA); PG8_STAGE(PG8_SB(1, 1), cB + hstep + kstep, voffB);
        PG8_WAIT_V(6); PG8_BAR;
    }
    for (;;) {
        const bool has_next = S.next(ui + 1, nxt);
        const char* nA = has_next ? (const char*)g.A + (size_t)nxt.pm * tstep : cA; const char* nB = has_next ? (const char*)g.Bt + (size_t)nxt.pn * tstep : cB;
        for (int t = 0; t < nt; t += 2) {
            const bool last = (t == nt - 2);
            const char* a1 = cA + (size_t)(t + 1) * kstep;
            const char* a2 = last ? nA : cA + (size_t)(t + 2) * kstep; const char* b2 = last ? nB : cB + (size_t)(t + 2) * kstep;
            const char* a3 = a2 + kstep; const char* b3 = b2 + kstep;
            if (last && has_next) S.a_ready(nxt);
            if constexpr (SP2) {
            PG8_LDB(B0, 0, 0); PG8_LDB(B1, 0, 1); PG8_SCHED; PG8_LDA(At, 0, 0); PG8_STAGE(PG8_SA(1, 1), a1 + hstep, voffA);
            PG8_WAIT_V(8); PG8_WAIT_L(0); PG8_BAR; PG8_MMA(0, 0, At, B0); PG8_MMA(0, 1, At, B1); PG8_BAR; PG8_SCHED;
            PG8_LDA(At, 0, 1); PG8_STAGE(PG8_SB(0, 0), b2, voffB); PG8_STAGE(PG8_SB(0, 1), b2 + hstep, voffB); PG8_STAGE(PG8_SA(0, 0), a2, voffA);
            PG8_WAIT_V(8); PG8_WAIT_L(0); PG8_BAR; PG8_MMA(1, 0, At, B0); PG8_MMA(1, 1, At, B1); PG8_BAR; PG8_SCHED;
            PG8_LDB(B0, 1, 0); PG8_LDB(B1, 1, 1); PG8_SCHED; PG8_LDA(At, 1, 0); PG8_STAGE(PG8_SA(0, 1), a2 + hstep, voffA);
            PG8_WAIT_V(8); PG8_WAIT_L(0); PG8_BAR; PG8_MMA(0, 0, At, B0); PG8_MMA(0, 1, At, B1); PG8_BAR; PG8_SCHED;
            PG8_LDA(At, 1, 1); PG8_STAGE(PG8_SB(1, 0), b3, voffB); PG8_STAGE(PG8_SB(1, 1), b3 + hstep, voffB); PG8_STAGE(PG8_SA(1, 0), a3, voffA);
            PG8_WAIT_V(8); PG8_WAIT_L(0); PG8_BAR; PG8_MMA(1, 0, At, B0); PG8_MMA(1, 1, At, B1); PG8_BAR; PG8_SCHED;
            } else {
            PG8_LDB(B0, 0, 0); PG8_SCHED; PG8_LDA(At, 0, 0); PG8_STAGE(PG8_SA(1, 1), a1 + hstep, voffA);
            PG8_WAIT_L(8); PG8_BAR; PG8_WAIT_L(0); PG8_MMA(0, 0, At, B0); PG8_BAR; PG8_SCHED;
            PG8_LDB(B1, 0, 1); PG8_STAGE(PG8_SB(0, 0), b2, voffB);
            PG8_BAR; PG8_WAIT_L(0); PG8_MMA(0, 1, At, B1); PG8_BAR;
            PG8_LDA(At, 0, 1); PG8_STAGE(PG8_SA(0, 0), a2, voffA);
            PG8_BAR; PG8_WAIT_L(0); PG8_MMA(1, 0, At, B0); PG8_BAR; PG8_SCHED;
            PG8_STAGE(PG8_SB(0, 1), b2 + hstep, voffB);
            PG8_WAIT_V(6); PG8_BAR; PG8_MMA(1, 1, At, B1); PG8_BAR;
            PG8_LDB(B0, 1, 0); PG8_SCHED; PG8_LDA(At, 1, 0); PG8_STAGE(PG8_SA(0, 1), a2 + hstep, voffA);
            PG8_WAIT_L(8); PG8_BAR; PG8_WAIT_L(0); PG8_MMA(0, 0, At, B0); PG8_BAR; PG8_SCHED;
            PG8_LDB(B1, 1, 1); PG8_STAGE(PG8_SB(1, 0), b3, voffB);
            PG8_BAR; PG8_WAIT_L(0); PG8_MMA(0, 1, At, B1); PG8_BAR;
            PG8_LDA(At, 1, 1); PG8_STAGE(PG8_SA(1, 0), a3, voffA);
            PG8_BAR; PG8_WAIT_L(0); PG8_MMA(1, 0, At, B0); PG8_BAR; PG8_SCHED;
            PG8_STAGE(PG8_SB(1, 1), b3 + hstep, voffB);
            PG8_WAIT_V(6); PG8_BAR; PG8_MMA(1, 1, At, B1); PG8_BAR;
            }
        }
        if constexpr (ALIGN_EPI) { if (wr == 0) PG8_BAR; }
        if constexpr (!Epi::AFTER_DRAIN) { E(acc, cur, wr, wc, fr, fq); S.done(cur); }
        if (!has_next) break;
#pragma unroll
        for (int a = 0; a < 2; ++a)
#pragma unroll
            for (int b = 0; b < 2; ++b)
#pragma unroll
                for (int m = 0; m < 4; ++m)
#pragma unroll
                    for (int n = 0; n < 2; ++n) acc[a][b][m][n] = (f32x4){0.f, 0.f, 0.f, 0.f};
        cur = nxt; cA = nA; cB = nB; ++ui;
        if constexpr (ALIGN_EPI) { if (wr == 1) PG8_BAR; }
    }
    PG8_WAIT_V(0);
    if constexpr (!ALIGN_EPI) { if (wr == 0) PG8_BAR; }
    PG8_BAR;
    if constexpr (Epi::AFTER_DRAIN) { E.fused(acc, cur, wr, wc, fr, fq, lds, wid, lane); S.done(cur); }
#undef PG8_SA
#undef PG8_SB
#undef PG8_STAGE
#undef PG8_LDA
#undef PG8_LDB
#undef PG8_MMA
#undef PG8_WAIT_V
#undef PG8_WAIT_L
#undef PG8_BAR
#undef PG8_SCHED
}
}

struct Params {
    const float *x, *c, *ctx, *c_ctx, *ada_w, *ada_b, *norm1_g, *norm2_g, *w_in, *pool_w, *pool_scale, *na_rpb, *swa_sink, *wba, *wbb, *wbc, *w_out, *peer_wq, *peer_keys, *peer_u, *peer_v, *final_g;
    float* out; unsigned char* ws;
};
#define TID (opaque_tid(WV))
#define BID ((int)blockIdx.x)
#define NBLK ((int)gridDim.x)

__device__ __forceinline__ void tr_tiles(const float* __restrict__ W, bf16_t* __restrict__ Wt, int K, int N, float* tile  , const int WV) {
    const int ntn = N / 64, ntiles = (K / 64) * ntn, tid = TID, c = tid & 63, r8 = tid >> 6;
    for (int vb = BID; vb < ntiles; vb += NBLK) {
        const int k0 = (vb / ntn) * 64, n0 = (vb % ntn) * 64;
#pragma unroll
        for (int i = 0; i < 8; ++i) tile[(i * 8 + r8) * 65 + c] = W[(size_t)(k0 + i * 8 + r8) * N + n0 + c];
        __syncthreads();
#pragma unroll
        for (int i = 0; i < 8; ++i) Wt[(size_t)(n0 + i * 8 + r8) * K + k0 + c] = f2bf(tile[c * 65 + i * 8 + r8]);
        __syncthreads();
    }
}
__device__ __forceinline__ void conv_bf16(const float* __restrict__ src, bf16_t* __restrict__ dst, size_t n8, const int WV) {
    for (size_t i = (size_t)BID * NTHREADS + TID; i < n8; i += (size_t)NBLK * NTHREADS) {
        const float4 a = ((const float4*)src)[2 * i], b = ((const float4*)src)[2 * i + 1];
        uint4 o; o.x = pk2(a.x, a.y); o.y = pk2(a.z, a.w); o.z = pk2(b.x, b.y); o.w = pk2(b.z, b.w);
        ((uint4*)dst)[i] = o;
    }
}
__device__ __forceinline__ void conv_fp8_rows(const float* __restrict__ src, unsigned* __restrict__ dst, float* __restrict__ inv, int nrows, const int WV) {
    const int tid = TID, lane = tid & 63, gw = BID * 8 + (tid >> 6);
    for (int row = gw; row < nrows; row += NBLK * 8) {
        const float4* sp = (const float4*)(src + (size_t)row * D);
        float4 v[4]; float amax = 0.f;
#pragma unroll
        for (int i = 0; i < 4; ++i) { v[i] = sp[i * 64 + lane]; amax = fmaxf(amax, fmaxf(fmaxf(fabsf(v[i].x), fabsf(v[i].y)), fmaxf(fabsf(v[i].z), fabsf(v[i].w)))); }
#pragma unroll
        for (int o = 32; o > 0; o >>= 1) amax = fmaxf(amax, __shfl_xor(amax, o));
        const int k = (int)((__float_as_uint(amax) >> 23) & 255u) - 127;
        const bool ok = amax > 1e-30f;
        const float s = ok ? __uint_as_float((unsigned)(127 + 7 - k) << 23) : 1.f;
#pragma unroll
        for (int i = 0; i < 4; ++i) { int w = __builtin_amdgcn_cvt_pk_fp8_f32(v[i].x * s, v[i].y * s, 0, false); w = __builtin_amdgcn_cvt_pk_fp8_f32(v[i].z * s, v[i].w * s, w, true);
            dst[(size_t)row * 256 + i * 64 + lane] = (unsigned)w; }
        if (lane == 0) inv[row] = ok ? __uint_as_float((unsigned)(127 - 7 + k) << 23) : 1.f;
    }
}
__device__ __forceinline__ void copy_f4(const float* __restrict__ src, float* __restrict__ dst, size_t n4, const int WV) {
    for (size_t i = (size_t)BID * NTHREADS + TID; i < n4; i += (size_t)NBLK * NTHREADS) ((float4*)dst)[i] = ((const float4*)src)[i];
}
__device__ __forceinline__ void ph_prep(const Params& p, float* smem, const int WV) {
    unsigned char* ws = p.ws;
    for (int l = 0; l < 2; ++l) {
        unsigned char* wl = ws + WS_W + l * W_LAYER;
        tr_tiles(p.w_in + (size_t)l * D * IN_COLS, (bf16_t*)(wl + W_WIN), D, IN_COLS, smem, WV);
        tr_tiles(p.wbb + (size_t)l * 512 * D, (bf16_t*)(wl + W_WB), 512, D, smem, WV);
        tr_tiles(p.wbc + (size_t)l * 512 * D, (bf16_t*)(wl + W_WC), 512, D, smem, WV);
        tr_tiles(p.w_out + (size_t)l * D * D, (bf16_t*)(wl + W_WO), D, D, smem, WV);
        tr_tiles(p.peer_wq + (size_t)l * D * 2048, (bf16_t*)(wl + W_WQ), D, 2048, smem, WV);
        {
            const float* pw = p.pool_w + (size_t)l * 4 * 128 * 128; const float* ps = p.pool_scale + l * 512; const float* wba = p.wba + (size_t)l * 512 * D; bf16_t* WaT = (bf16_t*)(wl + W_WA);
            for (int idx = BID * NTHREADS + TID; idx < 512 * D; idx += NBLK * NTHREADS) {
                const int n = idx % D, kk = idx / D, g = kk / 128, c = kk % 128;
                float acc = 0.f;
                for (int e = 0; e < 128; ++e) acc += pw[(g * 128 + c) * 128 + e] * ps[g * 128 + e] * wba[(size_t)(g * 128 + e) * D + n];
                WaT[(size_t)n * 512 + kk] = f2bf(acc);
            }
        }
        conv_bf16(p.peer_keys + (size_t)l * 8 * 2 * 128 * 128, (bf16_t*)(wl + W_KEYS), (size_t)8 * 2 * 128 * 128 / 8, WV);
        if (l == 0 && !FP8_L0) {
            conv_bf16(p.peer_u, (bf16_t*)(ws + WS_TAB0), (size_t)NEXP * D / 8, WV);
            conv_bf16(p.peer_v, (bf16_t*)(ws + WS_TAB0) + (size_t)NEXP * D, (size_t)NEXP * D / 8, WV);
        } else {
            unsigned char* tl = ws + (l == 0 ? WS_TAB0 : WS_TAB1);
            conv_fp8_rows(p.peer_u + (size_t)l * NEXP * D, (unsigned*)tl, (float*)(tl + (size_t)2 * NEXP * D), NEXP, WV);
            conv_fp8_rows(p.peer_v + (size_t)l * NEXP * D, (unsigned*)(tl + (size_t)NEXP * D), (float*)(tl + (size_t)2 * NEXP * D) + NEXP, NEXP, WV);
        }
    }
    {
        float* sv = smem; float* part = smem + 5 * 1024; float* mod = (float*)(ws + WS_MOD);
        const int tid = TID, lane = tid & 63, wid = tid >> 6;
        for (int vb = BID; vb < 2 * 96; vb += NBLK) {
            const int l = vb / 96, j0 = (vb % 96) * 64;
            for (int i = tid; i < 5 * 1024; i += NTHREADS) { const int r = i >> 10, k = i & 1023; const float v = r < 4 ? p.c[r * 1024 + k] : p.c_ctx[k]; sv[i] = v / (1.f + __expf(-v)); }
            __syncthreads();
            float a0 = 0.f, a1 = 0.f, a2 = 0.f, a3 = 0.f, a4 = 0.f;
            const float* w = p.ada_w + ((size_t)l * 1024 + wid * 128) * 6144 + j0 + lane;
            for (int k = 0; k < 128; ++k) { const float xw = w[(size_t)k * 6144]; const int kk = wid * 128 + k;
                a0 += sv[kk] * xw; a1 += sv[1024 + kk] * xw; a2 += sv[2048 + kk] * xw; a3 += sv[3072 + kk] * xw; a4 += sv[4096 + kk] * xw; }
            part[(wid * 5 + 0) * 64 + lane] = a0; part[(wid * 5 + 1) * 64 + lane] = a1; part[(wid * 5 + 2) * 64 + lane] = a2; part[(wid * 5 + 3) * 64 + lane] = a3; part[(wid * 5 + 4) * 64 + lane] = a4;
            __syncthreads();
            if (tid < 320) { const int r = tid >> 6; float s = 0.f;
#pragma unroll
                for (int w8 = 0; w8 < 8; ++w8) s += part[(w8 * 5 + r) * 64 + lane];
                mod[((size_t)l * 5 + r) * 6144 + j0 + lane] = s + p.ada_b[l * 6144 + j0 + lane]; }
            __syncthreads();
        }
    }
    {
        float* tab = (float*)(ws + WS_ROPE);
        for (int i = BID * NTHREADS + TID; i < 1024; i += NBLK * NTHREADS) { const int pos = i / 16, fi = i % 16; const float inv = powf(10000.0f, -(float)fi / 16.0f), ang = (float)pos * inv; tab[i] = cosf(ang); tab[1024 + i] = sinf(ang); }
    }
    copy_f4(p.x, p.out, (size_t)T_LAT * D / 4, WV);
    copy_f4(p.ctx, (float*)(ws + WS_XC), (size_t)T_CTX * D / 4, WV);
}

typedef float f32x2v __attribute__((ext_vector_type(2)));
__device__ __forceinline__ float wave_sum(float v) {
#pragma unroll
    for (int o = 32; o > 0; o >>= 1) v += __shfl_xor(v, o);
    return v;
}
__device__ __forceinline__ void ph_norm_mod(const float* __restrict__ Xl, const float* __restrict__ Xc, const float* __restrict__ g, const float* __restrict__ modl, int shift_idx, int scale_idx, bf16_t* __restrict__ H, int nrows, unsigned* __restrict__ H8, const int WV) {
    const int lane = TID & 63, gw = BID * 8 + (TID >> 6);
    for (int row = gw; row < nrows; row += NBLK * 8) {
        const float* src = row < T_LAT ? Xl + (size_t)row * D : Xc + (size_t)(row - T_LAT) * D;
        const int mrow = row < T_LAT ? row / S : 4;
        float4 v[4]; float ss = 0.f;
#pragma unroll
        for (int i = 0; i < 4; ++i) { v[i] = ((const float4*)src)[i * 64 + lane]; ss += v[i].x * v[i].x + v[i].y * v[i].y + v[i].z * v[i].z + v[i].w * v[i].w; }
        ss = wave_sum(ss);
        const float rstd = rsqrtf(ss * (1.0f / D) + EPS);
        const float* sh = modl + (size_t)mrow * 6144 + shift_idx * 1024; const float* sc = modl + (size_t)mrow * 6144 + scale_idx * 1024;
#pragma unroll
        for (int i = 0; i < 4; ++i) { const int k = (i * 64 + lane) * 4;
            const float4 gg = *(const float4*)(g + k), s4 = *(const float4*)(sc + k), h4 = *(const float4*)(sh + k);
            uint2 w; w.x = pk2(v[i].x * rstd * gg.x * (1.f + s4.x) + h4.x, v[i].y * rstd * gg.y * (1.f + s4.y) + h4.y);
            w.y = pk2(v[i].z * rstd * gg.z * (1.f + s4.z) + h4.z, v[i].w * rstd * gg.w * (1.f + s4.w) + h4.w);
            *(uint2*)(H + (size_t)row * D + k) = w;
            if (H8) {
                const float h0 = 8.f * lo16(w.x), h1 = 8.f * hi16(w.x), h2 = 8.f * lo16(w.y), h3 = 8.f * hi16(w.y);
                int hi = __builtin_amdgcn_cvt_pk_fp8_f32(h0, h1, 0, false); hi = __builtin_amdgcn_cvt_pk_fp8_f32(h2, h3, hi, true);
                const f32x2v d0 = __builtin_amdgcn_cvt_pk_f32_fp8(hi, false), d1 = __builtin_amdgcn_cvt_pk_f32_fp8(hi, true);
                int lo = __builtin_amdgcn_cvt_pk_fp8_f32(h0 - d0[0], h1 - d0[1], 0, false); lo = __builtin_amdgcn_cvt_pk_fp8_f32(h2 - d1[0], h3 - d1[1], lo, true);
                H8[(size_t)row * 256 + i * 64 + lane] = (unsigned)hi; H8[(size_t)T_ALL * 256 + (size_t)row * 256 + i * 64 + lane] = (unsigned)lo; } }
    }
}
__device__ __forceinline__ void ph_pool(const bf16_t* __restrict__ Z, bf16_t* __restrict__ Pa, int rows, int tid) {
    for (int idx = BID * NTHREADS + tid; idx < rows * 64; idx += NBLK * NTHREADS) {
        const int c8 = idx & 63, row = idx >> 6, g = c8 >> 4, w = 2 << g;
        const bool lat = row < T_LAT; const int len = lat ? S : L; const int t = lat ? (row & (S - 1)) : ((row - T_LAT) & (L - 1)); const int base = row - t;
        int lo = t - w / 2; if (lo < 0) lo = 0; int hi = t - w / 2 + w; if (hi > len) hi = len;
        float sum[8];
#pragma unroll
        for (int i = 0; i < 8; ++i) sum[i] = 0.f;
        const bf16_t* zp = Z + (size_t)base * IN_COLS + OFF_A + c8 * 8;
        for (int tt = lo; tt < hi; ++tt) { const uint4 v = *(const uint4*)(zp + (size_t)tt * IN_COLS);
            sum[0] += lo16(v.x); sum[1] += hi16(v.x); sum[2] += lo16(v.y); sum[3] += hi16(v.y); sum[4] += lo16(v.z); sum[5] += hi16(v.z); sum[6] += lo16(v.w); sum[7] += hi16(v.w); }
        const uint4 sv = *(const uint4*)(zp + (size_t)t * IN_COLS); const float inv = 1.f / (float)(hi - lo);
        uint4 o; o.x = pk2(sum[0] * inv - lo16(sv.x), sum[1] * inv - hi16(sv.x)); o.y = pk2(sum[2] * inv - lo16(sv.y), sum[3] * inv - hi16(sv.y));
        o.z = pk2(sum[4] * inv - lo16(sv.z), sum[5] * inv - hi16(sv.z)); o.w = pk2(sum[6] * inv - lo16(sv.w), sum[7] * inv - hi16(sv.w));
        *(uint4*)(Pa + (size_t)row * 512 + c8 * 8) = o;
    }
}
typedef short bf16x8v __attribute__((ext_vector_type(8)));
typedef float f32x4v __attribute__((ext_vector_type(4)));
constexpr float LOG2E = 1.4426950408889634f;
constexpr float QK_SCALE2 = 0.125f * LOG2E;
constexpr float MASKED = -3.0e38f;
__device__ __forceinline__ unsigned cvtpk(float lo, float hi) { unsigned r; asm volatile("v_cvt_pk_bf16_f32 %0, %1, %2" : "=v"(r) : "v"(lo), "v"(hi)); return r; }
__device__ __forceinline__ f32x4v mfma16(bf16x8v a, bf16x8v b, f32x4v c) { return __builtin_amdgcn_mfma_f32_16x16x32_bf16(a, b, c, 0, 0, 0); }
struct AttnSt { f32x4v o[4]; float m, l; };
__device__ __forceinline__ int clampi(int v, int lo, int hi) { return v < lo ? lo : (v > hi ? hi : v); }
template <class Dsc> __device__ __forceinline__ void attn_load_k(const Dsc& dsc, int c, bf16x8v (&kf)[2][2]) {
#pragma unroll
    for (int tt = 0; tt < 2; ++tt) { const bf16_t* kb = dsc.kbase(c); const unsigned ko = dsc.koff(c, tt); kf[tt][0] = *(const bf16x8v*)(kb + ko); kf[tt][1] = *(const bf16x8v*)(kb + (ko + 32u)); }
}
template <class Dsc> __device__ __forceinline__ void attn_load_v(const Dsc& dsc, int c, bf16x8v (&vf)[4]) {
    const bf16_t* vb = dsc.vbase(c); const unsigned vo = dsc.voff(c); const unsigned vs = dsc.vstride16();
#pragma unroll
    for (int dt = 0; dt < 4; ++dt) vf[dt] = *(const bf16x8v*)(vb + (size_t)(dt * vs) + vo);
}
template <class Dsc>
__device__ __forceinline__ void attn_chunk4(const Dsc& dsc, int c, int cnext, bf16x8v (&kf)[2][2], const bf16x8v (&vf)[4], const bf16x8v (&qf)[4][2], AttnSt (&st)[4], int lane) {
#pragma unroll
    for (int t = 0; t < 4; ++t) {
        const bool tl = dsc.tile_live(t, c);
        f32x4v s[2];
        if (tl) {
#pragma unroll
            for (int tt = 0; tt < 2; ++tt) { f32x4v acc = (f32x4v){0.f, 0.f, 0.f, 0.f}; acc = mfma16(kf[tt][0], qf[t][0], acc); acc = mfma16(kf[tt][1], qf[t][1], acc); s[tt] = acc; }
        }
        if (t == 3) { __builtin_amdgcn_sched_barrier(0); attn_load_k(dsc, cnext, kf); __builtin_amdgcn_sched_barrier(0); }
        if (!tl) continue;
#pragma unroll
        for (int tt = 0; tt < 2; ++tt)
#pragma unroll
            for (int r = 0; r < 4; ++r) s[tt][r] = dsc.score(t, c, tt, r, s[tt][r]);
        float gmax = fmaxf(fmaxf(fmaxf(s[0][0], s[0][1]), fmaxf(s[0][2], s[0][3])), fmaxf(fmaxf(s[1][0], s[1][1]), fmaxf(s[1][2], s[1][3])));
        gmax = fmaxf(gmax, __shfl_xor(gmax, 16)); gmax = fmaxf(gmax, __shfl_xor(gmax, 32));
        const float mnew = fmaxf(st[t].m, gmax), alpha = __builtin_amdgcn_exp2f(st[t].m - mnew);
        st[t].m = mnew;
        float psum = 0.f;
#pragma unroll
        for (int tt = 0; tt < 2; ++tt)
#pragma unroll
            for (int r = 0; r < 4; ++r) { const float pv = __builtin_amdgcn_exp2f(s[tt][r] - mnew); s[tt][r] = pv; psum += pv; }
        st[t].l = st[t].l * alpha + psum;
        if (!__all(alpha == 1.0f)) {
            const int gb = (lane >> 4) * 4;
#pragma unroll
            for (int r = 0; r < 4; ++r) { const float ar = __shfl(alpha, gb + r);
#pragma unroll
                for (int dt = 0; dt < 4; ++dt) st[t].o[dt][r] *= ar; }
        }
        union { unsigned u[4]; bf16x8v v; } pf;
        pf.u[0] = cvtpk(s[0][0], s[0][1]); pf.u[1] = cvtpk(s[0][2], s[0][3]); pf.u[2] = cvtpk(s[1][0], s[1][1]); pf.u[3] = cvtpk(s[1][2], s[1][3]);
#pragma unroll
        for (int dt = 0; dt < 4; ++dt) st[t].o[dt] = mfma16(pf.v, vf[dt], st[t].o[dt]);
        __builtin_amdgcn_sched_barrier(0);
    }
}
template <class Dsc>
__device__ __forceinline__ void attn_stream4(const Dsc& dsc, int nc, const bf16x8v (&qf)[4][2], AttnSt (&st)[4], int lane) {
    bf16x8v kf[2][2], vf[4];
    attn_load_k(dsc, 0, kf);
#pragma unroll 1
    for (int c = 0; c < nc; ++c) {
        attn_load_v(dsc, c, vf); __builtin_amdgcn_sched_barrier(0);
        attn_chunk4(dsc, c, (c + 1 < nc) ? c + 1 : c, kf, vf, qf, st, lane); __builtin_amdgcn_sched_barrier(0);
    }
}
__device__ __forceinline__ void attn_finish(AttnSt& st, float sink2, bool has_sink, bf16_t* orow  , int lane) {
    float l = st.l; l += __shfl_xor(l, 16); l += __shfl_xor(l, 32);
    if (has_sink) l += __builtin_amdgcn_exp2f(sink2 - st.m);
    const float inv = 1.0f / l;
    const int gb = (lane >> 4) * 4, d = lane & 15;
#pragma unroll
    for (int r = 0; r < 4; ++r) { const float ir = __shfl(inv, gb + r);
#pragma unroll
        for (int dt = 0; dt < 4; ++dt) orow[(size_t)(gb + r) * 512 + dt * 16 + d] = f2bf(st.o[dt][r] * ir); }
}
__device__ __forceinline__ void attn_init_st(AttnSt& st) {
#pragma unroll
    for (int dt = 0; dt < 4; ++dt) st.o[dt] = (f32x4v){0.f, 0.f, 0.f, 0.f};
    st.m = -1.0e30f; st.l = 0.f;
}
struct Na4Dsc {
    const bf16_t* kb0;
    const bf16_t* vb0;
    const float* rpb;
    unsigned ko[2], vo;
    int kc0, qc, qs;
    int Rlo, r0, nrow;
    __device__ __forceinline__ int crow(int c) const { return c < nrow ? c : nrow - 1; }
    __device__ __forceinline__ const bf16_t* kbase(int c) const { return kb0 + (size_t)crow(c) * 64 * IN_COLS; }
    __device__ __forceinline__ unsigned koff(int, int tt) const { return ko[tt]; }
    __device__ __forceinline__ const bf16_t* vbase(int c) const { return vb0 + crow(c) * 64; }
    __device__ __forceinline__ unsigned voff(int) const { return vo; }
    __device__ __forceinline__ unsigned vstride16() const { return 16u * S; }
    __device__ __forceinline__ bool tile_live(int t, int c) const { const int R0 = clampi(r0 + t - 4, 0, 56), kr = Rlo + c; return c < nrow && kr >= R0 && kr <= R0 + 7; }
    __device__ __forceinline__ float score(int t, int c, int tt, int r, float raw) const {
        const int kc = kc0 + 4 * tt + r; const int dc = clampi(kc - qc + 15, 0, 30);
        const float bias = rpb[(Rlo + c - (r0 + t) + 7) * 31 + dc];
        return (kc >= qs && kc < qs + 16) ? raw * QK_SCALE2 + bias : MASKED;
    }
};
struct Ctx4Dsc {
    const bf16_t* kb0;
    const bf16_t* vb0;
    unsigned ko[2], vo;
    __device__ __forceinline__ const bf16_t* kbase(int c) const { return kb0 + (size_t)c * 32 * IN_COLS; }
    __device__ __forceinline__ unsigned koff(int, int tt) const { return ko[tt]; }
    __device__ __forceinline__ const bf16_t* vbase(int c) const { return vb0 + c * 32; }
    __device__ __forceinline__ unsigned voff(int) const { return vo; }
    __device__ __forceinline__ unsigned vstride16() const { return 16u * L; }
    __device__ __forceinline__ bool tile_live(int, int) const { return true; }
    __device__ __forceinline__ float score(int, int, int, int, float raw) const { return raw * QK_SCALE2; }
};
struct Swa4Dsc {
    const bf16_t* zrow;
    const bf16_t* vrow;
    int p0, kslot0, g8, qpos, dS;
    __device__ __forceinline__ const bf16_t* kbase(int) const { return zrow; }
    __device__ __forceinline__ unsigned koff(int c, int tt) const { const int pos = clampi(p0 - 128 + 32 * c + kslot0 + 4 * tt, 0, S - 1); return (unsigned)pos * (unsigned)IN_COLS + (unsigned)g8; }
    __device__ __forceinline__ const bf16_t* vbase(int) const { return vrow; }
    __device__ __forceinline__ unsigned voff(int c) const { const int pos = clampi(p0 - 128 + 32 * c + g8, 0, S - 8); return (unsigned)(dS + pos); }
    __device__ __forceinline__ unsigned vstride16() const { return 16u * S; }
    __device__ __forceinline__ bool tile_live(int, int c) const { const int pos0 = p0 - 128 + 32 * c; return c < 9 && pos0 + 31 >= 0 && pos0 < S; }
    __device__ __forceinline__ float score(int, int c, int tt, int r, float raw) const {
        const int pos = p0 - 128 + 32 * c + g8 + 4 * tt + r; const int dlt = qpos - pos;
        return (pos >= 0 && pos < S && dlt <= 128 && dlt >= -128) ? raw * QK_SCALE2 : MASKED;
    }
};
__device__ __forceinline__ void ph_attn(const bf16_t* __restrict__ Z, const bf16_t* __restrict__ vtn, const bf16_t* __restrict__ vtnc, const bf16_t* __restrict__ vtw, const bf16_t* __restrict__ vtwc,
                                        const float* __restrict__ rpb, const float* __restrict__ sink, bf16_t* __restrict__ Ob, bf16_t* __restrict__ Oc, bool do_ctx, float* smem, bf16_t* __restrict__ Pa, int rows, const int WV) {
    const int tid = TID, lane = tid & 63, wid = tid >> 6;
    for (int i = tid; i < 8 * 465; i += NTHREADS) smem[i] = rpb[i] * LOG2E;
    ph_pool(Z, Pa, rows, tid);
    __syncthreads();
    const int q = lane & 15, g = lane >> 4, kslot0 = (q >> 2) * 8 + (q & 3);
    const int wu = __builtin_amdgcn_readfirstlane(wid);
    const int vcu = (NBLK % 8 == 0) ? (BID % 8) * (NBLK / 8) + BID / 8 : BID;
    const int nunits = 2048 + 2048 + (do_ctx ? 256 : 0);
    const unsigned ko0 = (unsigned)kslot0 * IN_COLS + 8u * g, ko1 = ko0 + 4u * IN_COLS, qo = (unsigned)q * IN_COLS + 8u * g;
    for (int u = vcu * 8 + wu; u < nunits; u += NBLK * 8) {
        AttnSt st[4]; bf16x8v qf[4][2];
#pragma unroll
        for (int t = 0; t < 4; ++t) attn_init_st(st[t]);
        if (u < 2048) {
            const int cb = u & 3, r4 = (u >> 2) & 15, h = (u >> 6) & 7, b = u >> 9, r0 = r4 * 4;
            const int Rlo = clampi(r0 - 4, 0, 56), Rhi = clampi(r0 + 3 - 4, 0, 56) + 7, nrow = Rhi - Rlo + 1;
            const int C0 = clampi(cb * 16 - 8, 0, 32), qc = cb * 16 + q;
            const size_t t0 = (size_t)b * S + r0 * GW + cb * 16;
            const bf16_t* qp = Z + t0 * IN_COLS + OFF_QN + h * 64;
#pragma unroll
            for (int t = 0; t < 4; ++t) { qf[t][0] = *(const bf16x8v*)(qp + (size_t)t * GW * IN_COLS + qo); qf[t][1] = *(const bf16x8v*)(qp + (size_t)t * GW * IN_COLS + (qo + 32u)); }
            Na4Dsc dl; dl.kb0 = Z + ((size_t)b * S + Rlo * GW + C0) * IN_COLS + OFF_KN + h * 64;
            dl.vb0 = vtn + (size_t)(b * 8 + h) * 64 * S + Rlo * GW + C0; dl.rpb = smem + h * 465;
            dl.ko[0] = ko0; dl.ko[1] = ko1; dl.vo = (unsigned)q * S + 8u * g;
            dl.kc0 = C0 + 8 * g; dl.qc = qc; dl.qs = clampi(qc - 8, 0, 48); dl.Rlo = Rlo; dl.r0 = r0; dl.nrow = nrow;
            attn_stream4(dl, nrow, qf, st, lane);
            Ctx4Dsc dc; dc.kb0 = Z + ((size_t)T_LAT + b * L) * IN_COLS + OFF_KN + h * 64; dc.vb0 = vtnc + (size_t)(b * 8 + h) * 64 * L;
            dc.ko[0] = ko0; dc.ko[1] = ko1; dc.vo = (unsigned)q * L + 8u * g;
            attn_stream4(dc, 8, qf, st, lane);
#pragma unroll
            for (int t = 0; t < 4; ++t) attn_finish(st[t], 0.f, false, Ob + (t0 + (size_t)t * GW) * 512 + h * 64, lane);
        } else if (u < 4096) {
            const int v = u - 2048, qt = v & 255, g2 = (v >> 8) & 1, b = v >> 9, p0 = qt * 16;
            const size_t t0 = (size_t)b * S + p0;
            const bf16_t* qp = Z + t0 * IN_COLS + OFF_QW + g2 * 256;
#pragma unroll
            for (int t = 0; t < 4; ++t) { qf[t][0] = *(const bf16x8v*)(qp + t * 64 + qo); qf[t][1] = *(const bf16x8v*)(qp + t * 64 + (qo + 32u)); }
            Swa4Dsc dl; dl.zrow = Z + (size_t)b * S * IN_COLS + OFF_KW + g2 * 64; dl.vrow = vtw + (size_t)(b * 2 + g2) * 64 * S;
            dl.p0 = p0; dl.kslot0 = kslot0; dl.g8 = 8 * g; dl.qpos = p0 + q; dl.dS = q * S;
            attn_stream4(dl, 9, qf, st, lane);
            Ctx4Dsc dc; dc.kb0 = Z + ((size_t)T_LAT + b * L) * IN_COLS + OFF_KW + g2 * 64; dc.vb0 = vtwc + (size_t)(b * 2 + g2) * 64 * L;
            dc.ko[0] = ko0; dc.ko[1] = ko1; dc.vo = (unsigned)q * L + 8u * g;
            attn_stream4(dc, 8, qf, st, lane);
#pragma unroll
            for (int t = 0; t < 4; ++t) attn_finish(st[t], sink[g2 * 4 + t] * LOG2E, true, Oc + t0 * 512 + (g2 * 4 + t) * 64, lane);
        } else {
            const int v = u - 4096, which = v >> 7;
            if (which == 0) {
                const int qt4 = v & 3, h = (v >> 2) & 7, b = (v >> 5) & 3;
                const size_t t0 = (size_t)T_LAT + b * L + qt4 * 64;
                const bf16_t* qp = Z + t0 * IN_COLS + OFF_QN + h * 64;
#pragma unroll
                for (int t = 0; t < 4; ++t) { qf[t][0] = *(const bf16x8v*)(qp + (size_t)t * 16 * IN_COLS + qo); qf[t][1] = *(const bf16x8v*)(qp + (size_t)t * 16 * IN_COLS + (qo + 32u)); }
                Ctx4Dsc dc; dc.kb0 = Z + ((size_t)T_LAT + b * L) * IN_COLS + OFF_KN + h * 64; dc.vb0 = vtnc + (size_t)(b * 8 + h) * 64 * L;
                dc.ko[0] = ko0; dc.ko[1] = ko1; dc.vo = (unsigned)q * L + 8u * g;
                attn_stream4(dc, 8, qf, st, lane);
#pragma unroll
                for (int t = 0; t < 4; ++t) attn_finish(st[t], 0.f, false, Ob + (t0 + t * 16) * 512 + h * 64, lane);
            } else {
                const int w = v - 128, qt = w & 15, g2 = (w >> 4) & 1, b = (w >> 5) & 3;
                const size_t t0 = (size_t)T_LAT + b * L + qt * 16;
                const bf16_t* qp = Z + t0 * IN_COLS + OFF_QW + g2 * 256;
#pragma unroll
                for (int t = 0; t < 4; ++t) { qf[t][0] = *(const bf16x8v*)(qp + t * 64 + qo); qf[t][1] = *(const bf16x8v*)(qp + t * 64 + (qo + 32u)); }
                Ctx4Dsc dc; dc.kb0 = Z + ((size_t)T_LAT + b * L) * IN_COLS + OFF_KW + g2 * 64; dc.vb0 = vtwc + (size_t)(b * 2 + g2) * 64 * L;
                dc.ko[0] = ko0; dc.ko[1] = ko1; dc.vo = (unsigned)q * L + 8u * g;
                attn_stream4(dc, 8, qf, st, lane);
#pragma unroll
                for (int t = 0; t < 4; ++t) attn_finish(st[t], sink[g2 * 4 + t] * LOG2E, true, Oc + t0 * 512 + (g2 * 4 + t) * 64, lane);
            }
        }
    }
}

__device__ __forceinline__ float embed(float v, unsigned mask, unsigned code) { return __uint_as_float((__float_as_uint(v) & ~mask) | code); }
__device__ __forceinline__ float gmax4(float v) { v = fmaxf(v, __shfl_xor(v, 16)); return fmaxf(v, __shfl_xor(v, 32)); }
__device__ __forceinline__ void ph_peer_topk(const bf16_t* __restrict__ Q, const bf16_t* __restrict__ keys, int* __restrict__ eidx, float* __restrict__ egate, int rows, float* smem, const int WV) {
    const int tid = TID, lane = tid & 63, wid = tid >> 6, n = lane & 15, g = lane >> 4;
    int* lidx = (int*)smem + wid * 512;
    const float NEG = -3.0e38f;
    const int nunits = (rows / 16) * 8;
    const int wu = __builtin_amdgcn_readfirstlane(wid);
    for (int u = BID * 8 + wu; u < nunits; u += NBLK * 8) {
        const int h = u & 7, t0 = (u >> 3) * 16;
        float tops[2][16];
#pragma unroll
        for (int pp = 0; pp < 2; ++pp) {
            const bf16_t* qb = Q + (size_t)t0 * 2048 + h * 256 + pp * 128; const unsigned qof = (unsigned)n * 2048u + 8u * g;
            bf16x8v qf[4];
#pragma unroll
            for (int ks = 0; ks < 4; ++ks) qf[ks] = *(const bf16x8v*)(qb + (qof + ks * 32));
            const bf16_t* kb = keys + (size_t)(h * 2 + pp) * 128 * 128; const unsigned kof = (unsigned)n * 128u + 8u * g;
            float sc[32];
            bf16x8v ka[2][4];
#pragma unroll
            for (int ks = 0; ks < 4; ++ks) ka[0][ks] = *(const bf16x8v*)(kb + (kof + ks * 32));
#pragma unroll
            for (int T = 0; T < 8; ++T) {
                if (T + 1 < 8) {
#pragma unroll
                    for (int ks = 0; ks < 4; ++ks) ka[(T + 1) & 1][ks] = *(const bf16x8v*)(kb + (kof + (T + 1) * 16 * 128 + ks * 32));
                }
                __builtin_amdgcn_sched_barrier(0);
                f32x4v acc = (f32x4v){0.f, 0.f, 0.f, 0.f};
#pragma unroll
                for (int ks = 0; ks < 4; ++ks) acc = mfma16(ka[T & 1][ks], qf[ks], acc);
#pragma unroll
                for (int r = 0; r < 4; ++r) sc[T * 4 + r] = embed(acc[r], 127u, (unsigned)(T * 16 + 4 * g + r));
                __builtin_amdgcn_sched_barrier(0);
            }
#pragma unroll
            for (int rd = 0; rd < 16; ++rd) {
                float mx = sc[0];
#pragma unroll
                for (int k = 1; k < 32; ++k) mx = fmaxf(mx, sc[k]);
                mx = gmax4(mx);
                tops[pp][rd] = mx;
                if (g == 0) lidx[(n * 2 + pp) * 16 + rd] = (int)(__float_as_uint(mx) & 127u);
#pragma unroll
                for (int k = 0; k < 32; ++k) sc[k] = (sc[k] == mx) ? NEG : sc[k];
            }
        }
        float bsel[4];
#pragma unroll
        for (int jj = 0; jj < 4; ++jj) bsel[jj] = g == 0 ? tops[1][4 * jj] : (g == 1 ? tops[1][4 * jj + 1] : (g == 2 ? tops[1][4 * jj + 2] : tops[1][4 * jj + 3]));
        float cd[21];
#pragma unroll
        for (int i = 0; i < 16; ++i) cd[i] = embed(tops[0][i] + bsel[0], 255u, (unsigned)((i << 4) | g));
#pragma unroll
        for (int i = 0; i < 3; ++i) cd[16 + i] = embed(tops[0][i] + bsel[1], 255u, (unsigned)((i << 4) | 4 | g));
        cd[19] = embed(tops[0][0] + bsel[2], 255u, (unsigned)(8 | g));
        cd[20] = embed(tops[0][0] + bsel[3], 255u, (unsigned)(12 | g));
        float best[16];
#pragma unroll
        for (int rd = 0; rd < 16; ++rd) {
            float mx = cd[0];
#pragma unroll
            for (int k = 1; k < 21; ++k) mx = fmaxf(mx, cd[k]);
            mx = gmax4(mx);
            best[rd] = mx;
#pragma unroll
            for (int k = 0; k < 21; ++k) cd[k] = (cd[k] == mx) ? NEG : cd[k];
        }
        float ex[16]; float sum = 0.f;
#pragma unroll
        for (int rd = 0; rd < 16; ++rd) { ex[rd] = __builtin_amdgcn_exp2f((best[rd] - best[0]) * LOG2E); sum += ex[rd]; }
        const float inv = 1.0f / sum;
        asm volatile("s_waitcnt lgkmcnt(0)" ::: "memory");
        int eo[4]; float go[4];
#pragma unroll
        for (int rr = 0; rr < 4; ++rr) {
            const float bv = g == 0 ? best[rr] : (g == 1 ? best[4 + rr] : (g == 2 ? best[8 + rr] : best[12 + rr]));
            const float ev = g == 0 ? ex[rr] : (g == 1 ? ex[4 + rr] : (g == 2 ? ex[8 + rr] : ex[12 + rr]));
            const unsigned code = __float_as_uint(bv) & 255u;
            eo[rr] = lidx[(n * 2 + 0) * 16 + (code >> 4)] * 128 + lidx[(n * 2 + 1) * 16 + (code & 15u)];
            go[rr] = ev * inv;
        }
        const size_t o = (size_t)(t0 + n) * 128 + h * 16 + 4 * g;
        *(int4*)(eidx + o) = make_int4(eo[0], eo[1], eo[2], eo[3]);
        *(float4*)(egate + o) = make_float4(go[0], go[1], go[2], go[3]);
        asm volatile("s_waitcnt lgkmcnt(0)" ::: "memory");
    }
}
__device__ __forceinline__ void ph_peer_gather_bf16(const bf16_t* __restrict__ H, const bf16_t* __restrict__ U, const bf16_t* __restrict__ V, const int* __restrict__ eidx, const float* __restrict__ egate,
                                               const float* __restrict__ modl, float* __restrict__ Xl, float* __restrict__ Xc, int rows,
                                               int mode, const float* __restrict__ gn, const float* __restrict__ modn, bf16_t* __restrict__ Hn, float* smem, bool dry, const int WV) {
    const int tid = TID, lane = tid & 63, wid = tid >> 6, m = lane & 15, gk = lane >> 4;
    float* wl = smem + wid * 128;
    for (int t = BID * 8 + wid; t < rows; t += NBLK * 8) {
        const int e0 = eidx[(size_t)t * 128 + lane], e1 = eidx[(size_t)t * 128 + 64 + lane];
        const bf16_t* rp[8];
#pragma unroll
        for (int T = 0; T < 8; ++T) { const int e = __shfl(T < 4 ? e0 : e1, (T & 3) * 16 + m); rp[T] = U + (size_t)e * D + 8 * gk; }
        f32x4v acc[8];
#pragma unroll
        for (int T = 0; T < 8; ++T) acc[T] = (f32x4v){0.f, 0.f, 0.f, 0.f};
        const bf16_t* hp = H + (size_t)t * D + 8 * gk;
#pragma unroll 2
        for (int ks = 0; ks < 32; ++ks) {
            const bf16x8v hb = *(const bf16x8v*)(hp + ks * 32);
#pragma unroll
            for (int T = 0; T < 8; ++T) { const bf16x8v a = *(const bf16x8v*)(rp[T] + ks * 32); acc[T] = mfma16(a, hb, acc[T]); }
        }
        const int myT = m >> 1, r0 = (m & 1) * 2;
        float va = 0.f, vb = 0.f;
#pragma unroll
        for (int T = 0; T < 8; ++T) { const float x0 = r0 ? acc[T][2] : acc[T][0], x1 = r0 ? acc[T][3] : acc[T][1]; if (myT == T) { va = x0; vb = x1; } }
        const int ee = myT * 16 + 4 * gk + r0;
        const float2 gg = *(const float2*)(egate + (size_t)t * 128 + ee);
        float2 ww; ww.x = gg.x * 0.5f * va * (1.f + erff(va * 0.70710678118654752f)); ww.y = gg.y * 0.5f * vb * (1.f + erff(vb * 0.70710678118654752f));
        *(float2*)(wl + ee) = ww;
        asm volatile("s_waitcnt lgkmcnt(0)" ::: "memory");
        const float w0 = wl[lane], w1 = wl[64 + lane];
        asm volatile("s_waitcnt lgkmcnt(0)" ::: "memory");
        float out[16];
#pragma unroll
        for (int i = 0; i < 16; ++i) out[i] = 0.f;
        const bf16_t* vb0 = V + lane * 8;
#pragma unroll
        for (int hh = 0; hh < 2; ++hh) {
            const int ev = hh ? e1 : e0; const int wbits = __float_as_int(hh ? w1 : w0);
#pragma unroll 8
            for (int k = 0; k < 64; ++k) {
                const int e = __builtin_amdgcn_readlane(ev, k); const float w = __int_as_float(__builtin_amdgcn_readlane(wbits, k));
                const bf16_t* vp = vb0 + (size_t)e * D;
                const uint4 a = *(const uint4*)vp, b = *(const uint4*)(vp + 512);
                out[0] += w * lo16(a.x); out[1] += w * hi16(a.x); out[2] += w * lo16(a.y); out[3] += w * hi16(a.y); out[4] += w * lo16(a.z); out[5] += w * hi16(a.z); out[6] += w * lo16(a.w); out[7] += w * hi16(a.w);
                out[8] += w * lo16(b.x); out[9] += w * hi16(b.x); out[10] += w * lo16(b.y); out[11] += w * hi16(b.y); out[12] += w * lo16(b.z); out[13] += w * hi16(b.z); out[14] += w * lo16(b.w); out[15] += w * hi16(b.w);
            }
        }
        const int mrow = t < T_LAT ? t / S : 4;
        float* xp = t < T_LAT ? Xl + (size_t)t * D : Xc + (size_t)(t - T_LAT) * D;
        const float* gt = modl + (size_t)mrow * 6144 + 5 * 1024;
        float xr[16]; float ss = 0.f;
#pragma unroll
        for (int q4 = 0; q4 < 4; ++q4) { const int col = (q4 >> 1) * 512 + lane * 8 + (q4 & 1) * 4;
            const float4 x = *(const float4*)(xp + col), g4 = *(const float4*)(gt + col);
            xr[q4 * 4 + 0] = x.x + g4.x * out[q4 * 4 + 0]; xr[q4 * 4 + 1] = x.y + g4.y * out[q4 * 4 + 1]; xr[q4 * 4 + 2] = x.z + g4.z * out[q4 * 4 + 2]; xr[q4 * 4 + 3] = x.w + g4.w * out[q4 * 4 + 3];
#pragma unroll
            for (int i = 0; i < 4; ++i) ss += xr[q4 * 4 + i] * xr[q4 * 4 + i]; }
        ss = wave_sum(ss);
        const float rstd = rsqrtf(ss * (1.0f / D) + EPS);
        if (dry && rstd != 12345.678f) continue;
        if (mode == 0) {
            const float* shn = modn + (size_t)mrow * 6144; const float* scn = shn + 1024;
#pragma unroll
            for (int q4 = 0; q4 < 4; ++q4) { const int col = (q4 >> 1) * 512 + lane * 8 + (q4 & 1) * 4;
                *(float4*)(xp + col) = make_float4(xr[q4 * 4], xr[q4 * 4 + 1], xr[q4 * 4 + 2], xr[q4 * 4 + 3]);
                const float4 g4 = *(const float4*)(gn + col), s4 = *(const float4*)(scn + col), h4 = *(const float4*)(shn + col);
                uint2 w; w.x = pk2(xr[q4 * 4] * rstd * g4.x * (1.f + s4.x) + h4.x, xr[q4 * 4 + 1] * rstd * g4.y * (1.f + s4.y) + h4.y);
                w.y = pk2(xr[q4 * 4 + 2] * rstd * g4.z * (1.f + s4.z) + h4.z, xr[q4 * 4 + 3] * rstd * g4.w * (1.f + s4.w) + h4.w);
                *(uint2*)(Hn + (size_t)t * D + col) = w; }
        } else {
#pragma unroll
            for (int q4 = 0; q4 < 4; ++q4) { const int col = (q4 >> 1) * 512 + lane * 8 + (q4 & 1) * 4;
                const float4 g4 = *(const float4*)(gn + col);
                *(float4*)(xp + col) = make_float4(xr[q4 * 4] * rstd * g4.x, xr[q4 * 4 + 1] * rstd * g4.y, xr[q4 * 4 + 2] * rstd * g4.z, xr[q4 * 4 + 3] * rstd * g4.w); }
        }
    }
}

typedef long i64v;
typedef long i64x2v __attribute__((ext_vector_type(2)));
__device__ __forceinline__ f32x4v mfma8(i64v a, i64v b, f32x4v c) { return __builtin_amdgcn_mfma_f32_16x16x32_fp8_fp8(a, b, c, 0, 0, 0); }
__device__ __forceinline__ void ph_peer_gather_fp8(const unsigned char* __restrict__ H8, const unsigned char* __restrict__ U8, const unsigned char* __restrict__ V8, const float* __restrict__ isu, const float* __restrict__ isv,
                                               const int* __restrict__ eidx, const float* __restrict__ egate,
                                               const float* __restrict__ modl, float* __restrict__ Xl, float* __restrict__ Xc, int rows,
                                               int mode, const float* __restrict__ gn, const float* __restrict__ modn, bf16_t* Hn, float* smem, bool dry, const int WV) {
    const int tid = TID, lane = tid & 63, wid = tid >> 6, m = lane & 15, gk = lane >> 4;
    float* wl = smem + wid * 128;
    for (int t = BID * 8 + wid; t < rows; t += NBLK * 8) {
        const int e0 = eidx[(size_t)t * 128 + lane], e1 = eidx[(size_t)t * 128 + 64 + lane];
        unsigned rp[8];
#pragma unroll
        for (int T = 0; T < 8; ++T) { const int e = __shfl(T < 4 ? e0 : e1, (T & 3) * 16 + m); rp[T] = (unsigned)e * (unsigned)D + 16u * (unsigned)gk; }
        f32x4v acc[8];
#pragma unroll
        for (int T = 0; T < 8; ++T) acc[T] = (f32x4v){0.f, 0.f, 0.f, 0.f};
        const unsigned char* hp = H8 + (size_t)t * D + 16 * gk;
#if RING_U
        i64x2v A[3][8], Bh[3], Bl[3];
#define GLOADK(ks) do { _Pragma("unroll") for (int T = 0; T < 8; ++T) A[(ks) % 3][T] = *(const i64x2v*)(U8 + (rp[T] + (unsigned)((ks) * 64))); \
                        Bh[(ks) % 3] = *(const i64x2v*)(hp + (ks) * 64); Bl[(ks) % 3] = *(const i64x2v*)(hp + (size_t)T_ALL * D + (ks) * 64); } while (0)
        GLOADK(0); GLOADK(1);
#pragma unroll
        for (int ks = 0; ks < 16; ++ks) {
            if (ks + 2 < 16) GLOADK(ks + 2);
            __builtin_amdgcn_sched_barrier(0);
#pragma unroll
            for (int T = 0; T < 8; ++T) { const i64x2v a = A[ks % 3][T];
                acc[T] = mfma8(a[0], Bh[ks % 3][0], acc[T]); acc[T] = mfma8(a[0], Bl[ks % 3][0], acc[T]); acc[T] = mfma8(a[1], Bh[ks % 3][1], acc[T]); acc[T] = mfma8(a[1], Bl[ks % 3][1], acc[T]); }
            __builtin_amdgcn_sched_barrier(0);
        }
#undef GLOADK
#else
#pragma unroll 2
        for (int ks = 0; ks < 16; ++ks) {
            const i64x2v bh = *(const i64x2v*)(hp + ks * 64), bl = *(const i64x2v*)(hp + (size_t)T_ALL * D + ks * 64);
            i64x2v a[8];
#pragma unroll
            for (int T = 0; T < 8; ++T) a[T] = *(const i64x2v*)(U8 + (rp[T] + (unsigned)(ks * 64)));
#pragma unroll
            for (int T = 0; T < 8; ++T) { acc[T] = mfma8(a[T][0], bh[0], acc[T]); acc[T] = mfma8(a[T][0], bl[0], acc[T]); acc[T] = mfma8(a[T][1], bh[1], acc[T]); acc[T] = mfma8(a[T][1], bl[1], acc[T]); }
        }
#endif
        const int myT = m >> 1, r0 = (m & 1) * 2;
        float va = 0.f, vb = 0.f;
#pragma unroll
        for (int T = 0; T < 8; ++T) { const float x0 = r0 ? acc[T][2] : acc[T][0], x1 = r0 ? acc[T][3] : acc[T][1]; if (myT == T) { va = x0; vb = x1; } }
        const int ee = myT * 16 + 4 * gk + r0;
        const int ida0 = __shfl(e0, ee & 63), ida1 = __shfl(e1, ee & 63), idb0 = __shfl(e0, (ee + 1) & 63), idb1 = __shfl(e1, (ee + 1) & 63);
        const int ida = ee < 64 ? ida0 : ida1, idb = ee < 64 ? idb0 : idb1;
        va *= 0.125f * isu[ida]; vb *= 0.125f * isu[idb];
        const float2 gg = *(const float2*)(egate + (size_t)t * 128 + ee);
        float2 ww; ww.x = gg.x * 0.5f * va * (1.f + erff(va * 0.70710678118654752f)); ww.y = gg.y * 0.5f * vb * (1.f + erff(vb * 0.70710678118654752f));
        *(float2*)(wl + ee) = ww;
        asm volatile("s_waitcnt lgkmcnt(0)" ::: "memory");
        const float w0 = wl[lane] * isv[e0], w1 = wl[64 + lane] * isv[e1];
        asm volatile("s_waitcnt lgkmcnt(0)" ::: "memory");
        float out[16];
#pragma unroll
        for (int i = 0; i < 16; ++i) out[i] = 0.f;
        const unsigned voff = 16u * (unsigned)lane;
#if RING_V
        uint4 VR[2][8];
#define VLOADC(c, slot) do { const int ev_ = ((c) & 8) ? e1 : e0; _Pragma("unroll") for (int j = 0; j < 8; ++j) { const int e = __builtin_amdgcn_readlane(ev_, ((c) & 7) * 8 + j); VR[slot][j] = *(const uint4*)(V8 + ((unsigned)e * (unsigned)D + voff)); } } while (0)
#define VCOMPC(c, slot) do { const int wb_ = __float_as_int(((c) & 8) ? w1 : w0); _Pragma("unroll") for (int j = 0; j < 8; ++j) { const float w = __int_as_float(__builtin_amdgcn_readlane(wb_, ((c) & 7) * 8 + j)); \
            const unsigned aw[4] = {VR[slot][j].x, VR[slot][j].y, VR[slot][j].z, VR[slot][j].w}; \
            _Pragma("unroll") for (int q = 0; q < 4; ++q) { const f32x2v d0 = __builtin_amdgcn_cvt_pk_f32_fp8((int)aw[q], false), d1 = __builtin_amdgcn_cvt_pk_f32_fp8((int)aw[q], true); \
                out[4 * q] += w * d0[0]; out[4 * q + 1] += w * d0[1]; out[4 * q + 2] += w * d1[0]; out[4 * q + 3] += w * d1[1]; } } } while (0)
        VLOADC(0, 0);
#pragma unroll 1
        for (int c2 = 0; c2 < 16; c2 += 2) {
            VLOADC(c2 + 1, 1); __builtin_amdgcn_sched_barrier(0); VCOMPC(c2, 0); __builtin_amdgcn_sched_barrier(0);
            if (c2 + 2 < 16) VLOADC(c2 + 2, 0); __builtin_amdgcn_sched_barrier(0); VCOMPC(c2 + 1, 1); __builtin_amdgcn_sched_barrier(0);
        }
#undef VLOADC
#undef VCOMPC
#else
#pragma unroll
        for (int hh = 0; hh < 2; ++hh) {
            const int ev = hh ? e1 : e0; const int wbits = __float_as_int(hh ? w1 : w0);
#pragma unroll 16
            for (int k = 0; k < 64; ++k) {
                const int e = __builtin_amdgcn_readlane(ev, k); const float w = __int_as_float(__builtin_amdgcn_readlane(wbits, k));
                const uint4 a = *(const uint4*)(V8 + ((unsigned)e * (unsigned)D + voff));
                const unsigned aw[4] = {a.x, a.y, a.z, a.w};
#pragma unroll
                for (int q = 0; q < 4; ++q) { const f32x2v d0 = __builtin_amdgcn_cvt_pk_f32_fp8((int)aw[q], false), d1 = __builtin_amdgcn_cvt_pk_f32_fp8((int)aw[q], true);
                    out[4 * q] += w * d0[0]; out[4 * q + 1] += w * d0[1]; out[4 * q + 2] += w * d1[0]; out[4 * q + 3] += w * d1[1]; }
            }
        }
#endif
        const int mrow = t < T_LAT ? t / S : 4;
        float* xp = (t < T_LAT ? Xl + (size_t)t * D : Xc + (size_t)(t - T_LAT) * D) + lane * 16;
        const float* gt = modl + (size_t)mrow * 6144 + 5 * 1024 + lane * 16;
        float xr[16]; float ss = 0.f;
#pragma unroll
        for (int q4 = 0; q4 < 4; ++q4) {
            const float4 x = *(const float4*)(xp + q4 * 4), g4 = *(const float4*)(gt + q4 * 4);
            xr[q4 * 4 + 0] = x.x + g4.x * out[q4 * 4 + 0]; xr[q4 * 4 + 1] = x.y + g4.y * out[q4 * 4 + 1]; xr[q4 * 4 + 2] = x.z + g4.z * out[q4 * 4 + 2]; xr[q4 * 4 + 3] = x.w + g4.w * out[q4 * 4 + 3];
#pragma unroll
            for (int i = 0; i < 4; ++i) ss += xr[q4 * 4 + i] * xr[q4 * 4 + i]; }
        ss = wave_sum(ss);
        const float rstd = rsqrtf(ss * (1.0f / D) + EPS);
        if (dry && rstd != 12345.678f) continue;
        if (mode == 0) {
            const float* shn = modn + (size_t)mrow * 6144 + lane * 16; const float* scn = shn + 1024; const float* gp = gn + lane * 16;
#pragma unroll
            for (int q4 = 0; q4 < 4; ++q4) {
                *(float4*)(xp + q4 * 4) = make_float4(xr[q4 * 4], xr[q4 * 4 + 1], xr[q4 * 4 + 2], xr[q4 * 4 + 3]);
                const float4 g4 = *(const float4*)(gp + q4 * 4), s4 = *(const float4*)(scn + q4 * 4), h4 = *(const float4*)(shn + q4 * 4);
                uint2 w; w.x = pk2(xr[q4 * 4] * rstd * g4.x * (1.f + s4.x) + h4.x, xr[q4 * 4 + 1] * rstd * g4.y * (1.f + s4.y) + h4.y);
                w.y = pk2(xr[q4 * 4 + 2] * rstd * g4.z * (1.f + s4.z) + h4.z, xr[q4 * 4 + 3] * rstd * g4.w * (1.f + s4.w) + h4.w);
                *(uint2*)(Hn + (size_t)t * D + lane * 16 + q4 * 4) = w; }
        } else {
            const float* gp = gn + lane * 16;
#pragma unroll
            for (int q4 = 0; q4 < 4; ++q4) { const float4 g4 = *(const float4*)(gp + q4 * 4);
                *(float4*)(xp + q4 * 4) = make_float4(xr[q4 * 4] * rstd * g4.x, xr[q4 * 4 + 1] * rstd * g4.y, xr[q4 * 4 + 2] * rstd * g4.z, xr[q4 * 4 + 3] * rstd * g4.w); }
        }
    }
}

#define LAS __attribute__((address_space(3)))
#define XB_TMO      128
#define XB_XCNT(j)  (256  + 64 * (j))
#define XB_XSUB(j)  (1280 + 64 * (j))
#define XB_XGEN(j)  (2304 + 64 * (j))
#define XB_TOP      3328
#define XB_TOPGEN   3392
#define XCD_BAR_WORDS 3456
#define XB_SPIN_CAP (1u << 18)

__device__ __forceinline__ unsigned xb_ld(unsigned* p)              { return __hip_atomic_load(p, __ATOMIC_RELAXED, __HIP_MEMORY_SCOPE_AGENT); }
__device__ __forceinline__ unsigned xb_add(unsigned* p, unsigned v) { return __hip_atomic_fetch_add(p, v, __ATOMIC_RELAXED, __HIP_MEMORY_SCOPE_AGENT); }
__device__ __forceinline__ unsigned xb_xcc_id() { return (unsigned)__builtin_amdgcn_s_getreg((3 << 11) | 20) & 0xFu; }
#define XB_SPIN(cond, bar) do { unsigned _sp = 0; while (cond) { __builtin_amdgcn_s_sleep(1); \
    if ((++_sp & 255u) == 0u) { if (xb_ld(&(bar)[XB_TMO])) break; if (_sp > XB_SPIN_CAP) { atomicAdd(&(bar)[XB_TMO], 1u); break; } } } } while (0)

struct XcdBarrier {
    unsigned* bar; unsigned x; int wv;
    volatile LAS unsigned* st;
};

__device__ __forceinline__ XcdBarrier xcd_barrier_post(unsigned* bar, volatile LAS unsigned* st, int wv) {
    XcdBarrier b; b.bar = bar; b.x = xb_xcc_id(); b.st = st; b.wv = wv;
    if (wv == 0 && lane_id() == 0) (void)xb_add(&bar[XB_XCNT(b.x)], 1u);
    return b;
}
__device__ __forceinline__ void xcd_barrier_complete(unsigned* bar, unsigned x, unsigned& nloc, unsigned& nx) {
    const unsigned G = gridDim.x * gridDim.y * gridDim.z;
    unsigned sum, cnt, mine, sp = 0u;
    for (;;) {
        sum = 0u; cnt = 0u; mine = 0u;
#pragma unroll
        for (unsigned j = 0; j < 16; ++j) { const unsigned c = xb_ld(&bar[XB_XCNT(j)]); sum += c; cnt += (c > 0u) ? 1u : 0u; mine = (j == x) ? c : mine; }
        if (sum == G) break;
        __builtin_amdgcn_s_sleep(1);
        if ((++sp & 255u) == 0u) { if (xb_ld(&bar[XB_TMO])) break; if (sp > XB_SPIN_CAP) { atomicAdd(&bar[XB_TMO], 1u); break; } }
    }
    nloc = mine > 0u ? mine : 1u; nx = cnt > 0u ? cnt : 1u;
}

__device__ __forceinline__ void xcd_barrier(const XcdBarrier& b) {
    asm volatile("s_waitcnt vmcnt(0)" ::: "memory");
    __syncthreads();
    if (b.wv == 0 && lane_id() == 0) {
        unsigned* bar = b.bar;
        __builtin_amdgcn_s_waitcnt(0);
        unsigned nloc = b.st[0], nx = b.st[1];
        if (nloc == 0u) { xcd_barrier_complete(bar, b.x, nloc, nx); b.st[0] = nloc; b.st[1] = nx; }
        const unsigned old = xb_add(&bar[XB_XSUB(b.x)], 1u);
        const unsigned gen = old / nloc;
        if (old + 1u == (gen + 1u) * nloc) {
            __builtin_amdgcn_fence(__ATOMIC_RELEASE, "agent");
            asm volatile("s_waitcnt vmcnt(0)" ::: "memory");
            const unsigned og = xb_add(&bar[XB_TOP], 1u);
            const unsigned tg = og / nx;
            if (og + 1u == (tg + 1u) * nx) xb_add(&bar[XB_TOPGEN], 1u);
            else XB_SPIN(xb_ld(&bar[XB_TOPGEN]) == tg, bar);
            __builtin_amdgcn_fence(__ATOMIC_ACQUIRE, "agent");
            xb_add(&bar[XB_XGEN(b.x)], 1u);
            asm volatile("s_waitcnt vmcnt(0)" ::: "memory");
        } else {
            XB_SPIN(xb_ld(&bar[XB_XGEN(b.x)]) == gen, bar);
            __builtin_amdgcn_fence(__ATOMIC_ACQUIRE, "agent");
            asm volatile("s_waitcnt vmcnt(0)" ::: "memory");
        }
    }
    __syncthreads();
}

__device__ __forceinline__ unsigned char* launder(unsigned char* q) { size_t z = 0; asm volatile("" : "+s"(z)); return q + z; }
struct WsPtrs { float *mod, *rope, *XC, *X; bf16_t *H, *Z, *vtn, *vtnc, *vtw, *vtwc, *AT; int* eidx; float* egate; unsigned char* wl; const float* modl; const unsigned char *U8, *V8, *H8; const float *isu, *isv; const bf16_t *U, *V; };
__device__ __forceinline__ WsPtrs mkptrs(const Params& p, int l) {
    unsigned char* ws = launder(p.ws); WsPtrs P;
    P.mod = (float*)(ws + WS_MOD); P.rope = (float*)(ws + WS_ROPE); P.XC = (float*)(ws + WS_XC); P.X = (float*)launder((unsigned char*)p.out);
    P.H = (bf16_t*)(ws + WS_H); P.Z = (bf16_t*)(ws + WS_Z); P.vtn = (bf16_t*)(ws + WS_VTN); P.vtnc = (bf16_t*)(ws + WS_VTNC); P.vtw = (bf16_t*)(ws + WS_VTW); P.vtwc = (bf16_t*)(ws + WS_VTWC);
    P.AT = (bf16_t*)(ws + WS_AT); P.eidx = (int*)(ws + WS_EIDX); P.egate = (float*)(ws + WS_EGATE);
    P.wl = ws + WS_W + l * W_LAYER; P.modl = P.mod + (size_t)l * 5 * 6144; P.U = (const bf16_t*)(ws + WS_TAB0); P.V = P.U + (size_t)NEXP * D; P.U8 = ws + ((l == 0) ? WS_TAB0 : WS_TAB1); P.V8 = P.U8 + (size_t)NEXP * D; P.isu = (const float*)(P.U8 + (size_t)2 * NEXP * D); P.isv = P.isu + NEXP; P.H8 = ws + WS_H8;
    return P;
}
__global__ void __launch_bounds__(NTHREADS, 2) mega_fwd(Params p) {
    extern __shared__ __attribute__((aligned(16))) unsigned char lds[];
    cg::grid_group grid = cg::this_grid();
    int WV; asm volatile("v_readfirstlane_b32 %0, %1" : "=s"(WV) : "v"((int)threadIdx.x >> 6));
    PG8_LAS unsigned char* ldsr = (PG8_LAS unsigned char*)lds;
    float* smem = (float*)lds;
    volatile LAS unsigned* bst = (volatile LAS unsigned*)((LAS unsigned char*)lds + 131072 + 256);
    if (WV == 0 && lane_id() < 2) bst[lane_id()] = 0u;
    __syncthreads();
    XcdBarrier xbar = xcd_barrier_post((unsigned*)(p.ws + WS_CTL), bst, WV);

#ifndef PROBE_DUP
#define PROBE_DUP 0
#endif

#define SYNC() xcd_barrier(xbar)
#define DUP(k, PH) do { PH; SYNC(); if (PROBE_DUP == (k)) { PH; SYNC(); } } while (0)
#define PH_NORM1() { const WsPtrs P = mkptrs(p, l); ph_norm_mod(P.X, P.XC, p.norm1_g, P.modl, 0, 1, P.H, T_ALL, nullptr, WV); }
#define PH_ZGEMM() {     \
            const WsPtrs P = mkptrs(p, l); \
            pg8::EpiZ E{P.Z, P.rope, P.vtn, P.vtnc, P.vtw, P.vtwc, 0, 0}; \
            if (!last) { pg8::Gemm g{P.H, (const bf16_t*)(P.wl + W_WIN), T_ALL, IN_COLS, D}; pg8::StaticOrder So; So.init(T_ALL, IN_COLS, NBLK, BID); \
                pg8::gemm_phase<pg8::EpiZ, pg8::StaticOrder, true, true>(ldsr, g, So, E, WV); } \
            else { pg8::Gemm g{P.H, (const bf16_t*)(P.wl + W_WIN), T_LAT, IN_COLS, D}; pg8::StaticOrder So; So.init(T_LAT, IN_COLS, NBLK, BID); \
                pg8::gemm_phase<pg8::EpiZ, pg8::StaticOrder, true, true>(ldsr, g, So, E, WV); \
                const WsPtrs P2 = mkptrs(p, l); \
                pg8::EpiZ E2{P2.Z, P2.rope, P2.vtn, P2.vtnc, P2.vtw, P2.vtwc, T_LAT, 0}; \
                pg8::Gemm g2{P2.H + (size_t)T_LAT * D, (const bf16_t*)(P2.wl + W_WIN), T_CTX, CTX_KV_COLS, D}; pg8::StaticOrder S2; S2.init(T_CTX, CTX_KV_COLS, NBLK, BID); \
                pg8::gemm_phase<pg8::EpiZ, pg8::StaticOrder, true, true>(ldsr, g2, S2, E2, WV); } }
#define PH_ATTN() { const WsPtrs P = mkptrs(p, l); ph_attn(P.Z, P.vtn, P.vtnc, P.vtw, P.vtwc, p.na_rpb + (size_t)l * 8 * 15 * 31, p.swa_sink + l * 8, P.AT + (size_t)T_ALL * 512, P.AT + (size_t)2 * T_ALL * 512, !last, smem, P.AT, rows, WV); }
#define PH_MERGE() {     \
            const WsPtrs P = mkptrs(p, l); \
            pg8::Gemm g{P.AT, (const bf16_t*)(P.wl + W_WA), 3 * T_ALL, 3 * D, 512}; pg8::MergeOrder Mo{(rows / 256) * 4, NBLK, BID, 0}; pg8::EpiMergeSeg E{P.Z, P.H}; \
            pg8::gemm_phase<pg8::EpiMergeSeg, pg8::MergeOrder, false, true>(ldsr, g, Mo, E, WV); }
#define PH_OUT(GIDX) {     \
            const WsPtrs P = mkptrs(p, l); \
            pg8::Gemm g{P.H, (const bf16_t*)(P.wl + W_WO), rows, D, D}; pg8::StaticOrder So; So.init(rows, D, NBLK, BID); pg8::EpiResid E{P.X, P.XC, P.modl, GIDX, 0}; \
            pg8::gemm_phase<pg8::EpiResid, pg8::StaticOrder, true, true>(ldsr, g, So, E, WV); }
#define PH_NORM2() { const WsPtrs P = mkptrs(p, l); ph_norm_mod(P.X, P.XC, p.norm2_g + l * D, P.modl, 3, 4, P.H, rows, (last || FP8_L0) ? (unsigned*)P.H8 : nullptr, WV); }
#define PH_QGEMM() { const WsPtrs P = mkptrs(p, l); \
            pg8::Gemm g{P.H, (const bf16_t*)(P.wl + W_WQ), rows, 2048, D}; pg8::StaticOrder So; So.init(rows, 2048, NBLK, BID); pg8::EpiStoreBf16 E{P.Z, 2048, 0}; \
            pg8::gemm_phase<pg8::EpiStoreBf16, pg8::StaticOrder, true, true>(ldsr, g, So, E, WV); }
#define PH_TOPK() { const WsPtrs P = mkptrs(p, l); ph_peer_topk(P.Z, (const bf16_t*)(P.wl + W_KEYS), P.eidx, P.egate, rows, smem, WV); }
#define PH_GATHER(DRY) { const WsPtrs P = mkptrs(p, l); \
            if (!last && !FP8_L0) ph_peer_gather_bf16(P.H, P.U, P.V, P.eidx, P.egate, P.modl, P.X, P.XC, rows, 0, p.norm1_g + D, P.modl + 5 * 6144, P.H, smem, DRY, WV); \
            else ph_peer_gather_fp8(P.H8, P.U8, P.V8, P.isu, P.isv, P.eidx, P.egate, P.modl, P.X, P.XC, rows, last ? 1 : 0, last ? p.final_g : p.norm1_g + D, P.modl + 5 * 6144, P.H, smem, DRY, WV); }

    ph_prep(p, smem, WV);
    grid.sync();
    if (PROBE_DUP == 1) { ph_prep(p, smem, WV); SYNC(); }
#define LAYER_BODY(LIDX) { constexpr int l = LIDX; \
        const bool last = (l == 1); \
        const int rows = last ? T_LAT : T_ALL; \
        if (l == 0) { PH_NORM1(); SYNC(); } \
        DUP(2, PH_ZGEMM()); \
        DUP(3, PH_ATTN()); \
        DUP(4, PH_MERGE()); \
        PH_OUT(2); SYNC(); \
        DUP(5, PH_NORM2()); \
        DUP(6, PH_QGEMM()); \
        DUP(7, PH_TOPK()); \
        if (PROBE_DUP == 8) { PH_GATHER(true); SYNC(); } \
        PH_GATHER(false); SYNC(); \
    }
    LAYER_BODY(0)
    LAYER_BODY(1)
}

extern "C" void kernel_launch(void* const* d_in, const int* in_sizes, int n_in, void* d_out, int out_size, void* d_ws, size_t ws_size, hipStream_t stream) {
    static int grid_blocks = 0;
    if (grid_blocks == 0) {
        if (ws_size < WS_END || n_in != 22) { fprintf(stderr, "kernel_launch: workspace %zu < %zu or n_in %d != 22\n", ws_size, (size_t)WS_END, n_in); grid_blocks = -1; return; }
        int dev = 0, cus = 0, per_cu = 0;
        (void)hipGetDevice(&dev); (void)hipDeviceGetAttribute(&cus, hipDeviceAttributeMultiprocessorCount, dev);
        if (hipFuncSetAttribute((const void*)mega_fwd, hipFuncAttributeMaxDynamicSharedMemorySize, LDS_BYTES) != hipSuccess) { fprintf(stderr, "kernel_launch: hipFuncSetAttribute failed\n"); grid_blocks = -1; return; }
        if (hipOccupancyMaxActiveBlocksPerMultiprocessor(&per_cu, (const void*)mega_fwd, NTHREADS, LDS_BYTES) != hipSuccess || per_cu < 1) { fprintf(stderr, "kernel_launch: occupancy query says %d\n", per_cu); per_cu = 1; }
        (void)hipGetLastError();
        grid_blocks = cus * 1;
        fprintf(stderr, "kernel_launch: %d CUs, occupancy query %d per CU, grid %d\n", cus, per_cu, grid_blocks);
    }
    if (grid_blocks < 0) return;
    (void)hipMemsetAsync((char*)d_ws + WS_CTL, 0, CTL_BYTES, stream);
    Params p{};
    p.x = (const float*)d_in[0]; p.c = (const float*)d_in[1]; p.ctx = (const float*)d_in[2]; p.c_ctx = (const float*)d_in[3]; p.ada_w = (const float*)d_in[4]; p.ada_b = (const float*)d_in[5];
    p.norm1_g = (const float*)d_in[6]; p.norm2_g = (const float*)d_in[7]; p.w_in = (const float*)d_in[8]; p.pool_w = (const float*)d_in[9]; p.pool_scale = (const float*)d_in[10]; p.na_rpb = (const float*)d_in[11];
    p.swa_sink = (const float*)d_in[12]; p.wba = (const float*)d_in[13]; p.wbb = (const float*)d_in[14]; p.wbc = (const float*)d_in[15]; p.w_out = (const float*)d_in[16]; p.peer_wq = (const float*)d_in[17];
    p.peer_keys = (const float*)d_in[18]; p.peer_u = (const float*)d_in[19]; p.peer_v = (const float*)d_in[20]; p.final_g = (const float*)d_in[21];
    p.out = (float*)d_out; p.ws = (unsigned char*)d_ws;
    void* args[] = {&p};
    const hipError_t e = hipLaunchCooperativeKernel((const void*)mega_fwd, dim3(grid_blocks), dim3(NTHREADS), args, LDS_BYTES, stream);
    if (e != hipSuccess) fprintf(stderr, "kernel_launch: cooperative launch failed: %s (grid %d)\n", hipGetErrorString(e), grid_blocks);
}
```

```cpp
#include <hip/hip_runtime.h>
#include <hip/hip_cooperative_groups.h>
#include <stdint.h>
#include <stdio.h>
namespace cg = cooperative_groups;

typedef unsigned short bf16_t;

constexpr int D = 1024, NB = 4, S = 4096, L = 256, GW = 64;
constexpr int T_LAT = NB * S, T_CTX = NB * L, T_ALL = T_LAT + T_CTX;
constexpr int IN_COLS = 5888;
constexpr int OFF_KN = 0, OFF_VN = 512, OFF_KW = 1024, OFF_VW = 1152, CTX_KV_COLS = 1280, OFF_QN = 1280, OFF_QW = 1792, OFF_A = 2304, OFF_G = 2816;
constexpr int NEXP = 16384;
constexpr float EPS = 1e-6f;
#ifndef FP8_L0
#define FP8_L0 1
#endif
#ifndef RING_U
#define RING_U 1
#endif
#ifndef RING_V
#define RING_V 1
#endif
constexpr int NTHREADS = 512;
constexpr int LDS_BYTES = 147456;

constexpr size_t al256(size_t x) { return (x + 255) & ~(size_t)255; }
constexpr size_t WS_CTL = 0, CTL_BYTES = 16384;
constexpr size_t WS_MOD = WS_CTL + CTL_BYTES;
constexpr size_t WS_ROPE = al256(WS_MOD + 2 * 5 * 6144 * 4);
constexpr size_t WS_XC = al256(WS_ROPE + 2 * 64 * 16 * 4);
constexpr size_t WS_H = al256(WS_XC + (size_t)T_CTX * D * 4);
constexpr size_t WS_Z = al256(WS_H + (size_t)T_ALL * D * 2);
constexpr size_t WS_VTN = al256(WS_Z + (size_t)T_ALL * IN_COLS * 2);
constexpr size_t WS_VTNC = al256(WS_VTN + (size_t)NB * 8 * 64 * S * 2);
constexpr size_t WS_VTW = al256(WS_VTNC + (size_t)NB * 8 * 64 * L * 2);
constexpr size_t WS_VTWC = al256(WS_VTW + (size_t)NB * 2 * 64 * S * 2);
constexpr size_t WS_AT = al256(WS_VTWC + (size_t)NB * 2 * 64 * L * 2);
constexpr size_t WS_EIDX = al256(WS_AT + (size_t)3 * T_ALL * 512 * 2);
constexpr size_t WS_EGATE = al256(WS_EIDX + (size_t)T_ALL * 128 * 4);
constexpr size_t WS_W = al256(WS_EGATE + (size_t)T_ALL * 128 * 4);
constexpr size_t W_WIN = 0;
constexpr size_t W_WA = W_WIN + (size_t)IN_COLS * D * 2;
constexpr size_t W_WB = W_WA + (size_t)D * 512 * 2;
constexpr size_t W_WC = W_WB + (size_t)D * 512 * 2;
constexpr size_t W_WO = W_WC + (size_t)D * 512 * 2;
constexpr size_t W_WQ = W_WO + (size_t)D * D * 2;
constexpr size_t W_KEYS = W_WQ + (size_t)2048 * D * 2;
constexpr size_t W_LAYER = al256(W_KEYS + (size_t)8 * 2 * 128 * 128 * 2);
constexpr size_t WS_H8 = al256(WS_W + 2 * W_LAYER);
constexpr size_t WS_TAB0 = al256(WS_H8 + (size_t)2 * T_ALL * D);
constexpr size_t WS_TAB1 = al256(WS_TAB0 + (size_t)2 * NEXP * D * 2);
constexpr size_t WS_END = WS_TAB1 + (size_t)2 * NEXP * D + (size_t)2 * NEXP * 4;

__device__ __forceinline__ float bf2f(bf16_t v) { return __uint_as_float((unsigned)v << 16); }
__device__ __forceinline__ bf16_t f2bf(float f) { unsigned u = __float_as_uint(f); u += 0x7fffu + ((u >> 16) & 1u); return (bf16_t)(u >> 16); }
__device__ __forceinline__ unsigned pk2(float lo, float hi) { return (unsigned)f2bf(lo) | ((unsigned)f2bf(hi) << 16); }
__device__ __forceinline__ float lo16(unsigned w) { return __uint_as_float(w << 16); }
__device__ __forceinline__ float hi16(unsigned w) { return __uint_as_float(w & 0xffff0000u); }

__device__ __forceinline__ int lane_id() { int l; asm volatile("v_mbcnt_lo_u32_b32 %0, -1, 0\n\tv_mbcnt_hi_u32_b32 %0, -1, %0" : "=&v"(l)); return l; }
__device__ __forceinline__ int opaque_tid(int wv) { int t = (wv << 6) | lane_id(); asm volatile("" : "+v"(t)); return t; }
namespace pg8 {
#define PG8_LAS __attribute__((address_space(3)))
typedef unsigned short bf16_t;
typedef short bf16x8 __attribute__((ext_vector_type(8)));
typedef float f32x4 __attribute__((ext_vector_type(4)));
typedef unsigned u32x4 __attribute__((ext_vector_type(4)));
constexpr int BM = 256, BK = 64, HALF = 128, HTB = HALF * BK * 2  , STAGE_BYTES = 8 * HTB, NXCD = 8, WGM = 8;

__host__ __device__ __forceinline__ int lds_byte(int r, int c) { const int st = (r >> 4) * 2 + (c >> 5), rr = r & 15, cc = c & 31, ob = rr * 64 + cc * 2; return st * 1024 + (ob ^ (((ob >> 9) & 1) << 5)); }
__host__ __device__ __forceinline__ void stage_rc(int b, int& R, int& C) { const int st = b / 1024, sb = b % 1024, swz = sb ^ (((sb >> 9) & 1) << 5); R = (st >> 1) * 16 + swz / 64; C = (st & 1) * 32 + (swz % 64) / 2; }
__host__ __device__ __forceinline__ int perm32(int rho) { const int n = rho >> 4, i = rho & 15; return 8 * (i >> 2) + 4 * n + (i & 3); }

struct Unit { int pm, pn; };
struct Gemm { const bf16_t* A; const bf16_t* Bt; int M, N, K; };

struct StaticOrder {
    int nM, nN, nwg, G, c;
    __host__ __device__ void init(int M, int N, int G_, int c_) { nM = M / BM; nN = N / BM; nwg = nM * nN; G = G_; c = c_; }
    __host__ __device__ bool next(int i, Unit& u) const {
        const long L = (long)i * G + c; if (L >= nwg) return false;
        int wgid = (int)L; { const int q = nwg / NXCD, r = nwg % NXCD, xcd = wgid % NXCD, off = wgid / NXCD; wgid = (xcd < r ? xcd * (q + 1) : r * (q + 1) + (xcd - r) * q) + off; }
        const int nig = WGM * nN, gid = wgid / nig, fm = gid * WGM, gsz = (nM - fm) < WGM ? (nM - fm) : WGM;
        u.pm = fm + ((wgid % nig) % gsz); u.pn = (wgid % nig) / gsz; return true;
    }
    __device__ __forceinline__ void a_ready(const Unit&) const {}
    __device__ __forceinline__ void done(const Unit&) const {}
};
__device__ __forceinline__ unsigned cvt_pk_bf16(float lo, float hi) { unsigned r; asm volatile("v_cvt_pk_bf16_f32 %0, %1, %2" : "=v"(r) : "v"(lo), "v"(hi)); return r; }
typedef unsigned u32x4 __attribute__((ext_vector_type(4)));
struct EpiStoreBf16 {
    static constexpr bool PERM = true, AFTER_DRAIN = false;
    bf16_t* O; int ldc; int pad;
    __device__ __forceinline__ void operator()(const f32x4 (&acc)[2][2][4][2], const Unit& u, int wr, int wc, int fr, int fq) const {
        const int row0 = u.pm * BM + wr * 64 + fr, col0 = u.pn * BM + wc * 32 + 8 * fq;
#pragma unroll
        for (int ai = 0; ai < 2; ++ai)
#pragma unroll
            for (int m = 0; m < 4; ++m) { bf16_t* rowp = O + (size_t)(row0 + ai * HALF + m * 16) * ldc + col0;
#pragma unroll
                for (int bj = 0; bj < 2; ++bj) { const f32x4 v0 = acc[ai][bj][m][0], v1 = acc[ai][bj][m][1];
                    u32x4 w; w.x = cvt_pk_bf16(v0[0], v0[1]); w.y = cvt_pk_bf16(v0[2], v0[3]); w.z = cvt_pk_bf16(v1[0], v1[1]); w.w = cvt_pk_bf16(v1[2], v1[3]);
                    *(u32x4*)(rowp + bj * HALF) = w; } }
    }
};

struct EpiZ {
    static constexpr bool PERM = true, AFTER_DRAIN = false;
    bf16_t* Z; const float* rope; bf16_t *vtn, *vtnc, *vtw, *vtwc; int row_base; int pad;
    __device__ __forceinline__ void operator()(const f32x4 (&acc)[2][2][4][2], const Unit& u, int wr, int wc, int fr, int fq) const {
        const int grow0 = row_base + u.pm * BM;
        const bool lat = grow0 < 16384;
        const int b = lat ? (grow0 >> 12) : ((grow0 - 16384) >> 8), len = lat ? 4096 : 256;
        const int tpos0 = (lat ? (grow0 & 4095) : ((grow0 - 16384) & 255)) + wr * 64 + fr;
#pragma unroll
        for (int bj = 0; bj < 2; ++bj) {
            const int cb = 2 * u.pn + bj;
            const int col0 = cb * 128 + wc * 32 + 8 * fq;
            if ((cb >= 4 && cb < 8) || cb == 9) {
                const int cl = wc * 32 + 8 * fq;
                bf16_t* dst;
                if (cb == 9) dst = (lat ? vtw : vtwc) + ((size_t)(b * 2 + (cl >> 6)) * 64 + (cl & 63)) * len + tpos0;
                else dst = (lat ? vtn : vtnc) + ((size_t)(b * 8 + (cb - 4) * 2 + (cl >> 6)) * 64 + (cl & 63)) * len + tpos0;
#pragma unroll
                for (int ai = 0; ai < 2; ++ai)
#pragma unroll
                    for (int m = 0; m < 4; ++m) { bf16_t* dp = dst + ai * HALF + m * 16;
#pragma unroll
                        for (int n = 0; n < 2; ++n)
#pragma unroll
                            for (int i = 0; i < 4; ++i) { const unsigned w = cvt_pk_bf16(acc[ai][bj][m][n][i], 0.f); dp[(size_t)(4 * n + i) * len] = (bf16_t)(w & 0xffffu); } }
            } else {
                const bool is_rope = lat && (cb == 8 || (cb >= 14 && cb < 18));
                const bool is_gate = cb >= 22;
#pragma unroll
                for (int ai = 0; ai < 2; ++ai)
#pragma unroll
                    for (int m = 0; m < 4; ++m) {
                        f32x4 v0 = acc[ai][bj][m][0], v1 = acc[ai][bj][m][1];
                        if (is_gate) {
#pragma unroll
                            for (int i = 0; i < 4; ++i) { v0[i] = __builtin_amdgcn_rcpf(1.f + __builtin_amdgcn_exp2f(-1.4426950408889634f * v0[i])); v1[i] = __builtin_amdgcn_rcpf(1.f + __builtin_amdgcn_exp2f(-1.4426950408889634f * v1[i])); }
                        } else if (is_rope) {
                            const int tp = tpos0 + ai * HALF + m * 16;
                            const int pos = (wc & 1) ? (tp & 63) : (tp >> 6);
                            const float* tb = rope + pos * 16 + 8 * (fq & 1);
                            const f32x4 c0 = *(const f32x4*)tb, c1 = *(const f32x4*)(tb + 4), s0 = *(const f32x4*)(tb + 1024), s1 = *(const f32x4*)(tb + 1028);
                            f32x4 p0, p1;
#pragma unroll
                            for (int i = 0; i < 4; ++i) { p0[i] = __shfl_xor(v0[i], 32); p1[i] = __shfl_xor(v1[i], 32); }
                            if (fq < 2) { v0 = v0 * c0 - p0 * s0; v1 = v1 * c1 - p1 * s1; }
                            else { v0 = p0 * s0 + v0 * c0; v1 = p1 * s1 + v1 * c1; }
                        }
                        u32x4 w; w.x = cvt_pk_bf16(v0[0], v0[1]); w.y = cvt_pk_bf16(v0[2], v0[3]); w.z = cvt_pk_bf16(v1[0], v1[1]); w.w = cvt_pk_bf16(v1[2], v1[3]);
                        *(u32x4*)(Z + (size_t)(grow0 + ai * HALF + wr * 64 + m * 16 + fr) * 5888 + col0) = w;
                    }
            }
        }
    }
};
constexpr int NTM_STACK = 68;
struct EpiMergeSeg {
    static constexpr bool PERM = true, AFTER_DRAIN = false;
    const bf16_t* Z; bf16_t* M;
    __device__ __forceinline__ void operator()(const f32x4 (&acc)[2][2][4][2], const Unit& u, int wr, int wc, int fr, int fq) const {
        const int seg = u.pn >> 2, tn = u.pn & 3, tm = u.pm - seg * NTM_STACK;
        const int row0 = tm * BM + wr * 64 + fr, col0 = tn * BM + wc * 32 + 8 * fq;
#pragma unroll
        for (int ai = 0; ai < 2; ++ai)
#pragma unroll
            for (int m = 0; m < 4; ++m) { const int row = row0 + ai * HALF + m * 16;
#pragma unroll
                for (int bj = 0; bj < 2; ++bj) { const int col = col0 + bj * HALF;
                    const u32x4 g = *(const u32x4*)(Z + (size_t)row * 5888 + 2816 + seg * 1024 + col);
                    bf16_t* mp = M + (size_t)row * 1024 + col;
                    u32x4 o = (u32x4){0u, 0u, 0u, 0u}; if (seg) o = *(const u32x4*)mp;
                    const f32x4 v0 = acc[ai][bj][m][0], v1 = acc[ai][bj][m][1];
                    u32x4 w;
                    w.x = cvt_pk_bf16(__uint_as_float(g.x << 16) * v0[0] + __uint_as_float(o.x << 16), __uint_as_float(g.x & 0xffff0000u) * v0[1] + __uint_as_float(o.x & 0xffff0000u));
                    w.y = cvt_pk_bf16(__uint_as_float(g.y << 16) * v0[2] + __uint_as_float(o.y << 16), __uint_as_float(g.y & 0xffff0000u) * v0[3] + __uint_as_float(o.y & 0xffff0000u));
                    w.z = cvt_pk_bf16(__uint_as_float(g.z << 16) * v1[0] + __uint_as_float(o.z << 16), __uint_as_float(g.z & 0xffff0000u) * v1[1] + __uint_as_float(o.z & 0xffff0000u));
                    w.w = cvt_pk_bf16(__uint_as_float(g.w << 16) * v1[2] + __uint_as_float(o.w << 16), __uint_as_float(g.w & 0xffff0000u) * v1[3] + __uint_as_float(o.w & 0xffff0000u));
                    *(u32x4*)mp = w; } }
    }
};
struct MergeOrder {
    int ntiles, G, c, pad;
    __device__ bool next(int i, Unit& u) const { const int ti = (i / 3) * G + c, seg = i % 3; if (ti >= ntiles) return false; u.pm = seg * NTM_STACK + (ti >> 2); u.pn = seg * 4 + (ti & 3); return true; }
    __device__ __forceinline__ void a_ready(const Unit&) const {}
    __device__ __forceinline__ void done(const Unit&) const {}
};
struct EpiResid {
    static constexpr bool PERM = false, AFTER_DRAIN = false;
    const float* Sl; const float* Sc; float* Xl; float* Xc; const float* modl; int gate_idx; int pad;
    __device__ __forceinline__ void operator()(const f32x4 (&acc)[2][2][4][2], const Unit& u, int wr, int wc, int fr, int fq) const {
        const int mrow = u.pm < 64 ? (u.pm >> 4) : 4;
        const size_t boff = u.pm < 64 ? (size_t)u.pm * BM * 1024 : (size_t)(u.pm - 64) * BM * 1024;
        const float* sbase = (u.pm < 64 ? Sl : Sc) + boff; float* dbase = (u.pm < 64 ? Xl : Xc) + boff;
        const float* gt = modl + (size_t)mrow * 6144 + gate_idx * 1024;
        const int col0 = u.pn * BM + wc * 32 + 4 * fq;
#pragma unroll
        for (int bj = 0; bj < 2; ++bj)
#pragma unroll
            for (int n = 0; n < 2; ++n) { const int col = col0 + bj * HALF + 16 * n; const f32x4 gv = *(const f32x4*)(gt + col);
#pragma unroll
                for (int ai = 0; ai < 2; ++ai)
#pragma unroll
                    for (int m = 0; m < 4; ++m) { const size_t o = (size_t)(ai * HALF + wr * 64 + m * 16 + fr) * 1024 + col;
                        f32x4 x = *(const f32x4*)(sbase + o); x = x + gv * acc[ai][bj][m][n]; *(f32x4*)(dbase + o) = x; } }
    }
};
struct ZLastOrder {
    StaticOrder S0; int G, c;
    __device__ bool next(int i, Unit& u) const {
        const long L = (long)i * G + c;
        if (L < S0.nwg) return S0.next(i, u);
        const int e = (int)(L - S0.nwg); if (e >= 20) return false;
        u.pm = 64 + e / 5; u.pn = e % 5; return true;
    }
    __device__ __forceinline__ void a_ready(const Unit&) const {}
    __device__ __forceinline__ void done(const Unit&) const {}
};
template <class Epi, class Sched, bool ALIGN_EPI = false, bool SP2 = false>
__device__ __forceinline__ void gemm_phase(PG8_LAS unsigned char* lds, const Gemm g, const Sched& S, const Epi& E, const int WV) {
    const int tid = opaque_tid(WV), wid = __builtin_amdgcn_readfirstlane(tid >> 6), lane = tid & 63, wr = wid >> 2, wc = wid & 3, fr = lane & 15, fq = lane >> 4;
    const int K = g.K, nt = K / BK;
    unsigned voffA[2], voffB[2];
#pragma unroll
    for (int i = 0; i < 2; ++i) { int R, C; stage_rc(tid * 16 + i * 8192, R, C); const int Rb = Epi::PERM ? ((R & ~31) + perm32(R & 31)) : R;
        voffA[i] = (unsigned)(R * K + C) * 2u; voffB[i] = (unsigned)(Rb * K + C) * 2u; }
    const size_t kstep = (size_t)(BK * 2);
    const size_t hstep = (size_t)HALF * K * 2;
    const size_t tstep = 2 * hstep;
    const unsigned ldsw = (unsigned)wid * 1024u;
    const int aoff = lds_byte(wr * 64 + fr, fq * 8), boff = lds_byte(wc * 32 + fr, fq * 8);
#define PG8_SA(b, h) (((b) * 2 + (h)) * HTB)
#define PG8_SB(b, h) ((4 + (b) * 2 + (h)) * HTB)
#define PG8_STAGE(bufoff, gbase, voff) do { _Pragma("unroll") for (int _i = 0; _i < 2; ++_i) \
        __builtin_amdgcn_global_load_lds((const unsigned*)((const char*)(gbase) + (voff)[_i]), (PG8_LAS unsigned*)(lds + (bufoff) + ldsw + _i * 8192), 16, 0, 0); } while (0)
#define PG8_LDA(dst, b, h) do { _Pragma("unroll") for (int m = 0; m < 4; ++m) _Pragma("unroll") for (int k = 0; k < 2; ++k) dst[m][k] = *(const PG8_LAS bf16x8*)(lds + PG8_SA(b, h) + aoff + m * 2048 + k * 1024); } while (0)
#define PG8_LDB(dst, b, h) do { _Pragma("unroll") for (int n = 0; n < 2; ++n) _Pragma("unroll") for (int k = 0; k < 2; ++k) dst[n][k] = *(const PG8_LAS bf16x8*)(lds + PG8_SB(b, h) + boff + n * 2048 + k * 1024); } while (0)
#define PG8_MMA(ai, bj, At, Bt) do { __builtin_amdgcn_s_setprio(1); _Pragma("unroll") for (int m = 0; m < 4; ++m) _Pragma("unroll") for (int n = 0; n < 2; ++n) _Pragma("unroll") for (int k = 0; k < 2; ++k) \
        acc[ai][bj][m][n] = __builtin_amdgcn_mfma_f32_16x16x32_bf16(Bt[n][k], At[m][k], acc[ai][bj][m][n], 0, 0, 0); __builtin_amdgcn_s_setprio(0); } while (0)
#define PG8_WAIT_V(n) asm volatile("s_waitcnt vmcnt(" #n ")" ::: "memory")
#define PG8_WAIT_L(n) asm volatile("s_waitcnt lgkmcnt(" #n ")" ::: "memory")
#define PG8_BAR __builtin_amdgcn_s_barrier()
#define PG8_SCHED __builtin_amdgcn_sched_barrier(0)
    Unit cur, nxt; int ui = 0;
    if (!S.next(0, cur)) return;
    f32x4 acc[2][2][4][2];
#pragma unroll
    for (int a = 0; a < 2; ++a)
#pragma unroll
        for (int b = 0; b < 2; ++b)
#pragma unroll
            for (int m = 0; m < 4; ++m)
#pragma unroll
                for (int n = 0; n < 2; ++n) acc[a][b][m][n] = (f32x4){0.f, 0.f, 0.f, 0.f};
    bf16x8 At[4][2], B0[2][2], B1[2][2];
    const char* cA = (const char*)g.A + (size_t)cur.pm * tstep; const char* cB = (const char*)g.Bt + (size_t)cur.pn * tstep;
    S.a_ready(cur);
    if constexpr (SP2) {
        PG8_STAGE(PG8_SB(0, 0), cB, voffB); PG8_STAGE(PG8_SB(0, 1), cB + hstep, voffB); PG8_STAGE(PG8_SA(0, 0), cA, voffA); PG8_STAGE(PG8_SA(0, 1), cA + hstep, voffA);
        if (wr == 1) PG8_BAR;
        PG8_WAIT_V(2); PG8_BAR;
        PG8_STAGE(PG8_SB(1, 0), cB + kstep, voffB); PG8_STAGE(PG8_SA(1, 0), cA + kstep, voffA); PG8_STAGE(PG8_SB(1, 1), cB + hstep + kstep, voffB);
        PG8_WAIT_V(6); PG8_BAR;
    } else {
        PG8_STAGE(PG8_SB(0, 0), cB, voffB); PG8_STAGE(PG8_SA(0, 0), cA, voffA); PG8_STAGE(PG8_SB(0, 1), cB + hstep, voffB); PG8_STAGE(PG8_SA(0, 1), cA + hstep, voffA);
        if (wr == 1) PG8_BAR;
        PG8_WAIT_V(4); PG8_BAR;
        PG8_STAGE(PG8_SB(1, 0), cB + kstep, voffB); PG8_STAGE(PG8_SA(1, 0), cA + kstep, voffA); PG8_STAGE(PG8_SB(1, 1), cB + hstep + kstep, voffB);
        PG8_WAIT_V(6); PG8_BAR;
    }
    for (;;) {
        const bool has_next = S.next(ui + 1, nxt);
        const char* nA = has_next ? (const char*)g.A + (size_t)nxt.pm * tstep : cA; const char* nB = has_next ? (const char*)g.Bt + (size_t)nxt.pn * tstep : cB;
        for (int t = 0; t < nt; t += 2) {
            const bool last = (t == nt - 2);
            const char* a1 = cA + (size_t)(t + 1) * kstep;
            const char* a2 = last ? nA : cA + (size_t)(t + 2) * kstep; const char* b2 = last ? nB : cB + (size_t)(t + 2) * kstep;
            const char* a3 = a2 + kstep; const char* b3 = b2 + kstep;
            if (last && has_next) S.a_ready(nxt);
            if constexpr (SP2) {
            PG8_LDB(B0, 0, 0); PG8_LDB(B1, 0, 1); PG8_SCHED; PG8_LDA(At, 0, 0); PG8_STAGE(PG8_SA(1, 1), a1 + hstep, voffA);
            PG8_WAIT_V(8); PG8_WAIT_L(0); PG8_BAR; PG8_MMA(0, 0, At, B0); PG8_MMA(0, 1, At, B1); PG8_BAR; PG8_SCHED;
            PG8_LDA(At, 0, 1); PG8_STAGE(PG8_SB(0, 0), b2, voffB); PG8_STAGE(PG8_SB(0, 1), b2 + hstep, voffB); PG8_STAGE(PG8_SA(0, 0), a2, voffA);
            PG8_WAIT_V(8); PG8_WAIT_L(0); PG8_BAR; PG8_MMA(1, 0, At, B0); PG8_MMA(1, 1, At, B1); PG8_BAR; PG8_SCHED;
            PG8_LDB(B0, 1, 0); PG8_LDB(B1, 1, 1); PG8_SCHED; PG8_LDA(At, 1, 0); PG8_STAGE(PG8_SA(0, 1), a2 + hstep, voffA);
            PG8_WAIT_V(8); PG8_WAIT_L(0); PG8_BAR; PG8_MMA(0, 0, At, B0); PG8_MMA(0, 1, At, B1); PG8_BAR; PG8_SCHED;
            PG8_LDA(At, 1, 1); PG8_STAGE(PG8_SB(1, 0), b3, voffB); PG8_STAGE(PG8_SB(1, 1), b3 + hstep, voffB); PG8_STAGE(PG8_SA(1, 0), a3, voffA);
            PG8_WAIT_V(8); PG8_WAIT_L(0); PG8_BAR; PG8_MMA(1, 0, At, B0); PG8_MMA(1, 1, At, B1); PG8_BAR; PG8_SCHED;
            } else {
            PG8_LDB(B0, 0, 0); PG8_SCHED; PG8_LDA(At, 0, 0); PG8_STAGE(PG8_SA(1, 1), a1 + hstep, voffA);
            PG8_WAIT_L(8); PG8_BAR; PG8_WAIT_L(0); PG8_MMA(0, 0, At, B0); PG8_BAR; PG8_SCHED;
            PG8_LDB(B1, 0, 1); PG8_STAGE(PG8_SB(0, 0), b2, voffB);
            PG8_BAR; PG8_WAIT_L(0); PG8_MMA(0, 1, At, B1); PG8_BAR;
            PG8_LDA(At, 0, 1); PG8_STAGE(PG8_SA(0, 0), a2, voffA);
            PG8_BAR; PG8_WAIT_L(0); PG8_MMA(1, 0, At, B0); PG8_BAR; PG8_SCHED;
            PG8_STAGE(PG8_SB(0, 1), b2 + hstep, voffB);
            PG8_WAIT_V(6); PG8_BAR; PG8_MMA(1, 1, At, B1); PG8_BAR;
            PG8_LDB(B0, 1, 0); PG8_SCHED; PG8_LDA(At, 1, 0); PG8_STAGE(PG8_SA(0, 1), a2 + hstep, voffA);
            PG8_WAIT_L(8); PG8_BAR; PG8_WAIT_L(0); PG8_MMA(0, 0, At, B0); PG8_BAR; PG8_SCHED;
            PG8_LDB(B1, 1, 1); PG8_STAGE(PG8_SB(1, 0), b3, voffB);
            PG8_BAR; PG8_WAIT_L(0); PG8_MMA(0, 1, At, B1); PG8_BAR;
            PG8_LDA(At, 1, 1); PG8_STAGE(PG8_SA(1, 0), a3, voffA);
            PG8_BAR; PG8_WAIT_L(0); PG8_MMA(1, 0, At, B0); PG8_BAR; PG8_SCHED;
            PG8_STAGE(PG8_SB(1, 1), b3 + hstep, voffB);
            PG8_WAIT_V(6); PG8_BAR; PG8_MMA(1, 1, At, B1); PG8_BAR;
            }
        }
        if constexpr (ALIGN_EPI) { if (wr == 0) PG8_BAR; }
        if constexpr (!Epi::AFTER_DRAIN) { E(acc, cur, wr, wc, fr, fq); S.done(cur); }
        if (!has_next) break;
#pragma unroll
        for (int a = 0; a < 2; ++a)
#pragma unroll
            for (int b = 0; b < 2; ++b)
#pragma unroll
                for (int m = 0; m < 4; ++m)
#pragma unroll
                    for (int n = 0; n < 2; ++n) acc[a][b][m][n] = (f32x4){0.f, 0.f, 0.f, 0.f};
        cur = nxt; cA = nA; cB = nB; ++ui;
        if constexpr (ALIGN_EPI) { if (wr == 1) PG8_BAR; }
    }
    PG8_WAIT_V(0);
    if constexpr (!ALIGN_EPI) { if (wr == 0) PG8_BAR; }
    PG8_BAR;
    if constexpr (Epi::AFTER_DRAIN) { E.fused(acc, cur, wr, wc, fr, fq, lds, wid, lane); S.done(cur); }
#undef PG8_SA
#undef PG8_SB
#undef PG8_STAGE
#undef PG8_LDA
#undef PG8_LDB
#undef PG8_MMA
#undef PG8_WAIT_V
#undef PG8_WAIT_L
#undef PG8_BAR
#undef PG8_SCHED
}
}

struct Params {
    const float *x, *c, *ctx, *c_ctx, *ada_w, *ada_b, *norm1_g, *norm2_g, *w_in, *pool_w, *pool_scale, *na_rpb, *swa_sink, *wba, *wbb, *wbc, *w_out, *peer_wq, *peer_keys, *peer_u, *peer_v, *final_g;
    float* out; unsigned char* ws;
};
#define TID (opaque_tid(WV))
#define BID ((int)blockIdx.x)
#define NBLK ((int)gridDim.x)

__device__ __forceinline__ void tr_tiles(const float* __restrict__ W, bf16_t* __restrict__ Wt, int K, int N, float* tile  , const int WV) {
    const int ntn = N / 64, ntiles = (K / 128) * ntn, tid = TID;
    for (int vb = BID; vb < ntiles; vb += NBLK) {
        const int k0 = (vb / ntn) * 128, n0 = (vb % ntn) * 64;
        float4 v[4];
#pragma unroll
        for (int i = 0; i < 4; ++i) { const int idx = tid + i * NTHREADS, r = idx >> 4, c4 = (idx & 15) * 4; v[i] = *(const float4*)(W + (size_t)(k0 + r) * N + n0 + c4); }
#pragma unroll
        for (int i = 0; i < 4; ++i) { const int idx = tid + i * NTHREADS, r = idx >> 4, c4 = (idx & 15) * 4; float* tp = tile + r * 65 + c4; tp[0] = v[i].x; tp[1] = v[i].y; tp[2] = v[i].z; tp[3] = v[i].w; }
        __syncthreads();
#pragma unroll
        for (int i = 0; i < 2; ++i) { const int idx = tid + i * NTHREADS, nn = idx >> 4, kg = (idx & 15) * 8; const float* tp = tile + kg * 65 + nn;
            uint4 o; o.x = pk2(tp[0], tp[65]); o.y = pk2(tp[130], tp[195]); o.z = pk2(tp[260], tp[325]); o.w = pk2(tp[390], tp[455]);
            *(uint4*)(Wt + (size_t)(n0 + nn) * K + k0 + kg) = o; }
        __syncthreads();
    }
}
__device__ __forceinline__ void conv_bf16(const float* __restrict__ src, bf16_t* __restrict__ dst, size_t n8, const int WV) {
    for (size_t i = (size_t)BID * NTHREADS + TID; i < n8; i += (size_t)NBLK * NTHREADS) {
        const float4 a = ((const float4*)src)[2 * i], b = ((const float4*)src)[2 * i + 1];
        uint4 o; o.x = pk2(a.x, a.y); o.y = pk2(a.z, a.w); o.z = pk2(b.x, b.y); o.w = pk2(b.z, b.w);
        ((uint4*)dst)[i] = o;
    }
}
__device__ __forceinline__ void conv_fp8_rows(const float* __restrict__ src, unsigned* __restrict__ dst, float* __restrict__ inv, int nrows, const int WV, int vblk = -1, int nvblk = 0) {
    const int tid = TID, lane = tid & 63;
    const int gw = (vblk >= 0 ? vblk : BID) * 8 + (tid >> 6), gstride = (vblk >= 0 ? nvblk : NBLK) * 8;
    for (int row = gw; row < nrows; row += gstride) {
        const float4* sp = (const float4*)(src + (size_t)row * D);
        float4 v[4]; float amax = 0.f;
#pragma unroll
        for (int i = 0; i < 4; ++i) { v[i] = sp[i * 64 + lane]; amax = fmaxf(amax, fmaxf(fmaxf(fabsf(v[i].x), fabsf(v[i].y)), fmaxf(fabsf(v[i].z), fabsf(v[i].w)))); }
#pragma unroll
        for (int o = 32; o > 0; o >>= 1) amax = fmaxf(amax, __shfl_xor(amax, o));
        const int k = (int)((__float_as_uint(amax) >> 23) & 255u) - 127;
        const bool ok = amax > 1e-30f;
        const float s = ok ? __uint_as_float((unsigned)(127 + 7 - k) << 23) : 1.f;
#pragma unroll
        for (int i = 0; i < 4; ++i) { int w = __builtin_amdgcn_cvt_pk_fp8_f32(v[i].x * s, v[i].y * s, 0, false); w = __builtin_amdgcn_cvt_pk_fp8_f32(v[i].z * s, v[i].w * s, w, true);
            dst[(size_t)row * 256 + i * 64 + lane] = (unsigned)w; }
        if (lane == 0) inv[row] = ok ? __uint_as_float((unsigned)(127 - 7 + k) << 23) : 1.f;
    }
}
__device__ __forceinline__ void copy_f4(const float* __restrict__ src, float* __restrict__ dst, size_t n4, const int WV) {
    for (size_t i = (size_t)BID * NTHREADS + TID; i < n4; i += (size_t)NBLK * NTHREADS) ((float4*)dst)[i] = ((const float4*)src)[i];
}
__device__ __forceinline__ void ph_prep(const Params& p, float* smem, const int WV) {
    unsigned char* ws = p.ws;
    for (int l = 0; l < 2; ++l) {
        unsigned char* wl = ws + WS_W + l * W_LAYER;
        tr_tiles(p.w_in + (size_t)l * D * IN_COLS, (bf16_t*)(wl + W_WIN), D, IN_COLS, smem, WV);
        tr_tiles(p.wbb + (size_t)l * 512 * D, (bf16_t*)(wl + W_WB), 512, D, smem, WV);
        tr_tiles(p.wbc + (size_t)l * 512 * D, (bf16_t*)(wl + W_WC), 512, D, smem, WV);
        tr_tiles(p.w_out + (size_t)l * D * D, (bf16_t*)(wl + W_WO), D, D, smem, WV);
        tr_tiles(p.peer_wq + (size_t)l * D * 2048, (bf16_t*)(wl + W_WQ), D, 2048, smem, WV);
        {
            const float* pw = p.pool_w + (size_t)l * 4 * 128 * 128; const float* ps = p.pool_scale + l * 512; const float* wba = p.wba + (size_t)l * 512 * D; bf16_t* WaT = (bf16_t*)(wl + W_WA);
            for (int idx = BID * NTHREADS + TID; idx < 512 * D; idx += NBLK * NTHREADS) {
                const int n = idx % D, kk = idx / D, g = kk / 128, c = kk % 128;
                float acc = 0.f;
                for (int e = 0; e < 128; ++e) acc += pw[(g * 128 + c) * 128 + e] * ps[g * 128 + e] * wba[(size_t)(g * 128 + e) * D + n];
                WaT[(size_t)n * 512 + kk] = f2bf(acc);
            }
        }
        conv_bf16(p.peer_keys + (size_t)l * 8 * 2 * 128 * 128, (bf16_t*)(wl + W_KEYS), (size_t)8 * 2 * 128 * 128 / 8, WV);
        if (l == 0 && !FP8_L0) {
            conv_bf16(p.peer_u, (bf16_t*)(ws + WS_TAB0), (size_t)NEXP * D / 8, WV);
            conv_bf16(p.peer_v, (bf16_t*)(ws + WS_TAB0) + (size_t)NEXP * D, (size_t)NEXP * D / 8, WV);
        }
    }
    {
        float* sv = smem; float* part = smem + 5 * 1024; float* mod = (float*)(ws + WS_MOD);
        const int tid = TID, lane = tid & 63, wid = tid >> 6;
        for (int vb = BID; vb < 2 * 96; vb += NBLK) {
            const int l = vb / 96, j0 = (vb % 96) * 64;
            for (int i = tid; i < 5 * 1024; i += NTHREADS) { const int r = i >> 10, k = i & 1023; const float v = r < 4 ? p.c[r * 1024 + k] : p.c_ctx[k]; sv[i] = v / (1.f + __expf(-v)); }
            __syncthreads();
            float a0 = 0.f, a1 = 0.f, a2 = 0.f, a3 = 0.f, a4 = 0.f;
            const float* w = p.ada_w + ((size_t)l * 1024 + wid * 128) * 6144 + j0 + lane;
#pragma unroll 16
            for (int k = 0; k < 128; ++k) { const float xw = w[(size_t)k * 6144]; const int kk = wid * 128 + k;
                a0 += sv[kk] * xw; a1 += sv[1024 + kk] * xw; a2 += sv[2048 + kk] * xw; a3 += sv[3072 + kk] * xw; a4 += sv[4096 + kk] * xw; }
            part[(wid * 5 + 0) * 64 + lane] = a0; part[(wid * 5 + 1) * 64 + lane] = a1; part[(wid * 5 + 2) * 64 + lane] = a2; part[(wid * 5 + 3) * 64 + lane] = a3; part[(wid * 5 + 4) * 64 + lane] = a4;
            __syncthreads();
            if (tid < 320) { const int r = tid >> 6; float s = 0.f;
#pragma unroll
                for (int w8 = 0; w8 < 8; ++w8) s += part[(w8 * 5 + r) * 64 + lane];
                mod[((size_t)l * 5 + r) * 6144 + j0 + lane] = s + p.ada_b[l * 6144 + j0 + lane]; }
            __syncthreads();
        }
    }
    {
        float* tab = (float*)(ws + WS_ROPE);
        for (int i = BID * NTHREADS + TID; i < 1024; i += NBLK * NTHREADS) { const int pos = i / 16, fi = i % 16; const float inv = powf(10000.0f, -(float)fi / 16.0f), ang = (float)pos * inv; tab[i] = cosf(ang); tab[1024 + i] = sinf(ang); }
    }
}

typedef float f32x2v __attribute__((ext_vector_type(2)));
__device__ __forceinline__ float wave_sum(float v) {
#pragma unroll
    for (int o = 32; o > 0; o >>= 1) v += __shfl_xor(v, o);
    return v;
}
__device__ __forceinline__ void ph_norm_mod(const float* __restrict__ Xl, const float* __restrict__ Xc, const float* __restrict__ g, const float* __restrict__ modl, int shift_idx, int scale_idx, bf16_t* __restrict__ H, int nrows, unsigned* __restrict__ H8, const int WV) {
    const int lane = TID & 63, gw = BID * 8 + (TID >> 6);
    for (int row = gw; row < nrows; row += NBLK * 8) {
        const float* src = row < T_LAT ? Xl + (size_t)row * D : Xc + (size_t)(row - T_LAT) * D;
        const int mrow = row < T_LAT ? row / S : 4;
        float4 v[4]; float ss = 0.f;
#pragma unroll
        for (int i = 0; i < 4; ++i) { v[i] = ((const float4*)src)[i * 64 + lane]; ss += v[i].x * v[i].x + v[i].y * v[i].y + v[i].z * v[i].z + v[i].w * v[i].w; }
        ss = wave_sum(ss);
        const float rstd = rsqrtf(ss * (1.0f / D) + EPS);
        const float* sh = modl + (size_t)mrow * 6144 + shift_idx * 1024; const float* sc = modl + (size_t)mrow * 6144 + scale_idx * 1024;
#pragma unroll
        for (int i = 0; i < 4; ++i) { const int k = (i * 64 + lane) * 4;
            const float4 gg = *(const float4*)(g + k), s4 = *(const float4*)(sc + k), h4 = *(const float4*)(sh + k);
            uint2 w; w.x = pk2(v[i].x * rstd * gg.x * (1.f + s4.x) + h4.x, v[i].y * rstd * gg.y * (1.f + s4.y) + h4.y);
            w.y = pk2(v[i].z * rstd * gg.z * (1.f + s4.z) + h4.z, v[i].w * rstd * gg.w * (1.f + s4.w) + h4.w);
            *(uint2*)(H + (size_t)row * D + k) = w;
            if (H8) {
                const float h0 = 8.f * lo16(w.x), h1 = 8.f * hi16(w.x), h2 = 8.f * lo16(w.y), h3 = 8.f * hi16(w.y);
                int hi = __builtin_amdgcn_cvt_pk_fp8_f32(h0, h1, 0, false); hi = __builtin_amdgcn_cvt_pk_fp8_f32(h2, h3, hi, true);
                const f32x2v d0 = __builtin_amdgcn_cvt_pk_f32_fp8(hi, false), d1 = __builtin_amdgcn_cvt_pk_f32_fp8(hi, true);
                int lo = __builtin_amdgcn_cvt_pk_fp8_f32(h0 - d0[0], h1 - d0[1], 0, false); lo = __builtin_amdgcn_cvt_pk_fp8_f32(h2 - d1[0], h3 - d1[1], lo, true);
                H8[(size_t)row * 256 + i * 64 + lane] = (unsigned)hi; H8[(size_t)T_ALL * 256 + (size_t)row * 256 + i * 64 + lane] = (unsigned)lo; } }
    }
}
__device__ __forceinline__ void ph_pool(const bf16_t* __restrict__ Z, bf16_t* __restrict__ Pa, int rows, int tid) {
    for (int idx = BID * NTHREADS + tid; idx < rows * 64; idx += NBLK * NTHREADS) {
        const int c8 = idx & 63, row = idx >> 6, g = c8 >> 4, w = 2 << g;
        const bool lat = row < T_LAT; const int len = lat ? S : L; const int t = lat ? (row & (S - 1)) : ((row - T_LAT) & (L - 1)); const int base = row - t;
        int lo = t - w / 2; if (lo < 0) lo = 0; int hi = t - w / 2 + w; if (hi > len) hi = len;
        float sum[8];
#pragma unroll
        for (int i = 0; i < 8; ++i) sum[i] = 0.f;
        const bf16_t* zp = Z + (size_t)base * IN_COLS + OFF_A + c8 * 8;
        for (int tt = lo; tt < hi; ++tt) { const uint4 v = *(const uint4*)(zp + (size_t)tt * IN_COLS);
            sum[0] += lo16(v.x); sum[1] += hi16(v.x); sum[2] += lo16(v.y); sum[3] += hi16(v.y); sum[4] += lo16(v.z); sum[5] += hi16(v.z); sum[6] += lo16(v.w); sum[7] += hi16(v.w); }
        const uint4 sv = *(const uint4*)(zp + (size_t)t * IN_COLS); const float inv = 1.f / (float)(hi - lo);
        uint4 o; o.x = pk2(sum[0] * inv - lo16(sv.x), sum[1] * inv - hi16(sv.x)); o.y = pk2(sum[2] * inv - lo16(sv.y), sum[3] * inv - hi16(sv.y));
        o.z = pk2(sum[4] * inv - lo16(sv.z), sum[5] * inv - hi16(sv.z)); o.w = pk2(sum[6] * inv - lo16(sv.w), sum[7] * inv - hi16(sv.w));
        *(uint4*)(Pa + (size_t)row * 512 + c8 * 8) = o;
    }
}
typedef short bf16x8v __attribute__((ext_vector_type(8)));
typedef float f32x4v __attribute__((ext_vector_type(4)));
constexpr float LOG2E = 1.4426950408889634f;
constexpr float QK_SCALE2 = 0.125f * LOG2E;
constexpr float MASKED = -3.0e38f;
__device__ __forceinline__ unsigned cvtpk(float lo, float hi) { unsigned r; asm volatile("v_cvt_pk_bf16_f32 %0, %1, %2" : "=v"(r) : "v"(lo), "v"(hi)); return r; }
__device__ __forceinline__ f32x4v mfma16(bf16x8v a, bf16x8v b, f32x4v c) { return __builtin_amdgcn_mfma_f32_16x16x32_bf16(a, b, c, 0, 0, 0); }
struct AttnSt { f32x4v o[4]; float m, l; };
__device__ __forceinline__ int clampi(int v, int lo, int hi) { return v < lo ? lo : (v > hi ? hi : v); }
template <class Dsc> __device__ __forceinline__ void attn_load_k(const Dsc& dsc, int c, bf16x8v (&kf)[2][2]) {
#pragma unroll
    for (int tt = 0; tt < 2; ++tt) { const bf16_t* kb = dsc.kbase(c); const unsigned ko = dsc.koff(c, tt); kf[tt][0] = *(const bf16x8v*)(kb + ko); kf[tt][1] = *(const bf16x8v*)(kb + (ko + 32u)); }
}
template <class Dsc> __device__ __forceinline__ void attn_load_v(const Dsc& dsc, int c, bf16x8v (&vf)[4]) {
    const bf16_t* vb = dsc.vbase(c); const unsigned vo = dsc.voff(c); const unsigned vs = dsc.vstride16();
#pragma unroll
    for (int dt = 0; dt < 4; ++dt) vf[dt] = *(const bf16x8v*)(vb + (size_t)(dt * vs) + vo);
}
template <int VAR, class Dsc>
__device__ __forceinline__ void attn_chunk4(const Dsc& dsc, int c, int cnext, bf16x8v (&kf)[2][2], const bf16x8v (&vf)[4], const bf16x8v (&qf)[4][2], AttnSt (&st)[4], int lane) {
    unsigned pk[4][4]; float al[4]; bool tl[4];
#pragma unroll
    for (int t = 0; t < 4; ++t) {
        tl[t] = dsc.tile_live(t, c);
        f32x4v s[2];
        if (tl[t]) {
#pragma unroll
            for (int tt = 0; tt < 2; ++tt) { f32x4v acc = (f32x4v){0.f, 0.f, 0.f, 0.f}; if (VAR != 4) { acc = mfma16(kf[tt][0], qf[t][0], acc); acc = mfma16(kf[tt][1], qf[t][1], acc); } else { acc[0] = (float)(c + tt); acc[1] = acc[0] + 1.f; acc[2] = acc[0] * 0.5f; acc[3] = acc[0] - 1.f; } s[tt] = acc; }
        }
        if (t == 3 && VAR != 4) { __builtin_amdgcn_sched_barrier(0); attn_load_k(dsc, cnext, kf); __builtin_amdgcn_sched_barrier(0); }
        al[t] = 1.0f;
        if (!tl[t]) continue;
#pragma unroll
        for (int tt = 0; tt < 2; ++tt)
#pragma unroll
            for (int r = 0; r < 4; ++r) s[tt][r] = (VAR == 5) ? s[tt][r] * QK_SCALE2 : dsc.score(t, c, tt, r, s[tt][r]);
        float gmax = fmaxf(fmaxf(fmaxf(s[0][0], s[0][1]), fmaxf(s[0][2], s[0][3])), fmaxf(fmaxf(s[1][0], s[1][1]), fmaxf(s[1][2], s[1][3])));
        if (__any(gmax > st[t].m + 8.0f)) {
            if (VAR != 2) { gmax = fmaxf(gmax, __shfl_xor(gmax, 16)); gmax = fmaxf(gmax, __shfl_xor(gmax, 32)); }
            const float mnew = fmaxf(st[t].m, gmax), alpha = __builtin_amdgcn_exp2f(st[t].m - mnew);
            st[t].m = mnew; al[t] = alpha; st[t].l *= alpha;
        }
        const float mref = st[t].m;
        float psum = 0.f;
#pragma unroll
        for (int tt = 0; tt < 2; ++tt)
#pragma unroll
            for (int r = 0; r < 4; ++r) { const float pv = (VAR == 1) ? (s[tt][r] - mref) : __builtin_amdgcn_exp2f(s[tt][r] - mref); s[tt][r] = pv; psum += pv; }
        st[t].l += psum;
        pk[t][0] = cvtpk(s[0][0], s[0][1]); pk[t][1] = cvtpk(s[0][2], s[0][3]); pk[t][2] = cvtpk(s[1][0], s[1][1]); pk[t][3] = cvtpk(s[1][2], s[1][3]);
    }
    __builtin_amdgcn_sched_barrier(0);
#pragma unroll
    for (int t = 0; t < 4; ++t) {
        if (!tl[t]) continue;
        if (!__all(al[t] == 1.0f)) {
            const int gb = (lane >> 4) * 4;
#pragma unroll
            for (int r = 0; r < 4; ++r) { const float ar = (VAR == 2) ? al[t] : __shfl(al[t], gb + r);
#pragma unroll
                for (int dt = 0; dt < 4; ++dt) st[t].o[dt][r] *= ar; }
        }
        union { unsigned u[4]; bf16x8v v; } pf;
        pf.u[0] = pk[t][0]; pf.u[1] = pk[t][1]; pf.u[2] = pk[t][2]; pf.u[3] = pk[t][3];
#pragma unroll
        for (int dt = 0; dt < 4; ++dt) { if (VAR != 3) st[t].o[dt] = mfma16(pf.v, vf[dt], st[t].o[dt]); else st[t].o[dt][0] += __uint_as_float(pf.u[dt]); }
    }
}
template <int VAR, class Dsc>
__device__ __forceinline__ void attn_stream4(const Dsc& dsc, int nc, const bf16x8v (&qf)[4][2], AttnSt (&st)[4], int lane) {
    bf16x8v kf[2][2], vf[4];
    if (VAR == 3) { for (int dt = 0; dt < 4; ++dt) vf[dt] = qf[dt][0]; }
    attn_load_k(dsc, 0, kf);
#pragma unroll 1
    for (int c = 0; c < nc; ++c) {
        if (VAR != 3) attn_load_v(dsc, c, vf); __builtin_amdgcn_sched_barrier(0);
        attn_chunk4<VAR>(dsc, c, (c + 1 < nc) ? c + 1 : c, kf, vf, qf, st, lane); __builtin_amdgcn_sched_barrier(0);
    }
}
__device__ __forceinline__ void attn_finish(AttnSt& st, float sink2, bool has_sink, bf16_t* orow  , int lane) {
    float l = st.l; l += __shfl_xor(l, 16); l += __shfl_xor(l, 32);
    if (has_sink) l += __builtin_amdgcn_exp2f(sink2 - st.m);
    const float inv = 1.0f / l;
    const int gb = (lane >> 4) * 4, d = lane & 15;
#pragma unroll
    for (int r = 0; r < 4; ++r) { const float ir = __shfl(inv, gb + r);
#pragma unroll
        for (int dt = 0; dt < 4; ++dt) orow[(size_t)(gb + r) * 512 + dt * 16 + d] = f2bf(st.o[dt][r] * ir); }
}
__device__ __forceinline__ void attn_init_st(AttnSt& st) {
#pragma unroll
    for (int dt = 0; dt < 4; ++dt) st.o[dt] = (f32x4v){0.f, 0.f, 0.f, 0.f};
    st.m = -1.0e30f; st.l = 0.f;
}
struct Na4Dsc {
    const bf16_t* kb0;
    const bf16_t* vb0;
    const float* rpb;
    unsigned ko[2], vo;
    int dc0; float mk[8];
    int Rlo, r0, nrow;
    __device__ __forceinline__ int crow(int c) const { return c < nrow ? c : nrow - 1; }
    __device__ __forceinline__ const bf16_t* kbase(int c) const { return kb0 + (size_t)crow(c) * 64 * IN_COLS; }
    __device__ __forceinline__ unsigned koff(int, int tt) const { return ko[tt]; }
    __device__ __forceinline__ const bf16_t* vbase(int c) const { return vb0 + crow(c) * 64; }
    __device__ __forceinline__ unsigned voff(int) const { return vo; }
    __device__ __forceinline__ unsigned vstride16() const { return 16u * S; }
    __device__ __forceinline__ bool tile_live(int t, int c) const { const int R0 = clampi(r0 + t - 4, 0, 56), kr = Rlo + c; return c < nrow && kr >= R0 && kr <= R0 + 7; }
    __device__ __forceinline__ float score(int t, int c, int tt, int r, float raw) const {
        const float bias = rpb[(Rlo + c - (r0 + t) + 7) * 31 + dc0 + 4 * tt + r];
        return raw * QK_SCALE2 + bias + mk[tt * 4 + r];
    }
};
struct Ctx4Dsc {
    const bf16_t* kb0;
    const bf16_t* vb0;
    unsigned ko[2], vo;
    __device__ __forceinline__ const bf16_t* kbase(int c) const { return kb0 + (size_t)c * 32 * IN_COLS; }
    __device__ __forceinline__ unsigned koff(int, int tt) const { return ko[tt]; }
    __device__ __forceinline__ const bf16_t* vbase(int c) const { return vb0 + c * 32; }
    __device__ __forceinline__ unsigned voff(int) const { return vo; }
    __device__ __forceinline__ unsigned vstride16() const { return 16u * L; }
    __device__ __forceinline__ bool tile_live(int, int) const { return true; }
    __device__ __forceinline__ float score(int, int, int, int, float raw) const { return raw * QK_SCALE2; }
};
struct Swa4Dsc {
    const bf16_t* zrow;
    const bf16_t* vrow;
    int p0, kslot0, g8, qpos, dS;
    __device__ __forceinline__ const bf16_t* kbase(int) const { return zrow; }
    __device__ __forceinline__ unsigned koff(int c, int tt) const { const int pos = clampi(p0 - 128 + 32 * c + kslot0 + 4 * tt, 0, S - 1); return (unsigned)pos * (unsigned)IN_COLS + (unsigned)g8; }
    __device__ __forceinline__ const bf16_t* vbase(int) const { return vrow; }
    __device__ __forceinline__ unsigned voff(int c) const { const int pos = clampi(p0 - 128 + 32 * c + g8, 0, S - 8); return (unsigned)(dS + pos); }
    __device__ __forceinline__ unsigned vstride16() const { return 16u * S; }
    __device__ __forceinline__ bool tile_live(int, int c) const { const int pos0 = p0 - 128 + 32 * c; return c < 9 && pos0 + 31 >= 0 && pos0 < S; }
    __device__ __forceinline__ float score(int, int c, int tt, int r, float raw) const {
        const int pos0 = p0 - 128 + 32 * c;
        if (c >= 1 && c <= 7 && pos0 >= 0 && pos0 + 31 < S) return raw * QK_SCALE2;
        const int pos = pos0 + g8 + 4 * tt + r; const int dlt = qpos - pos;
        return (pos >= 0 && pos < S && dlt <= 128 && dlt >= -128) ? raw * QK_SCALE2 : MASKED;
    }
};
template <int VAR>
__device__ __forceinline__ void ph_attn(const bf16_t* __restrict__ Z, const bf16_t* __restrict__ vtn, const bf16_t* __restrict__ vtnc, const bf16_t* __restrict__ vtw, const bf16_t* __restrict__ vtwc,
                                        const float* __restrict__ rpb, const float* __restrict__ sink, bf16_t* __restrict__ Ob, bf16_t* __restrict__ Oc, bool do_ctx, float* smem, bf16_t* __restrict__ Pa, int rows, const int WV) {
    const int tid = TID, lane = tid & 63, wid = tid >> 6;
    for (int i = tid; i < 8 * 465 + 64; i += NTHREADS) smem[i] = (i >= 16 && i < 16 + 8 * 465) ? rpb[i - 16] * LOG2E : 0.f;
    if (VAR == 0) ph_pool(Z, Pa, rows, tid);
    __syncthreads();
    const int q = lane & 15, g = lane >> 4, kslot0 = (q >> 2) * 8 + (q & 3);
    const int wu = __builtin_amdgcn_readfirstlane(wid);
    const int vcu = (NBLK % 8 == 0) ? (BID % 8) * (NBLK / 8) + BID / 8 : BID;
    const int nunits = 2048 + 2048 + (do_ctx ? 256 : 0);
    const unsigned ko0 = (unsigned)kslot0 * IN_COLS + 8u * g, ko1 = ko0 + 4u * IN_COLS, qo = (unsigned)q * IN_COLS + 8u * g;
    for (int uu = vcu * 8 + wu; uu < nunits; uu += NBLK * 8) {
        const int u = uu >= 4096 ? uu : (((uu & 255) < 128) ? ((uu >> 8) * 128 + (uu & 127)) : (2048 + (uu >> 8) * 128 + (uu & 127)));
        AttnSt st[4]; bf16x8v qf[4][2];
#pragma unroll
        for (int t = 0; t < 4; ++t) attn_init_st(st[t]);
        if (u < 2048) {
            const int cb = u & 3, r4 = (u >> 2) & 15, h = (u >> 6) & 7, b = u >> 9, r0 = r4 * 4;
            const int Rlo = clampi(r0 - 4, 0, 56), Rhi = clampi(r0 + 3 - 4, 0, 56) + 7, nrow = Rhi - Rlo + 1;
            const int C0 = clampi(cb * 16 - 8, 0, 32), qc = cb * 16 + q;
            const size_t t0 = (size_t)b * S + r0 * GW + cb * 16;
            const bf16_t* qp = Z + t0 * IN_COLS + OFF_QN + h * 64;
#pragma unroll
            for (int t = 0; t < 4; ++t) { qf[t][0] = *(const bf16x8v*)(qp + (size_t)t * GW * IN_COLS + qo); qf[t][1] = *(const bf16x8v*)(qp + (size_t)t * GW * IN_COLS + (qo + 32u)); }
            Na4Dsc dl; dl.kb0 = Z + ((size_t)b * S + Rlo * GW + C0) * IN_COLS + OFF_KN + h * 64;
            dl.vb0 = vtn + (size_t)(b * 8 + h) * 64 * S + Rlo * GW + C0; dl.rpb = smem + 16 + h * 465;
            dl.ko[0] = ko0; dl.ko[1] = ko1; dl.vo = (unsigned)q * S + 8u * g;
            dl.dc0 = C0 + 8 * g - qc + 15; dl.Rlo = Rlo; dl.r0 = r0; dl.nrow = nrow;
            { const int qs = clampi(qc - 8, 0, 48);
#pragma unroll
              for (int j = 0; j < 8; ++j) { const int kc = C0 + 8 * g + j; dl.mk[j] = (kc >= qs && kc < qs + 16) ? 0.f : MASKED; } }
            attn_stream4<VAR>(dl, nrow, qf, st, lane);
            Ctx4Dsc dc; dc.kb0 = Z + ((size_t)T_LAT + b * L) * IN_COLS + OFF_KN + h * 64; dc.vb0 = vtnc + (size_t)(b * 8 + h) * 64 * L;
            dc.ko[0] = ko0; dc.ko[1] = ko1; dc.vo = (unsigned)q * L + 8u * g;
            attn_stream4<VAR>(dc, 8, qf, st, lane);
#pragma unroll
            for (int t = 0; t < 4; ++t) attn_finish(st[t], 0.f, false, Ob + (t0 + (size_t)t * GW) * 512 + h * 64, lane);
        } else if (u < 4096) {
            const int v = u - 2048, qt = v & 255, g2 = (v >> 8) & 1, b = v >> 9, p0 = qt * 16;
            const size_t t0 = (size_t)b * S + p0;
            const bf16_t* qp = Z + t0 * IN_COLS + OFF_QW + g2 * 256;
#pragma unroll
            for (int t = 0; t < 4; ++t) { qf[t][0] = *(const bf16x8v*)(qp + t * 64 + qo); qf[t][1] = *(const bf16x8v*)(qp + t * 64 + (qo + 32u)); }
            Swa4Dsc dl; dl.zrow = Z + (size_t)b * S * IN_COLS + OFF_KW + g2 * 64; dl.vrow = vtw + (size_t)(b * 2 + g2) * 64 * S;
            dl.p0 = p0; dl.kslot0 = kslot0; dl.g8 = 8 * g; dl.qpos = p0 + q; dl.dS = q * S;
            attn_stream4<VAR>(dl, 9, qf, st, lane);
            Ctx4Dsc dc; dc.kb0 = Z + ((size_t)T_LAT + b * L) * IN_COLS + OFF_KW + g2 * 64; dc.vb0 = vtwc + (size_t)(b * 2 + g2) * 64 * L;
            dc.ko[0] = ko0; dc.ko[1] = ko1; dc.vo = (unsigned)q * L + 8u * g;
            attn_stream4<VAR>(dc, 8, qf, st, lane);
#pragma unroll
            for (int t = 0; t < 4; ++t) attn_finish(st[t], sink[g2 * 4 + t] * LOG2E, true, Oc + t0 * 512 + (g2 * 4 + t) * 64, lane);
        } else {
            const int v = u - 4096, which = v >> 7;
            if (which == 0) {
                const int qt4 = v & 3, h = (v >> 2) & 7, b = (v >> 5) & 3;
                const size_t t0 = (size_t)T_LAT + b * L + qt4 * 64;
                const bf16_t* qp = Z + t0 * IN_COLS + OFF_QN + h * 64;
#pragma unroll
                for (int t = 0; t < 4; ++t) { qf[t][0] = *(const bf16x8v*)(qp + (size_t)t * 16 * IN_COLS + qo); qf[t][1] = *(const bf16x8v*)(qp + (size_t)t * 16 * IN_COLS + (qo + 32u)); }
                Ctx4Dsc dc; dc.kb0 = Z + ((size_t)T_LAT + b * L) * IN_COLS + OFF_KN + h * 64; dc.vb0 = vtnc + (size_t)(b * 8 + h) * 64 * L;
                dc.ko[0] = ko0; dc.ko[1] = ko1; dc.vo = (unsigned)q * L + 8u * g;
                attn_stream4<VAR>(dc, 8, qf, st, lane);
#pragma unroll
                for (int t = 0; t < 4; ++t) attn_finish(st[t], 0.f, false, Ob + (t0 + t * 16) * 512 + h * 64, lane);
            } else {
                const int w = v - 128, qt = w & 15, g2 = (w >> 4) & 1, b = (w >> 5) & 3;
                const size_t t0 = (size_t)T_LAT + b * L + qt * 16;
                const bf16_t* qp = Z + t0 * IN_COLS + OFF_QW + g2 * 256;
#pragma unroll
                for (int t = 0; t < 4; ++t) { qf[t][0] = *(const bf16x8v*)(qp + t * 64 + qo); qf[t][1] = *(const bf16x8v*)(qp + t * 64 + (qo + 32u)); }
                Ctx4Dsc dc; dc.kb0 = Z + ((size_t)T_LAT + b * L) * IN_COLS + OFF_KW + g2 * 64; dc.vb0 = vtwc + (size_t)(b * 2 + g2) * 64 * L;
                dc.ko[0] = ko0; dc.ko[1] = ko1; dc.vo = (unsigned)q * L + 8u * g;
                attn_stream4<VAR>(dc, 8, qf, st, lane);
#pragma unroll
                for (int t = 0; t < 4; ++t) attn_finish(st[t], sink[g2 * 4 + t] * LOG2E, true, Oc + t0 * 512 + (g2 * 4 + t) * 64, lane);
            }
        }
    }
}

__device__ __forceinline__ int f2key(float v) { const int b = __float_as_int(v); return b ^ ((b >> 31) & 0x7fffffff); }
__device__ __forceinline__ float key2f(int k) { return __int_as_float(k ^ ((k >> 31) & 0x7fffffff)); }
__device__ __forceinline__ float embed(float v, unsigned mask, unsigned code) { return __uint_as_float((__float_as_uint(v) & ~mask) | code); }
template <int N> __device__ __forceinline__ void bitonic_merge_desc(int (&a)[N]) {
#pragma unroll
    for (int j = N >> 1; j > 0; j >>= 1)
#pragma unroll
        for (int i = 0; i < N; ++i) { const int l = i ^ j; if (l > i) { const int hi = max(a[i], a[l]), lo = min(a[i], a[l]); a[i] = hi; a[l] = lo; } }
}
template <int N> __device__ __forceinline__ void bitonic_sort_desc(int (&a)[N]) {
#pragma unroll
    for (int k = 2; k <= N; k <<= 1)
#pragma unroll
        for (int j = k >> 1; j > 0; j >>= 1)
#pragma unroll
            for (int i = 0; i < N; ++i) { const int l = i ^ j; if (l > i) { const int hi = max(a[i], a[l]), lo = min(a[i], a[l]); if ((i & k) == 0) { a[i] = hi; a[l] = lo; } else { a[i] = lo; a[l] = hi; } } }
}
__device__ __forceinline__ void xlane_top16(int (&h)[16], int mask) {
    int m[16];
#pragma unroll
    for (int i = 0; i < 16; ++i) m[i] = max(h[i], __shfl_xor(h[15 - i], mask));
    bitonic_merge_desc<16>(m);
#pragma unroll
    for (int i = 0; i < 16; ++i) h[i] = m[i];
}
__device__ __forceinline__ void ph_peer_topk(const bf16_t* __restrict__ Q, const bf16_t* __restrict__ keys, int* __restrict__ eidx, float* __restrict__ egate, int rows, float* smem, const int WV) {
    const int tid = TID, lane = tid & 63, wid = tid >> 6, n = lane & 15, g = lane >> 4;
    unsigned char* kl = (unsigned char*)smem;
    int* lidx = (int*)(kl + 65536) + wid * 512;
    const int KNEG = (int)0x80000001;
    const int ngroups = rows / 16, npass = ((ngroups + 7) / 8) * 8;
    const int wu = __builtin_amdgcn_readfirstlane(wid);
    for (int ps = BID; ps < npass; ps += NBLK) {
        const int h = ps & 7, grp = (ps >> 3) * 8 + wu;
        __syncthreads();
        {   const uint4* src = (const uint4*)(keys + (size_t)h * 2 * 128 * 128);
#pragma unroll
            for (int i = 0; i < 8; ++i) { const int cid = tid + i * NTHREADS; const uint4 v = src[cid]; const int row = (cid >> 4) & 127, ch = cid & 15;
                *(uint4*)(kl + ((cid >> 4) * 256 + ((ch ^ (row & 15)) << 4))) = v; }
        }
        __syncthreads();
        if (grp >= ngroups) continue;
        const int t0 = grp * 16;
        float tops[2][16];
#pragma unroll
        for (int pp = 0; pp < 2; ++pp) {
            const bf16_t* qb = Q + (size_t)t0 * 2048 + h * 256 + pp * 128; const unsigned qof = (unsigned)n * 2048u + 8u * g;
            bf16x8v qf[4];
#pragma unroll
            for (int ks = 0; ks < 4; ++ks) qf[ks] = *(const bf16x8v*)(qb + (qof + ks * 32));
            int ka_[2][16];
#pragma unroll
            for (int T = 0; T < 8; ++T) {
                f32x4v acc = (f32x4v){0.f, 0.f, 0.f, 0.f};
#pragma unroll
                for (int ks = 0; ks < 4; ++ks) {
                    const bf16x8v a = *(const bf16x8v*)(kl + ((pp * 128 + T * 16 + n) * 256 + (((ks * 4 + g) ^ n) << 4)));
                    acc = mfma16(a, qf[ks], acc); }
#pragma unroll
                for (int r = 0; r < 4; ++r) ka_[T >> 2][(T & 3) * 4 + r] = f2key(embed(acc[r], 127u, (unsigned)(T * 16 + 4 * g + r)));
            }
            bitonic_sort_desc<16>(ka_[0]); bitonic_sort_desc<16>(ka_[1]);
            int hh[16];
#pragma unroll
            for (int i = 0; i < 16; ++i) hh[i] = max(ka_[0][i], ka_[1][15 - i]);
            bitonic_merge_desc<16>(hh);
            xlane_top16(hh, 16); xlane_top16(hh, 32);
#pragma unroll
            for (int i = 0; i < 16; ++i) tops[pp][i] = key2f(hh[i]);
            if (g == 0) {
#pragma unroll
                for (int i = 0; i < 16; ++i) lidx[(n * 2 + pp) * 16 + i] = (int)(__float_as_uint(tops[pp][i]) & 127u);
            }
        }
        float bsel[4];
#pragma unroll
        for (int jj = 0; jj < 4; ++jj) bsel[jj] = g == 0 ? tops[1][4 * jj] : (g == 1 ? tops[1][4 * jj + 1] : (g == 2 ? tops[1][4 * jj + 2] : tops[1][4 * jj + 3]));
        int ca[16], ce[16];
#pragma unroll
        for (int i = 0; i < 16; ++i) ca[i] = f2key(embed(tops[0][i] + bsel[0], 255u, (unsigned)((i << 4) | g)));
#pragma unroll
        for (int i = 0; i < 3; ++i) ce[i] = f2key(embed(tops[0][i] + bsel[1], 255u, (unsigned)((i << 4) | 4 | g)));
        ce[3] = f2key(embed(tops[0][0] + bsel[2], 255u, (unsigned)(8 | g)));
        ce[4] = f2key(embed(tops[0][0] + bsel[3], 255u, (unsigned)(12 | g)));
#pragma unroll
        for (int i = 5; i < 16; ++i) ce[i] = KNEG;
        bitonic_sort_desc<16>(ce);
        int cb[16];
#pragma unroll
        for (int i = 0; i < 16; ++i) cb[i] = max(ca[i], ce[15 - i]);
        bitonic_sort_desc<16>(cb);
        xlane_top16(cb, 16); xlane_top16(cb, 32);
        float best[16];
#pragma unroll
        for (int rd = 0; rd < 16; ++rd) best[rd] = key2f(cb[rd]);
        float ex[16]; float sum = 0.f;
#pragma unroll
        for (int rd = 0; rd < 16; ++rd) { ex[rd] = __builtin_amdgcn_exp2f((best[rd] - best[0]) * LOG2E); sum += ex[rd]; }
        const float inv = 1.0f / sum;
        asm volatile("s_waitcnt lgkmcnt(0)" ::: "memory");
        int eo[4]; float go[4];
#pragma unroll
        for (int rr = 0; rr < 4; ++rr) {
            const float bv = g == 0 ? best[rr] : (g == 1 ? best[4 + rr] : (g == 2 ? best[8 + rr] : best[12 + rr]));
            const float ev = g == 0 ? ex[rr] : (g == 1 ? ex[4 + rr] : (g == 2 ? ex[8 + rr] : ex[12 + rr]));
            const unsigned code = __float_as_uint(bv) & 255u;
            eo[rr] = lidx[(n * 2 + 0) * 16 + (code >> 4)] * 128 + lidx[(n * 2 + 1) * 16 + (code & 15u)];
            go[rr] = ev * inv;
        }
        const size_t o = (size_t)(t0 + n) * 128 + h * 16 + 4 * g;
        *(int4*)(eidx + o) = make_int4(eo[0], eo[1], eo[2], eo[3]);
        *(float4*)(egate + o) = make_float4(go[0], go[1], go[2], go[3]);
        asm volatile("s_waitcnt lgkmcnt(0)" ::: "memory");
    }
}
__device__ __forceinline__ void ph_peer_gather_bf16(const bf16_t* __restrict__ H, const bf16_t* __restrict__ U, const bf16_t* __restrict__ V, const int* __restrict__ eidx, const float* __restrict__ egate,
                                               const float* __restrict__ modl, float* __restrict__ Xl, float* __restrict__ Xc, int rows,
                                               int mode, const float* __restrict__ gn, const float* __restrict__ modn, bf16_t* __restrict__ Hn, float* smem, bool dry, const int WV) {
    const int tid = TID, lane = tid & 63, wid = tid >> 6, m = lane & 15, gk = lane >> 4;
    float* wl = smem + wid * 128;
    for (int t = BID * 8 + wid; t < rows; t += NBLK * 8) {
        const int e0 = eidx[(size_t)t * 128 + lane], e1 = eidx[(size_t)t * 128 + 64 + lane];
        const bf16_t* rp[8];
#pragma unroll
        for (int T = 0; T < 8; ++T) { const int e = __shfl(T < 4 ? e0 : e1, (T & 3) * 16 + m); rp[T] = U + (size_t)e * D + 8 * gk; }
        f32x4v acc[8];
#pragma unroll
        for (int T = 0; T < 8; ++T) acc[T] = (f32x4v){0.f, 0.f, 0.f, 0.f};
        const bf16_t* hp = H + (size_t)t * D + 8 * gk;
#pragma unroll 2
        for (int ks = 0; ks < 32; ++ks) {
            const bf16x8v hb = *(const bf16x8v*)(hp + ks * 32);
#pragma unroll
            for (int T = 0; T < 8; ++T) { const bf16x8v a = *(const bf16x8v*)(rp[T] + ks * 32); acc[T] = mfma16(a, hb, acc[T]); }
        }
        const int myT = m >> 1, r0 = (m & 1) * 2;
        float va = 0.f, vb = 0.f;
#pragma unroll
        for (int T = 0; T < 8; ++T) { const float x0 = r0 ? acc[T][2] : acc[T][0], x1 = r0 ? acc[T][3] : acc[T][1]; if (myT == T) { va = x0; vb = x1; } }
        const int ee = myT * 16 + 4 * gk + r0;
        const float2 gg = *(const float2*)(egate + (size_t)t * 128 + ee);
        float2 ww; ww.x = gg.x * 0.5f * va * (1.f + erff(va * 0.70710678118654752f)); ww.y = gg.y * 0.5f * vb * (1.f + erff(vb * 0.70710678118654752f));
        *(float2*)(wl + ee) = ww;
        asm volatile("s_waitcnt lgkmcnt(0)" ::: "memory");
        const float w0 = wl[lane], w1 = wl[64 + lane];
        asm volatile("s_waitcnt lgkmcnt(0)" ::: "memory");
        float out[16];
#pragma unroll
        for (int i = 0; i < 16; ++i) out[i] = 0.f;
        const bf16_t* vb0 = V + lane * 8;
#pragma unroll
        for (int hh = 0; hh < 2; ++hh) {
            const int ev = hh ? e1 : e0; const int wbits = __float_as_int(hh ? w1 : w0);
#pragma unroll 8
            for (int k = 0; k < 64; ++k) {
                const int e = __builtin_amdgcn_readlane(ev, k); const float w = __int_as_float(__builtin_amdgcn_readlane(wbits, k));
                const bf16_t* vp = vb0 + (size_t)e * D;
                const uint4 a = *(const uint4*)vp, b = *(const uint4*)(vp + 512);
                out[0] += w * lo16(a.x); out[1] += w * hi16(a.x); out[2] += w * lo16(a.y); out[3] += w * hi16(a.y); out[4] += w * lo16(a.z); out[5] += w * hi16(a.z); out[6] += w * lo16(a.w); out[7] += w * hi16(a.w);
                out[8] += w * lo16(b.x); out[9] += w * hi16(b.x); out[10] += w * lo16(b.y); out[11] += w * hi16(b.y); out[12] += w * lo16(b.z); out[13] += w * hi16(b.z); out[14] += w * lo16(b.w); out[15] += w * hi16(b.w);
            }
        }
        const int mrow = t < T_LAT ? t / S : 4;
        float* xp = t < T_LAT ? Xl + (size_t)t * D : Xc + (size_t)(t - T_LAT) * D;
        const float* gt = modl + (size_t)mrow * 6144 + 5 * 1024;
        float xr[16]; float ss = 0.f;
#pragma unroll
        for (int q4 = 0; q4 < 4; ++q4) { const int col = (q4 >> 1) * 512 + lane * 8 + (q4 & 1) * 4;
            const float4 x = *(const float4*)(xp + col), g4 = *(const float4*)(gt + col);
            xr[q4 * 4 + 0] = x.x + g4.x * out[q4 * 4 + 0]; xr[q4 * 4 + 1] = x.y + g4.y * out[q4 * 4 + 1]; xr[q4 * 4 + 2] = x.z + g4.z * out[q4 * 4 + 2]; xr[q4 * 4 + 3] = x.w + g4.w * out[q4 * 4 + 3];
#pragma unroll
            for (int i = 0; i < 4; ++i) ss += xr[q4 * 4 + i] * xr[q4 * 4 + i]; }
        ss = wave_sum(ss);
        const float rstd = rsqrtf(ss * (1.0f / D) + EPS);
        if (dry && rstd != 12345.678f) continue;
        if (mode == 0) {
            const float* shn = modn + (size_t)mrow * 6144; const float* scn = shn + 1024;
#pragma unroll
            for (int q4 = 0; q4 < 4; ++q4) { const int col = (q4 >> 1) * 512 + lane * 8 + (q4 & 1) * 4;
                *(float4*)(xp + col) = make_float4(xr[q4 * 4], xr[q4 * 4 + 1], xr[q4 * 4 + 2], xr[q4 * 4 + 3]);
                const float4 g4 = *(const float4*)(gn + col), s4 = *(const float4*)(scn + col), h4 = *(const float4*)(shn + col);
                uint2 w; w.x = pk2(xr[q4 * 4] * rstd * g4.x * (1.f + s4.x) + h4.x, xr[q4 * 4 + 1] * rstd * g4.y * (1.f + s4.y) + h4.y);
                w.y = pk2(xr[q4 * 4 + 2] * rstd * g4.z * (1.f + s4.z) + h4.z, xr[q4 * 4 + 3] * rstd * g4.w * (1.f + s4.w) + h4.w);
                *(uint2*)(Hn + (size_t)t * D + col) = w; }
        } else {
#pragma unroll
            for (int q4 = 0; q4 < 4; ++q4) { const int col = (q4 >> 1) * 512 + lane * 8 + (q4 & 1) * 4;
                const float4 g4 = *(const float4*)(gn + col);
                *(float4*)(xp + col) = make_float4(xr[q4 * 4] * rstd * g4.x, xr[q4 * 4 + 1] * rstd * g4.y, xr[q4 * 4 + 2] * rstd * g4.z, xr[q4 * 4 + 3] * rstd * g4.w); }
        }
    }
}

typedef long i64v;
typedef long i64x2v __attribute__((ext_vector_type(2)));
__device__ __forceinline__ f32x4v mfma8(i64v a, i64v b, f32x4v c) { return __builtin_amdgcn_mfma_f32_16x16x32_fp8_fp8(a, b, c, 0, 0, 0); }
__device__ __forceinline__ void ph_peer_gather_fp8(const unsigned char* __restrict__ H8, const unsigned char* __restrict__ U8, const unsigned char* __restrict__ V8, const float* __restrict__ isu, const float* __restrict__ isv,
                                               const int* __restrict__ eidx, const float* __restrict__ egate,
                                               const float* __restrict__ modl, float* __restrict__ Xl, float* __restrict__ Xc, int rows,
                                               int mode, const float* __restrict__ gn, const float* __restrict__ modn, bf16_t* Hn, float* smem, bool dry, const int WV) {
    const int tid = TID, lane = tid & 63, wid = tid >> 6, m = lane & 15, gk = lane >> 4;
    float* wl = smem + wid * 128;
    for (int t = BID * 8 + wid; t < rows; t += NBLK * 8) {
        const int e0 = eidx[(size_t)t * 128 + lane], e1 = eidx[(size_t)t * 128 + 64 + lane];
        unsigned rp[8];
#pragma unroll
        for (int T = 0; T < 8; ++T) { const int e = __shfl(T < 4 ? e0 : e1, (T & 3) * 16 + m); rp[T] = (unsigned)e * (unsigned)D + 16u * (unsigned)gk; }
        f32x4v acc[8];
#pragma unroll
        for (int T = 0; T < 8; ++T) acc[T] = (f32x4v){0.f, 0.f, 0.f, 0.f};
        const unsigned char* hp = H8 + (size_t)t * D + 16 * gk;
#if RING_U
        i64x2v A[3][8], Bh[3], Bl[3];
#define GLOADK(ks) do { _Pragma("unroll") for (int T = 0; T < 8; ++T) A[(ks) % 3][T] = *(const i64x2v*)(U8 + (rp[T] + (unsigned)((ks) * 64))); \
                        Bh[(ks) % 3] = *(const i64x2v*)(hp + (ks) * 64); Bl[(ks) % 3] = *(const i64x2v*)(hp + (size_t)T_ALL * D + (ks) * 64); } while (0)
        GLOADK(0); GLOADK(1);
#pragma unroll
        for (int ks = 0; ks < 16; ++ks) {
            if (ks + 2 < 16) GLOADK(ks + 2);
            __builtin_amdgcn_sched_barrier(0);
#pragma unroll
            for (int T = 0; T < 8; ++T) { const i64x2v a = A[ks % 3][T];
                acc[T] = mfma8(a[0], Bh[ks % 3][0], acc[T]); acc[T] = mfma8(a[0], Bl[ks % 3][0], acc[T]); acc[T] = mfma8(a[1], Bh[ks % 3][1], acc[T]); acc[T] = mfma8(a[1], Bl[ks % 3][1], acc[T]); }
            __builtin_amdgcn_sched_barrier(0);
        }
#undef GLOADK
#else
#pragma unroll 2
        for (int ks = 0; ks < 16; ++ks) {
            const i64x2v bh = *(const i64x2v*)(hp + ks * 64), bl = *(const i64x2v*)(hp + (size_t)T_ALL * D + ks * 64);
            i64x2v a[8];
#pragma unroll
            for (int T = 0; T < 8; ++T) a[T] = *(const i64x2v*)(U8 + (rp[T] + (unsigned)(ks * 64)));
#pragma unroll
            for (int T = 0; T < 8; ++T) { acc[T] = mfma8(a[T][0], bh[0], acc[T]); acc[T] = mfma8(a[T][0], bl[0], acc[T]); acc[T] = mfma8(a[T][1], bh[1], acc[T]); acc[T] = mfma8(a[T][1], bl[1], acc[T]); }
        }
#endif
        const int myT = m >> 1, r0 = (m & 1) * 2;
        float va = 0.f, vb = 0.f;
#pragma unroll
        for (int T = 0; T < 8; ++T) { const float x0 = r0 ? acc[T][2] : acc[T][0], x1 = r0 ? acc[T][3] : acc[T][1]; if (myT == T) { va = x0; vb = x1; } }
        const int ee = myT * 16 + 4 * gk + r0;
        const int ida0 = __shfl(e0, ee & 63), ida1 = __shfl(e1, ee & 63), idb0 = __shfl(e0, (ee + 1) & 63), idb1 = __shfl(e1, (ee + 1) & 63);
        const int ida = ee < 64 ? ida0 : ida1, idb = ee < 64 ? idb0 : idb1;
        va *= 0.125f * isu[ida]; vb *= 0.125f * isu[idb];
        const float2 gg = *(const float2*)(egate + (size_t)t * 128 + ee);
        float2 ww; ww.x = gg.x * 0.5f * va * (1.f + erff(va * 0.70710678118654752f)); ww.y = gg.y * 0.5f * vb * (1.f + erff(vb * 0.70710678118654752f));
        *(float2*)(wl + ee) = ww;
        asm volatile("s_waitcnt lgkmcnt(0)" ::: "memory");
        const float w0 = wl[lane] * isv[e0], w1 = wl[64 + lane] * isv[e1];
        asm volatile("s_waitcnt lgkmcnt(0)" ::: "memory");
        float out[16];
#pragma unroll
        for (int i = 0; i < 16; ++i) out[i] = 0.f;
        const unsigned voff = 16u * (unsigned)lane;
#if RING_V
        uint4 VR[2][8];
#define VLOADC(c, slot) do { const int ev_ = ((c) & 8) ? e1 : e0; _Pragma("unroll") for (int j = 0; j < 8; ++j) { const int e = __builtin_amdgcn_readlane(ev_, ((c) & 7) * 8 + j); VR[slot][j] = *(const uint4*)(V8 + ((unsigned)e * (unsigned)D + voff)); } } while (0)
#define VCOMPC(c, slot) do { const int wb_ = __float_as_int(((c) & 8) ? w1 : w0); _Pragma("unroll") for (int j = 0; j < 8; ++j) { const float w = __int_as_float(__builtin_amdgcn_readlane(wb_, ((c) & 7) * 8 + j)); \
            const unsigned aw[4] = {VR[slot][j].x, VR[slot][j].y, VR[slot][j].z, VR[slot][j].w}; \
            _Pragma("unroll") for (int q = 0; q < 4; ++q) { const f32x2v d0 = __builtin_amdgcn_cvt_pk_f32_fp8((int)aw[q], false), d1 = __builtin_amdgcn_cvt_pk_f32_fp8((int)aw[q], true); \
                out[4 * q] += w * d0[0]; out[4 * q + 1] += w * d0[1]; out[4 * q + 2] += w * d1[0]; out[4 * q + 3] += w * d1[1]; } } } while (0)
        VLOADC(0, 0);
#pragma unroll 1
        for (int c2 = 0; c2 < 16; c2 += 2) {
            VLOADC(c2 + 1, 1); __builtin_amdgcn_sched_barrier(0); VCOMPC(c2, 0); __builtin_amdgcn_sched_barrier(0);
            if (c2 + 2 < 16) VLOADC(c2 + 2, 0); __builtin_amdgcn_sched_barrier(0); VCOMPC(c2 + 1, 1); __builtin_amdgcn_sched_barrier(0);
        }
#undef VLOADC
#undef VCOMPC
#else
#pragma unroll
        for (int hh = 0; hh < 2; ++hh) {
            const int ev = hh ? e1 : e0; const int wbits = __float_as_int(hh ? w1 : w0);
#pragma unroll 16
            for (int k = 0; k < 64; ++k) {
                const int e = __builtin_amdgcn_readlane(ev, k); const float w = __int_as_float(__builtin_amdgcn_readlane(wbits, k));
                const uint4 a = *(const uint4*)(V8 + ((unsigned)e * (unsigned)D + voff));
                const unsigned aw[4] = {a.x, a.y, a.z, a.w};
#pragma unroll
                for (int q = 0; q < 4; ++q) { const f32x2v d0 = __builtin_amdgcn_cvt_pk_f32_fp8((int)aw[q], false), d1 = __builtin_amdgcn_cvt_pk_f32_fp8((int)aw[q], true);
                    out[4 * q] += w * d0[0]; out[4 * q + 1] += w * d0[1]; out[4 * q + 2] += w * d1[0]; out[4 * q + 3] += w * d1[1]; }
            }
        }
#endif
        const int mrow = t < T_LAT ? t / S : 4;
        float* xp = (t < T_LAT ? Xl + (size_t)t * D : Xc + (size_t)(t - T_LAT) * D) + lane * 16;
        const float* gt = modl + (size_t)mrow * 6144 + 5 * 1024 + lane * 16;
        float xr[16]; float ss = 0.f;
#pragma unroll
        for (int q4 = 0; q4 < 4; ++q4) {
            const float4 x = *(const float4*)(xp + q4 * 4), g4 = *(const float4*)(gt + q4 * 4);
            xr[q4 * 4 + 0] = x.x + g4.x * out[q4 * 4 + 0]; xr[q4 * 4 + 1] = x.y + g4.y * out[q4 * 4 + 1]; xr[q4 * 4 + 2] = x.z + g4.z * out[q4 * 4 + 2]; xr[q4 * 4 + 3] = x.w + g4.w * out[q4 * 4 + 3];
#pragma unroll
            for (int i = 0; i < 4; ++i) ss += xr[q4 * 4 + i] * xr[q4 * 4 + i]; }
        ss = wave_sum(ss);
        const float rstd = rsqrtf(ss * (1.0f / D) + EPS);
        if (dry && rstd != 12345.678f) continue;
        if (mode == 0) {
            const float* shn = modn + (size_t)mrow * 6144 + lane * 16; const float* scn = shn + 1024; const float* gp = gn + lane * 16;
#pragma unroll
            for (int q4 = 0; q4 < 4; ++q4) {
                *(float4*)(xp + q4 * 4) = make_float4(xr[q4 * 4], xr[q4 * 4 + 1], xr[q4 * 4 + 2], xr[q4 * 4 + 3]);
                const float4 g4 = *(const float4*)(gp + q4 * 4), s4 = *(const float4*)(scn + q4 * 4), h4 = *(const float4*)(shn + q4 * 4);
                uint2 w; w.x = pk2(xr[q4 * 4] * rstd * g4.x * (1.f + s4.x) + h4.x, xr[q4 * 4 + 1] * rstd * g4.y * (1.f + s4.y) + h4.y);
                w.y = pk2(xr[q4 * 4 + 2] * rstd * g4.z * (1.f + s4.z) + h4.z, xr[q4 * 4 + 3] * rstd * g4.w * (1.f + s4.w) + h4.w);
                *(uint2*)(Hn + (size_t)t * D + lane * 16 + q4 * 4) = w; }
        } else {
            const float* gp = gn + lane * 16;
#pragma unroll
            for (int q4 = 0; q4 < 4; ++q4) { const float4 g4 = *(const float4*)(gp + q4 * 4);
                *(float4*)(xp + q4 * 4) = make_float4(xr[q4 * 4] * rstd * g4.x, xr[q4 * 4 + 1] * rstd * g4.y, xr[q4 * 4 + 2] * rstd * g4.z, xr[q4 * 4 + 3] * rstd * g4.w); }
        }
    }
}

#define LAS __attribute__((address_space(3)))
#define XB_TMO      128
#define XB_XCNT(j)  (256  + 64 * (j))
#define XB_XSUB(j)  (1280 + 64 * (j))
#define XB_XGEN(j)  (2304 + 64 * (j))
#define XB_TOP      3328
#define XB_TOPGEN   3392
#define XCD_BAR_WORDS 3456
#define XB_SPIN_CAP (1u << 18)

__device__ __forceinline__ unsigned xb_ld(unsigned* p)              { return __hip_atomic_load(p, __ATOMIC_RELAXED, __HIP_MEMORY_SCOPE_AGENT); }
__device__ __forceinline__ unsigned xb_add(unsigned* p, unsigned v) { return __hip_atomic_fetch_add(p, v, __ATOMIC_RELAXED, __HIP_MEMORY_SCOPE_AGENT); }
__device__ __forceinline__ unsigned xb_xcc_id() { return (unsigned)__builtin_amdgcn_s_getreg((3 << 11) | 20) & 0xFu; }
#define XB_SPIN(cond, bar) do { unsigned _sp = 0; while (cond) { __builtin_amdgcn_s_sleep(1); \
    if ((++_sp & 255u) == 0u) { if (xb_ld(&(bar)[XB_TMO])) break; if (_sp > XB_SPIN_CAP) { atomicAdd(&(bar)[XB_TMO], 1u); break; } } } } while (0)

struct XcdBarrier {
    unsigned* bar; unsigned x; int wv;
    volatile LAS unsigned* st;
};

__device__ __forceinline__ XcdBarrier xcd_barrier_post(unsigned* bar, volatile LAS unsigned* st, int wv) {
    XcdBarrier b; b.bar = bar; b.x = xb_xcc_id(); b.st = st; b.wv = wv;
    if (wv == 0 && lane_id() == 0) (void)xb_add(&bar[XB_XCNT(b.x)], 1u);
    return b;
}
__device__ __forceinline__ void xcd_barrier_complete(unsigned* bar, unsigned x, unsigned& nloc, unsigned& nx) {
    const unsigned G = gridDim.x * gridDim.y * gridDim.z;
    unsigned sum, cnt, mine, sp = 0u;
    for (;;) {
        sum = 0u; cnt = 0u; mine = 0u;
#pragma unroll
        for (unsigned j = 0; j < 16; ++j) { const unsigned c = xb_ld(&bar[XB_XCNT(j)]); sum += c; cnt += (c > 0u) ? 1u : 0u; mine = (j == x) ? c : mine; }
        if (sum == G) break;
        __builtin_amdgcn_s_sleep(1);
        if ((++sp & 255u) == 0u) { if (xb_ld(&bar[XB_TMO])) break; if (sp > XB_SPIN_CAP) { atomicAdd(&bar[XB_TMO], 1u); break; } }
    }
    nloc = mine > 0u ? mine : 1u; nx = cnt > 0u ? cnt : 1u;
}

__device__ __forceinline__ void xcd_barrier(const XcdBarrier& b) {
    asm volatile("s_waitcnt vmcnt(0)" ::: "memory");
    __syncthreads();
    if (b.wv == 0 && lane_id() == 0) {
        unsigned* bar = b.bar;
        __builtin_amdgcn_s_waitcnt(0);
        unsigned nloc = b.st[0], nx = b.st[1];
        if (nloc == 0u) { xcd_barrier_complete(bar, b.x, nloc, nx); b.st[0] = nloc; b.st[1] = nx; }
        const unsigned old = xb_add(&bar[XB_XSUB(b.x)], 1u);
        const unsigned gen = old / nloc;
        if (old + 1u == (gen + 1u) * nloc) {
            __builtin_amdgcn_fence(__ATOMIC_RELEASE, "agent");
            asm volatile("s_waitcnt vmcnt(0)" ::: "memory");
            const unsigned og = xb_add(&bar[XB_TOP], 1u);
            const unsigned tg = og / nx;
            if (og + 1u == (tg + 1u) * nx) xb_add(&bar[XB_TOPGEN], 1u);
            else XB_SPIN(xb_ld(&bar[XB_TOPGEN]) == tg, bar);
            __builtin_amdgcn_fence(__ATOMIC_ACQUIRE, "agent");
            xb_add(&bar[XB_XGEN(b.x)], 1u);
            asm volatile("s_waitcnt vmcnt(0)" ::: "memory");
        } else {
            XB_SPIN(xb_ld(&bar[XB_XGEN(b.x)]) == gen, bar);
            __builtin_amdgcn_fence(__ATOMIC_ACQUIRE, "agent");
            asm volatile("s_waitcnt vmcnt(0)" ::: "memory");
        }
    }
    __syncthreads();
}

__device__ __forceinline__ unsigned char* launder(unsigned char* q) { size_t z = 0; asm volatile("" : "+s"(z)); return q + z; }
__device__ __forceinline__ void ph_fill_tables(const Params& p, const int WV) {
    const int nidle = NBLK - 16; if (BID < 16 || nidle <= 0) return;
    unsigned char* ws = launder(p.ws);
#pragma unroll 1
    for (int tb = 0; tb < 4; ++tb) {
        const int l = tb >> 1, isv = tb & 1;
        unsigned char* tl = ws + (l == 0 ? WS_TAB0 : WS_TAB1);
        const float* src = (isv ? p.peer_v : p.peer_u) + (size_t)l * NEXP * D;
        conv_fp8_rows(src, (unsigned*)(tl + (size_t)isv * NEXP * D), (float*)(tl + (size_t)2 * NEXP * D) + isv * NEXP, NEXP, WV, BID - 16, nidle);
    }
}
struct WsPtrs { float *mod, *rope, *XC, *X; bf16_t *H, *Z, *vtn, *vtnc, *vtw, *vtwc, *AT; int* eidx; float* egate; unsigned char* wl; const float* modl; const unsigned char *U8, *V8, *H8; const float *isu, *isv; const bf16_t *U, *V; };
__device__ __forceinline__ WsPtrs mkptrs(const Params& p, int l) {
    unsigned char* ws = launder(p.ws); WsPtrs P;
    P.mod = (float*)(ws + WS_MOD); P.rope = (float*)(ws + WS_ROPE); P.XC = (float*)(ws + WS_XC); P.X = (float*)launder((unsigned char*)p.out);
    P.H = (bf16_t*)(ws + WS_H); P.Z = (bf16_t*)(ws + WS_Z); P.vtn = (bf16_t*)(ws + WS_VTN); P.vtnc = (bf16_t*)(ws + WS_VTNC); P.vtw = (bf16_t*)(ws + WS_VTW); P.vtwc = (bf16_t*)(ws + WS_VTWC);
    P.AT = (bf16_t*)(ws + WS_AT); P.eidx = (int*)(ws + WS_EIDX); P.egate = (float*)(ws + WS_EGATE);
    P.wl = ws + WS_W + l * W_LAYER; P.modl = P.mod + (size_t)l * 5 * 6144; P.U = (const bf16_t*)(ws + WS_TAB0); P.V = P.U + (size_t)NEXP * D; P.U8 = ws + ((l == 0) ? WS_TAB0 : WS_TAB1); P.V8 = P.U8 + (size_t)NEXP * D; P.isu = (const float*)(P.U8 + (size_t)2 * NEXP * D); P.isv = P.isu + NEXP; P.H8 = ws + WS_H8;
    return P;
}
__global__ void __launch_bounds__(NTHREADS, 2) mega_fwd(Params p) {
    extern __shared__ __attribute__((aligned(16))) unsigned char lds[];
    cg::grid_group grid = cg::this_grid();
    int WV; asm volatile("v_readfirstlane_b32 %0, %1" : "=s"(WV) : "v"((int)threadIdx.x >> 6));
    PG8_LAS unsigned char* ldsr = (PG8_LAS unsigned char*)lds;
    float* smem = (float*)lds;
    volatile LAS unsigned* bst = (volatile LAS unsigned*)((LAS unsigned char*)lds + 131072 + 256);
    if (WV == 0 && lane_id() < 2) bst[lane_id()] = 0u;
    __syncthreads();
    XcdBarrier xbar = xcd_barrier_post((unsigned*)(p.ws + WS_CTL), bst, WV);

#ifndef PROBE_DUP
#define PROBE_DUP 0
#endif

#define SYNC() xcd_barrier(xbar)
#define DUP(k, PH) do { PH; SYNC(); if (PROBE_DUP == (k)) { PH; SYNC(); } } while (0)
#define PH_NORM1() { const WsPtrs P = mkptrs(p, l); ph_norm_mod(p.x, p.ctx, p.norm1_g, P.modl, 0, 1, P.H, T_ALL, nullptr, WV); }
#define PH_ZGEMM() {     \
            const WsPtrs P = mkptrs(p, l); \
            pg8::EpiZ E{P.Z, P.rope, P.vtn, P.vtnc, P.vtw, P.vtwc, 0, 0}; \
            pg8::Gemm g{P.H, (const bf16_t*)(P.wl + W_WIN), T_ALL, IN_COLS, D}; \
            if (!last) { pg8::StaticOrder So; So.init(T_ALL, IN_COLS, NBLK, BID); pg8::gemm_phase<pg8::EpiZ, pg8::StaticOrder, true, true>(ldsr, g, So, E, WV); } \
            else { pg8::ZLastOrder So; So.S0.init(T_LAT, IN_COLS, NBLK, BID); So.G = NBLK; So.c = BID; pg8::gemm_phase<pg8::EpiZ, pg8::ZLastOrder, true, true>(ldsr, g, So, E, WV); } }
#define PH_ATTN() { const WsPtrs P = mkptrs(p, l); ph_attn<0>(P.Z, P.vtn, P.vtnc, P.vtw, P.vtwc, p.na_rpb + (size_t)l * 8 * 15 * 31, p.swa_sink + l * 8, P.AT + (size_t)T_ALL * 512, P.AT + (size_t)2 * T_ALL * 512, !last, smem, P.AT, rows, WV); }
#define PH_MERGE() {     \
            const WsPtrs P = mkptrs(p, l); \
            pg8::Gemm g{P.AT, (const bf16_t*)(P.wl + W_WA), 3 * T_ALL, 3 * D, 512}; pg8::MergeOrder Mo{(rows / 256) * 4, NBLK, BID, 0}; pg8::EpiMergeSeg E{P.Z, P.H}; \
            pg8::gemm_phase<pg8::EpiMergeSeg, pg8::MergeOrder, false, true>(ldsr, g, Mo, E, WV); \
            if (l == 0 && FP8_L0 && PROBE_DUP != 4) ph_fill_tables(p, WV); }
#define PH_OUT(GIDX) {     \
            const WsPtrs P = mkptrs(p, l); \
            pg8::Gemm g{P.H, (const bf16_t*)(P.wl + W_WO), rows, D, D}; pg8::StaticOrder So; So.init(rows, D, NBLK, BID); pg8::EpiResid E{l == 0 ? p.x : P.X, l == 0 ? p.ctx : P.XC, P.X, P.XC, P.modl, GIDX, 0}; \
            pg8::gemm_phase<pg8::EpiResid, pg8::StaticOrder, true, true>(ldsr, g, So, E, WV); }
#define PH_NORM2() { const WsPtrs P = mkptrs(p, l); ph_norm_mod(P.X, P.XC, p.norm2_g + l * D, P.modl, 3, 4, P.H, rows, (last || FP8_L0) ? (unsigned*)P.H8 : nullptr, WV); }
#define PH_QGEMM() { const WsPtrs P = mkptrs(p, l); \
            pg8::Gemm g{P.H, (const bf16_t*)(P.wl + W_WQ), rows, 2048, D}; pg8::StaticOrder So; So.init(rows, 2048, NBLK, BID); pg8::EpiStoreBf16 E{P.Z, 2048, 0}; \
            pg8::gemm_phase<pg8::EpiStoreBf16, pg8::StaticOrder, true, true>(ldsr, g, So, E, WV); }
#define PH_TOPK() { const WsPtrs P = mkptrs(p, l); ph_peer_topk(P.Z, (const bf16_t*)(P.wl + W_KEYS), P.eidx, P.egate, rows, smem, WV); }
#define PH_GATHER(DRY) { const WsPtrs P = mkptrs(p, l); \
            if (!last && !FP8_L0) ph_peer_gather_bf16(P.H, P.U, P.V, P.eidx, P.egate, P.modl, P.X, P.XC, rows, 0, p.norm1_g + D, P.modl + 5 * 6144, P.H, smem, DRY, WV); \
            else ph_peer_gather_fp8(P.H8, P.U8, P.V8, P.isu, P.isv, P.eidx, P.egate, P.modl, P.X, P.XC, rows, last ? 1 : 0, last ? p.final_g : p.norm1_g + D, P.modl + 5 * 6144, P.H, smem, DRY, WV); }

    ph_prep(p, smem, WV);
    grid.sync();
    if (PROBE_DUP == 1) { ph_prep(p, smem, WV); SYNC(); }
#define LAYER_BODY(LIDX) { constexpr int l = LIDX; \
        const bool last = (l == 1); \
        const int rows = last ? T_LAT : T_ALL; \
        if (l == 0) { PH_NORM1(); SYNC(); } \
        DUP(2, PH_ZGEMM()); \
        DUP(3, PH_ATTN()); \
        if (PROBE_DUP >= 30) { const WsPtrs P = mkptrs(p, l); bf16_t* dmy = (bf16_t*)(launder(p.ws) + WS_TAB0 + (size_t)34 * 1048576); ph_attn<PROBE_DUP - 30>(P.Z, P.vtn, P.vtnc, P.vtw, P.vtwc, p.na_rpb + (size_t)l * 8 * 15 * 31, p.swa_sink + l * 8, dmy, dmy, !last, smem, P.AT, rows, WV); SYNC(); } \
        DUP(4, PH_MERGE()); \
        PH_OUT(2); SYNC(); \
        DUP(5, PH_NORM2()); \
        DUP(6, PH_QGEMM()); \
        DUP(7, PH_TOPK()); \
        if (PROBE_DUP == 8) { PH_GATHER(true); SYNC(); } \
        PH_GATHER(false); SYNC(); \
    }
    LAYER_BODY(0)
    LAYER_BODY(1)
}

extern "C" void kernel_launch(void* const* d_in, const int* in_sizes, int n_in, void* d_out, int out_size, void* d_ws, size_t ws_size, hipStream_t stream) {
    static int grid_blocks = 0;
    if (grid_blocks == 0) {
        if (ws_size < WS_END || n_in != 22) { fprintf(stderr, "kernel_launch: workspace %zu < %zu or n_in %d != 22\n", ws_size, (size_t)WS_END, n_in); grid_blocks = -1; return; }
        int dev = 0, cus = 0, per_cu = 0;
        (void)hipGetDevice(&dev); (void)hipDeviceGetAttribute(&cus, hipDeviceAttributeMultiprocessorCount, dev);
        if (hipFuncSetAttribute((const void*)mega_fwd, hipFuncAttributeMaxDynamicSharedMemorySize, LDS_BYTES) != hipSuccess) { fprintf(stderr, "kernel_launch: hipFuncSetAttribute failed\n"); grid_blocks = -1; return; }
        if (hipOccupancyMaxActiveBlocksPerMultiprocessor(&per_cu, (const void*)mega_fwd, NTHREADS, LDS_BYTES) != hipSuccess || per_cu < 1) { fprintf(stderr, "kernel_launch: occupancy query says %d\n", per_cu); per_cu = 1; }
        (void)hipGetLastError();
        grid_blocks = cus * 1;
        fprintf(stderr, "kernel_launch: %d CUs, occupancy query %d per CU, grid %d\n", cus, per_cu, grid_blocks);
    }
    if (grid_blocks < 0) return;
    (void)hipMemsetAsync((char*)d_ws + WS_CTL, 0, CTL_BYTES, stream);
    Params p{};
    p.x = (const float*)d_in[0]; p.c = (const float*)d_in[1]; p.ctx = (const float*)d_in[2]; p.c_ctx = (const float*)d_in[3]; p.ada_w = (const float*)d_in[4]; p.ada_b = (const float*)d_in[5];
    p.norm1_g = (const float*)d_in[6]; p.norm2_g = (const float*)d_in[7]; p.w_in = (const float*)d_in[8]; p.pool_w = (const float*)d_in[9]; p.pool_scale = (const float*)d_in[10]; p.na_rpb = (const float*)d_in[11];
    p.swa_sink = (const float*)d_in[12]; p.wba = (const float*)d_in[13]; p.wbb = (const float*)d_in[14]; p.wbc = (const float*)d_in[15]; p.w_out = (const float*)d_in[16]; p.peer_wq = (const float*)d_in[17];
    p.peer_keys = (const float*)d_in[18]; p.peer_u = (const float*)d_in[19]; p.peer_v = (const float*)d_in[20]; p.final_g = (const float*)d_in[21];
    p.out = (float*)d_out; p.ws = (unsigned char*)d_ws;
    void* args[] = {&p};
    const hipError_t e = hipLaunchCooperativeKernel((const void*)mega_fwd, dim3(grid_blocks), dim3(NTHREADS), args, LDS_BYTES, stream);
    if (e != hipSuccess) fprintf(stderr, "kernel_launch: cooperative launch failed: %s (grid %d)\n", hipGetErrorString(e), grid_blocks);
}
```

```cpp
#include <hip/hip_runtime.h>
#include <hip/hip_cooperative_groups.h>
#include <stdint.h>
#include <stdio.h>
namespace cg = cooperative_groups;

typedef unsigned short bf16_t;

constexpr int D = 1024, NB = 4, S = 4096, L = 256, GW = 64;
constexpr int T_LAT = NB * S, T_CTX = NB * L, T_ALL = T_LAT + T_CTX;
constexpr int IN_COLS = 5888;
constexpr int OFF_KN = 0, OFF_VN = 512, OFF_KW = 1024, OFF_VW = 1152, CTX_KV_COLS = 1280, OFF_QN = 1280, OFF_QW = 1792, OFF_A = 2304, OFF_G = 2816;
constexpr int NEXP = 16384;
constexpr float EPS = 1e-6f;
#ifndef FP8_L0
#define FP8_L0 1
#endif
#ifndef RING_U
#define RING_U 1
#endif
#ifndef RING_V
#define RING_V 1
#endif
#ifndef URING
#define URING 3
#endif
#ifndef VRING
#define VRING 2
#endif
#ifndef VCH
#define VCH 8
#endif
constexpr int NTHREADS = 512;
constexpr int LDS_BYTES = 147456;

constexpr size_t al256(size_t x) { return (x + 255) & ~(size_t)255; }
constexpr size_t WS_CTL = 0, CTL_BYTES = 16384;
constexpr size_t WS_MOD = WS_CTL + CTL_BYTES;
constexpr size_t WS_ROPE = al256(WS_MOD + 2 * 5 * 6144 * 4);
constexpr size_t WS_XC = al256(WS_ROPE + 2 * 64 * 16 * 4);
constexpr size_t WS_H = al256(WS_XC + (size_t)T_CTX * D * 4);
constexpr size_t WS_Z = al256(WS_H + (size_t)T_ALL * D * 2);
constexpr size_t WS_VTN = al256(WS_Z + (size_t)T_ALL * IN_COLS * 2);
constexpr size_t WS_VTNC = al256(WS_VTN + (size_t)NB * 8 * 64 * S * 2);
constexpr size_t WS_VTW = al256(WS_VTNC + (size_t)NB * 8 * 64 * L * 2);
constexpr size_t WS_VTWC = al256(WS_VTW + (size_t)NB * 2 * 64 * S * 2);
constexpr size_t WS_AT = al256(WS_VTWC + (size_t)NB * 2 * 64 * L * 2);
constexpr size_t WS_EIDX = al256(WS_AT + (size_t)3 * T_ALL * 512 * 2);
constexpr size_t WS_EGATE = al256(WS_EIDX + (size_t)T_ALL * 128 * 4);
constexpr size_t WS_W = al256(WS_EGATE + (size_t)T_ALL * 128 * 4);
constexpr size_t W_WIN = 0;
constexpr size_t W_WA = W_WIN + (size_t)IN_COLS * D * 2;
constexpr size_t W_WB = W_WA + (size_t)D * 512 * 2;
constexpr size_t W_WC = W_WB + (size_t)D * 512 * 2;
constexpr size_t W_WO = W_WC + (size_t)D * 512 * 2;
constexpr size_t W_WQ = W_WO + (size_t)D * D * 2;
constexpr size_t W_KEYS = W_WQ + (size_t)2048 * D * 2;
constexpr size_t W_LAYER = al256(W_KEYS + (size_t)8 * 2 * 128 * 128 * 2);
constexpr size_t WS_H8 = al256(WS_W + 2 * W_LAYER);
constexpr size_t WS_TAB0 = al256(WS_H8 + (size_t)2 * T_ALL * D);
constexpr size_t WS_TAB1 = al256(WS_TAB0 + (size_t)2 * NEXP * D * 2);
constexpr size_t WS_END = WS_TAB1 + (size_t)2 * NEXP * D + (size_t)2 * NEXP * 4;

__device__ __forceinline__ float bf2f(bf16_t v) { return __uint_as_float((unsigned)v << 16); }
__device__ __forceinline__ bf16_t f2bf(float f) { unsigned u = __float_as_uint(f); u += 0x7fffu + ((u >> 16) & 1u); return (bf16_t)(u >> 16); }
__device__ __forceinline__ unsigned pk2(float lo, float hi) { return (unsigned)f2bf(lo) | ((unsigned)f2bf(hi) << 16); }
__device__ __forceinline__ float lo16(unsigned w) { return __uint_as_float(w << 16); }
__device__ __forceinline__ float hi16(unsigned w) { return __uint_as_float(w & 0xffff0000u); }

__device__ __forceinline__ int lane_id() { int l; asm volatile("v_mbcnt_lo_u32_b32 %0, -1, 0\n\tv_mbcnt_hi_u32_b32 %0, -1, %0" : "=&v"(l)); return l; }
__device__ __forceinline__ int opaque_tid(int wv) { int t = (wv << 6) | lane_id(); asm volatile("" : "+v"(t)); return t; }
namespace pg8 {
#define PG8_LAS __attribute__((address_space(3)))
typedef unsigned short bf16_t;
typedef short bf16x8 __attribute__((ext_vector_type(8)));
typedef float f32x4 __attribute__((ext_vector_type(4)));
typedef unsigned u32x4 __attribute__((ext_vector_type(4)));
constexpr int BM = 256, BK = 64, HALF = 128, HTB = HALF * BK * 2  , STAGE_BYTES = 8 * HTB, NXCD = 8, WGM = 8;

__host__ __device__ __forceinline__ int lds_byte(int r, int c) { const int st = (r >> 4) * 2 + (c >> 5), rr = r & 15, cc = c & 31, ob = rr * 64 + cc * 2; return st * 1024 + (ob ^ (((ob >> 9) & 1) << 5)); }
__host__ __device__ __forceinline__ void stage_rc(int b, int& R, int& C) { const int st = b / 1024, sb = b % 1024, swz = sb ^ (((sb >> 9) & 1) << 5); R = (st >> 1) * 16 + swz / 64; C = (st & 1) * 32 + (swz % 64) / 2; }
__host__ __device__ __forceinline__ int perm32(int rho) { const int n = rho >> 4, i = rho & 15; return 8 * (i >> 2) + 4 * n + (i & 3); }

struct Unit { int pm, pn; };
struct Gemm { const bf16_t* A; const bf16_t* Bt; int M, N, K; };

struct StaticOrder {
    int nM, nN, nwg, G, c;
    __host__ __device__ void init(int M, int N, int G_, int c_) { nM = M / BM; nN = N / BM; nwg = nM * nN; G = G_; c = c_; }
    __host__ __device__ bool next(int i, Unit& u) const {
        const long L = (long)i * G + c; if (L >= nwg) return false;
        int wgid = (int)L; { const int q = nwg / NXCD, r = nwg % NXCD, xcd = wgid % NXCD, off = wgid / NXCD; wgid = (xcd < r ? xcd * (q + 1) : r * (q + 1) + (xcd - r) * q) + off; }
        const int nig = WGM * nN, gid = wgid / nig, fm = gid * WGM, gsz = (nM - fm) < WGM ? (nM - fm) : WGM;
        u.pm = fm + ((wgid % nig) % gsz); u.pn = (wgid % nig) / gsz; return true;
    }
    __device__ __forceinline__ void a_ready(const Unit&) const {}
    __device__ __forceinline__ void done(const Unit&) const {}
};
__device__ __forceinline__ unsigned cvt_pk_bf16(float lo, float hi) { unsigned r; asm volatile("v_cvt_pk_bf16_f32 %0, %1, %2" : "=v"(r) : "v"(lo), "v"(hi)); return r; }
typedef unsigned u32x4 __attribute__((ext_vector_type(4)));
struct EpiStoreBf16 {
    static constexpr bool PERM = true, AFTER_DRAIN = false;
    bf16_t* O; int ldc; int pad;
    __device__ __forceinline__ void operator()(const f32x4 (&acc)[2][2][4][2], const Unit& u, int wr, int wc, int fr, int fq) const {
        const int row0 = u.pm * BM + wr * 64 + fr, col0 = u.pn * BM + wc * 32 + 8 * fq;
#pragma unroll
        for (int ai = 0; ai < 2; ++ai)
#pragma unroll
            for (int m = 0; m < 4; ++m) { bf16_t* rowp = O + (size_t)(row0 + ai * HALF + m * 16) * ldc + col0;
#pragma unroll
                for (int bj = 0; bj < 2; ++bj) { const f32x4 v0 = acc[ai][bj][m][0], v1 = acc[ai][bj][m][1];
                    u32x4 w; w.x = cvt_pk_bf16(v0[0], v0[1]); w.y = cvt_pk_bf16(v0[2], v0[3]); w.z = cvt_pk_bf16(v1[0], v1[1]); w.w = cvt_pk_bf16(v1[2], v1[3]);
                    *(u32x4*)(rowp + bj * HALF) = w; } }
    }
};

struct EpiZ {
    static constexpr bool PERM = true, AFTER_DRAIN = false;
    bf16_t* Z; const float* rope; bf16_t *vtn, *vtnc, *vtw, *vtwc; int row_base; int pad;
    __device__ __forceinline__ void operator()(const f32x4 (&acc)[2][2][4][2], const Unit& u, int wr, int wc, int fr, int fq) const {
        const int grow0 = row_base + u.pm * BM;
        const bool lat = grow0 < 16384;
        const int b = lat ? (grow0 >> 12) : ((grow0 - 16384) >> 8), len = lat ? 4096 : 256;
        const int tpos0 = (lat ? (grow0 & 4095) : ((grow0 - 16384) & 255)) + wr * 64 + fr;
#pragma unroll
        for (int bj = 0; bj < 2; ++bj) {
            const int cb = 2 * u.pn + bj;
            const int col0 = cb * 128 + wc * 32 + 8 * fq;
            if ((cb >= 4 && cb < 8) || cb == 9) {
                const int cl = wc * 32 + 8 * fq;
                bf16_t* dst;
                if (cb == 9) dst = (lat ? vtw : vtwc) + ((size_t)(b * 2 + (cl >> 6)) * 64 + (cl & 63)) * len + tpos0;
                else dst = (lat ? vtn : vtnc) + ((size_t)(b * 8 + (cb - 4) * 2 + (cl >> 6)) * 64 + (cl & 63)) * len + tpos0;
#pragma unroll
                for (int ai = 0; ai < 2; ++ai)
#pragma unroll
                    for (int m = 0; m < 4; ++m) { bf16_t* dp = dst + ai * HALF + m * 16;
#pragma unroll
                        for (int n = 0; n < 2; ++n)
#pragma unroll
                            for (int i = 0; i < 4; ++i) { const unsigned w = cvt_pk_bf16(acc[ai][bj][m][n][i], 0.f); dp[(size_t)(4 * n + i) * len] = (bf16_t)(w & 0xffffu); } }
            } else {
                const bool is_rope = lat && (cb == 8 || (cb >= 14 && cb < 18));
                const bool is_gate = cb >= 22;
#pragma unroll
                for (int ai = 0; ai < 2; ++ai)
#pragma unroll
                    for (int m = 0; m < 4; ++m) {
                        f32x4 v0 = acc[ai][bj][m][0], v1 = acc[ai][bj][m][1];
                        if (is_gate) {
#pragma unroll
                            for (int i = 0; i < 4; ++i) { v0[i] = __builtin_amdgcn_rcpf(1.f + __builtin_amdgcn_exp2f(-1.4426950408889634f * v0[i])); v1[i] = __builtin_amdgcn_rcpf(1.f + __builtin_amdgcn_exp2f(-1.4426950408889634f * v1[i])); }
                        } else if (is_rope) {
                            const int tp = tpos0 + ai * HALF + m * 16;
                            const int pos = (wc & 1) ? (tp & 63) : (tp >> 6);
                            const float* tb = rope + pos * 16 + 8 * (fq & 1);
                            const f32x4 c0 = *(const f32x4*)tb, c1 = *(const f32x4*)(tb + 4), s0 = *(const f32x4*)(tb + 1024), s1 = *(const f32x4*)(tb + 1028);
                            f32x4 p0, p1;
#pragma unroll
                            for (int i = 0; i < 4; ++i) { p0[i] = __shfl_xor(v0[i], 32); p1[i] = __shfl_xor(v1[i], 32); }
                            if (fq < 2) { v0 = v0 * c0 - p0 * s0; v1 = v1 * c1 - p1 * s1; }
                            else { v0 = p0 * s0 + v0 * c0; v1 = p1 * s1 + v1 * c1; }
                        }
                        u32x4 w; w.x = cvt_pk_bf16(v0[0], v0[1]); w.y = cvt_pk_bf16(v0[2], v0[3]); w.z = cvt_pk_bf16(v1[0], v1[1]); w.w = cvt_pk_bf16(v1[2], v1[3]);
                        *(u32x4*)(Z + (size_t)(grow0 + ai * HALF + wr * 64 + m * 16 + fr) * 5888 + col0) = w;
                    }
            }
        }
    }
};
constexpr int NTM_STACK = 68;
struct EpiMergeSeg {
    static constexpr bool PERM = true, AFTER_DRAIN = false;
    const bf16_t* Z; bf16_t* M;
    __device__ __forceinline__ void operator()(const f32x4 (&acc)[2][2][4][2], const Unit& u, int wr, int wc, int fr, int fq) const {
        const int seg = u.pn >> 2, tn = u.pn & 3, tm = u.pm - seg * NTM_STACK;
        const int row0 = tm * BM + wr * 64 + fr, col0 = tn * BM + wc * 32 + 8 * fq;
        const bf16_t* zb = Z + (size_t)row0 * 5888 + 2816 + seg * 1024 + col0; bf16_t* mb = M + (size_t)row0 * 1024 + col0;
#pragma unroll
        for (int ai = 0; ai < 2; ++ai) {
            u32x4 g[4][2], o[4][2];
#pragma unroll
            for (int m = 0; m < 4; ++m)
#pragma unroll
                for (int bj = 0; bj < 2; ++bj) { const size_t ro = (size_t)(ai * HALF + m * 16);
                    g[m][bj] = *(const u32x4*)(zb + ro * 5888 + bj * HALF);
                    o[m][bj] = seg ? *(const u32x4*)(mb + ro * 1024 + bj * HALF) : (u32x4){0u, 0u, 0u, 0u}; }
            __builtin_amdgcn_sched_barrier(0);
#pragma unroll
            for (int m = 0; m < 4; ++m)
#pragma unroll
                for (int bj = 0; bj < 2; ++bj) { const u32x4 gg = g[m][bj], oo = o[m][bj]; const f32x4 v0 = acc[ai][bj][m][0], v1 = acc[ai][bj][m][1];
                    u32x4 w;
                    w.x = cvt_pk_bf16(__uint_as_float(gg.x << 16) * v0[0] + __uint_as_float(oo.x << 16), __uint_as_float(gg.x & 0xffff0000u) * v0[1] + __uint_as_float(oo.x & 0xffff0000u));
                    w.y = cvt_pk_bf16(__uint_as_float(gg.y << 16) * v0[2] + __uint_as_float(oo.y << 16), __uint_as_float(gg.y & 0xffff0000u) * v0[3] + __uint_as_float(oo.y & 0xffff0000u));
                    w.z = cvt_pk_bf16(__uint_as_float(gg.z << 16) * v1[0] + __uint_as_float(oo.z << 16), __uint_as_float(gg.z & 0xffff0000u) * v1[1] + __uint_as_float(oo.z & 0xffff0000u));
                    w.w = cvt_pk_bf16(__uint_as_float(gg.w << 16) * v1[2] + __uint_as_float(oo.w << 16), __uint_as_float(gg.w & 0xffff0000u) * v1[3] + __uint_as_float(oo.w & 0xffff0000u));
                    *(u32x4*)(mb + (size_t)(ai * HALF + m * 16) * 1024 + bj * HALF) = w; }
            __builtin_amdgcn_sched_barrier(0);
        }
    }
};
struct MergeOrder {
    int ntiles, G, c, pad;
    __device__ bool next(int i, Unit& u) const { const int ti = (i / 3) * G + c, seg = i % 3; if (ti >= ntiles) return false; u.pm = seg * NTM_STACK + (ti >> 2); u.pn = seg * 4 + (ti & 3); return true; }
    __device__ __forceinline__ void a_ready(const Unit&) const {}
    __device__ __forceinline__ void done(const Unit&) const {}
};
struct EpiResid {
    static constexpr bool PERM = false, AFTER_DRAIN = false;
    const float* Sl; const float* Sc; float* Xl; float* Xc; const float* modl; int gate_idx; int pad;
    __device__ __forceinline__ void operator()(const f32x4 (&acc)[2][2][4][2], const Unit& u, int wr, int wc, int fr, int fq) const {
        const int mrow = u.pm < 64 ? (u.pm >> 4) : 4;
        const size_t boff = u.pm < 64 ? (size_t)u.pm * BM * 1024 : (size_t)(u.pm - 64) * BM * 1024;
        const int col0 = u.pn * BM + wc * 32 + 4 * fq;
        const float* sbase = (u.pm < 64 ? Sl : Sc) + boff + (size_t)(wr * 64 + fr) * 1024 + col0; float* dbase = (u.pm < 64 ? Xl : Xc) + boff + (size_t)(wr * 64 + fr) * 1024 + col0;
        const float* gt = modl + (size_t)mrow * 6144 + gate_idx * 1024 + col0;
        f32x4 gv[2][2];
#pragma unroll
        for (int bj = 0; bj < 2; ++bj)
#pragma unroll
            for (int n = 0; n < 2; ++n) gv[bj][n] = *(const f32x4*)(gt + bj * HALF + 16 * n);
#pragma unroll
        for (int ai = 0; ai < 2; ++ai) {
            f32x4 x[4][2][2];
#pragma unroll
            for (int m = 0; m < 4; ++m)
#pragma unroll
                for (int bj = 0; bj < 2; ++bj)
#pragma unroll
                    for (int n = 0; n < 2; ++n) x[m][bj][n] = *(const f32x4*)(sbase + (size_t)(ai * HALF + m * 16) * 1024 + bj * HALF + 16 * n);
            __builtin_amdgcn_sched_barrier(0);
#pragma unroll
            for (int m = 0; m < 4; ++m)
#pragma unroll
                for (int bj = 0; bj < 2; ++bj)
#pragma unroll
                    for (int n = 0; n < 2; ++n) *(f32x4*)(dbase + (size_t)(ai * HALF + m * 16) * 1024 + bj * HALF + 16 * n) = x[m][bj][n] + gv[bj][n] * acc[ai][bj][m][n];
            __builtin_amdgcn_sched_barrier(0);
        }
    }
};
struct ZLastOrder {
    StaticOrder S0; int G, c;
    __device__ bool next(int i, Unit& u) const {
        const long L = (long)i * G + c;
        if (L < S0.nwg) return S0.next(i, u);
        const int e = (int)(L - S0.nwg); if (e >= 20) return false;
        u.pm = 64 + e / 5; u.pn = e % 5; return true;
    }
    __device__ __forceinline__ void a_ready(const Unit&) const {}
    __device__ __forceinline__ void done(const Unit&) const {}
};
template <class Epi, class Sched, bool ALIGN_EPI = false, bool SP2 = false>
__device__ __forceinline__ void gemm_phase(PG8_LAS unsigned char* lds, const Gemm g, const Sched& S, const Epi& E, const int WV) {
    const int tid = opaque_tid(WV), wid = __builtin_amdgcn_readfirstlane(tid >> 6), lane = tid & 63, wr = wid >> 2, wc = wid & 3, fr = lane & 15, fq = lane >> 4;
    const int K = g.K, nt = K / BK;
    unsigned voffA[2], voffB[2];
#pragma unroll
    for (int i = 0; i < 2; ++i) { int R, C; stage_rc(tid * 16 + i * 8192, R, C); const int Rb = Epi::PERM ? ((R & ~31) + perm32(R & 31)) : R;
        voffA[i] = (unsigned)(R * K + C) * 2u; voffB[i] = (unsigned)(Rb * K + C) * 2u; }
    const size_t kstep = (size_t)(BK * 2);
    const size_t hstep = (size_t)HALF * K * 2;
    const size_t tstep = 2 * hstep;
    const unsigned ldsw = (unsigned)wid * 1024u;
    const int aoff = lds_byte(wr * 64 + fr, fq * 8), boff = lds_byte(wc * 32 + fr, fq * 8);
#define PG8_SA(b, h) (((b) * 2 + (h)) * HTB)
#define PG8_SB(b, h) ((4 + (b) * 2 + (h)) * HTB)
#define PG8_STAGE(bufoff, gbase, voff) do { _Pragma("unroll") for (int _i = 0; _i < 2; ++_i) \
        __builtin_amdgcn_global_load_lds((const unsigned*)((const char*)(gbase) + (voff)[_i]), (PG8_LAS unsigned*)(lds + (bufoff) + ldsw + _i * 8192), 16, 0, 0); } while (0)
#define PG8_LDA(dst, b, h) do { _Pragma("unroll") for (int m = 0; m < 4; ++m) _Pragma("unroll") for (int k = 0; k < 2; ++k) dst[m][k] = *(const PG8_LAS bf16x8*)(lds + PG8_SA(b, h) + aoff + m * 2048 + k * 1024); } while (0)
#define PG8_LDB(dst, b, h) do { _Pragma("unroll") for (int n = 0; n < 2; ++n) _Pragma("unroll") for (int k = 0; k < 2; ++k) dst[n][k] = *(const PG8_LAS bf16x8*)(lds + PG8_SB(b, h) + boff + n * 2048 + k * 1024); } while (0)
#define PG8_MMA(ai, bj, At, Bt) do { __builtin_amdgcn_s_setprio(1); _Pragma("unroll") for (int m = 0; m < 4; ++m) _Pragma("unroll") for (int n = 0; n < 2; ++n) _Pragma("unroll") for (int k = 0; k < 2; ++k) \
        acc[ai][bj][m][n] = __builtin_amdgcn_mfma_f32_16x16x32_bf16(Bt[n][k], At[m][k], acc[ai][bj][m][n], 0, 0, 0); __builtin_amdgcn_s_setprio(0); } while (0)
#define PG8_WAIT_V(n) asm volatile("s_waitcnt vmcnt(" #n ")" ::: "memory")
#define PG8_WAIT_L(n) asm volatile("s_waitcnt lgkmcnt(" #n ")" ::: "memory")
#define PG8_BAR __builtin_amdgcn_s_barrier()
#define PG8_SCHED __builtin_amdgcn_sched_barrier(0)
    Unit cur, nxt; int ui = 0;
    if (!S.next(0, cur)) return;
    f32x4 acc[2][2][4][2];
#pragma unroll
    for (int a = 0; a < 2; ++a)
#pragma unroll
        for (int b = 0; b < 2; ++b)
#pragma unroll
            for (int m = 0; m < 4; ++m)
#pragma unroll
                for (int n = 0; n < 2; ++n) acc[a][b][m][n] = (f32x4){0.f, 0.f, 0.f, 0.f};
    bf16x8 At[4][2], B0[2][2], B1[2][2];
    const char* cA = (const char*)g.A + (size_t)cur.pm * tstep; const char* cB = (const char*)g.Bt + (size_t)cur.pn * tstep;
    S.a_ready(cur);
    if constexpr (SP2) {
        PG8_STAGE(PG8_SB(0, 0), cB, voffB); PG8_STAGE(PG8_SB(0, 1), cB + hstep, voffB); PG8_STAGE(PG8_SA(0, 0), cA, voffA); PG8_STAGE(PG8_SA(0, 1), cA + hstep, voffA);
        if (wr == 1) PG8_BAR;
        PG8_WAIT_V(2); PG8_BAR;
        PG8_STAGE(PG8_SB(1, 0), cB + kstep, voffB); PG8_STAGE(PG8_SA(1, 0), cA + kstep, voffA); PG8_STAGE(PG8_SB(1, 1), cB + hstep + kstep, voffB);
        PG8_WAIT_V(6); PG8_BAR;
    } else {
        PG8_STAGE(PG8_SB(0, 0), cB, voffB); PG8_STAGE(PG8_SA(0, 0), cA, voffA); PG8_STAGE(PG8_SB(0, 1), cB + hstep, voffB); PG8_STAGE(PG8_SA(0, 1), cA + hstep, voffA);
        if (wr == 1) PG8_BAR;
        PG8_WAIT_V(4); PG8_BAR;
        PG8_STAGE(PG8_SB(1, 0), cB + kstep, voffB); PG8_STAGE(PG8_SA(1, 0), cA + kstep, voffA); PG8_STAGE(PG8_SB(1, 1), cB + hstep + kstep, voffB);
        PG8_WAIT_V(6); PG8_BAR;
    }
    for (;;) {
        const bool has_next = S.next(ui + 1, nxt);
        const char* nA = has_next ? (const char*)g.A + (size_t)nxt.pm * tstep : cA; const char* nB = has_next ? (const char*)g.Bt + (size_t)nxt.pn * tstep : cB;
        for (int t = 0; t < nt; t += 2) {
            const bool last = (t == nt - 2);
            const char* a1 = cA + (size_t)(t + 1) * kstep;
            const char* a2 = last ? nA : cA + (size_t)(t + 2) * kstep; const char* b2 = last ? nB : cB + (size_t)(t + 2) * kstep;
            const char* a3 = a2 + kstep; const char* b3 = b2 + kstep;
            if (last && has_next) S.a_ready(nxt);
            if constexpr (SP2) {
            PG8_LDB(B0, 0, 0); PG8_LDB(B1, 0, 1); PG8_SCHED; PG8_LDA(At, 0, 0); PG8_STAGE(PG8_SA(1, 1), a1 + hstep, voffA);
            PG8_WAIT_V(8); PG8_WAIT_L(0); PG8_BAR; PG8_MMA(0, 0, At, B0); PG8_MMA(0, 1, At, B1); PG8_BAR; PG8_SCHED;
            PG8_LDA(At, 0, 1); PG8_STAGE(PG8_SB(0, 0), b2, voffB); PG8_STAGE(PG8_SB(0, 1), b2 + hstep, voffB); PG8_STAGE(PG8_SA(0, 0), a2, voffA);
            PG8_WAIT_V(8); PG8_WAIT_L(0); PG8_BAR; PG8_MMA(1, 0, At, B0); PG8_MMA(1, 1, At, B1); PG8_BAR; PG8_SCHED;
            PG8_LDB(B0, 1, 0); PG8_LDB(B1, 1, 1); PG8_SCHED; PG8_LDA(At, 1, 0); PG8_STAGE(PG8_SA(0, 1), a2 + hstep, voffA);
            PG8_WAIT_V(8); PG8_WAIT_L(0); PG8_BAR; PG8_MMA(0, 0, At, B0); PG8_MMA(0, 1, At, B1); PG8_BAR; PG8_SCHED;
            PG8_LDA(At, 1, 1); PG8_STAGE(PG8_SB(1, 0), b3, voffB); PG8_STAGE(PG8_SB(1, 1), b3 + hstep, voffB); PG8_STAGE(PG8_SA(1, 0), a3, voffA);
            PG8_WAIT_V(8); PG8_WAIT_L(0); PG8_BAR; PG8_MMA(1, 0, At, B0); PG8_MMA(1, 1, At, B1); PG8_BAR; PG8_SCHED;
            } else {
            PG8_LDB(B0, 0, 0); PG8_SCHED; PG8_LDA(At, 0, 0); PG8_STAGE(PG8_SA(1, 1), a1 + hstep, voffA);
            PG8_WAIT_L(8); PG8_BAR; PG8_WAIT_L(0); PG8_MMA(0, 0, At, B0); PG8_BAR; PG8_SCHED;
            PG8_LDB(B1, 0, 1); PG8_STAGE(PG8_SB(0, 0), b2, voffB);
            PG8_BAR; PG8_WAIT_L(0); PG8_MMA(0, 1, At, B1); PG8_BAR;
            PG8_LDA(At, 0, 1); PG8_STAGE(PG8_SA(0, 0), a2, voffA);
            PG8_BAR; PG8_WAIT_L(0); PG8_MMA(1, 0, At, B0); PG8_BAR; PG8_SCHED;
            PG8_STAGE(PG8_SB(0, 1), b2 + hstep, voffB);
            PG8_WAIT_V(6); PG8_BAR; PG8_MMA(1, 1, At, B1); PG8_BAR;
            PG8_LDB(B0, 1, 0); PG8_SCHED; PG8_LDA(At, 1, 0); PG8_STAGE(PG8_SA(0, 1), a2 + hstep, voffA);
            PG8_WAIT_L(8); PG8_BAR; PG8_WAIT_L(0); PG8_MMA(0, 0, At, B0); PG8_BAR; PG8_SCHED;
            PG8_LDB(B1, 1, 1); PG8_STAGE(PG8_SB(1, 0), b3, voffB);
            PG8_BAR; PG8_WAIT_L(0); PG8_MMA(0, 1, At, B1); PG8_BAR;
            PG8_LDA(At, 1, 1); PG8_STAGE(PG8_SA(1, 0), a3, voffA);
            PG8_BAR; PG8_WAIT_L(0); PG8_MMA(1, 0, At, B0); PG8_BAR; PG8_SCHED;
            PG8_STAGE(PG8_SB(1, 1), b3 + hstep, voffB);
            PG8_WAIT_V(6); PG8_BAR; PG8_MMA(1, 1, At, B1); PG8_BAR;
            }
        }
        if constexpr (ALIGN_EPI) { if (wr == 0) PG8_BAR; }
        if constexpr (!Epi::AFTER_DRAIN) { E(acc, cur, wr, wc, fr, fq); S.done(cur); }
        if (!has_next) break;
#pragma unroll
        for (int a = 0; a < 2; ++a)
#pragma unroll
            for (int b = 0; b < 2; ++b)
#pragma unroll
                for (int m = 0; m < 4; ++m)
#pragma unroll
                    for (int n = 0; n < 2; ++n) acc[a][b][m][n] = (f32x4){0.f, 0.f, 0.f, 0.f};
        cur = nxt; cA = nA; cB = nB; ++ui;
        if constexpr (ALIGN_EPI) { if (wr == 1) PG8_BAR; }
    }
    PG8_WAIT_V(0);
    if constexpr (!ALIGN_EPI) { if (wr == 0) PG8_BAR; }
    PG8_BAR;
    if constexpr (Epi::AFTER_DRAIN) { E.fused(acc, cur, wr, wc, fr, fq, lds, wid, lane); S.done(cur); }
#undef PG8_SA
#undef PG8_SB
#undef PG8_STAGE
#undef PG8_LDA
#undef PG8_LDB
#undef PG8_MMA
#undef PG8_WAIT_V
#undef PG8_WAIT_L
#undef PG8_BAR
#undef PG8_SCHED
}
}

struct Params {
    const float *x, *c, *ctx, *c_ctx, *ada_w, *ada_b, *norm1_g, *norm2_g, *w_in, *pool_w, *pool_scale, *na_rpb, *swa_sink, *wba, *wbb, *wbc, *w_out, *peer_wq, *peer_keys, *peer_u, *peer_v, *final_g;
    float* out; unsigned char* ws;
};
#define TID (opaque_tid(WV))
#define BID ((int)blockIdx.x)
#define NBLK ((int)gridDim.x)

__device__ __forceinline__ void tr_tiles(const float* __restrict__ W, bf16_t* __restrict__ Wt, int K, int N, float* tile  , const int WV) {
    const int ntn = N / 64, ntiles = (K / 128) * ntn, tid = TID;
    for (int vb = BID; vb < ntiles; vb += NBLK) {
        const int k0 = (vb / ntn) * 128, n0 = (vb % ntn) * 64;
        float4 v[4];
#pragma unroll
        for (int i = 0; i < 4; ++i) { const int idx = tid + i * NTHREADS, r = idx >> 4, c4 = (idx & 15) * 4; v[i] = *(const float4*)(W + (size_t)(k0 + r) * N + n0 + c4); }
#pragma unroll
        for (int i = 0; i < 4; ++i) { const int idx = tid + i * NTHREADS, r = idx >> 4, c4 = (idx & 15) * 4; float* tp = tile + r * 65 + c4; tp[0] = v[i].x; tp[1] = v[i].y; tp[2] = v[i].z; tp[3] = v[i].w; }
        __syncthreads();
#pragma unroll
        for (int i = 0; i < 2; ++i) { const int idx = tid + i * NTHREADS, nn = idx >> 4, kg = (idx & 15) * 8; const float* tp = tile + kg * 65 + nn;
            uint4 o; o.x = pk2(tp[0], tp[65]); o.y = pk2(tp[130], tp[195]); o.z = pk2(tp[260], tp[325]); o.w = pk2(tp[390], tp[455]);
            *(uint4*)(Wt + (size_t)(n0 + nn) * K + k0 + kg) = o; }
        __syncthreads();
    }
}
__device__ __forceinline__ void conv_bf16(const float* __restrict__ src, bf16_t* __restrict__ dst, size_t n8, const int WV) {
    for (size_t i = (size_t)BID * NTHREADS + TID; i < n8; i += (size_t)NBLK * NTHREADS) {
        const float4 a = ((const float4*)src)[2 * i], b = ((const float4*)src)[2 * i + 1];
        uint4 o; o.x = pk2(a.x, a.y); o.y = pk2(a.z, a.w); o.z = pk2(b.x, b.y); o.w = pk2(b.z, b.w);
        ((uint4*)dst)[i] = o;
    }
}
__device__ __forceinline__ void conv_fp8_rows(const float* __restrict__ src, unsigned* __restrict__ dst, float* __restrict__ inv, int nrows, const int WV, int vblk = -1, int nvblk = 0) {
    const int tid = TID, lane = tid & 63;
    const int gw = (vblk >= 0 ? vblk : BID) * 8 + (tid >> 6), gstride = (vblk >= 0 ? nvblk : NBLK) * 8;
    for (int row = gw; row < nrows; row += gstride) {
        const float4* sp = (const float4*)(src + (size_t)row * D);
        float4 v[4]; float amax = 0.f;
#pragma unroll
        for (int i = 0; i < 4; ++i) { v[i] = sp[i * 64 + lane]; amax = fmaxf(amax, fmaxf(fmaxf(fabsf(v[i].x), fabsf(v[i].y)), fmaxf(fabsf(v[i].z), fabsf(v[i].w)))); }
#pragma unroll
        for (int o = 32; o > 0; o >>= 1) amax = fmaxf(amax, __shfl_xor(amax, o));
        const int k = (int)((__float_as_uint(amax) >> 23) & 255u) - 127;
        const bool ok = amax > 1e-30f;
        const float s = ok ? __uint_as_float((unsigned)(127 + 7 - k) << 23) : 1.f;
#pragma unroll
        for (int i = 0; i < 4; ++i) { int w = __builtin_amdgcn_cvt_pk_fp8_f32(v[i].x * s, v[i].y * s, 0, false); w = __builtin_amdgcn_cvt_pk_fp8_f32(v[i].z * s, v[i].w * s, w, true);
            dst[(size_t)row * 256 + i * 64 + lane] = (unsigned)w; }
        if (lane == 0) inv[row] = ok ? __uint_as_float((unsigned)(127 - 7 + k) << 23) : 1.f;
    }
}
__device__ __forceinline__ void copy_f4(const float* __restrict__ src, float* __restrict__ dst, size_t n4, const int WV) {
    for (size_t i = (size_t)BID * NTHREADS + TID; i < n4; i += (size_t)NBLK * NTHREADS) ((float4*)dst)[i] = ((const float4*)src)[i];
}
__device__ __forceinline__ void ph_prep(const Params& p, float* smem, const int WV) {
    unsigned char* ws = p.ws;
    for (int l = 0; l < 2; ++l) {
        unsigned char* wl = ws + WS_W + l * W_LAYER;
        tr_tiles(p.w_in + (size_t)l * D * IN_COLS, (bf16_t*)(wl + W_WIN), D, IN_COLS, smem, WV);
        tr_tiles(p.wbb + (size_t)l * 512 * D, (bf16_t*)(wl + W_WB), 512, D, smem, WV);
        tr_tiles(p.wbc + (size_t)l * 512 * D, (bf16_t*)(wl + W_WC), 512, D, smem, WV);
        tr_tiles(p.w_out + (size_t)l * D * D, (bf16_t*)(wl + W_WO), D, D, smem, WV);
        tr_tiles(p.peer_wq + (size_t)l * D * 2048, (bf16_t*)(wl + W_WQ), D, 2048, smem, WV);
        {
            const float* pw = p.pool_w + (size_t)l * 4 * 128 * 128; const float* ps = p.pool_scale + l * 512; const float* wba = p.wba + (size_t)l * 512 * D; bf16_t* WaT = (bf16_t*)(wl + W_WA);
            for (int idx = BID * NTHREADS + TID; idx < 512 * D; idx += NBLK * NTHREADS) {
                const int n = idx % D, kk = idx / D, g = kk / 128, c = kk % 128;
                float acc = 0.f;
                for (int e = 0; e < 128; ++e) acc += pw[(g * 128 + c) * 128 + e] * ps[g * 128 + e] * wba[(size_t)(g * 128 + e) * D + n];
                WaT[(size_t)n * 512 + kk] = f2bf(acc);
            }
        }
        conv_bf16(p.peer_keys + (size_t)l * 8 * 2 * 128 * 128, (bf16_t*)(wl + W_KEYS), (size_t)8 * 2 * 128 * 128 / 8, WV);
        if (l == 0 && !FP8_L0) {
            conv_bf16(p.peer_u, (bf16_t*)(ws + WS_TAB0), (size_t)NEXP * D / 8, WV);
            conv_bf16(p.peer_v, (bf16_t*)(ws + WS_TAB0) + (size_t)NEXP * D, (size_t)NEXP * D / 8, WV);
        }
    }
    {
        float* sv = smem; float* part = smem + 5 * 1024; float* mod = (float*)(ws + WS_MOD);
        const int tid = TID, lane = tid & 63, wid = tid >> 6;
        for (int vb = BID; vb < 2 * 96; vb += NBLK) {
            const int l = vb / 96, j0 = (vb % 96) * 64;
            for (int i = tid; i < 5 * 1024; i += NTHREADS) { const int r = i >> 10, k = i & 1023; const float v = r < 4 ? p.c[r * 1024 + k] : p.c_ctx[k]; sv[i] = v / (1.f + __expf(-v)); }
            __syncthreads();
            float a0 = 0.f, a1 = 0.f, a2 = 0.f, a3 = 0.f, a4 = 0.f;
            const float* w = p.ada_w + ((size_t)l * 1024 + wid * 128) * 6144 + j0 + lane;
#pragma unroll 16
            for (int k = 0; k < 128; ++k) { const float xw = w[(size_t)k * 6144]; const int kk = wid * 128 + k;
                a0 += sv[kk] * xw; a1 += sv[1024 + kk] * xw; a2 += sv[2048 + kk] * xw; a3 += sv[3072 + kk] * xw; a4 += sv[4096 + kk] * xw; }
            part[(wid * 5 + 0) * 64 + lane] = a0; part[(wid * 5 + 1) * 64 + lane] = a1; part[(wid * 5 + 2) * 64 + lane] = a2; part[(wid * 5 + 3) * 64 + lane] = a3; part[(wid * 5 + 4) * 64 + lane] = a4;
            __syncthreads();
            if (tid < 320) { const int r = tid >> 6; float s = 0.f;
#pragma unroll
                for (int w8 = 0; w8 < 8; ++w8) s += part[(w8 * 5 + r) * 64 + lane];
                mod[((size_t)l * 5 + r) * 6144 + j0 + lane] = s + p.ada_b[l * 6144 + j0 + lane]; }
            __syncthreads();
        }
    }
    {
        float* tab = (float*)(ws + WS_ROPE);
        for (int i = BID * NTHREADS + TID; i < 1024; i += NBLK * NTHREADS) { const int pos = i / 16, fi = i % 16; const float inv = powf(10000.0f, -(float)fi / 16.0f), ang = (float)pos * inv; tab[i] = cosf(ang); tab[1024 + i] = sinf(ang); }
    }
}

typedef float f32x2v __attribute__((ext_vector_type(2)));
__device__ __forceinline__ float wave_sum(float v) {
#pragma unroll
    for (int o = 32; o > 0; o >>= 1) v += __shfl_xor(v, o);
    return v;
}
__device__ __forceinline__ void ph_norm_mod(const float* __restrict__ Xl, const float* __restrict__ Xc, const float* __restrict__ g, const float* __restrict__ modl, int shift_idx, int scale_idx, bf16_t* __restrict__ H, int nrows, unsigned* __restrict__ H8, const int WV) {
    const int lane = TID & 63, gw = BID * 8 + (TID >> 6);
    for (int row = gw; row < nrows; row += NBLK * 8) {
        const float* src = row < T_LAT ? Xl + (size_t)row * D : Xc + (size_t)(row - T_LAT) * D;
        const int mrow = row < T_LAT ? row / S : 4;
        float4 v[4]; float ss = 0.f;
#pragma unroll
        for (int i = 0; i < 4; ++i) { v[i] = ((const float4*)src)[i * 64 + lane]; ss += v[i].x * v[i].x + v[i].y * v[i].y + v[i].z * v[i].z + v[i].w * v[i].w; }
        ss = wave_sum(ss);
        const float rstd = rsqrtf(ss * (1.0f / D) + EPS);
        const float* sh = modl + (size_t)mrow * 6144 + shift_idx * 1024; const float* sc = modl + (size_t)mrow * 6144 + scale_idx * 1024;
#pragma unroll
        for (int i = 0; i < 4; ++i) { const int k = (i * 64 + lane) * 4;
            const float4 gg = *(const float4*)(g + k), s4 = *(const float4*)(sc + k), h4 = *(const float4*)(sh + k);
            uint2 w; w.x = pk2(v[i].x * rstd * gg.x * (1.f + s4.x) + h4.x, v[i].y * rstd * gg.y * (1.f + s4.y) + h4.y);
            w.y = pk2(v[i].z * rstd * gg.z * (1.f + s4.z) + h4.z, v[i].w * rstd * gg.w * (1.f + s4.w) + h4.w);
            *(uint2*)(H + (size_t)row * D + k) = w;
            if (H8) {
                const float h0 = 8.f * lo16(w.x), h1 = 8.f * hi16(w.x), h2 = 8.f * lo16(w.y), h3 = 8.f * hi16(w.y);
                int hi = __builtin_amdgcn_cvt_pk_fp8_f32(h0, h1, 0, false); hi = __builtin_amdgcn_cvt_pk_fp8_f32(h2, h3, hi, true);
                const f32x2v d0 = __builtin_amdgcn_cvt_pk_f32_fp8(hi, false), d1 = __builtin_amdgcn_cvt_pk_f32_fp8(hi, true);
                int lo = __builtin_amdgcn_cvt_pk_fp8_f32(h0 - d0[0], h1 - d0[1], 0, false); lo = __builtin_amdgcn_cvt_pk_fp8_f32(h2 - d1[0], h3 - d1[1], lo, true);
                H8[(size_t)row * 256 + i * 64 + lane] = (unsigned)hi; H8[(size_t)T_ALL * 256 + (size_t)row * 256 + i * 64 + lane] = (unsigned)lo; } }
    }
}
__device__ __forceinline__ void ph_pool(const bf16_t* __restrict__ Z, bf16_t* __restrict__ Pa, int rows, int tid) {
    for (int idx = BID * NTHREADS + tid; idx < rows * 64; idx += NBLK * NTHREADS) {
        const int c8 = idx & 63, row = idx >> 6, g = c8 >> 4, w = 2 << g;
        const bool lat = row < T_LAT; const int len = lat ? S : L; const int t = lat ? (row & (S - 1)) : ((row - T_LAT) & (L - 1)); const int base = row - t;
        int lo = t - w / 2; if (lo < 0) lo = 0; int hi = t - w / 2 + w; if (hi > len) hi = len;
        float sum[8];
#pragma unroll
        for (int i = 0; i < 8; ++i) sum[i] = 0.f;
        const bf16_t* zp = Z + (size_t)base * IN_COLS + OFF_A + c8 * 8;
        for (int tt = lo; tt < hi; ++tt) { const uint4 v = *(const uint4*)(zp + (size_t)tt * IN_COLS);
            sum[0] += lo16(v.x); sum[1] += hi16(v.x); sum[2] += lo16(v.y); sum[3] += hi16(v.y); sum[4] += lo16(v.z); sum[5] += hi16(v.z); sum[6] += lo16(v.w); sum[7] += hi16(v.w); }
        const uint4 sv = *(const uint4*)(zp + (size_t)t * IN_COLS); const float inv = 1.f / (float)(hi - lo);
        uint4 o; o.x = pk2(sum[0] * inv - lo16(sv.x), sum[1] * inv - hi16(sv.x)); o.y = pk2(sum[2] * inv - lo16(sv.y), sum[3] * inv - hi16(sv.y));
        o.z = pk2(sum[4] * inv - lo16(sv.z), sum[5] * inv - hi16(sv.z)); o.w = pk2(sum[6] * inv - lo16(sv.w), sum[7] * inv - hi16(sv.w));
        *(uint4*)(Pa + (size_t)row * 512 + c8 * 8) = o;
    }
}
typedef short bf16x8v __attribute__((ext_vector_type(8)));
typedef float f32x4v __attribute__((ext_vector_type(4)));
constexpr float LOG2E = 1.4426950408889634f;
constexpr float QK_SCALE2 = 0.125f * LOG2E;
constexpr float MASKED = -3.0e38f;
__device__ __forceinline__ unsigned cvtpk(float lo, float hi) { unsigned r; asm volatile("v_cvt_pk_bf16_f32 %0, %1, %2" : "=v"(r) : "v"(lo), "v"(hi)); return r; }
__device__ __forceinline__ f32x4v mfma16(bf16x8v a, bf16x8v b, f32x4v c) { return __builtin_amdgcn_mfma_f32_16x16x32_bf16(a, b, c, 0, 0, 0); }
struct AttnSt { f32x4v o[4]; float m, l; };
__device__ __forceinline__ int clampi(int v, int lo, int hi) { return v < lo ? lo : (v > hi ? hi : v); }
template <class Dsc> __device__ __forceinline__ void attn_load_k(const Dsc& dsc, int c, bf16x8v (&kf)[2][2]) {
#pragma unroll
    for (int tt = 0; tt < 2; ++tt) { const bf16_t* kb = dsc.kbase(c); const unsigned ko = dsc.koff(c, tt); kf[tt][0] = *(const bf16x8v*)(kb + ko); kf[tt][1] = *(const bf16x8v*)(kb + (ko + 32u)); }
}
template <class Dsc> __device__ __forceinline__ void attn_load_v(const Dsc& dsc, int c, bf16x8v (&vf)[4]) {
    const bf16_t* vb = dsc.vbase(c); const unsigned vo = dsc.voff(c); const unsigned vs = dsc.vstride16();
#pragma unroll
    for (int dt = 0; dt < 4; ++dt) vf[dt] = *(const bf16x8v*)(vb + (size_t)(dt * vs) + vo);
}
template <int VAR, class Dsc>
__device__ __forceinline__ void attn_chunk4(const Dsc& dsc, int c, int cnext, bf16x8v (&kf)[2][2], const bf16x8v (&vf)[4], const bf16x8v (&qf)[4][2], AttnSt (&st)[4], int lane) {
    unsigned pk[4][4]; float al[4]; bool tl[4];
#pragma unroll
    for (int t = 0; t < 4; ++t) {
        tl[t] = dsc.tile_live(t, c);
        f32x4v s[2];
        if (tl[t]) {
#pragma unroll
            for (int tt = 0; tt < 2; ++tt) { f32x4v acc = (f32x4v){0.f, 0.f, 0.f, 0.f}; if (VAR != 4) { acc = mfma16(kf[tt][0], qf[t][0], acc); acc = mfma16(kf[tt][1], qf[t][1], acc); } else { acc[0] = (float)(c + tt); acc[1] = acc[0] + 1.f; acc[2] = acc[0] * 0.5f; acc[3] = acc[0] - 1.f; } s[tt] = acc; }
        }
        if (t == 3 && VAR != 4) { __builtin_amdgcn_sched_barrier(0); attn_load_k(dsc, cnext, kf); __builtin_amdgcn_sched_barrier(0); }
        al[t] = 1.0f;
        if (!tl[t]) continue;
#pragma unroll
        for (int tt = 0; tt < 2; ++tt)
#pragma unroll
            for (int r = 0; r < 4; ++r) s[tt][r] = (VAR == 5) ? s[tt][r] * QK_SCALE2 : dsc.score(t, c, tt, r, s[tt][r]);
        float gmax = fmaxf(fmaxf(fmaxf(s[0][0], s[0][1]), fmaxf(s[0][2], s[0][3])), fmaxf(fmaxf(s[1][0], s[1][1]), fmaxf(s[1][2], s[1][3])));
        if (__any(gmax > st[t].m + 8.0f)) {
            if (VAR != 2) { gmax = fmaxf(gmax, __shfl_xor(gmax, 16)); gmax = fmaxf(gmax, __shfl_xor(gmax, 32)); }
            const float mnew = fmaxf(st[t].m, gmax), alpha = __builtin_amdgcn_exp2f(st[t].m - mnew);
            st[t].m = mnew; al[t] = alpha; st[t].l *= alpha;
        }
        const float mref = st[t].m;
        float psum = 0.f;
#pragma unroll
        for (int tt = 0; tt < 2; ++tt)
#pragma unroll
            for (int r = 0; r < 4; ++r) { const float pv = (VAR == 1) ? (s[tt][r] - mref) : __builtin_amdgcn_exp2f(s[tt][r] - mref); s[tt][r] = pv; psum += pv; }
        st[t].l += psum;
        pk[t][0] = cvtpk(s[0][0], s[0][1]); pk[t][1] = cvtpk(s[0][2], s[0][3]); pk[t][2] = cvtpk(s[1][0], s[1][1]); pk[t][3] = cvtpk(s[1][2], s[1][3]);
    }
    __builtin_amdgcn_sched_barrier(0);
#pragma unroll
    for (int t = 0; t < 4; ++t) {
        if (!tl[t]) continue;
        if (!__all(al[t] == 1.0f)) {
            const int gb = (lane >> 4) * 4;
#pragma unroll
            for (int r = 0; r < 4; ++r) { const float ar = (VAR == 2) ? al[t] : __shfl(al[t], gb + r);
#pragma unroll
                for (int dt = 0; dt < 4; ++dt) st[t].o[dt][r] *= ar; }
        }
        union { unsigned u[4]; bf16x8v v; } pf;
        pf.u[0] = pk[t][0]; pf.u[1] = pk[t][1]; pf.u[2] = pk[t][2]; pf.u[3] = pk[t][3];
#pragma unroll
        for (int dt = 0; dt < 4; ++dt) { if (VAR != 3) st[t].o[dt] = mfma16(pf.v, vf[dt], st[t].o[dt]); else st[t].o[dt][0] += __uint_as_float(pf.u[dt]); }
    }
}
template <int VAR, class Dsc>
__device__ __forceinline__ void attn_stream4(const Dsc& dsc, int nc, const bf16x8v (&qf)[4][2], AttnSt (&st)[4], int lane) {
    bf16x8v kf[2][2], vf[4];
    if (VAR == 3) { for (int dt = 0; dt < 4; ++dt) vf[dt] = qf[dt][0]; }
    attn_load_k(dsc, 0, kf);
#pragma unroll 1
    for (int c = 0; c < nc; ++c) {
        if (VAR != 3) attn_load_v(dsc, c, vf); __builtin_amdgcn_sched_barrier(0);
        attn_chunk4<VAR>(dsc, c, (c + 1 < nc) ? c + 1 : c, kf, vf, qf, st, lane); __builtin_amdgcn_sched_barrier(0);
    }
}
__device__ __forceinline__ void attn_finish(AttnSt& st, float sink2, bool has_sink, bf16_t* orow  , int lane) {
    float l = st.l; l += __shfl_xor(l, 16); l += __shfl_xor(l, 32);
    if (has_sink) l += __builtin_amdgcn_exp2f(sink2 - st.m);
    const float inv = 1.0f / l;
    const int gb = (lane >> 4) * 4, d = lane & 15;
#pragma unroll
    for (int r = 0; r < 4; ++r) { const float ir = __shfl(inv, gb + r);
#pragma unroll
        for (int dt = 0; dt < 4; ++dt) orow[(size_t)(gb + r) * 512 + dt * 16 + d] = f2bf(st.o[dt][r] * ir); }
}
__device__ __forceinline__ void attn_init_st(AttnSt& st) {
#pragma unroll
    for (int dt = 0; dt < 4; ++dt) st.o[dt] = (f32x4v){0.f, 0.f, 0.f, 0.f};
    st.m = -1.0e30f; st.l = 0.f;
}
struct Na4Dsc {
    const bf16_t* kb0;
    const bf16_t* vb0;
    const float* rpb;
    unsigned ko[2], vo;
    int dc0; float mk[8];
    int Rlo, r0, nrow;
    __device__ __forceinline__ int crow(int c) const { return c < nrow ? c : nrow - 1; }
    __device__ __forceinline__ const bf16_t* kbase(int c) const { return kb0 + (size_t)crow(c) * 64 * IN_COLS; }
    __device__ __forceinline__ unsigned koff(int, int tt) const { return ko[tt]; }
    __device__ __forceinline__ const bf16_t* vbase(int c) const { return vb0 + crow(c) * 64; }
    __device__ __forceinline__ unsigned voff(int) const { return vo; }
    __device__ __forceinline__ unsigned vstride16() const { return 16u * S; }
    __device__ __forceinline__ bool tile_live(int t, int c) const { const int R0 = clampi(r0 + t - 4, 0, 56), kr = Rlo + c; return c < nrow && kr >= R0 && kr <= R0 + 7; }
    __device__ __forceinline__ float score(int t, int c, int tt, int r, float raw) const {
        const float bias = rpb[(Rlo + c - (r0 + t) + 7) * 31 + dc0 + 4 * tt + r];
        return raw * QK_SCALE2 + bias + mk[tt * 4 + r];
    }
};
struct Ctx4Dsc {
    const bf16_t* kb0;
    const bf16_t* vb0;
    unsigned ko[2], vo;
    __device__ __forceinline__ const bf16_t* kbase(int c) const { return kb0 + (size_t)c * 32 * IN_COLS; }
    __device__ __forceinline__ unsigned koff(int, int tt) const { return ko[tt]; }
    __device__ __forceinline__ const bf16_t* vbase(int c) const { return vb0 + c * 32; }
    __device__ __forceinline__ unsigned voff(int) const { return vo; }
    __device__ __forceinline__ unsigned vstride16() const { return 16u * L; }
    __device__ __forceinline__ bool tile_live(int, int) const { return true; }
    __device__ __forceinline__ float score(int, int, int, int, float raw) const { return raw * QK_SCALE2; }
};
struct Swa4Dsc {
    const bf16_t* zrow;
    const bf16_t* vrow;
    int p0, kslot0, g8, qpos, dS;
    __device__ __forceinline__ const bf16_t* kbase(int) const { return zrow; }
    __device__ __forceinline__ unsigned koff(int c, int tt) const { const int pos = clampi(p0 - 128 + 32 * c + kslot0 + 4 * tt, 0, S - 1); return (unsigned)pos * (unsigned)IN_COLS + (unsigned)g8; }
    __device__ __forceinline__ const bf16_t* vbase(int) const { return vrow; }
    __device__ __forceinline__ unsigned voff(int c) const { const int pos = clampi(p0 - 128 + 32 * c + g8, 0, S - 8); return (unsigned)(dS + pos); }
    __device__ __forceinline__ unsigned vstride16() const { return 16u * S; }
    __device__ __forceinline__ bool tile_live(int, int c) const { const int pos0 = p0 - 128 + 32 * c; return c < 9 && pos0 + 31 >= 0 && pos0 < S; }
    __device__ __forceinline__ float score(int, int c, int tt, int r, float raw) const {
        const int pos0 = p0 - 128 + 32 * c;
        if (c >= 1 && c <= 7 && pos0 >= 0 && pos0 + 31 < S) return raw * QK_SCALE2;
        const int pos = pos0 + g8 + 4 * tt + r; const int dlt = qpos - pos;
        return (pos >= 0 && pos < S && dlt <= 128 && dlt >= -128) ? raw * QK_SCALE2 : MASKED;
    }
};
template <int VAR>
__device__ __forceinline__ void ph_attn(const bf16_t* __restrict__ Z, const bf16_t* __restrict__ vtn, const bf16_t* __restrict__ vtnc, const bf16_t* __restrict__ vtw, const bf16_t* __restrict__ vtwc,
                                        const float* __restrict__ rpb, const float* __restrict__ sink, bf16_t* __restrict__ Ob, bf16_t* __restrict__ Oc, bool do_ctx, float* smem, bf16_t* __restrict__ Pa, int rows, const int WV) {
    const int tid = TID, lane = tid & 63, wid = tid >> 6;
    for (int i = tid; i < 8 * 465 + 64; i += NTHREADS) smem[i] = (i >= 16 && i < 16 + 8 * 465) ? rpb[i - 16] * LOG2E : 0.f;
    if (VAR == 0) ph_pool(Z, Pa, rows, tid);
    __syncthreads();
    const int q = lane & 15, g = lane >> 4, kslot0 = (q >> 2) * 8 + (q & 3);
    const int wu = __builtin_amdgcn_readfirstlane(wid);
    const int vcu = (NBLK % 8 == 0) ? (BID % 8) * (NBLK / 8) + BID / 8 : BID;
    const int nunits = 2048 + 2048 + (do_ctx ? 256 : 0);
    const unsigned ko0 = (unsigned)kslot0 * IN_COLS + 8u * g, ko1 = ko0 + 4u * IN_COLS, qo = (unsigned)q * IN_COLS + 8u * g;
    for (int uu = vcu * 8 + wu; uu < nunits; uu += NBLK * 8) {
        const int u = uu >= 4096 ? uu : (((uu & 255) < 128) ? ((uu >> 8) * 128 + (uu & 127)) : (2048 + (uu >> 8) * 128 + (uu & 127)));
        AttnSt st[4]; bf16x8v qf[4][2];
#pragma unroll
        for (int t = 0; t < 4; ++t) attn_init_st(st[t]);
        if (u < 2048) {
            const int cb = u & 3, r4 = (u >> 2) & 15, h = (u >> 6) & 7, b = u >> 9, r0 = r4 * 4;
            const int Rlo = clampi(r0 - 4, 0, 56), Rhi = clampi(r0 + 3 - 4, 0, 56) + 7, nrow = Rhi - Rlo + 1;
            const int C0 = clampi(cb * 16 - 8, 0, 32), qc = cb * 16 + q;
            const size_t t0 = (size_t)b * S + r0 * GW + cb * 16;
            const bf16_t* qp = Z + t0 * IN_COLS + OFF_QN + h * 64;
#pragma unroll
            for (int t = 0; t < 4; ++t) { qf[t][0] = *(const bf16x8v*)(qp + (size_t)t * GW * IN_COLS + qo); qf[t][1] = *(const bf16x8v*)(qp + (size_t)t * GW * IN_COLS + (qo + 32u)); }
            Na4Dsc dl; dl.kb0 = Z + ((size_t)b * S + Rlo * GW + C0) * IN_COLS + OFF_KN + h * 64;
            dl.vb0 = vtn + (size_t)(b * 8 + h) * 64 * S + Rlo * GW + C0; dl.rpb = smem + 16 + h * 465;
            dl.ko[0] = ko0; dl.ko[1] = ko1; dl.vo = (unsigned)q * S + 8u * g;
            dl.dc0 = C0 + 8 * g - qc + 15; dl.Rlo = Rlo; dl.r0 = r0; dl.nrow = nrow;
            { const int qs = clampi(qc - 8, 0, 48);
#pragma unroll
              for (int j = 0; j < 8; ++j) { const int kc = C0 + 8 * g + j; dl.mk[j] = (kc >= qs && kc < qs + 16) ? 0.f : MASKED; } }
            attn_stream4<VAR>(dl, nrow, qf, st, lane);
            Ctx4Dsc dc; dc.kb0 = Z + ((size_t)T_LAT + b * L) * IN_COLS + OFF_KN + h * 64; dc.vb0 = vtnc + (size_t)(b * 8 + h) * 64 * L;
            dc.ko[0] = ko0; dc.ko[1] = ko1; dc.vo = (unsigned)q * L + 8u * g;
            attn_stream4<VAR>(dc, 8, qf, st, lane);
#pragma unroll
            for (int t = 0; t < 4; ++t) attn_finish(st[t], 0.f, false, Ob + (t0 + (size_t)t * GW) * 512 + h * 64, lane);
        } else if (u < 4096) {
            const int v = u - 2048, qt = v & 255, g2 = (v >> 8) & 1, b = v >> 9, p0 = qt * 16;
            const size_t t0 = (size_t)b * S + p0;
            const bf16_t* qp = Z + t0 * IN_COLS + OFF_QW + g2 * 256;
#pragma unroll
            for (int t = 0; t < 4; ++t) { qf[t][0] = *(const bf16x8v*)(qp + t * 64 + qo); qf[t][1] = *(const bf16x8v*)(qp + t * 64 + (qo + 32u)); }
            Swa4Dsc dl; dl.zrow = Z + (size_t)b * S * IN_COLS + OFF_KW + g2 * 64; dl.vrow = vtw + (size_t)(b * 2 + g2) * 64 * S;
            dl.p0 = p0; dl.kslot0 = kslot0; dl.g8 = 8 * g; dl.qpos = p0 + q; dl.dS = q * S;
            attn_stream4<VAR>(dl, 9, qf, st, lane);
            Ctx4Dsc dc; dc.kb0 = Z + ((size_t)T_LAT + b * L) * IN_COLS + OFF_KW + g2 * 64; dc.vb0 = vtwc + (size_t)(b * 2 + g2) * 64 * L;
            dc.ko[0] = ko0; dc.ko[1] = ko1; dc.vo = (unsigned)q * L + 8u * g;
            attn_stream4<VAR>(dc, 8, qf, st, lane);
#pragma unroll
            for (int t = 0; t < 4; ++t) attn_finish(st[t], sink[g2 * 4 + t] * LOG2E, true, Oc + t0 * 512 + (g2 * 4 + t) * 64, lane);
        } else {
            const int v = u - 4096, which = v >> 7;
            if (which == 0) {
                const int qt4 = v & 3, h = (v >> 2) & 7, b = (v >> 5) & 3;
                const size_t t0 = (size_t)T_LAT + b * L + qt4 * 64;
                const bf16_t* qp = Z + t0 * IN_COLS + OFF_QN + h * 64;
#pragma unroll
                for (int t = 0; t < 4; ++t) { qf[t][0] = *(const bf16x8v*)(qp + (size_t)t * 16 * IN_COLS + qo); qf[t][1] = *(const bf16x8v*)(qp + (size_t)t * 16 * IN_COLS + (qo + 32u)); }
                Ctx4Dsc dc; dc.kb0 = Z + ((size_t)T_LAT + b * L) * IN_COLS + OFF_KN + h * 64; dc.vb0 = vtnc + (size_t)(b * 8 + h) * 64 * L;
                dc.ko[0] = ko0; dc.ko[1] = ko1; dc.vo = (unsigned)q * L + 8u * g;
                attn_stream4<VAR>(dc, 8, qf, st, lane);
#pragma unroll
                for (int t = 0; t < 4; ++t) attn_finish(st[t], 0.f, false, Ob + (t0 + t * 16) * 512 + h * 64, lane);
            } else {
                const int w = v - 128, qt = w & 15, g2 = (w >> 4) & 1, b = (w >> 5) & 3;
                const size_t t0 = (size_t)T_LAT + b * L + qt * 16;
                const bf16_t* qp = Z + t0 * IN_COLS + OFF_QW + g2 * 256;
#pragma unroll
                for (int t = 0; t < 4; ++t) { qf[t][0] = *(const bf16x8v*)(qp + t * 64 + qo); qf[t][1] = *(const bf16x8v*)(qp + t * 64 + (qo + 32u)); }
                Ctx4Dsc dc; dc.kb0 = Z + ((size_t)T_LAT + b * L) * IN_COLS + OFF_KW + g2 * 64; dc.vb0 = vtwc + (size_t)(b * 2 + g2) * 64 * L;
                dc.ko[0] = ko0; dc.ko[1] = ko1; dc.vo = (unsigned)q * L + 8u * g;
                attn_stream4<VAR>(dc, 8, qf, st, lane);
#pragma unroll
                for (int t = 0; t < 4; ++t) attn_finish(st[t], sink[g2 * 4 + t] * LOG2E, true, Oc + t0 * 512 + (g2 * 4 + t) * 64, lane);
            }
        }
    }
}

__device__ __forceinline__ int f2key(float v) { const int b = __float_as_int(v); return b ^ ((b >> 31) & 0x7fffffff); }
__device__ __forceinline__ float key2f(int k) { return __int_as_float(k ^ ((k >> 31) & 0x7fffffff)); }
__device__ __forceinline__ float embed(float v, unsigned mask, unsigned code) { return __uint_as_float((__float_as_uint(v) & ~mask) | code); }
template <int N> __device__ __forceinline__ void bitonic_merge_desc(int (&a)[N]) {
#pragma unroll
    for (int j = N >> 1; j > 0; j >>= 1)
#pragma unroll
        for (int i = 0; i < N; ++i) { const int l = i ^ j; if (l > i) { const int hi = max(a[i], a[l]), lo = min(a[i], a[l]); a[i] = hi; a[l] = lo; } }
}
template <int N> __device__ __forceinline__ void bitonic_sort_desc(int (&a)[N]) {
#pragma unroll
    for (int k = 2; k <= N; k <<= 1)
#pragma unroll
        for (int j = k >> 1; j > 0; j >>= 1)
#pragma unroll
            for (int i = 0; i < N; ++i) { const int l = i ^ j; if (l > i) { const int hi = max(a[i], a[l]), lo = min(a[i], a[l]); if ((i & k) == 0) { a[i] = hi; a[l] = lo; } else { a[i] = lo; a[l] = hi; } } }
}
__device__ __forceinline__ void xlane_top16(int (&h)[16], int mask) {
    int m[16];
#pragma unroll
    for (int i = 0; i < 16; ++i) m[i] = max(h[i], __shfl_xor(h[15 - i], mask));
    bitonic_merge_desc<16>(m);
#pragma unroll
    for (int i = 0; i < 16; ++i) h[i] = m[i];
}
__device__ __forceinline__ void ph_peer_topk(const bf16_t* __restrict__ Q, const bf16_t* __restrict__ keys, int* __restrict__ eidx, float* __restrict__ egate, int rows, float* smem, const int WV) {
    const int tid = TID, lane = tid & 63, wid = tid >> 6, n = lane & 15, g = lane >> 4;
    unsigned char* kl = (unsigned char*)smem;
    int* lidx = (int*)(kl + 65536) + wid * 512;
    const int KNEG = (int)0x80000001;
    const int ngroups = rows / 16, npass = ((ngroups + 7) / 8) * 8;
    const int wu = __builtin_amdgcn_readfirstlane(wid);
    for (int ps = BID; ps < npass; ps += NBLK) {
        const int h = ps & 7, grp = (ps >> 3) * 8 + wu;
        __syncthreads();
        {   const uint4* src = (const uint4*)(keys + (size_t)h * 2 * 128 * 128);
#pragma unroll
            for (int i = 0; i < 8; ++i) { const int cid = tid + i * NTHREADS; const uint4 v = src[cid]; const int row = (cid >> 4) & 127, ch = cid & 15;
                *(uint4*)(kl + ((cid >> 4) * 256 + ((ch ^ (row & 15)) << 4))) = v; }
        }
        __syncthreads();
        if (grp >= ngroups) continue;
        const int t0 = grp * 16;
        float tops[2][16];
        bf16x8v qfa[2][4];
        { const bf16_t* qb = Q + (size_t)t0 * 2048 + h * 256; const unsigned qof = (unsigned)n * 2048u + 8u * g;
#pragma unroll
          for (int pp = 0; pp < 2; ++pp)
#pragma unroll
            for (int ks = 0; ks < 4; ++ks) qfa[pp][ks] = *(const bf16x8v*)(qb + (qof + pp * 128 + ks * 32)); }
#pragma unroll
        for (int pp = 0; pp < 2; ++pp) {
            const bf16x8v (&qf)[4] = qfa[pp];
            int ka_[2][16];
#pragma unroll
            for (int T = 0; T < 8; ++T) {
                f32x4v acc = (f32x4v){0.f, 0.f, 0.f, 0.f};
#pragma unroll
                for (int ks = 0; ks < 4; ++ks) {
                    const bf16x8v a = *(const bf16x8v*)(kl + ((pp * 128 + T * 16 + n) * 256 + (((ks * 4 + g) ^ n) << 4)));
                    acc = mfma16(a, qf[ks], acc); }
#pragma unroll
                for (int r = 0; r < 4; ++r) ka_[T >> 2][(T & 3) * 4 + r] = f2key(embed(acc[r], 127u, (unsigned)(T * 16 + 4 * g + r)));
            }
            bitonic_sort_desc<16>(ka_[0]); bitonic_sort_desc<16>(ka_[1]);
            int hh[16];
#pragma unroll
            for (int i = 0; i < 16; ++i) hh[i] = max(ka_[0][i], ka_[1][15 - i]);
            bitonic_merge_desc<16>(hh);
            xlane_top16(hh, 16); xlane_top16(hh, 32);
#pragma unroll
            for (int i = 0; i < 16; ++i) tops[pp][i] = key2f(hh[i]);
            if (g == 0) {
#pragma unroll
                for (int i = 0; i < 16; ++i) lidx[(n * 2 + pp) * 16 + i] = (int)(__float_as_uint(tops[pp][i]) & 127u);
            }
        }
        float bsel[4];
#pragma unroll
        for (int jj = 0; jj < 4; ++jj) bsel[jj] = g == 0 ? tops[1][4 * jj] : (g == 1 ? tops[1][4 * jj + 1] : (g == 2 ? tops[1][4 * jj + 2] : tops[1][4 * jj + 3]));
        int ca[16], ce[16];
#pragma unroll
        for (int i = 0; i < 16; ++i) ca[i] = f2key(embed(tops[0][i] + bsel[0], 255u, (unsigned)((i << 4) | g)));
#pragma unroll
        for (int i = 0; i < 3; ++i) ce[i] = f2key(embed(tops[0][i] + bsel[1], 255u, (unsigned)((i << 4) | 4 | g)));
        ce[3] = f2key(embed(tops[0][0] + bsel[2], 255u, (unsigned)(8 | g)));
        ce[4] = f2key(embed(tops[0][0] + bsel[3], 255u, (unsigned)(12 | g)));
#pragma unroll
        for (int i = 5; i < 16; ++i) ce[i] = KNEG;
        bitonic_sort_desc<16>(ce);
        int cb[16];
#pragma unroll
        for (int i = 0; i < 16; ++i) cb[i] = max(ca[i], ce[15 - i]);
        bitonic_sort_desc<16>(cb);
        xlane_top16(cb, 16); xlane_top16(cb, 32);
        float best[16];
#pragma unroll
        for (int rd = 0; rd < 16; ++rd) best[rd] = key2f(cb[rd]);
        float ex[16]; float sum = 0.f;
#pragma unroll
        for (int rd = 0; rd < 16; ++rd) { ex[rd] = __builtin_amdgcn_exp2f((best[rd] - best[0]) * LOG2E); sum += ex[rd]; }
        const float inv = 1.0f / sum;
        asm volatile("s_waitcnt lgkmcnt(0)" ::: "memory");
        int eo[4]; float go[4];
#pragma unroll
        for (int rr = 0; rr < 4; ++rr) {
            const float bv = g == 0 ? best[rr] : (g == 1 ? best[4 + rr] : (g == 2 ? best[8 + rr] : best[12 + rr]));
            const float ev = g == 0 ? ex[rr] : (g == 1 ? ex[4 + rr] : (g == 2 ? ex[8 + rr] : ex[12 + rr]));
            const unsigned code = __float_as_uint(bv) & 255u;
            eo[rr] = lidx[(n * 2 + 0) * 16 + (code >> 4)] * 128 + lidx[(n * 2 + 1) * 16 + (code & 15u)];
            go[rr] = ev * inv;
        }
        const size_t o = (size_t)(t0 + n) * 128 + h * 16 + 4 * g;
        *(int4*)(eidx + o) = make_int4(eo[0], eo[1], eo[2], eo[3]);
        *(float4*)(egate + o) = make_float4(go[0], go[1], go[2], go[3]);
        asm volatile("s_waitcnt lgkmcnt(0)" ::: "memory");
    }
}
__device__ __forceinline__ void ph_peer_gather_bf16(const bf16_t* __restrict__ H, const bf16_t* __restrict__ U, const bf16_t* __restrict__ V, const int* __restrict__ eidx, const float* __restrict__ egate,
                                               const float* __restrict__ modl, float* __restrict__ Xl, float* __restrict__ Xc, int rows,
                                               int mode, const float* __restrict__ gn, const float* __restrict__ modn, bf16_t* __restrict__ Hn, float* smem, bool dry, const int WV) {
    const int tid = TID, lane = tid & 63, wid = tid >> 6, m = lane & 15, gk = lane >> 4;
    float* wl = smem + wid * 128;
    for (int t = BID * 8 + wid; t < rows; t += NBLK * 8) {
        const int e0 = eidx[(size_t)t * 128 + lane], e1 = eidx[(size_t)t * 128 + 64 + lane];
        const bf16_t* rp[8];
#pragma unroll
        for (int T = 0; T < 8; ++T) { const int e = __shfl(T < 4 ? e0 : e1, (T & 3) * 16 + m); rp[T] = U + (size_t)e * D + 8 * gk; }
        f32x4v acc[8];
#pragma unroll
        for (int T = 0; T < 8; ++T) acc[T] = (f32x4v){0.f, 0.f, 0.f, 0.f};
        const bf16_t* hp = H + (size_t)t * D + 8 * gk;
#pragma unroll 2
        for (int ks = 0; ks < 32; ++ks) {
            const bf16x8v hb = *(const bf16x8v*)(hp + ks * 32);
#pragma unroll
            for (int T = 0; T < 8; ++T) { const bf16x8v a = *(const bf16x8v*)(rp[T] + ks * 32); acc[T] = mfma16(a, hb, acc[T]); }
        }
        const int myT = m >> 1, r0 = (m & 1) * 2;
        float va = 0.f, vb = 0.f;
#pragma unroll
        for (int T = 0; T < 8; ++T) { const float x0 = r0 ? acc[T][2] : acc[T][0], x1 = r0 ? acc[T][3] : acc[T][1]; if (myT == T) { va = x0; vb = x1; } }
        const int ee = myT * 16 + 4 * gk + r0;
        const float2 gg = *(const float2*)(egate + (size_t)t * 128 + ee);
        float2 ww; ww.x = gg.x * 0.5f * va * (1.f + erff(va * 0.70710678118654752f)); ww.y = gg.y * 0.5f * vb * (1.f + erff(vb * 0.70710678118654752f));
        *(float2*)(wl + ee) = ww;
        asm volatile("s_waitcnt lgkmcnt(0)" ::: "memory");
        const float w0 = wl[lane], w1 = wl[64 + lane];
        asm volatile("s_waitcnt lgkmcnt(0)" ::: "memory");
        float out[16];
#pragma unroll
        for (int i = 0; i < 16; ++i) out[i] = 0.f;
        const bf16_t* vb0 = V + lane * 8;
#pragma unroll
        for (int hh = 0; hh < 2; ++hh) {
            const int ev = hh ? e1 : e0; const int wbits = __float_as_int(hh ? w1 : w0);
#pragma unroll 8
            for (int k = 0; k < 64; ++k) {
                const int e = __builtin_amdgcn_readlane(ev, k); const float w = __int_as_float(__builtin_amdgcn_readlane(wbits, k));
                const bf16_t* vp = vb0 + (size_t)e * D;
                const uint4 a = *(const uint4*)vp, b = *(const uint4*)(vp + 512);
                out[0] += w * lo16(a.x); out[1] += w * hi16(a.x); out[2] += w * lo16(a.y); out[3] += w * hi16(a.y); out[4] += w * lo16(a.z); out[5] += w * hi16(a.z); out[6] += w * lo16(a.w); out[7] += w * hi16(a.w);
                out[8] += w * lo16(b.x); out[9] += w * hi16(b.x); out[10] += w * lo16(b.y); out[11] += w * hi16(b.y); out[12] += w * lo16(b.z); out[13] += w * hi16(b.z); out[14] += w * lo16(b.w); out[15] += w * hi16(b.w);
            }
        }
        const int mrow = t < T_LAT ? t / S : 4;
        float* xp = t < T_LAT ? Xl + (size_t)t * D : Xc + (size_t)(t - T_LAT) * D;
        const float* gt = modl + (size_t)mrow * 6144 + 5 * 1024;
        float xr[16]; float ss = 0.f;
#pragma unroll
        for (int q4 = 0; q4 < 4; ++q4) { const int col = (q4 >> 1) * 512 + lane * 8 + (q4 & 1) * 4;
            const float4 x = *(const float4*)(xp + col), g4 = *(const float4*)(gt + col);
            xr[q4 * 4 + 0] = x.x + g4.x * out[q4 * 4 + 0]; xr[q4 * 4 + 1] = x.y + g4.y * out[q4 * 4 + 1]; xr[q4 * 4 + 2] = x.z + g4.z * out[q4 * 4 + 2]; xr[q4 * 4 + 3] = x.w + g4.w * out[q4 * 4 + 3];
#pragma unroll
            for (int i = 0; i < 4; ++i) ss += xr[q4 * 4 + i] * xr[q4 * 4 + i]; }
        ss = wave_sum(ss);
        const float rstd = rsqrtf(ss * (1.0f / D) + EPS);
        if (dry && rstd != 12345.678f) continue;
        if (mode == 0) {
            const float* shn = modn + (size_t)mrow * 6144; const float* scn = shn + 1024;
#pragma unroll
            for (int q4 = 0; q4 < 4; ++q4) { const int col = (q4 >> 1) * 512 + lane * 8 + (q4 & 1) * 4;
                *(float4*)(xp + col) = make_float4(xr[q4 * 4], xr[q4 * 4 + 1], xr[q4 * 4 + 2], xr[q4 * 4 + 3]);
                const float4 g4 = *(const float4*)(gn + col), s4 = *(const float4*)(scn + col), h4 = *(const float4*)(shn + col);
                uint2 w; w.x = pk2(xr[q4 * 4] * rstd * g4.x * (1.f + s4.x) + h4.x, xr[q4 * 4 + 1] * rstd * g4.y * (1.f + s4.y) + h4.y);
                w.y = pk2(xr[q4 * 4 + 2] * rstd * g4.z * (1.f + s4.z) + h4.z, xr[q4 * 4 + 3] * rstd * g4.w * (1.f + s4.w) + h4.w);
                *(uint2*)(Hn + (size_t)t * D + col) = w; }
        } else {
#pragma unroll
            for (int q4 = 0; q4 < 4; ++q4) { const int col = (q4 >> 1) * 512 + lane * 8 + (q4 & 1) * 4;
                const float4 g4 = *(const float4*)(gn + col);
                *(float4*)(xp + col) = make_float4(xr[q4 * 4] * rstd * g4.x, xr[q4 * 4 + 1] * rstd * g4.y, xr[q4 * 4 + 2] * rstd * g4.z, xr[q4 * 4 + 3] * rstd * g4.w); }
        }
    }
}

typedef long i64v;
typedef long i64x2v __attribute__((ext_vector_type(2)));
__device__ __forceinline__ f32x4v mfma8(i64v a, i64v b, f32x4v c) { return __builtin_amdgcn_mfma_f32_16x16x32_fp8_fp8(a, b, c, 0, 0, 0); }
__device__ __forceinline__ void ph_peer_gather_fp8(const unsigned char* __restrict__ H8, const unsigned char* __restrict__ U8, const unsigned char* __restrict__ V8, const float* __restrict__ isu, const float* __restrict__ isv,
                                               const int* __restrict__ eidx, const float* __restrict__ egate,
                                               const float* __restrict__ modl, float* __restrict__ Xl, float* __restrict__ Xc, int rows,
                                               int mode, const float* __restrict__ gn, const float* __restrict__ modn, bf16_t* Hn, float* smem, bool dry, const int WV) {
    const int tid = TID, lane = tid & 63, wid = tid >> 6, m = lane & 15, gk = lane >> 4;
    float* wl = smem + wid * 128;
    const int myT = m >> 1, r0 = (m & 1) * 2, ee = myT * 16 + 4 * gk + r0;
    int t = BID * 8 + wid;
    int e0n = 0, e1n = 0;
    if (t < rows) { e0n = eidx[(size_t)t * 128 + lane]; e1n = eidx[(size_t)t * 128 + 64 + lane]; }
    for (; t < rows; t += NBLK * 8) {
        const int e0 = e0n, e1 = e1n;
        { const int tn = t + NBLK * 8; if (tn < rows) { e0n = eidx[(size_t)tn * 128 + lane]; e1n = eidx[(size_t)tn * 128 + 64 + lane]; } }
        const int ida0 = __shfl(e0, ee & 63), ida1 = __shfl(e1, ee & 63), idb0 = __shfl(e0, (ee + 1) & 63), idb1 = __shfl(e1, (ee + 1) & 63);
        const int ida = ee < 64 ? ida0 : ida1, idb = ee < 64 ? idb0 : idb1;
        const float sua = isu[ida], sub = isu[idb], sv0 = isv[e0], sv1 = isv[e1];
        const float2 gg = *(const float2*)(egate + (size_t)t * 128 + ee);
        unsigned rp[8];
#pragma unroll
        for (int T = 0; T < 8; ++T) { const int e = __shfl(T < 4 ? e0 : e1, (T & 3) * 16 + m); rp[T] = (unsigned)e * (unsigned)D + 16u * (unsigned)gk; }
        f32x4v acc[8];
#pragma unroll
        for (int T = 0; T < 8; ++T) acc[T] = (f32x4v){0.f, 0.f, 0.f, 0.f};
        const unsigned char* hp = H8 + (size_t)t * D + 16 * gk;
#if RING_U
        i64x2v A[URING][8], Bh[URING], Bl[URING];
#define GLOADK(ks) do { _Pragma("unroll") for (int T = 0; T < 8; ++T) A[(ks) % URING][T] = *(const i64x2v*)(U8 + (rp[T] + (unsigned)((ks) * 64))); \
                        Bh[(ks) % URING] = *(const i64x2v*)(hp + (ks) * 64); Bl[(ks) % URING] = *(const i64x2v*)(hp + (size_t)T_ALL * D + (ks) * 64); } while (0)
#pragma unroll
        for (int k0 = 0; k0 < URING - 1; ++k0) GLOADK(k0);
#pragma unroll
        for (int ks = 0; ks < 16; ++ks) {
            if (ks + URING - 1 < 16) GLOADK(ks + URING - 1);
            __builtin_amdgcn_sched_barrier(0);
#pragma unroll
            for (int T = 0; T < 8; ++T) { const i64x2v a = A[ks % URING][T];
                acc[T] = mfma8(a[0], Bh[ks % URING][0], acc[T]); acc[T] = mfma8(a[0], Bl[ks % URING][0], acc[T]); acc[T] = mfma8(a[1], Bh[ks % URING][1], acc[T]); acc[T] = mfma8(a[1], Bl[ks % URING][1], acc[T]); }
            __builtin_amdgcn_sched_barrier(0);
        }
#undef GLOADK
#else
#pragma unroll 2
        for (int ks = 0; ks < 16; ++ks) {
            const i64x2v bh = *(const i64x2v*)(hp + ks * 64), bl = *(const i64x2v*)(hp + (size_t)T_ALL * D + ks * 64);
            i64x2v a[8];
#pragma unroll
            for (int T = 0; T < 8; ++T) a[T] = *(const i64x2v*)(U8 + (rp[T] + (unsigned)(ks * 64)));
#pragma unroll
            for (int T = 0; T < 8; ++T) { acc[T] = mfma8(a[T][0], bh[0], acc[T]); acc[T] = mfma8(a[T][0], bl[0], acc[T]); acc[T] = mfma8(a[T][1], bh[1], acc[T]); acc[T] = mfma8(a[T][1], bl[1], acc[T]); }
        }
#endif
        float va = 0.f, vb = 0.f;
#pragma unroll
        for (int T = 0; T < 8; ++T) { const float x0 = r0 ? acc[T][2] : acc[T][0], x1 = r0 ? acc[T][3] : acc[T][1]; if (myT == T) { va = x0; vb = x1; } }
        va *= 0.125f * sua; vb *= 0.125f * sub;
        float2 ww; ww.x = gg.x * 0.5f * va * (1.f + erff(va * 0.70710678118654752f)); ww.y = gg.y * 0.5f * vb * (1.f + erff(vb * 0.70710678118654752f));
        *(float2*)(wl + ee) = ww;
        asm volatile("s_waitcnt lgkmcnt(0)" ::: "memory");
        const float w0 = wl[lane] * sv0, w1 = wl[64 + lane] * sv1;
        asm volatile("s_waitcnt lgkmcnt(0)" ::: "memory");
        float out[16];
#pragma unroll
        for (int i = 0; i < 16; ++i) out[i] = 0.f;
        const unsigned voff = 16u * (unsigned)lane;
#if RING_V
        uint4 VR[VRING][VCH];
#define VLOADC(c, slot) do { const int ev_ = (((c) * VCH) & 64) ? e1 : e0; _Pragma("unroll") for (int j = 0; j < VCH; ++j) { const int e = __builtin_amdgcn_readlane(ev_, (((c) * VCH) & 63) + j); VR[slot][j] = *(const uint4*)(V8 + ((unsigned)e * (unsigned)D + voff)); } } while (0)
#define VCOMPC(c, slot) do { const int wb_ = __float_as_int((((c) * VCH) & 64) ? w1 : w0); _Pragma("unroll") for (int j = 0; j < VCH; ++j) { const float w = __int_as_float(__builtin_amdgcn_readlane(wb_, (((c) * VCH) & 63) + j)); \
            const unsigned aw[4] = {VR[slot][j].x, VR[slot][j].y, VR[slot][j].z, VR[slot][j].w}; \
            _Pragma("unroll") for (int q = 0; q < 4; ++q) { const f32x2v d0 = __builtin_amdgcn_cvt_pk_f32_fp8((int)aw[q], false), d1 = __builtin_amdgcn_cvt_pk_f32_fp8((int)aw[q], true); \
                out[4 * q] += w * d0[0]; out[4 * q + 1] += w * d0[1]; out[4 * q + 2] += w * d1[0]; out[4 * q + 3] += w * d1[1]; } } } while (0)
        constexpr int NVC = 128 / VCH;
#pragma unroll
        for (int s0 = 0; s0 < VRING - 1; ++s0) VLOADC(s0, s0);
#pragma unroll 1
        for (int cb = 0; cb < NVC; cb += VRING) {
#pragma unroll
            for (int s0 = 0; s0 < VRING; ++s0) {
                if (cb + s0 < NVC) {
                    if (cb + s0 + VRING - 1 < NVC) VLOADC(cb + s0 + VRING - 1, (s0 + VRING - 1) % VRING);
                    __builtin_amdgcn_sched_barrier(0); VCOMPC(cb + s0, s0); __builtin_amdgcn_sched_barrier(0);
                }
            }
        }
#undef VLOADC
#undef VCOMPC
#else
#pragma unroll
        for (int hh = 0; hh < 2; ++hh) {
            const int ev = hh ? e1 : e0; const int wbits = __float_as_int(hh ? w1 : w0);
#pragma unroll 16
            for (int k = 0; k < 64; ++k) {
                const int e = __builtin_amdgcn_readlane(ev, k); const float w = __int_as_float(__builtin_amdgcn_readlane(wbits, k));
                const uint4 a = *(const uint4*)(V8 + ((unsigned)e * (unsigned)D + voff));
                const unsigned aw[4] = {a.x, a.y, a.z, a.w};
#pragma unroll
                for (int q = 0; q < 4; ++q) { const f32x2v d0 = __builtin_amdgcn_cvt_pk_f32_fp8((int)aw[q], false), d1 = __builtin_amdgcn_cvt_pk_f32_fp8((int)aw[q], true);
                    out[4 * q] += w * d0[0]; out[4 * q + 1] += w * d0[1]; out[4 * q + 2] += w * d1[0]; out[4 * q + 3] += w * d1[1]; }
            }
        }
#endif
        const int mrow = t < T_LAT ? t / S : 4;
        float* xp = (t < T_LAT ? Xl + (size_t)t * D : Xc + (size_t)(t - T_LAT) * D) + lane * 16;
        const float* gt = modl + (size_t)mrow * 6144 + 5 * 1024 + lane * 16;
        float xr[16]; float ss = 0.f;
#pragma unroll
        for (int q4 = 0; q4 < 4; ++q4) {
            const float4 x = *(const float4*)(xp + q4 * 4), g4 = *(const float4*)(gt + q4 * 4);
            xr[q4 * 4 + 0] = x.x + g4.x * out[q4 * 4 + 0]; xr[q4 * 4 + 1] = x.y + g4.y * out[q4 * 4 + 1]; xr[q4 * 4 + 2] = x.z + g4.z * out[q4 * 4 + 2]; xr[q4 * 4 + 3] = x.w + g4.w * out[q4 * 4 + 3];
#pragma unroll
            for (int i = 0; i < 4; ++i) ss += xr[q4 * 4 + i] * xr[q4 * 4 + i]; }
        ss = wave_sum(ss);
        const float rstd = rsqrtf(ss * (1.0f / D) + EPS);
        if (dry && rstd != 12345.678f) continue;
        if (mode == 0) {
            const float* shn = modn + (size_t)mrow * 6144 + lane * 16; const float* scn = shn + 1024; const float* gp = gn + lane * 16;
#pragma unroll
            for (int q4 = 0; q4 < 4; ++q4) {
                *(float4*)(xp + q4 * 4) = make_float4(xr[q4 * 4], xr[q4 * 4 + 1], xr[q4 * 4 + 2], xr[q4 * 4 + 3]);
                const float4 g4 = *(const float4*)(gp + q4 * 4), s4 = *(const float4*)(scn + q4 * 4), h4 = *(const float4*)(shn + q4 * 4);
                uint2 w; w.x = pk2(xr[q4 * 4] * rstd * g4.x * (1.f + s4.x) + h4.x, xr[q4 * 4 + 1] * rstd * g4.y * (1.f + s4.y) + h4.y);
                w.y = pk2(xr[q4 * 4 + 2] * rstd * g4.z * (1.f + s4.z) + h4.z, xr[q4 * 4 + 3] * rstd * g4.w * (1.f + s4.w) + h4.w);
                *(uint2*)(Hn + (size_t)t * D + lane * 16 + q4 * 4) = w; }
        } else {
            const float* gp = gn + lane * 16;
#pragma unroll
            for (int q4 = 0; q4 < 4; ++q4) { const float4 g4 = *(const float4*)(gp + q4 * 4);
                *(float4*)(xp + q4 * 4) = make_float4(xr[q4 * 4] * rstd * g4.x, xr[q4 * 4 + 1] * rstd * g4.y, xr[q4 * 4 + 2] * rstd * g4.z, xr[q4 * 4 + 3] * rstd * g4.w); }
        }
    }
}

#define LAS __attribute__((address_space(3)))
#define XB_TMO      128
#define XB_XCNT(j)  (256  + 64 * (j))
#define XB_XSUB(j)  (1280 + 64 * (j))
#define XB_XGEN(j)  (2304 + 64 * (j))
#define XB_TOP      3328
#define XB_TOPGEN   3392
#define XCD_BAR_WORDS 3456
#define XB_SPIN_CAP (1u << 18)

__device__ __forceinline__ unsigned xb_ld(unsigned* p)              { return __hip_atomic_load(p, __ATOMIC_RELAXED, __HIP_MEMORY_SCOPE_AGENT); }
__device__ __forceinline__ unsigned xb_add(unsigned* p, unsigned v) { return __hip_atomic_fetch_add(p, v, __ATOMIC_RELAXED, __HIP_MEMORY_SCOPE_AGENT); }
__device__ __forceinline__ unsigned xb_xcc_id() { return (unsigned)__builtin_amdgcn_s_getreg((3 << 11) | 20) & 0xFu; }
#define XB_SPIN(cond, bar) do { unsigned _sp = 0; while (cond) { __builtin_amdgcn_s_sleep(1); \
    if ((++_sp & 255u) == 0u) { if (xb_ld(&(bar)[XB_TMO])) break; if (_sp > XB_SPIN_CAP) { atomicAdd(&(bar)[XB_TMO], 1u); break; } } } } while (0)

struct XcdBarrier {
    unsigned* bar; unsigned x; int wv;
    volatile LAS unsigned* st;
};

__device__ __forceinline__ XcdBarrier xcd_barrier_post(unsigned* bar, volatile LAS unsigned* st, int wv) {
    XcdBarrier b; b.bar = bar; b.x = xb_xcc_id(); b.st = st; b.wv = wv;
    if (wv == 0 && lane_id() == 0) (void)xb_add(&bar[XB_XCNT(b.x)], 1u);
    return b;
}
__device__ __forceinline__ void xcd_barrier_complete(unsigned* bar, unsigned x, unsigned& nloc, unsigned& nx) {
    const unsigned G = gridDim.x * gridDim.y * gridDim.z;
    unsigned sum, cnt, mine, sp = 0u;
    for (;;) {
        sum = 0u; cnt = 0u; mine = 0u;
#pragma unroll
        for (unsigned j = 0; j < 16; ++j) { const unsigned c = xb_ld(&bar[XB_XCNT(j)]); sum += c; cnt += (c > 0u) ? 1u : 0u; mine = (j == x) ? c : mine; }
        if (sum == G) break;
        __builtin_amdgcn_s_sleep(1);
        if ((++sp & 255u) == 0u) { if (xb_ld(&bar[XB_TMO])) break; if (sp > XB_SPIN_CAP) { atomicAdd(&bar[XB_TMO], 1u); break; } }
    }
    nloc = mine > 0u ? mine : 1u; nx = cnt > 0u ? cnt : 1u;
}

__device__ __forceinline__ void xcd_barrier(const XcdBarrier& b) {
    asm volatile("s_waitcnt vmcnt(0)" ::: "memory");
    __syncthreads();
    if (b.wv == 0 && lane_id() == 0) {
        unsigned* bar = b.bar;
        __builtin_amdgcn_s_waitcnt(0);
        unsigned nloc = b.st[0], nx = b.st[1];
        if (nloc == 0u) { xcd_barrier_complete(bar, b.x, nloc, nx); b.st[0] = nloc; b.st[1] = nx; }
        const unsigned old = xb_add(&bar[XB_XSUB(b.x)], 1u);
        const unsigned gen = old / nloc;
        if (old + 1u == (gen + 1u) * nloc) {
            __builtin_amdgcn_fence(__ATOMIC_RELEASE, "agent");
            asm volatile("s_waitcnt vmcnt(0)" ::: "memory");
            const unsigned og = xb_add(&bar[XB_TOP], 1u);
            const unsigned tg = og / nx;
            if (og + 1u == (tg + 1u) * nx) xb_add(&bar[XB_TOPGEN], 1u);
            else XB_SPIN(xb_ld(&bar[XB_TOPGEN]) == tg, bar);
            __builtin_amdgcn_fence(__ATOMIC_ACQUIRE, "agent");
            xb_add(&bar[XB_XGEN(b.x)], 1u);
            asm volatile("s_waitcnt vmcnt(0)" ::: "memory");
        } else {
            XB_SPIN(xb_ld(&bar[XB_XGEN(b.x)]) == gen, bar);
            __builtin_amdgcn_fence(__ATOMIC_ACQUIRE, "agent");
            asm volatile("s_waitcnt vmcnt(0)" ::: "memory");
        }
    }
    __syncthreads();
}

__device__ __forceinline__ unsigned char* launder(unsigned char* q) { size_t z = 0; asm volatile("" : "+s"(z)); return q + z; }
__device__ __forceinline__ void ph_fill_tables(const Params& p, const int WV) {
    const int nidle = NBLK - 16; if (BID < 16 || nidle <= 0) return;
    unsigned char* ws = launder(p.ws);
#pragma unroll 1
    for (int tb = 0; tb < 4; ++tb) {
        const int l = tb >> 1, isv = tb & 1;
        unsigned char* tl = ws + (l == 0 ? WS_TAB0 : WS_TAB1);
        const float* src = (isv ? p.peer_v : p.peer_u) + (size_t)l * NEXP * D;
        conv_fp8_rows(src, (unsigned*)(tl + (size_t)isv * NEXP * D), (float*)(tl + (size_t)2 * NEXP * D) + isv * NEXP, NEXP, WV, BID - 16, nidle);
    }
}
struct WsPtrs { float *mod, *rope, *XC, *X; bf16_t *H, *Z, *vtn, *vtnc, *vtw, *vtwc, *AT; int* eidx; float* egate; unsigned char* wl; const float* modl; const unsigned char *U8, *V8, *H8; const float *isu, *isv; const bf16_t *U, *V; };
__device__ __forceinline__ WsPtrs mkptrs(const Params& p, int l) {
    unsigned char* ws = launder(p.ws); WsPtrs P;
    P.mod = (float*)(ws + WS_MOD); P.rope = (float*)(ws + WS_ROPE); P.XC = (float*)(ws + WS_XC); P.X = (float*)launder((unsigned char*)p.out);
    P.H = (bf16_t*)(ws + WS_H); P.Z = (bf16_t*)(ws + WS_Z); P.vtn = (bf16_t*)(ws + WS_VTN); P.vtnc = (bf16_t*)(ws + WS_VTNC); P.vtw = (bf16_t*)(ws + WS_VTW); P.vtwc = (bf16_t*)(ws + WS_VTWC);
    P.AT = (bf16_t*)(ws + WS_AT); P.eidx = (int*)(ws + WS_EIDX); P.egate = (float*)(ws + WS_EGATE);
    P.wl = ws + WS_W + l * W_LAYER; P.modl = P.mod + (size_t)l * 5 * 6144; P.U = (const bf16_t*)(ws + WS_TAB0); P.V = P.U + (size_t)NEXP * D; P.U8 = ws + ((l == 0) ? WS_TAB0 : WS_TAB1); P.V8 = P.U8 + (size_t)NEXP * D; P.isu = (const float*)(P.U8 + (size_t)2 * NEXP * D); P.isv = P.isu + NEXP; P.H8 = ws + WS_H8;
    return P;
}
__global__ void __launch_bounds__(NTHREADS, 2) mega_fwd(Params p) {
    extern __shared__ __attribute__((aligned(16))) unsigned char lds[];
    cg::grid_group grid = cg::this_grid();
    int WV; asm volatile("v_readfirstlane_b32 %0, %1" : "=s"(WV) : "v"((int)threadIdx.x >> 6));
    PG8_LAS unsigned char* ldsr = (PG8_LAS unsigned char*)lds;
    float* smem = (float*)lds;
    volatile LAS unsigned* bst = (volatile LAS unsigned*)((LAS unsigned char*)lds + 131072 + 256);
    if (WV == 0 && lane_id() < 2) bst[lane_id()] = 0u;
    __syncthreads();
    XcdBarrier xbar = xcd_barrier_post((unsigned*)(p.ws + WS_CTL), bst, WV);

#ifndef PROBE_DUP
#define PROBE_DUP 0
#endif

#define SYNC() xcd_barrier(xbar)
#define DUP(k, PH) do { PH; SYNC(); if (PROBE_DUP == (k)) { PH; SYNC(); } } while (0)
#define PH_NORM1() { const WsPtrs P = mkptrs(p, l); ph_norm_mod(p.x, p.ctx, p.norm1_g, P.modl, 0, 1, P.H, T_ALL, nullptr, WV); }
#define PH_ZGEMM() {     \
            const WsPtrs P = mkptrs(p, l); \
            pg8::EpiZ E{P.Z, P.rope, P.vtn, P.vtnc, P.vtw, P.vtwc, 0, 0}; \
            pg8::Gemm g{P.H, (const bf16_t*)(P.wl + W_WIN), T_ALL, IN_COLS, D}; \
            if (!last) { pg8::StaticOrder So; So.init(T_ALL, IN_COLS, NBLK, BID); pg8::gemm_phase<pg8::EpiZ, pg8::StaticOrder, true, true>(ldsr, g, So, E, WV); } \
            else { pg8::ZLastOrder So; So.S0.init(T_LAT, IN_COLS, NBLK, BID); So.G = NBLK; So.c = BID; pg8::gemm_phase<pg8::EpiZ, pg8::ZLastOrder, true, true>(ldsr, g, So, E, WV); } }
#define PH_ATTN() { const WsPtrs P = mkptrs(p, l); ph_attn<0>(P.Z, P.vtn, P.vtnc, P.vtw, P.vtwc, p.na_rpb + (size_t)l * 8 * 15 * 31, p.swa_sink + l * 8, P.AT + (size_t)T_ALL * 512, P.AT + (size_t)2 * T_ALL * 512, !last, smem, P.AT, rows, WV); }
#define PH_MERGE() {     \
            const WsPtrs P = mkptrs(p, l); \
            pg8::Gemm g{P.AT, (const bf16_t*)(P.wl + W_WA), 3 * T_ALL, 3 * D, 512}; pg8::MergeOrder Mo{(rows / 256) * 4, NBLK, BID, 0}; pg8::EpiMergeSeg E{P.Z, P.H}; \
            pg8::gemm_phase<pg8::EpiMergeSeg, pg8::MergeOrder, false, true>(ldsr, g, Mo, E, WV); \
            if (l == 0 && FP8_L0 && PROBE_DUP != 4) ph_fill_tables(p, WV); }
#define PH_OUT(GIDX) {     \
            const WsPtrs P = mkptrs(p, l); \
            pg8::Gemm g{P.H, (const bf16_t*)(P.wl + W_WO), rows, D, D}; pg8::StaticOrder So; So.init(rows, D, NBLK, BID); pg8::EpiResid E{l == 0 ? p.x : P.X, l == 0 ? p.ctx : P.XC, P.X, P.XC, P.modl, GIDX, 0}; \
            pg8::gemm_phase<pg8::EpiResid, pg8::StaticOrder, true, true>(ldsr, g, So, E, WV); }
#define PH_NORM2() { const WsPtrs P = mkptrs(p, l); ph_norm_mod(P.X, P.XC, p.norm2_g + l * D, P.modl, 3, 4, P.H, rows, (last || FP8_L0) ? (unsigned*)P.H8 : nullptr, WV); }
#define PH_QGEMM() { const WsPtrs P = mkptrs(p, l); \
            pg8::Gemm g{P.H, (const bf16_t*)(P.wl + W_WQ), rows, 2048, D}; pg8::StaticOrder So; So.init(rows, 2048, NBLK, BID); pg8::EpiStoreBf16 E{P.Z, 2048, 0}; \
            pg8::gemm_phase<pg8::EpiStoreBf16, pg8::StaticOrder, true, true>(ldsr, g, So, E, WV); }
#define PH_TOPK() { const WsPtrs P = mkptrs(p, l); ph_peer_topk(P.Z, (const bf16_t*)(P.wl + W_KEYS), P.eidx, P.egate, rows, smem, WV); }
#define PH_GATHER(DRY) { const WsPtrs P = mkptrs(p, l); \
            if (!last && !FP8_L0) ph_peer_gather_bf16(P.H, P.U, P.V, P.eidx, P.egate, P.modl, P.X, P.XC, rows, 0, p.norm1_g + D, P.modl + 5 * 6144, P.H, smem, DRY, WV); \
            else ph_peer_gather_fp8(P.H8, P.U8, P.V8, P.isu, P.isv, P.eidx, P.egate, P.modl, P.X, P.XC, rows, last ? 1 : 0, last ? p.final_g : p.norm1_g + D, P.modl + 5 * 6144, P.H, smem, DRY, WV); }

    ph_prep(p, smem, WV);
    grid.sync();
    if (PROBE_DUP == 1) { ph_prep(p, smem, WV); SYNC(); }
#define LAYER_BODY(LIDX) { constexpr int l = LIDX; \
        const bool last = (l == 1); \
        const int rows = last ? T_LAT : T_ALL; \
        if (l == 0) { PH_NORM1(); SYNC(); } \
        DUP(2, PH_ZGEMM()); \
        DUP(3, PH_ATTN()); \
        if (PROBE_DUP >= 30) { const WsPtrs P = mkptrs(p, l); bf16_t* dmy = (bf16_t*)(launder(p.ws) + WS_TAB0 + (size_t)34 * 1048576); ph_attn<PROBE_DUP - 30>(P.Z, P.vtn, P.vtnc, P.vtw, P.vtwc, p.na_rpb + (size_t)l * 8 * 15 * 31, p.swa_sink + l * 8, dmy, dmy, !last, smem, P.AT, rows, WV); SYNC(); } \
        DUP(4, PH_MERGE()); \
        PH_OUT(2); SYNC(); \
        DUP(5, PH_NORM2()); \
        DUP(6, PH_QGEMM()); \
        DUP(7, PH_TOPK()); \
        if (PROBE_DUP == 8) { PH_GATHER(true); SYNC(); } \
        PH_GATHER(false); SYNC(); \
    }
    LAYER_BODY(0)
    LAYER_BODY(1)
}

extern "C" void kernel_launch(void* const* d_in, const int* in_sizes, int n_in, void* d_out, int out_size, void* d_ws, size_t ws_size, hipStream_t stream) {
    static int grid_blocks = 0;
    if (grid_blocks == 0) {
        if (ws_size < WS_END || n_in != 22) { fprintf(stderr, "kernel_launch: workspace %zu < %zu or n_in %d != 22\n", ws_size, (size_t)WS_END, n_in); grid_blocks = -1; return; }
        int dev = 0, cus = 0, per_cu = 0;
        (void)hipGetDevice(&dev); (void)hipDeviceGetAttribute(&cus, hipDeviceAttributeMultiprocessorCount, dev);
        if (hipFuncSetAttribute((const void*)mega_fwd, hipFuncAttributeMaxDynamicSharedMemorySize, LDS_BYTES) != hipSuccess) { fprintf(stderr, "kernel_launch: hipFuncSetAttribute failed\n"); grid_blocks = -1; return; }
        if (hipOccupancyMaxActiveBlocksPerMultiprocessor(&per_cu, (const void*)mega_fwd, NTHREADS, LDS_BYTES) != hipSuccess || per_cu < 1) { fprintf(stderr, "kernel_launch: occupancy query says %d\n", per_cu); per_cu = 1; }
        (void)hipGetLastError();
        grid_blocks = cus * 1;
        fprintf(stderr, "kernel_launch: %d CUs, occupancy query %d per CU, grid %d\n", cus, per_cu, grid_blocks);
    }
    if (grid_blocks < 0) return;
    (void)hipMemsetAsync((char*)d_ws + WS_CTL, 0, CTL_BYTES, stream);
    Params p{};
    p.x = (const float*)d_in[0]; p.c = (const float*)d_in[1]; p.ctx = (const float*)d_in[2]; p.c_ctx = (const float*)d_in[3]; p.ada_w = (const float*)d_in[4]; p.ada_b = (const float*)d_in[5];
    p.norm1_g = (const float*)d_in[6]; p.norm2_g = (const float*)d_in[7]; p.w_in = (const float*)d_in[8]; p.pool_w = (const float*)d_in[9]; p.pool_scale = (const float*)d_in[10]; p.na_rpb = (const float*)d_in[11];
    p.swa_sink = (const float*)d_in[12]; p.wba = (const float*)d_in[13]; p.wbb = (const float*)d_in[14]; p.wbc = (const float*)d_in[15]; p.w_out = (const float*)d_in[16]; p.peer_wq = (const float*)d_in[17];
    p.peer_keys = (const float*)d_in[18]; p.peer_u = (const float*)d_in[19]; p.peer_v = (const float*)d_in[20]; p.final_g = (const float*)d_in[21];
    p.out = (float*)d_out; p.ws = (unsigned char*)d_ws;
    void* args[] = {&p};
    const hipError_t e = hipLaunchCooperativeKernel((const void*)mega_fwd, dim3(grid_blocks), dim3(NTHREADS), args, LDS_BYTES, stream);
    if (e != hipSuccess) fprintf(stderr, "kernel_launch: cooperative launch failed: %s (grid %d)\n", hipGetErrorString(e), grid_blocks);
}
```

```cpp
#include <hip/hip_runtime.h>
#include <hip/hip_cooperative_groups.h>
#include <stdint.h>
#include <stdio.h>
namespace cg = cooperative_groups;

typedef unsigned short bf16_t;

constexpr int D = 1024, NB = 4, S = 4096, L = 256, GW = 64;
constexpr int T_LAT = NB * S, T_CTX = NB * L, T_ALL = T_LAT + T_CTX;
constexpr int IN_COLS = 5888;
constexpr int OFF_KN = 0, OFF_VN = 512, OFF_KW = 1024, OFF_VW = 1152, CTX_KV_COLS = 1280, OFF_QN = 1280, OFF_QW = 1792, OFF_A = 2304, OFF_G = 2816;
constexpr int NEXP = 16384;
constexpr float EPS = 1e-6f;
#ifndef FP8_L0
#define FP8_L0 1
#endif
#ifndef RING_U
#define RING_U 1
#endif
#ifndef RING_V
#define RING_V 1
#endif
#ifndef URING
#define URING 3
#endif
#ifndef VRING
#define VRING 2
#endif
#ifndef VCH
#define VCH 8
#endif
#ifndef FILL_W1
#define FILL_W1 1
#endif
constexpr int NTHREADS = 512;
constexpr int LDS_BYTES = 147456;

constexpr size_t al256(size_t x) { return (x + 255) & ~(size_t)255; }
constexpr size_t WS_CTL = 0, CTL_BYTES = 16384;
constexpr size_t WS_MOD = WS_CTL + CTL_BYTES;
constexpr size_t WS_ROPE = al256(WS_MOD + 2 * 5 * 6144 * 4);
constexpr size_t WS_XC = al256(WS_ROPE + 2 * 64 * 16 * 4);
constexpr size_t WS_H = al256(WS_XC + (size_t)T_CTX * D * 4);
constexpr size_t WS_Z = al256(WS_H + (size_t)T_ALL * D * 2);
constexpr size_t WS_VTN = al256(WS_Z + (size_t)T_ALL * IN_COLS * 2);
constexpr size_t WS_VTNC = al256(WS_VTN + (size_t)NB * 8 * 64 * S * 2);
constexpr size_t WS_VTW = al256(WS_VTNC + (size_t)NB * 8 * 64 * L * 2);
constexpr size_t WS_VTWC = al256(WS_VTW + (size_t)NB * 2 * 64 * S * 2);
constexpr size_t WS_AT = al256(WS_VTWC + (size_t)NB * 2 * 64 * L * 2);
constexpr size_t WS_EIDX = al256(WS_AT + (size_t)3 * T_ALL * 512 * 2);
constexpr size_t WS_EGATE = al256(WS_EIDX + (size_t)T_ALL * 128 * 4);
constexpr size_t WS_W = al256(WS_EGATE + (size_t)T_ALL * 128 * 4);
constexpr size_t W_WIN = 0;
constexpr size_t W_WA = W_WIN + (size_t)IN_COLS * D * 2;
constexpr size_t W_WB = W_WA + (size_t)D * 512 * 2;
constexpr size_t W_WC = W_WB + (size_t)D * 512 * 2;
constexpr size_t W_WO = W_WC + (size_t)D * 512 * 2;
constexpr size_t W_WQ = W_WO + (size_t)D * D * 2;
constexpr size_t W_KEYS = W_WQ + (size_t)2048 * D * 2;
constexpr size_t W_LAYER = al256(W_KEYS + (size_t)8 * 2 * 128 * 128 * 2);
constexpr size_t WS_H8 = al256(WS_W + 2 * W_LAYER);
constexpr size_t WS_TAB0 = al256(WS_H8 + (size_t)2 * T_ALL * D);
constexpr size_t WS_TAB1 = al256(WS_TAB0 + (size_t)2 * NEXP * D * 2);
constexpr size_t WS_END = WS_TAB1 + (size_t)2 * NEXP * D + (size_t)2 * NEXP * 4;

__device__ __forceinline__ float bf2f(bf16_t v) { return __uint_as_float((unsigned)v << 16); }
__device__ __forceinline__ bf16_t f2bf(float f) { unsigned u = __float_as_uint(f); u += 0x7fffu + ((u >> 16) & 1u); return (bf16_t)(u >> 16); }
__device__ __forceinline__ unsigned pk2(float lo, float hi) { return (unsigned)f2bf(lo) | ((unsigned)f2bf(hi) << 16); }
__device__ __forceinline__ float lo16(unsigned w) { return __uint_as_float(w << 16); }
__device__ __forceinline__ float hi16(unsigned w) { return __uint_as_float(w & 0xffff0000u); }

__device__ __forceinline__ int lane_id() { int l; asm volatile("v_mbcnt_lo_u32_b32 %0, -1, 0\n\tv_mbcnt_hi_u32_b32 %0, -1, %0" : "=&v"(l)); return l; }
__device__ __forceinline__ int opaque_tid(int wv) { int t = (wv << 6) | lane_id(); asm volatile("" : "+v"(t)); return t; }
namespace pg8 {
#define PG8_LAS __attribute__((address_space(3)))
typedef unsigned short bf16_t;
typedef short bf16x8 __attribute__((ext_vector_type(8)));
typedef float f32x4 __attribute__((ext_vector_type(4)));
typedef unsigned u32x4 __attribute__((ext_vector_type(4)));
constexpr int BM = 256, BK = 64, HALF = 128, HTB = HALF * BK * 2  , STAGE_BYTES = 8 * HTB, NXCD = 8, WGM = 8;

__host__ __device__ __forceinline__ int lds_byte(int r, int c) { const int st = (r >> 4) * 2 + (c >> 5), rr = r & 15, cc = c & 31, ob = rr * 64 + cc * 2; return st * 1024 + (ob ^ (((ob >> 9) & 1) << 5)); }
__host__ __device__ __forceinline__ void stage_rc(int b, int& R, int& C) { const int st = b / 1024, sb = b % 1024, swz = sb ^ (((sb >> 9) & 1) << 5); R = (st >> 1) * 16 + swz / 64; C = (st & 1) * 32 + (swz % 64) / 2; }
__host__ __device__ __forceinline__ int perm32(int rho) { const int n = rho >> 4, i = rho & 15; return 8 * (i >> 2) + 4 * n + (i & 3); }

struct Unit { int pm, pn; };
struct Gemm { const bf16_t* A; const bf16_t* Bt; int M, N, K; };

struct StaticOrder {
    int nM, nN, nwg, G, c;
    __host__ __device__ void init(int M, int N, int G_, int c_) { nM = M / BM; nN = N / BM; nwg = nM * nN; G = G_; c = c_; }
    __host__ __device__ bool next(int i, Unit& u) const {
        const long L = (long)i * G + c; if (L >= nwg) return false;
        int wgid = (int)L; { const int q = nwg / NXCD, r = nwg % NXCD, xcd = wgid % NXCD, off = wgid / NXCD; wgid = (xcd < r ? xcd * (q + 1) : r * (q + 1) + (xcd - r) * q) + off; }
        const int nig = WGM * nN, gid = wgid / nig, fm = gid * WGM, gsz = (nM - fm) < WGM ? (nM - fm) : WGM;
        u.pm = fm + ((wgid % nig) % gsz); u.pn = (wgid % nig) / gsz; return true;
    }
    __device__ __forceinline__ void a_ready(const Unit&) const {}
    __device__ __forceinline__ void done(const Unit&) const {}
};
__device__ __forceinline__ unsigned cvt_pk_bf16(float lo, float hi) { unsigned r; asm volatile("v_cvt_pk_bf16_f32 %0, %1, %2" : "=v"(r) : "v"(lo), "v"(hi)); return r; }
typedef unsigned u32x4 __attribute__((ext_vector_type(4)));
struct EpiStoreBf16 {
    static constexpr bool PERM = true, AFTER_DRAIN = false;
    bf16_t* O; int ldc; int pad;
    __device__ __forceinline__ void operator()(const f32x4 (&acc)[2][2][4][2], const Unit& u, int wr, int wc, int fr, int fq) const {
        const int row0 = u.pm * BM + wr * 64 + fr, col0 = u.pn * BM + wc * 32 + 8 * fq;
#pragma unroll
        for (int ai = 0; ai < 2; ++ai)
#pragma unroll
            for (int m = 0; m < 4; ++m) { bf16_t* rowp = O + (size_t)(row0 + ai * HALF + m * 16) * ldc + col0;
#pragma unroll
                for (int bj = 0; bj < 2; ++bj) { const f32x4 v0 = acc[ai][bj][m][0], v1 = acc[ai][bj][m][1];
                    u32x4 w; w.x = cvt_pk_bf16(v0[0], v0[1]); w.y = cvt_pk_bf16(v0[2], v0[3]); w.z = cvt_pk_bf16(v1[0], v1[1]); w.w = cvt_pk_bf16(v1[2], v1[3]);
                    *(u32x4*)(rowp + bj * HALF) = w; } }
    }
};

struct EpiZ {
    static constexpr bool PERM = true, AFTER_DRAIN = false;
    bf16_t* Z; const float* rope; bf16_t *vtn, *vtnc, *vtw, *vtwc; int row_base; int pad;
    __device__ __forceinline__ void operator()(const f32x4 (&acc)[2][2][4][2], const Unit& u, int wr, int wc, int fr, int fq) const {
        const int grow0 = row_base + u.pm * BM;
        const bool lat = grow0 < 16384;
        const int b = lat ? (grow0 >> 12) : ((grow0 - 16384) >> 8), len = lat ? 4096 : 256;
        const int tpos0 = (lat ? (grow0 & 4095) : ((grow0 - 16384) & 255)) + wr * 64 + fr;
#pragma unroll
        for (int bj = 0; bj < 2; ++bj) {
            const int cb = 2 * u.pn + bj;
            const int col0 = cb * 128 + wc * 32 + 8 * fq;
            if ((cb >= 4 && cb < 8) || cb == 9) {
                const int cl = wc * 32 + 8 * fq;
                bf16_t* dst;
                if (cb == 9) dst = (lat ? vtw : vtwc) + ((size_t)(b * 2 + (cl >> 6)) * 64 + (cl & 63)) * len + tpos0;
                else dst = (lat ? vtn : vtnc) + ((size_t)(b * 8 + (cb - 4) * 2 + (cl >> 6)) * 64 + (cl & 63)) * len + tpos0;
#pragma unroll
                for (int ai = 0; ai < 2; ++ai)
#pragma unroll
                    for (int m = 0; m < 4; ++m) { bf16_t* dp = dst + ai * HALF + m * 16;
#pragma unroll
                        for (int n = 0; n < 2; ++n)
#pragma unroll
                            for (int i = 0; i < 4; ++i) { const unsigned w = cvt_pk_bf16(acc[ai][bj][m][n][i], 0.f); dp[(size_t)(4 * n + i) * len] = (bf16_t)(w & 0xffffu); } }
            } else {
                const bool is_rope = lat && (cb == 8 || (cb >= 14 && cb < 18));
                const bool is_gate = cb >= 22;
#pragma unroll
                for (int ai = 0; ai < 2; ++ai)
#pragma unroll
                    for (int m = 0; m < 4; ++m) {
                        f32x4 v0 = acc[ai][bj][m][0], v1 = acc[ai][bj][m][1];
                        if (is_gate) {
#pragma unroll
                            for (int i = 0; i < 4; ++i) { v0[i] = __builtin_amdgcn_rcpf(1.f + __builtin_amdgcn_exp2f(-1.4426950408889634f * v0[i])); v1[i] = __builtin_amdgcn_rcpf(1.f + __builtin_amdgcn_exp2f(-1.4426950408889634f * v1[i])); }
                        } else if (is_rope) {
                            const int tp = tpos0 + ai * HALF + m * 16;
                            const int pos = (wc & 1) ? (tp & 63) : (tp >> 6);
                            const float* tb = rope + pos * 16 + 8 * (fq & 1);
                            const f32x4 c0 = *(const f32x4*)tb, c1 = *(const f32x4*)(tb + 4), s0 = *(const f32x4*)(tb + 1024), s1 = *(const f32x4*)(tb + 1028);
                            f32x4 p0, p1;
#pragma unroll
                            for (int i = 0; i < 4; ++i) { p0[i] = __shfl_xor(v0[i], 32); p1[i] = __shfl_xor(v1[i], 32); }
                            if (fq < 2) { v0 = v0 * c0 - p0 * s0; v1 = v1 * c1 - p1 * s1; }
                            else { v0 = p0 * s0 + v0 * c0; v1 = p1 * s1 + v1 * c1; }
                        }
                        u32x4 w; w.x = cvt_pk_bf16(v0[0], v0[1]); w.y = cvt_pk_bf16(v0[2], v0[3]); w.z = cvt_pk_bf16(v1[0], v1[1]); w.w = cvt_pk_bf16(v1[2], v1[3]);
                        *(u32x4*)(Z + (size_t)(grow0 + ai * HALF + wr * 64 + m * 16 + fr) * 5888 + col0) = w;
                    }
            }
        }
    }
};
constexpr int NTM_STACK = 68;
struct EpiMergeSeg {
    static constexpr bool PERM = true, AFTER_DRAIN = false;
    const bf16_t* Z; bf16_t* M;
    __device__ __forceinline__ void operator()(const f32x4 (&acc)[2][2][4][2], const Unit& u, int wr, int wc, int fr, int fq) const {
        const int seg = u.pn >> 2, tn = u.pn & 3, tm = u.pm - seg * NTM_STACK;
        const int row0 = tm * BM + wr * 64 + fr, col0 = tn * BM + wc * 32 + 8 * fq;
        const bf16_t* zb = Z + (size_t)row0 * 5888 + 2816 + seg * 1024 + col0; bf16_t* mb = M + (size_t)row0 * 1024 + col0;
#pragma unroll
        for (int ai = 0; ai < 2; ++ai) {
            u32x4 g[4][2], o[4][2];
#pragma unroll
            for (int m = 0; m < 4; ++m)
#pragma unroll
                for (int bj = 0; bj < 2; ++bj) { const size_t ro = (size_t)(ai * HALF + m * 16);
                    g[m][bj] = *(const u32x4*)(zb + ro * 5888 + bj * HALF);
                    o[m][bj] = seg ? *(const u32x4*)(mb + ro * 1024 + bj * HALF) : (u32x4){0u, 0u, 0u, 0u}; }
            __builtin_amdgcn_sched_barrier(0);
#pragma unroll
            for (int m = 0; m < 4; ++m)
#pragma unroll
                for (int bj = 0; bj < 2; ++bj) { const u32x4 gg = g[m][bj], oo = o[m][bj]; const f32x4 v0 = acc[ai][bj][m][0], v1 = acc[ai][bj][m][1];
                    u32x4 w;
                    w.x = cvt_pk_bf16(__uint_as_float(gg.x << 16) * v0[0] + __uint_as_float(oo.x << 16), __uint_as_float(gg.x & 0xffff0000u) * v0[1] + __uint_as_float(oo.x & 0xffff0000u));
                    w.y = cvt_pk_bf16(__uint_as_float(gg.y << 16) * v0[2] + __uint_as_float(oo.y << 16), __uint_as_float(gg.y & 0xffff0000u) * v0[3] + __uint_as_float(oo.y & 0xffff0000u));
                    w.z = cvt_pk_bf16(__uint_as_float(gg.z << 16) * v1[0] + __uint_as_float(oo.z << 16), __uint_as_float(gg.z & 0xffff0000u) * v1[1] + __uint_as_float(oo.z & 0xffff0000u));
                    w.w = cvt_pk_bf16(__uint_as_float(gg.w << 16) * v1[2] + __uint_as_float(oo.w << 16), __uint_as_float(gg.w & 0xffff0000u) * v1[3] + __uint_as_float(oo.w & 0xffff0000u));
                    *(u32x4*)(mb + (size_t)(ai * HALF + m * 16) * 1024 + bj * HALF) = w; }
            __builtin_amdgcn_sched_barrier(0);
        }
    }
};
struct MergeOrder {
    int ntiles, G, c, pad;
    __device__ bool next(int i, Unit& u) const { const int ti = (i / 3) * G + c, seg = i % 3; if (ti >= ntiles) return false; u.pm = seg * NTM_STACK + (ti >> 2); u.pn = seg * 4 + (ti & 3); return true; }
    __device__ __forceinline__ void a_ready(const Unit&) const {}
    __device__ __forceinline__ void done(const Unit&) const {}
};
struct EpiResid {
    static constexpr bool PERM = false, AFTER_DRAIN = false;
    const float* Sl; const float* Sc; float* Xl; float* Xc; const float* modl; int gate_idx; int pad;
    __device__ __forceinline__ void operator()(const f32x4 (&acc)[2][2][4][2], const Unit& u, int wr, int wc, int fr, int fq) const {
        const int mrow = u.pm < 64 ? (u.pm >> 4) : 4;
        const size_t boff = u.pm < 64 ? (size_t)u.pm * BM * 1024 : (size_t)(u.pm - 64) * BM * 1024;
        const int col0 = u.pn * BM + wc * 32 + 4 * fq;
        const float* sbase = (u.pm < 64 ? Sl : Sc) + boff + (size_t)(wr * 64 + fr) * 1024 + col0; float* dbase = (u.pm < 64 ? Xl : Xc) + boff + (size_t)(wr * 64 + fr) * 1024 + col0;
        const float* gt = modl + (size_t)mrow * 6144 + gate_idx * 1024 + col0;
        f32x4 gv[2][2];
#pragma unroll
        for (int bj = 0; bj < 2; ++bj)
#pragma unroll
            for (int n = 0; n < 2; ++n) gv[bj][n] = *(const f32x4*)(gt + bj * HALF + 16 * n);
#pragma unroll
        for (int ai = 0; ai < 2; ++ai) {
            f32x4 x[4][2][2];
#pragma unroll
            for (int m = 0; m < 4; ++m)
#pragma unroll
                for (int bj = 0; bj < 2; ++bj)
#pragma unroll
                    for (int n = 0; n < 2; ++n) x[m][bj][n] = *(const f32x4*)(sbase + (size_t)(ai * HALF + m * 16) * 1024 + bj * HALF + 16 * n);
            __builtin_amdgcn_sched_barrier(0);
#pragma unroll
            for (int m = 0; m < 4; ++m)
#pragma unroll
                for (int bj = 0; bj < 2; ++bj)
#pragma unroll
                    for (int n = 0; n < 2; ++n) *(f32x4*)(dbase + (size_t)(ai * HALF + m * 16) * 1024 + bj * HALF + 16 * n) = x[m][bj][n] + gv[bj][n] * acc[ai][bj][m][n];
            __builtin_amdgcn_sched_barrier(0);
        }
    }
};
struct ZLastOrder {
    StaticOrder S0; int G, c;
    __device__ bool next(int i, Unit& u) const {
        const long L = (long)i * G + c;
        if (L < S0.nwg) return S0.next(i, u);
        const int e = (int)(L - S0.nwg); if (e >= 20) return false;
        u.pm = 64 + e / 5; u.pn = e % 5; return true;
    }
    __device__ __forceinline__ void a_ready(const Unit&) const {}
    __device__ __forceinline__ void done(const Unit&) const {}
};
template <class Epi, class Sched, bool ALIGN_EPI = false, bool SP2 = false>
__device__ __forceinline__ void gemm_phase(PG8_LAS unsigned char* lds, const Gemm g, const Sched& S, const Epi& E, const int WV) {
    const int tid = opaque_tid(WV), wid = __builtin_amdgcn_readfirstlane(tid >> 6), lane = tid & 63, wr = wid >> 2, wc = wid & 3, fr = lane & 15, fq = lane >> 4;
    const int K = g.K, nt = K / BK;
    unsigned voffA[2], voffB[2];
#pragma unroll
    for (int i = 0; i < 2; ++i) { int R, C; stage_rc(tid * 16 + i * 8192, R, C); const int Rb = Epi::PERM ? ((R & ~31) + perm32(R & 31)) : R;
        voffA[i] = (unsigned)(R * K + C) * 2u; voffB[i] = (unsigned)(Rb * K + C) * 2u; }
    const size_t kstep = (size_t)(BK * 2);
    const size_t hstep = (size_t)HALF * K * 2;
    const size_t tstep = 2 * hstep;
    const unsigned ldsw = (unsigned)wid * 1024u;
    const int aoff = lds_byte(wr * 64 + fr, fq * 8), boff = lds_byte(wc * 32 + fr, fq * 8);
#define PG8_SA(b, h) (((b) * 2 + (h)) * HTB)
#define PG8_SB(b, h) ((4 + (b) * 2 + (h)) * HTB)
#define PG8_STAGE(bufoff, gbase, voff) do { _Pragma("unroll") for (int _i = 0; _i < 2; ++_i) \
        __builtin_amdgcn_global_load_lds((const unsigned*)((const char*)(gbase) + (voff)[_i]), (PG8_LAS unsigned*)(lds + (bufoff) + ldsw + _i * 8192), 16, 0, 0); } while (0)
#define PG8_LDA(dst, b, h) do { _Pragma("unroll") for (int m = 0; m < 4; ++m) _Pragma("unroll") for (int k = 0; k < 2; ++k) dst[m][k] = *(const PG8_LAS bf16x8*)(lds + PG8_SA(b, h) + aoff + m * 2048 + k * 1024); } while (0)
#define PG8_LDB(dst, b, h) do { _Pragma("unroll") for (int n = 0; n < 2; ++n) _Pragma("unroll") for (int k = 0; k < 2; ++k) dst[n][k] = *(const PG8_LAS bf16x8*)(lds + PG8_SB(b, h) + boff + n * 2048 + k * 1024); } while (0)
#define PG8_MMA(ai, bj, At, Bt) do { __builtin_amdgcn_s_setprio(1); _Pragma("unroll") for (int m = 0; m < 4; ++m) _Pragma("unroll") for (int n = 0; n < 2; ++n) _Pragma("unroll") for (int k = 0; k < 2; ++k) \
        acc[ai][bj][m][n] = __builtin_amdgcn_mfma_f32_16x16x32_bf16(Bt[n][k], At[m][k], acc[ai][bj][m][n], 0, 0, 0); __builtin_amdgcn_s_setprio(0); } while (0)
#define PG8_WAIT_V(n) asm volatile("s_waitcnt vmcnt(" #n ")" ::: "memory")
#define PG8_WAIT_L(n) asm volatile("s_waitcnt lgkmcnt(" #n ")" ::: "memory")
#define PG8_BAR __builtin_amdgcn_s_barrier()
#define PG8_SCHED __builtin_amdgcn_sched_barrier(0)
    Unit cur, nxt; int ui = 0;
    if (!S.next(0, cur)) return;
    f32x4 acc[2][2][4][2];
#pragma unroll
    for (int a = 0; a < 2; ++a)
#pragma unroll
        for (int b = 0; b < 2; ++b)
#pragma unroll
            for (int m = 0; m < 4; ++m)
#pragma unroll
                for (int n = 0; n < 2; ++n) acc[a][b][m][n] = (f32x4){0.f, 0.f, 0.f, 0.f};
    bf16x8 At[4][2], B0[2][2], B1[2][2];
    const char* cA = (const char*)g.A + (size_t)cur.pm * tstep; const char* cB = (const char*)g.Bt + (size_t)cur.pn * tstep;
    S.a_ready(cur);
    if constexpr (SP2) {
        PG8_STAGE(PG8_SB(0, 0), cB, voffB); PG8_STAGE(PG8_SB(0, 1), cB + hstep, voffB); PG8_STAGE(PG8_SA(0, 0), cA, voffA); PG8_STAGE(PG8_SA(0, 1), cA + hstep, voffA);
        if (wr == 1) PG8_BAR;
        PG8_WAIT_V(2); PG8_BAR;
        PG8_STAGE(PG8_SB(1, 0), cB + kstep, voffB); PG8_STAGE(PG8_SA(1, 0), cA + kstep, voffA); PG8_STAGE(PG8_SB(1, 1), cB + hstep + kstep, voffB);
        PG8_WAIT_V(6); PG8_BAR;
    } else {
        PG8_STAGE(PG8_SB(0, 0), cB, voffB); PG8_STAGE(PG8_SA(0, 0), cA, voffA); PG8_STAGE(PG8_SB(0, 1), cB + hstep, voffB); PG8_STAGE(PG8_SA(0, 1), cA + hstep, voffA);
        if (wr == 1) PG8_BAR;
        PG8_WAIT_V(4); PG8_BAR;
        PG8_STAGE(PG8_SB(1, 0), cB + kstep, voffB); PG8_STAGE(PG8_SA(1, 0), cA + kstep, voffA); PG8_STAGE(PG8_SB(1, 1), cB + hstep + kstep, voffB);
        PG8_WAIT_V(6); PG8_BAR;
    }
    for (;;) {
        const bool has_next = S.next(ui + 1, nxt);
        const char* nA = has_next ? (const char*)g.A + (size_t)nxt.pm * tstep : cA; const char* nB = has_next ? (const char*)g.Bt + (size_t)nxt.pn * tstep : cB;
        for (int t = 0; t < nt; t += 2) {
            const bool last = (t == nt - 2);
            const char* a1 = cA + (size_t)(t + 1) * kstep;
            const char* a2 = last ? nA : cA + (size_t)(t + 2) * kstep; const char* b2 = last ? nB : cB + (size_t)(t + 2) * kstep;
            const char* a3 = a2 + kstep; const char* b3 = b2 + kstep;
            if (last && has_next) S.a_ready(nxt);
            if constexpr (SP2) {
            PG8_LDB(B0, 0, 0); PG8_LDB(B1, 0, 1); PG8_SCHED; PG8_LDA(At, 0, 0); PG8_STAGE(PG8_SA(1, 1), a1 + hstep, voffA);
            PG8_WAIT_V(8); PG8_WAIT_L(0); PG8_BAR; PG8_MMA(0, 0, At, B0); PG8_MMA(0, 1, At, B1); PG8_BAR; PG8_SCHED;
            PG8_LDA(At, 0, 1); PG8_STAGE(PG8_SB(0, 0), b2, voffB); PG8_STAGE(PG8_SB(0, 1), b2 + hstep, voffB); PG8_STAGE(PG8_SA(0, 0), a2, voffA);
            PG8_WAIT_V(8); PG8_WAIT_L(0); PG8_BAR; PG8_MMA(1, 0, At, B0); PG8_MMA(1, 1, At, B1); PG8_BAR; PG8_SCHED;
            PG8_LDB(B0, 1, 0); PG8_LDB(B1, 1, 1); PG8_SCHED; PG8_LDA(At, 1, 0); PG8_STAGE(PG8_SA(0, 1), a2 + hstep, voffA);
            PG8_WAIT_V(8); PG8_WAIT_L(0); PG8_BAR; PG8_MMA(0, 0, At, B0); PG8_MMA(0, 1, At, B1); PG8_BAR; PG8_SCHED;
            PG8_LDA(At, 1, 1); PG8_STAGE(PG8_SB(1, 0), b3, voffB); PG8_STAGE(PG8_SB(1, 1), b3 + hstep, voffB); PG8_STAGE(PG8_SA(1, 0), a3, voffA);
            PG8_WAIT_V(8); PG8_WAIT_L(0); PG8_BAR; PG8_MMA(1, 0, At, B0); PG8_MMA(1, 1, At, B1); PG8_BAR; PG8_SCHED;
            } else {
            PG8_LDB(B0, 0, 0); PG8_SCHED; PG8_LDA(At, 0, 0); PG8_STAGE(PG8_SA(1, 1), a1 + hstep, voffA);
            PG8_WAIT_L(8); PG8_BAR; PG8_WAIT_L(0); PG8_MMA(0, 0, At, B0); PG8_BAR; PG8_SCHED;
            PG8_LDB(B1, 0, 1); PG8_STAGE(PG8_SB(0, 0), b2, voffB);
            PG8_BAR; PG8_WAIT_L(0); PG8_MMA(0, 1, At, B1); PG8_BAR;
            PG8_LDA(At, 0, 1); PG8_STAGE(PG8_SA(0, 0), a2, voffA);
            PG8_BAR; PG8_WAIT_L(0); PG8_MMA(1, 0, At, B0); PG8_BAR; PG8_SCHED;
            PG8_STAGE(PG8_SB(0, 1), b2 + hstep, voffB);
            PG8_WAIT_V(6); PG8_BAR; PG8_MMA(1, 1, At, B1); PG8_BAR;
            PG8_LDB(B0, 1, 0); PG8_SCHED; PG8_LDA(At, 1, 0); PG8_STAGE(PG8_SA(0, 1), a2 + hstep, voffA);
            PG8_WAIT_L(8); PG8_BAR; PG8_WAIT_L(0); PG8_MMA(0, 0, At, B0); PG8_BAR; PG8_SCHED;
            PG8_LDB(B1, 1, 1); PG8_STAGE(PG8_SB(1, 0), b3, voffB);
            PG8_BAR; PG8_WAIT_L(0); PG8_MMA(0, 1, At, B1); PG8_BAR;
            PG8_LDA(At, 1, 1); PG8_STAGE(PG8_SA(1, 0), a3, voffA);
            PG8_BAR; PG8_WAIT_L(0); PG8_MMA(1, 0, At, B0); PG8_BAR; PG8_SCHED;
            PG8_STAGE(PG8_SB(1, 1), b3 + hstep, voffB);
            PG8_WAIT_V(6); PG8_BAR; PG8_MMA(1, 1, At, B1); PG8_BAR;
            }
        }
        if constexpr (ALIGN_EPI) { if (wr == 0) PG8_BAR; }
        if constexpr (!Epi::AFTER_DRAIN) { E(acc, cur, wr, wc, fr, fq); S.done(cur); }
        if (!has_next) break;
#pragma unroll
        for (int a = 0; a < 2; ++a)
#pragma unroll
            for (int b = 0; b < 2; ++b)
#pragma unroll
                for (int m = 0; m < 4; ++m)
#pragma unroll
                    for (int n = 0; n < 2; ++n) acc[a][b][m][n] = (f32x4){0.f, 0.f, 0.f, 0.f};
        cur = nxt; cA = nA; cB = nB; ++ui;
        if constexpr (ALIGN_EPI) { if (wr == 1) PG8_BAR; }
    }
    PG8_WAIT_V(0);
    if constexpr (!ALIGN_EPI) { if (wr == 0) PG8_BAR; }
    PG8_BAR;
    if constexpr (Epi::AFTER_DRAIN) { E.fused(acc, cur, wr, wc, fr, fq, lds, wid, lane); S.done(cur); }
#undef PG8_SA
#undef PG8_SB
#undef PG8_STAGE
#undef PG8_LDA
#undef PG8_LDB
#undef PG8_MMA
#undef PG8_WAIT_V
#undef PG8_WAIT_L
#undef PG8_BAR
#undef PG8_SCHED
}
}

struct Params {
    const float *x, *c, *ctx, *c_ctx, *ada_w, *ada_b, *norm1_g, *norm2_g, *w_in, *pool_w, *pool_scale, *na_rpb, *swa_sink, *wba, *wbb, *wbc, *w_out, *peer_wq, *peer_keys, *peer_u, *peer_v, *final_g;
    float* out; unsigned char* ws;
};
#define TID (opaque_tid(WV))
#define BID ((int)blockIdx.x)
#define NBLK ((int)gridDim.x)

__device__ __forceinline__ void tr_tiles(const float* __restrict__ W, bf16_t* __restrict__ Wt, int K, int N, float* tile  , const int WV, int vblk, int nvblk) {
    const int ntn = N / 64, ntiles = (K / 128) * ntn, tid = TID;
    for (int vb = vblk; vb < ntiles; vb += nvblk) {
        const int k0 = (vb / ntn) * 128, n0 = (vb % ntn) * 64;
        float4 v[4];
#pragma unroll
        for (int i = 0; i < 4; ++i) { const int idx = tid + i * NTHREADS, r = idx >> 4, c4 = (idx & 15) * 4; v[i] = *(const float4*)(W + (size_t)(k0 + r) * N + n0 + c4); }
#pragma unroll
        for (int i = 0; i < 4; ++i) { const int idx = tid + i * NTHREADS, r = idx >> 4, c4 = (idx & 15) * 4; float* tp = tile + r * 65 + c4; tp[0] = v[i].x; tp[1] = v[i].y; tp[2] = v[i].z; tp[3] = v[i].w; }
        __syncthreads();
#pragma unroll
        for (int i = 0; i < 2; ++i) { const int idx = tid + i * NTHREADS, nn = idx >> 4, kg = (idx & 15) * 8; const float* tp = tile + kg * 65 + nn;
            uint4 o; o.x = pk2(tp[0], tp[65]); o.y = pk2(tp[130], tp[195]); o.z = pk2(tp[260], tp[325]); o.w = pk2(tp[390], tp[455]);
            *(uint4*)(Wt + (size_t)(n0 + nn) * K + k0 + kg) = o; }
        __syncthreads();
    }
}
__device__ __forceinline__ void conv_bf16(const float* __restrict__ src, bf16_t* __restrict__ dst, size_t n8, const int WV, int vblk, int nvblk) {
    for (size_t i = (size_t)vblk * NTHREADS + TID; i < n8; i += (size_t)nvblk * NTHREADS) {
        const float4 a = ((const float4*)src)[2 * i], b = ((const float4*)src)[2 * i + 1];
        uint4 o; o.x = pk2(a.x, a.y); o.y = pk2(a.z, a.w); o.z = pk2(b.x, b.y); o.w = pk2(b.z, b.w);
        ((uint4*)dst)[i] = o;
    }
}
__device__ __forceinline__ void conv_fp8_rows(const float* __restrict__ src, unsigned* __restrict__ dst, float* __restrict__ inv, int nrows, const int WV, int vblk = -1, int nvblk = 0) {
    const int tid = TID, lane = tid & 63;
    const int gw = (vblk >= 0 ? vblk : BID) * 8 + (tid >> 6), gstride = (vblk >= 0 ? nvblk : NBLK) * 8;
    for (int row = gw; row < nrows; row += gstride) {
        const float4* sp = (const float4*)(src + (size_t)row * D);
        float4 v[4]; float amax = 0.f;
#pragma unroll
        for (int i = 0; i < 4; ++i) { v[i] = sp[i * 64 + lane]; amax = fmaxf(amax, fmaxf(fmaxf(fabsf(v[i].x), fabsf(v[i].y)), fmaxf(fabsf(v[i].z), fabsf(v[i].w)))); }
#pragma unroll
        for (int o = 32; o > 0; o >>= 1) amax = fmaxf(amax, __shfl_xor(amax, o));
        const int k = (int)((__float_as_uint(amax) >> 23) & 255u) - 127;
        const bool ok = amax > 1e-30f;
        const float s = ok ? __uint_as_float((unsigned)(127 + 7 - k) << 23) : 1.f;
#pragma unroll
        for (int i = 0; i < 4; ++i) { int w = __builtin_amdgcn_cvt_pk_fp8_f32(v[i].x * s, v[i].y * s, 0, false); w = __builtin_amdgcn_cvt_pk_fp8_f32(v[i].z * s, v[i].w * s, w, true);
            dst[(size_t)row * 256 + i * 64 + lane] = (unsigned)w; }
        if (lane == 0) inv[row] = ok ? __uint_as_float((unsigned)(127 - 7 + k) << 23) : 1.f;
    }
}
__device__ __forceinline__ void copy_f4(const float* __restrict__ src, float* __restrict__ dst, size_t n4, const int WV) {
    for (size_t i = (size_t)BID * NTHREADS + TID; i < n4; i += (size_t)NBLK * NTHREADS) ((float4*)dst)[i] = ((const float4*)src)[i];
}
__device__ __forceinline__ void ph_prep_weights(const Params& p, int l, float* smem, const int WV, int vblk, int nvblk) {
    unsigned char* ws = p.ws;
    unsigned char* wl = ws + WS_W + l * W_LAYER;
    tr_tiles(p.w_in + (size_t)l * D * IN_COLS, (bf16_t*)(wl + W_WIN), D, IN_COLS, smem, WV, vblk, nvblk);
    tr_tiles(p.wbb + (size_t)l * 512 * D, (bf16_t*)(wl + W_WB), 512, D, smem, WV, vblk, nvblk);
    tr_tiles(p.wbc + (size_t)l * 512 * D, (bf16_t*)(wl + W_WC), 512, D, smem, WV, vblk, nvblk);
    tr_tiles(p.w_out + (size_t)l * D * D, (bf16_t*)(wl + W_WO), D, D, smem, WV, vblk, nvblk);
    tr_tiles(p.peer_wq + (size_t)l * D * 2048, (bf16_t*)(wl + W_WQ), D, 2048, smem, WV, vblk, nvblk);
    {
        const float* pw = p.pool_w + (size_t)l * 4 * 128 * 128; const float* ps = p.pool_scale + l * 512; const float* wba = p.wba + (size_t)l * 512 * D; bf16_t* WaT = (bf16_t*)(wl + W_WA);
        for (int idx = vblk * NTHREADS + TID; idx < 512 * D; idx += nvblk * NTHREADS) {
            const int n = idx % D, kk = idx / D, g = kk / 128, c = kk % 128;
            float acc = 0.f;
#pragma unroll 8
            for (int e = 0; e < 128; ++e) acc += pw[(g * 128 + c) * 128 + e] * ps[g * 128 + e] * wba[(size_t)(g * 128 + e) * D + n];
            WaT[(size_t)n * 512 + kk] = f2bf(acc);
        }
    }
    conv_bf16(p.peer_keys + (size_t)l * 8 * 2 * 128 * 128, (bf16_t*)(wl + W_KEYS), (size_t)8 * 2 * 128 * 128 / 8, WV, vblk, nvblk);
}
__device__ __forceinline__ void ph_prep(const Params& p, float* smem, const int WV) {
    unsigned char* ws = p.ws;
    ph_prep_weights(p, 0, smem, WV, BID, NBLK);
#if !FILL_W1
    ph_prep_weights(p, 1, smem, WV, BID, NBLK);
#endif
    {
        float* sv = smem; float* part = smem + 5 * 1024; float* mod = (float*)(ws + WS_MOD);
        const int tid = TID, lane = tid & 63, wid = tid >> 6;
        for (int vb = BID; vb < 2 * 96; vb += NBLK) {
            const int l = vb / 96, j0 = (vb % 96) * 64;
            for (int i = tid; i < 5 * 1024; i += NTHREADS) { const int r = i >> 10, k = i & 1023; const float v = r < 4 ? p.c[r * 1024 + k] : p.c_ctx[k]; sv[i] = v / (1.f + __expf(-v)); }
            __syncthreads();
            float a0 = 0.f, a1 = 0.f, a2 = 0.f, a3 = 0.f, a4 = 0.f;
            const float* w = p.ada_w + ((size_t)l * 1024 + wid * 128) * 6144 + j0 + lane;
#pragma unroll 16
            for (int k = 0; k < 128; ++k) { const float xw = w[(size_t)k * 6144]; const int kk = wid * 128 + k;
                a0 += sv[kk] * xw; a1 += sv[1024 + kk] * xw; a2 += sv[2048 + kk] * xw; a3 += sv[3072 + kk] * xw; a4 += sv[4096 + kk] * xw; }
            part[(wid * 5 + 0) * 64 + lane] = a0; part[(wid * 5 + 1) * 64 + lane] = a1; part[(wid * 5 + 2) * 64 + lane] = a2; part[(wid * 5 + 3) * 64 + lane] = a3; part[(wid * 5 + 4) * 64 + lane] = a4;
            __syncthreads();
            if (tid < 320) { const int r = tid >> 6; float s = 0.f;
#pragma unroll
                for (int w8 = 0; w8 < 8; ++w8) s += part[(w8 * 5 + r) * 64 + lane];
                mod[((size_t)l * 5 + r) * 6144 + j0 + lane] = s + p.ada_b[l * 6144 + j0 + lane]; }
            __syncthreads();
        }
    }
    {
        float* tab = (float*)(ws + WS_ROPE);
        for (int i = BID * NTHREADS + TID; i < 1024; i += NBLK * NTHREADS) { const int pos = i / 16, fi = i % 16; const float inv = powf(10000.0f, -(float)fi / 16.0f), ang = (float)pos * inv; tab[i] = cosf(ang); tab[1024 + i] = sinf(ang); }
    }
}

typedef float f32x2v __attribute__((ext_vector_type(2)));
__device__ __forceinline__ float wave_sum(float v) {
#pragma unroll
    for (int o = 32; o > 0; o >>= 1) v += __shfl_xor(v, o);
    return v;
}
__device__ __forceinline__ void ph_norm_mod(const float* __restrict__ Xl, const float* __restrict__ Xc, const float* __restrict__ g, const float* __restrict__ modl, int shift_idx, int scale_idx, bf16_t* __restrict__ H, int nrows, unsigned* __restrict__ H8, const int WV) {
    const int lane = TID & 63, gw = BID * 8 + (TID >> 6);
    for (int row = gw; row < nrows; row += NBLK * 8) {
        const float* src = row < T_LAT ? Xl + (size_t)row * D : Xc + (size_t)(row - T_LAT) * D;
        const int mrow = row < T_LAT ? row / S : 4;
        float4 v[4]; float ss = 0.f;
#pragma unroll
        for (int i = 0; i < 4; ++i) { v[i] = ((const float4*)src)[i * 64 + lane]; ss += v[i].x * v[i].x + v[i].y * v[i].y + v[i].z * v[i].z + v[i].w * v[i].w; }
        ss = wave_sum(ss);
        const float rstd = rsqrtf(ss * (1.0f / D) + EPS);
        const float* sh = modl + (size_t)mrow * 6144 + shift_idx * 1024; const float* sc = modl + (size_t)mrow * 6144 + scale_idx * 1024;
#pragma unroll
        for (int i = 0; i < 4; ++i) { const int k = (i * 64 + lane) * 4;
            const float4 gg = *(const float4*)(g + k), s4 = *(const float4*)(sc + k), h4 = *(const float4*)(sh + k);
            uint2 w; w.x = pk2(v[i].x * rstd * gg.x * (1.f + s4.x) + h4.x, v[i].y * rstd * gg.y * (1.f + s4.y) + h4.y);
            w.y = pk2(v[i].z * rstd * gg.z * (1.f + s4.z) + h4.z, v[i].w * rstd * gg.w * (1.f + s4.w) + h4.w);
            *(uint2*)(H + (size_t)row * D + k) = w;
            if (H8) {
                const float h0 = 8.f * lo16(w.x), h1 = 8.f * hi16(w.x), h2 = 8.f * lo16(w.y), h3 = 8.f * hi16(w.y);
                int hi = __builtin_amdgcn_cvt_pk_fp8_f32(h0, h1, 0, false); hi = __builtin_amdgcn_cvt_pk_fp8_f32(h2, h3, hi, true);
                const f32x2v d0 = __builtin_amdgcn_cvt_pk_f32_fp8(hi, false), d1 = __builtin_amdgcn_cvt_pk_f32_fp8(hi, true);
                int lo = __builtin_amdgcn_cvt_pk_fp8_f32(h0 - d0[0], h1 - d0[1], 0, false); lo = __builtin_amdgcn_cvt_pk_fp8_f32(h2 - d1[0], h3 - d1[1], lo, true);
                H8[(size_t)row * 256 + i * 64 + lane] = (unsigned)hi; H8[(size_t)T_ALL * 256 + (size_t)row * 256 + i * 64 + lane] = (unsigned)lo; } }
    }
}
__device__ __forceinline__ void ph_pool(const bf16_t* __restrict__ Z, bf16_t* __restrict__ Pa, int rows, int tid) {
    for (int idx = BID * NTHREADS + tid; idx < rows * 64; idx += NBLK * NTHREADS) {
        const int c8 = idx & 63, row = idx >> 6, g = c8 >> 4, w = 2 << g;
        const bool lat = row < T_LAT; const int len = lat ? S : L; const int t = lat ? (row & (S - 1)) : ((row - T_LAT) & (L - 1)); const int base = row - t;
        int lo = t - w / 2; if (lo < 0) lo = 0; int hi = t - w / 2 + w; if (hi > len) hi = len;
        float sum[8];
#pragma unroll
        for (int i = 0; i < 8; ++i) sum[i] = 0.f;
        const bf16_t* zp = Z + (size_t)base * IN_COLS + OFF_A + c8 * 8;
        for (int tt = lo; tt < hi; ++tt) { const uint4 v = *(const uint4*)(zp + (size_t)tt * IN_COLS);
            sum[0] += lo16(v.x); sum[1] += hi16(v.x); sum[2] += lo16(v.y); sum[3] += hi16(v.y); sum[4] += lo16(v.z); sum[5] += hi16(v.z); sum[6] += lo16(v.w); sum[7] += hi16(v.w); }
        const uint4 sv = *(const uint4*)(zp + (size_t)t * IN_COLS); const float inv = 1.f / (float)(hi - lo);
        uint4 o; o.x = pk2(sum[0] * inv - lo16(sv.x), sum[1] * inv - hi16(sv.x)); o.y = pk2(sum[2] * inv - lo16(sv.y), sum[3] * inv - hi16(sv.y));
        o.z = pk2(sum[4] * inv - lo16(sv.z), sum[5] * inv - hi16(sv.z)); o.w = pk2(sum[6] * inv - lo16(sv.w), sum[7] * inv - hi16(sv.w));
        *(uint4*)(Pa + (size_t)row * 512 + c8 * 8) = o;
    }
}
typedef short bf16x8v __attribute__((ext_vector_type(8)));
typedef float f32x4v __attribute__((ext_vector_type(4)));
constexpr float LOG2E = 1.4426950408889634f;
constexpr float QK_SCALE2 = 0.125f * LOG2E;
constexpr float MASKED = -3.0e38f;
__device__ __forceinline__ unsigned cvtpk(float lo, float hi) { unsigned r; asm volatile("v_cvt_pk_bf16_f32 %0, %1, %2" : "=v"(r) : "v"(lo), "v"(hi)); return r; }
__device__ __forceinline__ f32x4v mfma16(bf16x8v a, bf16x8v b, f32x4v c) { return __builtin_amdgcn_mfma_f32_16x16x32_bf16(a, b, c, 0, 0, 0); }
struct AttnSt { f32x4v o[4]; float m, l; };
__device__ __forceinline__ int clampi(int v, int lo, int hi) { return v < lo ? lo : (v > hi ? hi : v); }
template <class Dsc> __device__ __forceinline__ void attn_load_k(const Dsc& dsc, int c, bf16x8v (&kf)[2][2]) {
#pragma unroll
    for (int tt = 0; tt < 2; ++tt) { const bf16_t* kb = dsc.kbase(c); const unsigned ko = dsc.koff(c, tt); kf[tt][0] = *(const bf16x8v*)(kb + ko); kf[tt][1] = *(const bf16x8v*)(kb + (ko + 32u)); }
}
template <class Dsc> __device__ __forceinline__ void attn_load_v(const Dsc& dsc, int c, bf16x8v (&vf)[4]) {
    const bf16_t* vb = dsc.vbase(c); const unsigned vo = dsc.voff(c); const unsigned vs = dsc.vstride16();
#pragma unroll
    for (int dt = 0; dt < 4; ++dt) vf[dt] = *(const bf16x8v*)(vb + (size_t)(dt * vs) + vo);
}
template <int VAR, class Dsc>
__device__ __forceinline__ void attn_chunk4(const Dsc& dsc, int c, int, const bf16x8v (&kf)[2][2], const bf16x8v (&vf)[4], const bf16x8v (&qf)[4][2], AttnSt (&st)[4], int lane) {
#pragma unroll
    for (int t = 0; t < 4; ++t) {
        if (!dsc.tile_live(t, c)) continue;
        f32x4v s[2];
#pragma unroll
        for (int tt = 0; tt < 2; ++tt) { f32x4v acc = (f32x4v){0.f, 0.f, 0.f, 0.f}; acc = mfma16(kf[tt][0], qf[t][0], acc); acc = mfma16(kf[tt][1], qf[t][1], acc); s[tt] = acc; }
#pragma unroll
        for (int tt = 0; tt < 2; ++tt)
#pragma unroll
            for (int r = 0; r < 4; ++r) s[tt][r] = dsc.score(t, c, tt, r, s[tt][r]);
        float gmax = fmaxf(fmaxf(fmaxf(s[0][0], s[0][1]), fmaxf(s[0][2], s[0][3])), fmaxf(fmaxf(s[1][0], s[1][1]), fmaxf(s[1][2], s[1][3])));
        if (__any(gmax > st[t].m + 8.0f)) {
            gmax = fmaxf(gmax, __shfl_xor(gmax, 16)); gmax = fmaxf(gmax, __shfl_xor(gmax, 32));
            const float mnew = fmaxf(st[t].m, gmax), alpha = __builtin_amdgcn_exp2f(st[t].m - mnew);
            st[t].m = mnew; st[t].l *= alpha;
            const int gb = (lane >> 4) * 4;
#pragma unroll
            for (int r = 0; r < 4; ++r) { const float ar = __shfl(alpha, gb + r);
#pragma unroll
                for (int dt = 0; dt < 4; ++dt) st[t].o[dt][r] *= ar; }
        }
        const float mref = st[t].m;
        float psum = 0.f;
#pragma unroll
        for (int tt = 0; tt < 2; ++tt)
#pragma unroll
            for (int r = 0; r < 4; ++r) { const float pv = __builtin_amdgcn_exp2f(s[tt][r] - mref); s[tt][r] = pv; psum += pv; }
        st[t].l += psum;
        union { unsigned u[4]; bf16x8v v; } pf;
        pf.u[0] = cvtpk(s[0][0], s[0][1]); pf.u[1] = cvtpk(s[0][2], s[0][3]); pf.u[2] = cvtpk(s[1][0], s[1][1]); pf.u[3] = cvtpk(s[1][2], s[1][3]);
#pragma unroll
        for (int dt = 0; dt < 4; ++dt) st[t].o[dt] = mfma16(pf.v, vf[dt], st[t].o[dt]);
    }
}
template <int VAR, class Dsc>
__device__ __forceinline__ void attn_stream4(const Dsc& dsc, int nc, const bf16x8v (&qf)[4][2], AttnSt (&st)[4], int lane) {
    bf16x8v kA[2][2], kB[2][2], vf[4];
    attn_load_k(dsc, 0, kA);
#pragma unroll 1
    for (int c = 0; c < nc; c += 2) {
        attn_load_k(dsc, (c + 1 < nc) ? c + 1 : c, kB); attn_load_v(dsc, c, vf);
        __builtin_amdgcn_sched_barrier(0);
        attn_chunk4<VAR>(dsc, c, c, kA, vf, qf, st, lane); __builtin_amdgcn_sched_barrier(0);
        if (c + 1 < nc) {
            attn_load_k(dsc, (c + 2 < nc) ? c + 2 : c + 1, kA); attn_load_v(dsc, c + 1, vf);
            __builtin_amdgcn_sched_barrier(0);
            attn_chunk4<VAR>(dsc, c + 1, c + 1, kB, vf, qf, st, lane); __builtin_amdgcn_sched_barrier(0);
        }
    }
}
__device__ __forceinline__ void attn_finish(AttnSt& st, float sink2, bool has_sink, bf16_t* orow  , int lane, bf16_t* scr  ) {
    float l = st.l; l += __shfl_xor(l, 16); l += __shfl_xor(l, 32);
    if (has_sink) l += __builtin_amdgcn_exp2f(sink2 - st.m);
    const float inv = 1.0f / l;
    const int gb = (lane >> 4) * 4, d = lane & 15;
#pragma unroll
    for (int r = 0; r < 4; ++r) { const float ir = __shfl(inv, gb + r);
#pragma unroll
        for (int dt = 0; dt < 4; ++dt) scr[(gb + r) * 64 + dt * 16 + d] = f2bf(st.o[dt][r] * ir); }
    asm volatile("s_waitcnt lgkmcnt(0)" ::: "memory");
    const int row = lane >> 2, part = lane & 3;
    const uint4 a = *(const uint4*)(scr + row * 64 + part * 16), b = *(const uint4*)(scr + row * 64 + part * 16 + 8);
    asm volatile("s_waitcnt lgkmcnt(0)" ::: "memory");
    *(uint4*)(orow + (size_t)row * 512 + part * 16) = a; *(uint4*)(orow + (size_t)row * 512 + part * 16 + 8) = b;
}
__device__ __forceinline__ void attn_init_st(AttnSt& st) {
#pragma unroll
    for (int dt = 0; dt < 4; ++dt) st.o[dt] = (f32x4v){0.f, 0.f, 0.f, 0.f};
    st.m = -1.0e30f; st.l = 0.f;
}
struct Na4Dsc {
    const bf16_t* kb0;
    const bf16_t* vb0;
    const float* rpb;
    unsigned ko[2], vo;
    int dc0; float mk[8];
    int Rlo, r0, nrow;
    __device__ __forceinline__ int crow(int c) const { return c < nrow ? c : nrow - 1; }
    __device__ __forceinline__ const bf16_t* kbase(int c) const { return kb0 + (size_t)crow(c) * 64 * IN_COLS; }
    __device__ __forceinline__ unsigned koff(int, int tt) const { return ko[tt]; }
    __device__ __forceinline__ const bf16_t* vbase(int c) const { return vb0 + crow(c) * 64; }
    __device__ __forceinline__ unsigned voff(int) const { return vo; }
    __device__ __forceinline__ unsigned vstride16() const { return 16u * S; }
    __device__ __forceinline__ bool tile_live(int t, int c) const { const int R0 = clampi(r0 + t - 4, 0, 56), kr = Rlo + c; return c < nrow && kr >= R0 && kr <= R0 + 7; }
    __device__ __forceinline__ float score(int t, int c, int tt, int r, float raw) const {
        const float bias = rpb[(Rlo + c - (r0 + t) + 7) * 31 + dc0 + 4 * tt + r];
        return raw * QK_SCALE2 + bias + mk[tt * 4 + r];
    }
};
struct Ctx4Dsc {
    const bf16_t* kb0;
    const bf16_t* vb0;
    unsigned ko[2], vo;
    __device__ __forceinline__ const bf16_t* kbase(int c) const { return kb0 + (size_t)c * 32 * IN_COLS; }
    __device__ __forceinline__ unsigned koff(int, int tt) const { return ko[tt]; }
    __device__ __forceinline__ const bf16_t* vbase(int c) const { return vb0 + c * 32; }
    __device__ __forceinline__ unsigned voff(int) const { return vo; }
    __device__ __forceinline__ unsigned vstride16() const { return 16u * L; }
    __device__ __forceinline__ bool tile_live(int, int) const { return true; }
    __device__ __forceinline__ float score(int, int, int, int, float raw) const { return raw * QK_SCALE2; }
};
struct Swa4Dsc {
    const bf16_t* zrow;
    const bf16_t* vrow;
    int p0, kslot0, g8, qpos, dS;
    __device__ __forceinline__ const bf16_t* kbase(int) const { return zrow; }
    __device__ __forceinline__ unsigned koff(int c, int tt) const { const int pos = clampi(p0 - 128 + 32 * c + kslot0 + 4 * tt, 0, S - 1); return (unsigned)pos * (unsigned)IN_COLS + (unsigned)g8; }
    __device__ __forceinline__ const bf16_t* vbase(int) const { return vrow; }
    __device__ __forceinline__ unsigned voff(int c) const { const int pos = clampi(p0 - 128 + 32 * c + g8, 0, S - 8); return (unsigned)(dS + pos); }
    __device__ __forceinline__ unsigned vstride16() const { return 16u * S; }
    __device__ __forceinline__ bool tile_live(int, int c) const { const int pos0 = p0 - 128 + 32 * c; return c < 9 && pos0 + 31 >= 0 && pos0 < S; }
    __device__ __forceinline__ float score(int, int c, int tt, int r, float raw) const {
        const int pos0 = p0 - 128 + 32 * c;
        if (c >= 1 && c <= 7 && pos0 >= 0 && pos0 + 31 < S) return raw * QK_SCALE2;
        const int pos = pos0 + g8 + 4 * tt + r; const int dlt = qpos - pos;
        return (pos >= 0 && pos < S && dlt <= 128 && dlt >= -128) ? raw * QK_SCALE2 : MASKED;
    }
};
template <int VAR>
__device__ __forceinline__ void ph_attn(const bf16_t* __restrict__ Z, const bf16_t* __restrict__ vtn, const bf16_t* __restrict__ vtnc, const bf16_t* __restrict__ vtw, const bf16_t* __restrict__ vtwc,
                                        const float* __restrict__ rpb, const float* __restrict__ sink, bf16_t* __restrict__ Ob, bf16_t* __restrict__ Oc, bool do_ctx, float* smem, bf16_t* __restrict__ Pa, int rows, const int WV) {
    const int tid = TID, lane = tid & 63, wid = tid >> 6;
    for (int i = tid; i < 8 * 465 + 64; i += NTHREADS) smem[i] = (i >= 16 && i < 16 + 8 * 465) ? rpb[i - 16] * LOG2E : 0.f;
    if (VAR == 0) ph_pool(Z, Pa, rows, tid);
    __syncthreads();
    const int q = lane & 15, g = lane >> 4, kslot0 = (q >> 2) * 8 + (q & 3);
    bf16_t* oscr = (bf16_t*)((unsigned char*)smem + 16384 + wid * 2048);
    const int wu = __builtin_amdgcn_readfirstlane(wid);
    const int vcu = (NBLK % 8 == 0) ? (BID % 8) * (NBLK / 8) + BID / 8 : BID;
    const int nunits = 2048 + 2048 + (do_ctx ? 256 : 0);
    const unsigned ko0 = (unsigned)kslot0 * IN_COLS + 8u * g, ko1 = ko0 + 4u * IN_COLS, qo = (unsigned)q * IN_COLS + 8u * g;
    for (int uu = vcu * 8 + wu; uu < nunits; uu += NBLK * 8) {
        const int u = uu >= 4096 ? uu : (((uu & 255) < 128) ? ((uu >> 8) * 128 + (uu & 127)) : (2048 + (uu >> 8) * 128 + (uu & 127)));
        if ((VAR == 6 || VAR == 8 || VAR == 9) && u >= 2048) continue;
        if (VAR == 7 && (u < 2048 || u >= 4096)) continue;
        AttnSt st[4]; bf16x8v qf[4][2];
#pragma unroll
        for (int t = 0; t < 4; ++t) attn_init_st(st[t]);
        if (u < 2048) {
            const int cb = u & 3, r4 = (u >> 2) & 15, h = (u >> 6) & 7, b = u >> 9, r0 = r4 * 4;
            const int Rlo = clampi(r0 - 4, 0, 56), Rhi = clampi(r0 + 3 - 4, 0, 56) + 7, nrow = Rhi - Rlo + 1;
            const int C0 = clampi(cb * 16 - 8, 0, 32), qc = cb * 16 + q;
            const size_t t0 = (size_t)b * S + r0 * GW + cb * 16;
            const bf16_t* qp = Z + t0 * IN_COLS + OFF_QN + h * 64;
#pragma unroll
            for (int t = 0; t < 4; ++t) { qf[t][0] = *(const bf16x8v*)(qp + (size_t)t * GW * IN_COLS + qo); qf[t][1] = *(const bf16x8v*)(qp + (size_t)t * GW * IN_COLS + (qo + 32u)); }
            Na4Dsc dl; dl.kb0 = Z + ((size_t)b * S + Rlo * GW + C0) * IN_COLS + OFF_KN + h * 64;
            dl.vb0 = vtn + (size_t)(b * 8 + h) * 64 * S + Rlo * GW + C0; dl.rpb = smem + 16 + h * 465;
            dl.ko[0] = ko0; dl.ko[1] = ko1; dl.vo = (unsigned)q * S + 8u * g;
            dl.dc0 = C0 + 8 * g - qc + 15; dl.Rlo = Rlo; dl.r0 = r0; dl.nrow = nrow;
            { const int qs = clampi(qc - 8, 0, 48);
#pragma unroll
              for (int j = 0; j < 8; ++j) { const int kc = C0 + 8 * g + j; dl.mk[j] = (kc >= qs && kc < qs + 16) ? 0.f : MASKED; } }
            if (VAR != 8) attn_stream4<VAR>(dl, nrow, qf, st, lane);
            Ctx4Dsc dc; dc.kb0 = Z + ((size_t)T_LAT + b * L) * IN_COLS + OFF_KN + h * 64; dc.vb0 = vtnc + (size_t)(b * 8 + h) * 64 * L;
            dc.ko[0] = ko0; dc.ko[1] = ko1; dc.vo = (unsigned)q * L + 8u * g;
            attn_stream4<VAR>(dc, 8, qf, st, lane);
#pragma unroll
            for (int t = 0; t < 4; ++t) { if (VAR != 9) attn_finish(st[t], 0.f, false, Ob + (t0 + (size_t)t * GW) * 512 + h * 64, lane, oscr); else if (st[t].l == 12345.f) Ob[lane] = 0; }
        } else if (u < 4096) {
            const int v = u - 2048, qt = v & 255, g2 = (v >> 8) & 1, b = v >> 9, p0 = qt * 16;
            const size_t t0 = (size_t)b * S + p0;
            const bf16_t* qp = Z + t0 * IN_COLS + OFF_QW + g2 * 256;
#pragma unroll
            for (int t = 0; t < 4; ++t) { qf[t][0] = *(const bf16x8v*)(qp + t * 64 + qo); qf[t][1] = *(const bf16x8v*)(qp + t * 64 + (qo + 32u)); }
            Swa4Dsc dl; dl.zrow = Z + (size_t)b * S * IN_COLS + OFF_KW + g2 * 64; dl.vrow = vtw + (size_t)(b * 2 + g2) * 64 * S;
            dl.p0 = p0; dl.kslot0 = kslot0; dl.g8 = 8 * g; dl.qpos = p0 + q; dl.dS = q * S;
            attn_stream4<VAR>(dl, 9, qf, st, lane);
            Ctx4Dsc dc; dc.kb0 = Z + ((size_t)T_LAT + b * L) * IN_COLS + OFF_KW + g2 * 64; dc.vb0 = vtwc + (size_t)(b * 2 + g2) * 64 * L;
            dc.ko[0] = ko0; dc.ko[1] = ko1; dc.vo = (unsigned)q * L + 8u * g;
            attn_stream4<VAR>(dc, 8, qf, st, lane);
#pragma unroll
            for (int t = 0; t < 4; ++t) attn_finish(st[t], sink[g2 * 4 + t] * LOG2E, true, Oc + t0 * 512 + (g2 * 4 + t) * 64, lane, oscr);
        } else {
            const int v = u - 4096, which = v >> 7;
            if (which == 0) {
                const int qt4 = v & 3, h = (v >> 2) & 7, b = (v >> 5) & 3;
                const size_t t0 = (size_t)T_LAT + b * L + qt4 * 64;
                const bf16_t* qp = Z + t0 * IN_COLS + OFF_QN + h * 64;
#pragma unroll
                for (int t = 0; t < 4; ++t) { qf[t][0] = *(const bf16x8v*)(qp + (size_t)t * 16 * IN_COLS + qo); qf[t][1] = *(const bf16x8v*)(qp + (size_t)t * 16 * IN_COLS + (qo + 32u)); }
                Ctx4Dsc dc; dc.kb0 = Z + ((size_t)T_LAT + b * L) * IN_COLS + OFF_KN + h * 64; dc.vb0 = vtnc + (size_t)(b * 8 + h) * 64 * L;
                dc.ko[0] = ko0; dc.ko[1] = ko1; dc.vo = (unsigned)q * L + 8u * g;
                attn_stream4<VAR>(dc, 8, qf, st, lane);
#pragma unroll
                for (int t = 0; t < 4; ++t) attn_finish(st[t], 0.f, false, Ob + (t0 + t * 16) * 512 + h * 64, lane, oscr);
            } else {
                const int w = v - 128, qt = w & 15, g2 = (w >> 4) & 1, b = (w >> 5) & 3;
                const size_t t0 = (size_t)T_LAT + b * L + qt * 16;
                const bf16_t* qp = Z + t0 * IN_COLS + OFF_QW + g2 * 256;
#pragma unroll
                for (int t = 0; t < 4; ++t) { qf[t][0] = *(const bf16x8v*)(qp + t * 64 + qo); qf[t][1] = *(const bf16x8v*)(qp + t * 64 + (qo + 32u)); }
                Ctx4Dsc dc; dc.kb0 = Z + ((size_t)T_LAT + b * L) * IN_COLS + OFF_KW + g2 * 64; dc.vb0 = vtwc + (size_t)(b * 2 + g2) * 64 * L;
                dc.ko[0] = ko0; dc.ko[1] = ko1; dc.vo = (unsigned)q * L + 8u * g;
                attn_stream4<VAR>(dc, 8, qf, st, lane);
#pragma unroll
                for (int t = 0; t < 4; ++t) attn_finish(st[t], sink[g2 * 4 + t] * LOG2E, true, Oc + t0 * 512 + (g2 * 4 + t) * 64, lane, oscr);
            }
        }
    }
}

__device__ __forceinline__ int f2key(float v) { const int b = __float_as_int(v); return b ^ ((b >> 31) & 0x7fffffff); }
__device__ __forceinline__ float key2f(int k) { return __int_as_float(k ^ ((k >> 31) & 0x7fffffff)); }
__device__ __forceinline__ float embed(float v, unsigned mask, unsigned code) { return __uint_as_float((__float_as_uint(v) & ~mask) | code); }
template <int N> __device__ __forceinline__ void bitonic_merge_desc(int (&a)[N]) {
#pragma unroll
    for (int j = N >> 1; j > 0; j >>= 1)
#pragma unroll
        for (int i = 0; i < N; ++i) { const int l = i ^ j; if (l > i) { const int hi = max(a[i], a[l]), lo = min(a[i], a[l]); a[i] = hi; a[l] = lo; } }
}
template <int N> __device__ __forceinline__ void bitonic_sort_desc(int (&a)[N]) {
#pragma unroll
    for (int k = 2; k <= N; k <<= 1)
#pragma unroll
        for (int j = k >> 1; j > 0; j >>= 1)
#pragma unroll
            for (int i = 0; i < N; ++i) { const int l = i ^ j; if (l > i) { const int hi = max(a[i], a[l]), lo = min(a[i], a[l]); if ((i & k) == 0) { a[i] = hi; a[l] = lo; } else { a[i] = lo; a[l] = hi; } } }
}
__device__ __forceinline__ void xlane_top16(int (&h)[16], int mask) {
    int m[16];
#pragma unroll
    for (int i = 0; i < 16; ++i) m[i] = max(h[i], __shfl_xor(h[15 - i], mask));
    bitonic_merge_desc<16>(m);
#pragma unroll
    for (int i = 0; i < 16; ++i) h[i] = m[i];
}
__device__ __forceinline__ void ph_peer_topk(const bf16_t* __restrict__ Q, const bf16_t* __restrict__ keys, int* __restrict__ eidx, float* __restrict__ egate, int rows, float* smem, const int WV) {
    const int tid = TID, lane = tid & 63, wid = tid >> 6, n = lane & 15, g = lane >> 4;
    unsigned char* kl = (unsigned char*)smem;
    int* lidx = (int*)(kl + 65536) + wid * 512;
    const int KNEG = (int)0x80000001;
    const int ngroups = rows / 16, npass = ((ngroups + 7) / 8) * 8;
    const int wu = __builtin_amdgcn_readfirstlane(wid);
    for (int ps = BID; ps < npass; ps += NBLK) {
        const int h = ps & 7, grp = (ps >> 3) * 8 + wu;
        __syncthreads();
        {   const uint4* src = (const uint4*)(keys + (size_t)h * 2 * 128 * 128);
#pragma unroll
            for (int i = 0; i < 8; ++i) { const int cid = tid + i * NTHREADS; const uint4 v = src[cid]; const int row = (cid >> 4) & 127, ch = cid & 15;
                *(uint4*)(kl + ((cid >> 4) * 256 + ((ch ^ (row & 15)) << 4))) = v; }
        }
        __syncthreads();
        if (grp >= ngroups) continue;
        const int t0 = grp * 16;
        float tops[2][16];
        bf16x8v qfa[2][4];
        { const bf16_t* qb = Q + (size_t)t0 * 2048 + h * 256; const unsigned qof = (unsigned)n * 2048u + 8u * g;
#pragma unroll
          for (int pp = 0; pp < 2; ++pp)
#pragma unroll
            for (int ks = 0; ks < 4; ++ks) qfa[pp][ks] = *(const bf16x8v*)(qb + (qof + pp * 128 + ks * 32)); }
#pragma unroll
        for (int pp = 0; pp < 2; ++pp) {
            const bf16x8v (&qf)[4] = qfa[pp];
            int ka_[2][16];
#pragma unroll
            for (int T = 0; T < 8; ++T) {
                f32x4v acc = (f32x4v){0.f, 0.f, 0.f, 0.f};
#pragma unroll
                for (int ks = 0; ks < 4; ++ks) {
                    const bf16x8v a = *(const bf16x8v*)(kl + ((pp * 128 + T * 16 + n) * 256 + (((ks * 4 + g) ^ n) << 4)));
                    acc = mfma16(a, qf[ks], acc); }
#pragma unroll
                for (int r = 0; r < 4; ++r) ka_[T >> 2][(T & 3) * 4 + r] = f2key(embed(acc[r], 127u, (unsigned)(T * 16 + 4 * g + r)));
            }
            bitonic_sort_desc<16>(ka_[0]); bitonic_sort_desc<16>(ka_[1]);
            int hh[16];
#pragma unroll
            for (int i = 0; i < 16; ++i) hh[i] = max(ka_[0][i], ka_[1][15 - i]);
            bitonic_merge_desc<16>(hh);
            xlane_top16(hh, 16); xlane_top16(hh, 32);
#pragma unroll
            for (int i = 0; i < 16; ++i) tops[pp][i] = key2f(hh[i]);
            if (g == 0) {
#pragma unroll
                for (int i = 0; i < 16; ++i) lidx[(n * 2 + pp) * 16 + i] = (int)(__float_as_uint(tops[pp][i]) & 127u);
            }
        }
        float bsel[4];
#pragma unroll
        for (int jj = 0; jj < 4; ++jj) bsel[jj] = g == 0 ? tops[1][4 * jj] : (g == 1 ? tops[1][4 * jj + 1] : (g == 2 ? tops[1][4 * jj + 2] : tops[1][4 * jj + 3]));
        int ca[16], ce[16];
#pragma unroll
        for (int i = 0; i < 16; ++i) ca[i] = f2key(embed(tops[0][i] + bsel[0], 255u, (unsigned)((i << 4) | g)));
#pragma unroll
        for (int i = 0; i < 3; ++i) ce[i] = f2key(embed(tops[0][i] + bsel[1], 255u, (unsigned)((i << 4) | 4 | g)));
        ce[3] = f2key(embed(tops[0][0] + bsel[2], 255u, (unsigned)(8 | g)));
        ce[4] = f2key(embed(tops[0][0] + bsel[3], 255u, (unsigned)(12 | g)));
#pragma unroll
        for (int i = 5; i < 16; ++i) ce[i] = KNEG;
        bitonic_sort_desc<16>(ce);
        int cb[16];
#pragma unroll
        for (int i = 0; i < 16; ++i) cb[i] = max(ca[i], ce[15 - i]);
        bitonic_sort_desc<16>(cb);
        xlane_top16(cb, 16); xlane_top16(cb, 32);
        float best[16];
#pragma unroll
        for (int rd = 0; rd < 16; ++rd) best[rd] = key2f(cb[rd]);
        float ex[16]; float sum = 0.f;
#pragma unroll
        for (int rd = 0; rd < 16; ++rd) { ex[rd] = __builtin_amdgcn_exp2f((best[rd] - best[0]) * LOG2E); sum += ex[rd]; }
        const float inv = 1.0f / sum;
        asm volatile("s_waitcnt lgkmcnt(0)" ::: "memory");
        int eo[4]; float go[4];
#pragma unroll
        for (int rr = 0; rr < 4; ++rr) {
            const float bv = g == 0 ? best[rr] : (g == 1 ? best[4 + rr] : (g == 2 ? best[8 + rr] : best[12 + rr]));
            const float ev = g == 0 ? ex[rr] : (g == 1 ? ex[4 + rr] : (g == 2 ? ex[8 + rr] : ex[12 + rr]));
            const unsigned code = __float_as_uint(bv) & 255u;
            eo[rr] = lidx[(n * 2 + 0) * 16 + (code >> 4)] * 128 + lidx[(n * 2 + 1) * 16 + (code & 15u)];
            go[rr] = ev * inv;
        }
        const size_t o = (size_t)(t0 + n) * 128 + h * 16 + 4 * g;
        *(int4*)(eidx + o) = make_int4(eo[0], eo[1], eo[2], eo[3]);
        *(float4*)(egate + o) = make_float4(go[0], go[1], go[2], go[3]);
        asm volatile("s_waitcnt lgkmcnt(0)" ::: "memory");
    }
}
__device__ __forceinline__ void ph_peer_gather_bf16(const bf16_t* __restrict__ H, const bf16_t* __restrict__ U, const bf16_t* __restrict__ V, const int* __restrict__ eidx, const float* __restrict__ egate,
                                               const float* __restrict__ modl, float* __restrict__ Xl, float* __restrict__ Xc, int rows,
                                               int mode, const float* __restrict__ gn, const float* __restrict__ modn, bf16_t* __restrict__ Hn, float* smem, bool dry, const int WV) {
    const int tid = TID, lane = tid & 63, wid = tid >> 6, m = lane & 15, gk = lane >> 4;
    float* wl = smem + wid * 128;
    for (int t = BID * 8 + wid; t < rows; t += NBLK * 8) {
        const int e0 = eidx[(size_t)t * 128 + lane], e1 = eidx[(size_t)t * 128 + 64 + lane];
        const bf16_t* rp[8];
#pragma unroll
        for (int T = 0; T < 8; ++T) { const int e = __shfl(T < 4 ? e0 : e1, (T & 3) * 16 + m); rp[T] = U + (size_t)e * D + 8 * gk; }
        f32x4v acc[8];
#pragma unroll
        for (int T = 0; T < 8; ++T) acc[T] = (f32x4v){0.f, 0.f, 0.f, 0.f};
        const bf16_t* hp = H + (size_t)t * D + 8 * gk;
#pragma unroll 2
        for (int ks = 0; ks < 32; ++ks) {
            const bf16x8v hb = *(const bf16x8v*)(hp + ks * 32);
#pragma unroll
            for (int T = 0; T < 8; ++T) { const bf16x8v a = *(const bf16x8v*)(rp[T] + ks * 32); acc[T] = mfma16(a, hb, acc[T]); }
        }
        const int myT = m >> 1, r0 = (m & 1) * 2;
        float va = 0.f, vb = 0.f;
#pragma unroll
        for (int T = 0; T < 8; ++T) { const float x0 = r0 ? acc[T][2] : acc[T][0], x1 = r0 ? acc[T][3] : acc[T][1]; if (myT == T) { va = x0; vb = x1; } }
        const int ee = myT * 16 + 4 * gk + r0;
        const float2 gg = *(const float2*)(egate + (size_t)t * 128 + ee);
        float2 ww; ww.x = gg.x * 0.5f * va * (1.f + erff(va * 0.70710678118654752f)); ww.y = gg.y * 0.5f * vb * (1.f + erff(vb * 0.70710678118654752f));
        *(float2*)(wl + ee) = ww;
        asm volatile("s_waitcnt lgkmcnt(0)" ::: "memory");
        const float w0 = wl[lane], w1 = wl[64 + lane];
        asm volatile("s_waitcnt lgkmcnt(0)" ::: "memory");
        float out[16];
#pragma unroll
        for (int i = 0; i < 16; ++i) out[i] = 0.f;
        const bf16_t* vb0 = V + lane * 8;
#pragma unroll
        for (int hh = 0; hh < 2; ++hh) {
            const int ev = hh ? e1 : e0; const int wbits = __float_as_int(hh ? w1 : w0);
#pragma unroll 8
            for (int k = 0; k < 64; ++k) {
                const int e = __builtin_amdgcn_readlane(ev, k); const float w = __int_as_float(__builtin_amdgcn_readlane(wbits, k));
                const bf16_t* vp = vb0 + (size_t)e * D;
                const uint4 a = *(const uint4*)vp, b = *(const uint4*)(vp + 512);
                out[0] += w * lo16(a.x); out[1] += w * hi16(a.x); out[2] += w * lo16(a.y); out[3] += w * hi16(a.y); out[4] += w * lo16(a.z); out[5] += w * hi16(a.z); out[6] += w * lo16(a.w); out[7] += w * hi16(a.w);
                out[8] += w * lo16(b.x); out[9] += w * hi16(b.x); out[10] += w * lo16(b.y); out[11] += w * hi16(b.y); out[12] += w * lo16(b.z); out[13] += w * hi16(b.z); out[14] += w * lo16(b.w); out[15] += w * hi16(b.w);
            }
        }
        const int mrow = t < T_LAT ? t / S : 4;
        float* xp = t < T_LAT ? Xl + (size_t)t * D : Xc + (size_t)(t - T_LAT) * D;
        const float* gt = modl + (size_t)mrow * 6144 + 5 * 1024;
        float xr[16]; float ss = 0.f;
#pragma unroll
        for (int q4 = 0; q4 < 4; ++q4) { const int col = (q4 >> 1) * 512 + lane * 8 + (q4 & 1) * 4;
            const float4 x = *(const float4*)(xp + col), g4 = *(const float4*)(gt + col);
            xr[q4 * 4 + 0] = x.x + g4.x * out[q4 * 4 + 0]; xr[q4 * 4 + 1] = x.y + g4.y * out[q4 * 4 + 1]; xr[q4 * 4 + 2] = x.z + g4.z * out[q4 * 4 + 2]; xr[q4 * 4 + 3] = x.w + g4.w * out[q4 * 4 + 3];
#pragma unroll
            for (int i = 0; i < 4; ++i) ss += xr[q4 * 4 + i] * xr[q4 * 4 + i]; }
        ss = wave_sum(ss);
        const float rstd = rsqrtf(ss * (1.0f / D) + EPS);
        if (dry && rstd != 12345.678f) continue;
        if (mode == 0) {
            const float* shn = modn + (size_t)mrow * 6144; const float* scn = shn + 1024;
#pragma unroll
            for (int q4 = 0; q4 < 4; ++q4) { const int col = (q4 >> 1) * 512 + lane * 8 + (q4 & 1) * 4;
                *(float4*)(xp + col) = make_float4(xr[q4 * 4], xr[q4 * 4 + 1], xr[q4 * 4 + 2], xr[q4 * 4 + 3]);
                const float4 g4 = *(const float4*)(gn + col), s4 = *(const float4*)(scn + col), h4 = *(const float4*)(shn + col);
                uint2 w; w.x = pk2(xr[q4 * 4] * rstd * g4.x * (1.f + s4.x) + h4.x, xr[q4 * 4 + 1] * rstd * g4.y * (1.f + s4.y) + h4.y);
                w.y = pk2(xr[q4 * 4 + 2] * rstd * g4.z * (1.f + s4.z) + h4.z, xr[q4 * 4 + 3] * rstd * g4.w * (1.f + s4.w) + h4.w);
                *(uint2*)(Hn + (size_t)t * D + col) = w; }
        } else {
#pragma unroll
            for (int q4 = 0; q4 < 4; ++q4) { const int col = (q4 >> 1) * 512 + lane * 8 + (q4 & 1) * 4;
                const float4 g4 = *(const float4*)(gn + col);
                *(float4*)(xp + col) = make_float4(xr[q4 * 4] * rstd * g4.x, xr[q4 * 4 + 1] * rstd * g4.y, xr[q4 * 4 + 2] * rstd * g4.z, xr[q4 * 4 + 3] * rstd * g4.w); }
        }
    }
}

typedef long i64v;
typedef long i64x2v __attribute__((ext_vector_type(2)));
__device__ __forceinline__ f32x4v mfma8(i64v a, i64v b, f32x4v c) { return __builtin_amdgcn_mfma_f32_16x16x32_fp8_fp8(a, b, c, 0, 0, 0); }
__device__ __forceinline__ void ph_peer_gather_fp8(const unsigned char* __restrict__ H8, const unsigned char* __restrict__ U8, const unsigned char* __restrict__ V8, const float* __restrict__ isu, const float* __restrict__ isv,
                                               const int* __restrict__ eidx, const float* __restrict__ egate,
                                               const float* __restrict__ modl, float* __restrict__ Xl, float* __restrict__ Xc, int rows,
                                               int mode, const float* __restrict__ gn, const float* __restrict__ modn, bf16_t* Hn, float* smem, bool dry, const int WV) {
    const int tid = TID, lane = tid & 63, wid = tid >> 6, m = lane & 15, gk = lane >> 4;
    float* wl = smem + wid * 128;
    const int myT = m >> 1, r0 = (m & 1) * 2, ee = myT * 16 + 4 * gk + r0;
    int t = BID * 8 + wid;
    int e0n = 0, e1n = 0;
    if (t < rows) { e0n = eidx[(size_t)t * 128 + lane]; e1n = eidx[(size_t)t * 128 + 64 + lane]; }
    for (; t < rows; t += NBLK * 8) {
        const int e0 = e0n, e1 = e1n;
        { const int tn = t + NBLK * 8; if (tn < rows) { e0n = eidx[(size_t)tn * 128 + lane]; e1n = eidx[(size_t)tn * 128 + 64 + lane]; } }
        const int ida0 = __shfl(e0, ee & 63), ida1 = __shfl(e1, ee & 63), idb0 = __shfl(e0, (ee + 1) & 63), idb1 = __shfl(e1, (ee + 1) & 63);
        const int ida = ee < 64 ? ida0 : ida1, idb = ee < 64 ? idb0 : idb1;
        const float sua = isu[ida], sub = isu[idb], sv0 = isv[e0], sv1 = isv[e1];
        const float2 gg = *(const float2*)(egate + (size_t)t * 128 + ee);
        unsigned rp[8];
#pragma unroll
        for (int T = 0; T < 8; ++T) { const int e = __shfl(T < 4 ? e0 : e1, (T & 3) * 16 + m); rp[T] = (unsigned)e * (unsigned)D + 16u * (unsigned)gk; }
        f32x4v acc[8];
#pragma unroll
        for (int T = 0; T < 8; ++T) acc[T] = (f32x4v){0.f, 0.f, 0.f, 0.f};
        const unsigned char* hp = H8 + (size_t)t * D + 16 * gk;
#if RING_U
        i64x2v A[URING][8], Bh[URING], Bl[URING];
#define GLOADK(ks) do { _Pragma("unroll") for (int T = 0; T < 8; ++T) A[(ks) % URING][T] = *(const i64x2v*)(U8 + (rp[T] + (unsigned)((ks) * 64))); \
                        Bh[(ks) % URING] = *(const i64x2v*)(hp + (ks) * 64); Bl[(ks) % URING] = *(const i64x2v*)(hp + (size_t)T_ALL * D + (ks) * 64); } while (0)
#pragma unroll
        for (int k0 = 0; k0 < URING - 1; ++k0) GLOADK(k0);
#pragma unroll
        for (int ks = 0; ks < 16; ++ks) {
            if (ks + URING - 1 < 16) GLOADK(ks + URING - 1);
            __builtin_amdgcn_sched_barrier(0);
#pragma unroll
            for (int T = 0; T < 8; ++T) { const i64x2v a = A[ks % URING][T];
                acc[T] = mfma8(a[0], Bh[ks % URING][0], acc[T]); acc[T] = mfma8(a[0], Bl[ks % URING][0], acc[T]); acc[T] = mfma8(a[1], Bh[ks % URING][1], acc[T]); acc[T] = mfma8(a[1], Bl[ks % URING][1], acc[T]); }
            __builtin_amdgcn_sched_barrier(0);
        }
#undef GLOADK
#else
#pragma unroll 2
        for (int ks = 0; ks < 16; ++ks) {
            const i64x2v bh = *(const i64x2v*)(hp + ks * 64), bl = *(const i64x2v*)(hp + (size_t)T_ALL * D + ks * 64);
            i64x2v a[8];
#pragma unroll
            for (int T = 0; T < 8; ++T) a[T] = *(const i64x2v*)(U8 + (rp[T] + (unsigned)(ks * 64)));
#pragma unroll
            for (int T = 0; T < 8; ++T) { acc[T] = mfma8(a[T][0], bh[0], acc[T]); acc[T] = mfma8(a[T][0], bl[0], acc[T]); acc[T] = mfma8(a[T][1], bh[1], acc[T]); acc[T] = mfma8(a[T][1], bl[1], acc[T]); }
        }
#endif
        float va = 0.f, vb = 0.f;
#pragma unroll
        for (int T = 0; T < 8; ++T) { const float x0 = r0 ? acc[T][2] : acc[T][0], x1 = r0 ? acc[T][3] : acc[T][1]; if (myT == T) { va = x0; vb = x1; } }
        va *= 0.125f * sua; vb *= 0.125f * sub;
        float2 ww; ww.x = gg.x * 0.5f * va * (1.f + erff(va * 0.70710678118654752f)); ww.y = gg.y * 0.5f * vb * (1.f + erff(vb * 0.70710678118654752f));
        *(float2*)(wl + ee) = ww;
        asm volatile("s_waitcnt lgkmcnt(0)" ::: "memory");
        const float w0 = wl[lane] * sv0, w1 = wl[64 + lane] * sv1;
        asm volatile("s_waitcnt lgkmcnt(0)" ::: "memory");
        float out[16];
#pragma unroll
        for (int i = 0; i < 16; ++i) out[i] = 0.f;
        const unsigned voff = 16u * (unsigned)lane;
#if RING_V
        uint4 VR[VRING][VCH];
#define VLOADC(c, slot) do { const int ev_ = (((c) * VCH) & 64) ? e1 : e0; _Pragma("unroll") for (int j = 0; j < VCH; ++j) { const int e = __builtin_amdgcn_readlane(ev_, (((c) * VCH) & 63) + j); VR[slot][j] = *(const uint4*)(V8 + ((unsigned)e * (unsigned)D + voff)); } } while (0)
#define VCOMPC(c, slot) do { const int wb_ = __float_as_int((((c) * VCH) & 64) ? w1 : w0); _Pragma("unroll") for (int j = 0; j < VCH; ++j) { const float w = __int_as_float(__builtin_amdgcn_readlane(wb_, (((c) * VCH) & 63) + j)); \
            const unsigned aw[4] = {VR[slot][j].x, VR[slot][j].y, VR[slot][j].z, VR[slot][j].w}; \
            _Pragma("unroll") for (int q = 0; q < 4; ++q) { const f32x2v d0 = __builtin_amdgcn_cvt_pk_f32_fp8((int)aw[q], false), d1 = __builtin_amdgcn_cvt_pk_f32_fp8((int)aw[q], true); \
                out[4 * q] += w * d0[0]; out[4 * q + 1] += w * d0[1]; out[4 * q + 2] += w * d1[0]; out[4 * q + 3] += w * d1[1]; } } } while (0)
        constexpr int NVC = 128 / VCH;
#pragma unroll
        for (int s0 = 0; s0 < VRING - 1; ++s0) VLOADC(s0, s0);
#pragma unroll 1
        for (int cb = 0; cb < NVC; cb += VRING) {
#pragma unroll
            for (int s0 = 0; s0 < VRING; ++s0) {
                if (cb + s0 < NVC) {
                    if (cb + s0 + VRING - 1 < NVC) VLOADC(cb + s0 + VRING - 1, (s0 + VRING - 1) % VRING);
                    __builtin_amdgcn_sched_barrier(0); VCOMPC(cb + s0, s0); __builtin_amdgcn_sched_barrier(0);
                }
            }
        }
#undef VLOADC
#undef VCOMPC
#else
#pragma unroll
        for (int hh = 0; hh < 2; ++hh) {
            const int ev = hh ? e1 : e0; const int wbits = __float_as_int(hh ? w1 : w0);
#pragma unroll 16
            for (int k = 0; k < 64; ++k) {
                const int e = __builtin_amdgcn_readlane(ev, k); const float w = __int_as_float(__builtin_amdgcn_readlane(wbits, k));
                const uint4 a = *(const uint4*)(V8 + ((unsigned)e * (unsigned)D + voff));
                const unsigned aw[4] = {a.x, a.y, a.z, a.w};
#pragma unroll
                for (int q = 0; q < 4; ++q) { const f32x2v d0 = __builtin_amdgcn_cvt_pk_f32_fp8((int)aw[q], false), d1 = __builtin_amdgcn_cvt_pk_f32_fp8((int)aw[q], true);
                    out[4 * q] += w * d0[0]; out[4 * q + 1] += w * d0[1]; out[4 * q + 2] += w * d1[0]; out[4 * q + 3] += w * d1[1]; }
            }
        }
#endif
        const int mrow = t < T_LAT ? t / S : 4;
        float* xp = (t < T_LAT ? Xl + (size_t)t * D : Xc + (size_t)(t - T_LAT) * D) + lane * 16;
        const float* gt = modl + (size_t)mrow * 6144 + 5 * 1024 + lane * 16;
        float xr[16]; float ss = 0.f;
#pragma unroll
        for (int q4 = 0; q4 < 4; ++q4) {
            const float4 x = *(const float4*)(xp + q4 * 4), g4 = *(const float4*)(gt + q4 * 4);
            xr[q4 * 4 + 0] = x.x + g4.x * out[q4 * 4 + 0]; xr[q4 * 4 + 1] = x.y + g4.y * out[q4 * 4 + 1]; xr[q4 * 4 + 2] = x.z + g4.z * out[q4 * 4 + 2]; xr[q4 * 4 + 3] = x.w + g4.w * out[q4 * 4 + 3];
#pragma unroll
            for (int i = 0; i < 4; ++i) ss += xr[q4 * 4 + i] * xr[q4 * 4 + i]; }
        ss = wave_sum(ss);
        const float rstd = rsqrtf(ss * (1.0f / D) + EPS);
        if (dry && rstd != 12345.678f) continue;
        if (mode == 0) {
            const float* shn = modn + (size_t)mrow * 6144 + lane * 16; const float* scn = shn + 1024; const float* gp = gn + lane * 16;
#pragma unroll
            for (int q4 = 0; q4 < 4; ++q4) {
                *(float4*)(xp + q4 * 4) = make_float4(xr[q4 * 4], xr[q4 * 4 + 1], xr[q4 * 4 + 2], xr[q4 * 4 + 3]);
                const float4 g4 = *(const float4*)(gp + q4 * 4), s4 = *(const float4*)(scn + q4 * 4), h4 = *(const float4*)(shn + q4 * 4);
                uint2 w; w.x = pk2(xr[q4 * 4] * rstd * g4.x * (1.f + s4.x) + h4.x, xr[q4 * 4 + 1] * rstd * g4.y * (1.f + s4.y) + h4.y);
                w.y = pk2(xr[q4 * 4 + 2] * rstd * g4.z * (1.f + s4.z) + h4.z, xr[q4 * 4 + 3] * rstd * g4.w * (1.f + s4.w) + h4.w);
                *(uint2*)(Hn + (size_t)t * D + lane * 16 + q4 * 4) = w; }
        } else {
            const float* gp = gn + lane * 16;
#pragma unroll
            for (int q4 = 0; q4 < 4; ++q4) { const float4 g4 = *(const float4*)(gp + q4 * 4);
                *(float4*)(xp + q4 * 4) = make_float4(xr[q4 * 4] * rstd * g4.x, xr[q4 * 4 + 1] * rstd * g4.y, xr[q4 * 4 + 2] * rstd * g4.z, xr[q4 * 4 + 3] * rstd * g4.w); }
        }
    }
}

#define LAS __attribute__((address_space(3)))
#define XB_TMO      128
#define XB_XCNT(j)  (256  + 64 * (j))
#define XB_XSUB(j)  (1280 + 64 * (j))
#define XB_XGEN(j)  (2304 + 64 * (j))
#define XB_TOP      3328
#define XB_TOPGEN   3392
#define XCD_BAR_WORDS 3456
#define XB_SPIN_CAP (1u << 18)

__device__ __forceinline__ unsigned xb_ld(unsigned* p)              { return __hip_atomic_load(p, __ATOMIC_RELAXED, __HIP_MEMORY_SCOPE_AGENT); }
__device__ __forceinline__ unsigned xb_add(unsigned* p, unsigned v) { return __hip_atomic_fetch_add(p, v, __ATOMIC_RELAXED, __HIP_MEMORY_SCOPE_AGENT); }
__device__ __forceinline__ unsigned xb_xcc_id() { return (unsigned)__builtin_amdgcn_s_getreg((3 << 11) | 20) & 0xFu; }
#define XB_SPIN(cond, bar) do { unsigned _sp = 0; while (cond) { __builtin_amdgcn_s_sleep(1); \
    if ((++_sp & 255u) == 0u) { if (xb_ld(&(bar)[XB_TMO])) break; if (_sp > XB_SPIN_CAP) { atomicAdd(&(bar)[XB_TMO], 1u); break; } } } } while (0)

struct XcdBarrier {
    unsigned* bar; unsigned x; int wv;
    volatile LAS unsigned* st;
};

__device__ __forceinline__ XcdBarrier xcd_barrier_post(unsigned* bar, volatile LAS unsigned* st, int wv) {
    XcdBarrier b; b.bar = bar; b.x = xb_xcc_id(); b.st = st; b.wv = wv;
    if (wv == 0 && lane_id() == 0) (void)xb_add(&bar[XB_XCNT(b.x)], 1u);
    return b;
}
__device__ __forceinline__ void xcd_barrier_complete(unsigned* bar, unsigned x, unsigned& nloc, unsigned& nx) {
    const unsigned G = gridDim.x * gridDim.y * gridDim.z;
    unsigned sum, cnt, mine, sp = 0u;
    for (;;) {
        sum = 0u; cnt = 0u; mine = 0u;
#pragma unroll
        for (unsigned j = 0; j < 16; ++j) { const unsigned c = xb_ld(&bar[XB_XCNT(j)]); sum += c; cnt += (c > 0u) ? 1u : 0u; mine = (j == x) ? c : mine; }
        if (sum == G) break;
        __builtin_amdgcn_s_sleep(1);
        if ((++sp & 255u) == 0u) { if (xb_ld(&bar[XB_TMO])) break; if (sp > XB_SPIN_CAP) { atomicAdd(&bar[XB_TMO], 1u); break; } }
    }
    nloc = mine > 0u ? mine : 1u; nx = cnt > 0u ? cnt : 1u;
}

__device__ __forceinline__ void xcd_barrier(const XcdBarrier& b) {
    asm volatile("s_waitcnt vmcnt(0)" ::: "memory");
    __syncthreads();
    if (b.wv == 0 && lane_id() == 0) {
        unsigned* bar = b.bar;
        __builtin_amdgcn_s_waitcnt(0);
        unsigned nloc = b.st[0], nx = b.st[1];
        if (nloc == 0u) { xcd_barrier_complete(bar, b.x, nloc, nx); b.st[0] = nloc; b.st[1] = nx; }
        const unsigned old = xb_add(&bar[XB_XSUB(b.x)], 1u);
        const unsigned gen = old / nloc;
        if (old + 1u == (gen + 1u) * nloc) {
            __builtin_amdgcn_fence(__ATOMIC_RELEASE, "agent");
            asm volatile("s_waitcnt vmcnt(0)" ::: "memory");
            const unsigned og = xb_add(&bar[XB_TOP], 1u);
            const unsigned tg = og / nx;
            if (og + 1u == (tg + 1u) * nx) xb_add(&bar[XB_TOPGEN], 1u);
            else XB_SPIN(xb_ld(&bar[XB_TOPGEN]) == tg, bar);
            __builtin_amdgcn_fence(__ATOMIC_ACQUIRE, "agent");
            xb_add(&bar[XB_XGEN(b.x)], 1u);
            asm volatile("s_waitcnt vmcnt(0)" ::: "memory");
        } else {
            XB_SPIN(xb_ld(&bar[XB_XGEN(b.x)]) == gen, bar);
            __builtin_amdgcn_fence(__ATOMIC_ACQUIRE, "agent");
            asm volatile("s_waitcnt vmcnt(0)" ::: "memory");
        }
    }
    __syncthreads();
}

__device__ __forceinline__ unsigned char* launder(unsigned char* q) { size_t z = 0; asm volatile("" : "+s"(z)); return q + z; }
__device__ __forceinline__ void ph_fill_tables(const Params& p, const int WV) {
    const int nidle = NBLK - 16; if (BID < 16 || nidle <= 0) return;
    unsigned char* ws = launder(p.ws);
#pragma unroll 1
    for (int tb = 0; tb < 4; ++tb) {
        const int l = tb >> 1, isv = tb & 1;
        unsigned char* tl = ws + (l == 0 ? WS_TAB0 : WS_TAB1);
        const float* src = (isv ? p.peer_v : p.peer_u) + (size_t)l * NEXP * D;
        conv_fp8_rows(src, (unsigned*)(tl + (size_t)isv * NEXP * D), (float*)(tl + (size_t)2 * NEXP * D) + isv * NEXP, NEXP, WV, BID - 16, nidle);
    }
}
struct WsPtrs { float *mod, *rope, *XC, *X; bf16_t *H, *Z, *vtn, *vtnc, *vtw, *vtwc, *AT; int* eidx; float* egate; unsigned char* wl; const float* modl; const unsigned char *U8, *V8, *H8; const float *isu, *isv; const bf16_t *U, *V; };
__device__ __forceinline__ WsPtrs mkptrs(const Params& p, int l) {
    unsigned char* ws = launder(p.ws); WsPtrs P;
    P.mod = (float*)(ws + WS_MOD); P.rope = (float*)(ws + WS_ROPE); P.XC = (float*)(ws + WS_XC); P.X = (float*)launder((unsigned char*)p.out);
    P.H = (bf16_t*)(ws + WS_H); P.Z = (bf16_t*)(ws + WS_Z); P.vtn = (bf16_t*)(ws + WS_VTN); P.vtnc = (bf16_t*)(ws + WS_VTNC); P.vtw = (bf16_t*)(ws + WS_VTW); P.vtwc = (bf16_t*)(ws + WS_VTWC);
    P.AT = (bf16_t*)(ws + WS_AT); P.eidx = (int*)(ws + WS_EIDX); P.egate = (float*)(ws + WS_EGATE);
    P.wl = ws + WS_W + l * W_LAYER; P.modl = P.mod + (size_t)l * 5 * 6144; P.U = (const bf16_t*)(ws + WS_TAB0); P.V = P.U + (size_t)NEXP * D; P.U8 = ws + ((l == 0) ? WS_TAB0 : WS_TAB1); P.V8 = P.U8 + (size_t)NEXP * D; P.isu = (const float*)(P.U8 + (size_t)2 * NEXP * D); P.isv = P.isu + NEXP; P.H8 = ws + WS_H8;
    return P;
}
__global__ void __launch_bounds__(NTHREADS, 2) mega_fwd(Params p) {
    extern __shared__ __attribute__((aligned(16))) unsigned char lds[];
    cg::grid_group grid = cg::this_grid();
    int WV; asm volatile("v_readfirstlane_b32 %0, %1" : "=s"(WV) : "v"((int)threadIdx.x >> 6));
    PG8_LAS unsigned char* ldsr = (PG8_LAS unsigned char*)lds;
    float* smem = (float*)lds;
    volatile LAS unsigned* bst = (volatile LAS unsigned*)((LAS unsigned char*)lds + 131072 + 256);
    if (WV == 0 && lane_id() < 2) bst[lane_id()] = 0u;
    __syncthreads();
    XcdBarrier xbar = xcd_barrier_post((unsigned*)(p.ws + WS_CTL), bst, WV);

#ifndef PROBE_DUP
#define PROBE_DUP 0
#endif

#define SYNC() xcd_barrier(xbar)
#define DUP(k, PH) do { PH; SYNC(); if (PROBE_DUP == (k)) { PH; SYNC(); } } while (0)
#define PH_NORM1() { const WsPtrs P = mkptrs(p, l); ph_norm_mod(p.x, p.ctx, p.norm1_g, P.modl, 0, 1, P.H, T_ALL, nullptr, WV); }
#define PH_ZGEMM() {     \
            const WsPtrs P = mkptrs(p, l); \
            pg8::EpiZ E{P.Z, P.rope, P.vtn, P.vtnc, P.vtw, P.vtwc, 0, 0}; \
            pg8::Gemm g{P.H, (const bf16_t*)(P.wl + W_WIN), T_ALL, IN_COLS, D}; \
            if (!last) { pg8::StaticOrder So; So.init(T_ALL, IN_COLS, NBLK, BID); pg8::gemm_phase<pg8::EpiZ, pg8::StaticOrder, true, true>(ldsr, g, So, E, WV); } \
            else { pg8::ZLastOrder So; So.S0.init(T_LAT, IN_COLS, NBLK, BID); So.G = NBLK; So.c = BID; pg8::gemm_phase<pg8::EpiZ, pg8::ZLastOrder, true, true>(ldsr, g, So, E, WV); } }
#define PH_ATTN() { const WsPtrs P = mkptrs(p, l); ph_attn<0>(P.Z, P.vtn, P.vtnc, P.vtw, P.vtwc, p.na_rpb + (size_t)l * 8 * 15 * 31, p.swa_sink + l * 8, P.AT + (size_t)T_ALL * 512, P.AT + (size_t)2 * T_ALL * 512, !last, smem, P.AT, rows, WV); }
#define PH_MERGE() {     \
            const WsPtrs P = mkptrs(p, l); \
            pg8::Gemm g{P.AT, (const bf16_t*)(P.wl + W_WA), 3 * T_ALL, 3 * D, 512}; pg8::MergeOrder Mo{(rows / 256) * 4, NBLK, BID, 0}; pg8::EpiMergeSeg E{P.Z, P.H}; \
            pg8::gemm_phase<pg8::EpiMergeSeg, pg8::MergeOrder, false, true>(ldsr, g, Mo, E, WV); \
            if (l == 0 && FP8_L0) ph_fill_tables(p, WV); }
#define PH_OUT(GIDX) {     \
            const WsPtrs P = mkptrs(p, l); \
            pg8::Gemm g{P.H, (const bf16_t*)(P.wl + W_WO), rows, D, D}; pg8::StaticOrder So; So.init(rows, D, NBLK, BID); pg8::EpiResid E{l == 0 ? p.x : P.X, l == 0 ? p.ctx : P.XC, P.X, P.XC, P.modl, GIDX, 0}; \
            pg8::gemm_phase<pg8::EpiResid, pg8::StaticOrder, true, true>(ldsr, g, So, E, WV); \
            if (l == 0 && FILL_W1 && BID >= 16 && NBLK > 16) { __syncthreads(); ph_prep_weights(p, 1, smem, WV, BID - 16, NBLK - 16); } }
#define PH_NORM2() { const WsPtrs P = mkptrs(p, l); ph_norm_mod(P.X, P.XC, p.norm2_g + l * D, P.modl, 3, 4, P.H, rows, (last || FP8_L0) ? (unsigned*)P.H8 : nullptr, WV); }
#define PH_QGEMM() { const WsPtrs P = mkptrs(p, l); \
            pg8::Gemm g{P.H, (const bf16_t*)(P.wl + W_WQ), rows, 2048, D}; pg8::StaticOrder So; So.init(rows, 2048, NBLK, BID); pg8::EpiStoreBf16 E{P.Z, 2048, 0}; \
            pg8::gemm_phase<pg8::EpiStoreBf16, pg8::StaticOrder, true, true>(ldsr, g, So, E, WV); }
#define PH_TOPK() { const WsPtrs P = mkptrs(p, l); ph_peer_topk(P.Z, (const bf16_t*)(P.wl + W_KEYS), P.eidx, P.egate, rows, smem, WV); }
#define PH_GATHER(DRY) { const WsPtrs P = mkptrs(p, l); \
            if (!last && !FP8_L0) ph_peer_gather_bf16(P.H, P.U, P.V, P.eidx, P.egate, P.modl, P.X, P.XC, rows, 0, p.norm1_g + D, P.modl + 5 * 6144, P.H, smem, DRY, WV); \
            else ph_peer_gather_fp8(P.H8, P.U8, P.V8, P.isu, P.isv, P.eidx, P.egate, P.modl, P.X, P.XC, rows, last ? 1 : 0, last ? p.final_g : p.norm1_g + D, P.modl + 5 * 6144, P.H, smem, DRY, WV); }

    ph_prep(p, smem, WV);
    grid.sync();
    if (PROBE_DUP == 1) { ph_prep(p, smem, WV); SYNC(); }
#define LAYER_BODY(LIDX) { constexpr int l = LIDX; \
        const bool last = (l == 1); \
        const int rows = last ? T_LAT : T_ALL; \
        if (l == 0) { PH_NORM1(); SYNC(); } \
        DUP(2, PH_ZGEMM()); \
        DUP(3, PH_ATTN()); \
        if (PROBE_DUP >= 30) { const WsPtrs P = mkptrs(p, l); bf16_t* dmy = (bf16_t*)(launder(p.ws) + WS_TAB0 + (size_t)34 * 1048576); ph_attn<PROBE_DUP - 30>(P.Z, P.vtn, P.vtnc, P.vtw, P.vtwc, p.na_rpb + (size_t)l * 8 * 15 * 31, p.swa_sink + l * 8, dmy, dmy, !last, smem, P.AT, rows, WV); SYNC(); } \
        DUP(4, PH_MERGE()); \
        PH_OUT(2); SYNC(); \
        DUP(5, PH_NORM2()); \
        DUP(6, PH_QGEMM()); \
        DUP(7, PH_TOPK()); \
        if (PROBE_DUP == 8) { PH_GATHER(true); SYNC(); } \
        PH_GATHER(false); SYNC(); \
    }
    LAYER_BODY(0)
    LAYER_BODY(1)
}

extern "C" void kernel_launch(void* const* d_in, const int* in_sizes, int n_in, void* d_out, int out_size, void* d_ws, size_t ws_size, hipStream_t stream) {
    static int grid_blocks = 0;
    if (grid_blocks == 0) {
        if (ws_size < WS_END || n_in != 22) { fprintf(stderr, "kernel_launch: workspace %zu < %zu or n_in %d != 22\n", ws_size, (size_t)WS_END, n_in); grid_blocks = -1; return; }
        int dev = 0, cus = 0, per_cu = 0;
        (void)hipGetDevice(&dev); (void)hipDeviceGetAttribute(&cus, hipDeviceAttributeMultiprocessorCount, dev);
        if (hipFuncSetAttribute((const void*)mega_fwd, hipFuncAttributeMaxDynamicSharedMemorySize, LDS_BYTES) != hipSuccess) { fprintf(stderr, "kernel_launch: hipFuncSetAttribute failed\n"); grid_blocks = -1; return; }
        if (hipOccupancyMaxActiveBlocksPerMultiprocessor(&per_cu, (const void*)mega_fwd, NTHREADS, LDS_BYTES) != hipSuccess || per_cu < 1) { fprintf(stderr, "kernel_launch: occupancy query says %d\n", per_cu); per_cu = 1; }
        (void)hipGetLastError();
        grid_blocks = cus * 1;
        fprintf(stderr, "kernel_launch: %d CUs, occupancy query %d per CU, grid %d\n", cus, per_cu, grid_blocks);
    }
    if (grid_blocks < 0) return;
    (void)hipMemsetAsync((char*)d_ws + WS_CTL, 0, CTL_BYTES, stream);
    Params p{};
    p.x = (const float*)d_in[0]; p.c = (const float*)d_in[1]; p.ctx = (const float*)d_in[2]; p.c_ctx = (const float*)d_in[3]; p.ada_w = (const float*)d_in[4]; p.ada_b = (const float*)d_in[5];
    p.norm1_g = (const float*)d_in[6]; p.norm2_g = (const float*)d_in[7]; p.w_in = (const float*)d_in[8]; p.pool_w = (const float*)d_in[9]; p.pool_scale = (const float*)d_in[10]; p.na_rpb = (const float*)d_in[11];
    p.swa_sink = (const float*)d_in[12]; p.wba = (const float*)d_in[13]; p.wbb = (const float*)d_in[14]; p.wbc = (const float*)d_in[15]; p.w_out = (const float*)d_in[16]; p.peer_wq = (const float*)d_in[17];
    p.peer_keys = (const float*)d_in[18]; p.peer_u = (const float*)d_in[19]; p.peer_v = (const float*)d_in[20]; p.final_g = (const float*)d_in[21];
    p.out = (float*)d_out; p.ws = (unsigned char*)d_ws;
    void* args[] = {&p};
    const hipError_t e = hipLaunchCooperativeKernel((const void*)mega_fwd, dim3(grid_blocks), dim3(NTHREADS), args, LDS_BYTES, stream);
    if (e != hipSuccess) fprintf(stderr, "kernel_launch: cooperative launch failed: %s (grid %d)\n", hipGetErrorString(e), grid_blocks);
}
```

```cpp
#include <hip/hip_runtime.h>
#include <hip/hip_cooperative_groups.h>
#include <stdint.h>
#include <stdio.h>
namespace cg = cooperative_groups;

typedef unsigned short bf16_t;

constexpr int D = 1024, NB = 4, S = 4096, L = 256, GW = 64;
constexpr int T_LAT = NB * S, T_CTX = NB * L, T_ALL = T_LAT + T_CTX;
constexpr int IN_COLS = 5888;
constexpr int OFF_KN = 0, OFF_VN = 512, OFF_KW = 1024, OFF_VW = 1152, CTX_KV_COLS = 1280, OFF_QN = 1280, OFF_QW = 1792, OFF_A = 2304, OFF_G = 2816;
constexpr int NEXP = 16384;
constexpr float EPS = 1e-6f;
#ifndef FP8_L0
#define FP8_L0 1
#endif
#ifndef RING_U
#define RING_U 1
#endif
#ifndef RING_V
#define RING_V 1
#endif
#ifndef URING
#define URING 3
#endif
#ifndef VRING
#define VRING 2
#endif
#ifndef VCH
#define VCH 8
#endif
#ifndef FILL_W1
#define FILL_W1 1
#endif
constexpr int NTHREADS = 512;
constexpr int LDS_BYTES = 147456;

constexpr size_t al256(size_t x) { return (x + 255) & ~(size_t)255; }
constexpr size_t WS_CTL = 0, CTL_BYTES = 16384;
constexpr size_t WS_MOD = WS_CTL + CTL_BYTES;
constexpr size_t WS_ROPE = al256(WS_MOD + 2 * 5 * 6144 * 4);
constexpr size_t WS_XC = al256(WS_ROPE + 2 * 64 * 16 * 4);
constexpr size_t WS_H = al256(WS_XC + (size_t)T_CTX * D * 4);
constexpr size_t WS_Z = al256(WS_H + (size_t)T_ALL * D * 2);
constexpr size_t WS_VTN = al256(WS_Z + (size_t)T_ALL * IN_COLS * 2);
constexpr size_t WS_VTNC = al256(WS_VTN + (size_t)NB * 8 * 64 * S * 2);
constexpr size_t WS_VTW = al256(WS_VTNC + (size_t)NB * 8 * 64 * L * 2);
constexpr size_t WS_VTWC = al256(WS_VTW + (size_t)NB * 2 * 64 * S * 2);
constexpr size_t WS_AT = al256(WS_VTWC + (size_t)NB * 2 * 64 * L * 2);
constexpr size_t WS_EIDX = al256(WS_AT + (size_t)3 * T_ALL * 512 * 2);
constexpr size_t WS_EGATE = al256(WS_EIDX + (size_t)T_ALL * 128 * 4);
constexpr size_t WS_W = al256(WS_EGATE + (size_t)T_ALL * 128 * 4);
constexpr size_t W_WIN = 0;
constexpr size_t W_WA = W_WIN + (size_t)IN_COLS * D * 2;
constexpr size_t W_WB = W_WA + (size_t)D * 512 * 2;
constexpr size_t W_WC = W_WB + (size_t)D * 512 * 2;
constexpr size_t W_WO = W_WC + (size_t)D * 512 * 2;
constexpr size_t W_WQ = W_WO + (size_t)D * D * 2;
constexpr size_t W_KEYS = W_WQ + (size_t)2048 * D * 2;
constexpr size_t W_LAYER = al256(W_KEYS + (size_t)8 * 2 * 128 * 128 * 2);
constexpr size_t WS_H8 = al256(WS_W + 2 * W_LAYER);
constexpr size_t WS_TAB0 = al256(WS_H8 + (size_t)2 * T_ALL * D);
constexpr size_t WS_TAB1 = al256(WS_TAB0 + (size_t)2 * NEXP * D * 2);
constexpr size_t WS_END = WS_TAB1 + (size_t)2 * NEXP * D + (size_t)2 * NEXP * 4;

__device__ __forceinline__ float bf2f(bf16_t v) { return __uint_as_float((unsigned)v << 16); }
__device__ __forceinline__ bf16_t f2bf(float f) { unsigned u = __float_as_uint(f); u += 0x7fffu + ((u >> 16) & 1u); return (bf16_t)(u >> 16); }
__device__ __forceinline__ unsigned pk2(float lo, float hi) { return (unsigned)f2bf(lo) | ((unsigned)f2bf(hi) << 16); }
__device__ __forceinline__ float lo16(unsigned w) { return __uint_as_float(w << 16); }
__device__ __forceinline__ float hi16(unsigned w) { return __uint_as_float(w & 0xffff0000u); }

__device__ __forceinline__ int lane_id() { int l; asm volatile("v_mbcnt_lo_u32_b32 %0, -1, 0\n\tv_mbcnt_hi_u32_b32 %0, -1, %0" : "=&v"(l)); return l; }
__device__ __forceinline__ int opaque_tid(int wv) { int t = (wv << 6) | lane_id(); asm volatile("" : "+v"(t)); return t; }
namespace pg8 {
#define PG8_LAS __attribute__((address_space(3)))
typedef unsigned short bf16_t;
typedef short bf16x8 __attribute__((ext_vector_type(8)));
typedef float f32x4 __attribute__((ext_vector_type(4)));
typedef unsigned u32x4 __attribute__((ext_vector_type(4)));
constexpr int BM = 256, BK = 64, HALF = 128, HTB = HALF * BK * 2  , STAGE_BYTES = 8 * HTB, NXCD = 8, WGM = 8;

__host__ __device__ __forceinline__ int lds_byte(int r, int c) { const int st = (r >> 4) * 2 + (c >> 5), rr = r & 15, cc = c & 31, ob = rr * 64 + cc * 2; return st * 1024 + (ob ^ (((ob >> 9) & 1) << 5)); }
__host__ __device__ __forceinline__ void stage_rc(int b, int& R, int& C) { const int st = b / 1024, sb = b % 1024, swz = sb ^ (((sb >> 9) & 1) << 5); R = (st >> 1) * 16 + swz / 64; C = (st & 1) * 32 + (swz % 64) / 2; }
__host__ __device__ __forceinline__ int perm32(int rho) { const int n = rho >> 4, i = rho & 15; return 8 * (i >> 2) + 4 * n + (i & 3); }

struct Unit { int pm, pn; };
struct Gemm { const bf16_t* A; const bf16_t* Bt; int M, N, K; };

struct StaticOrder {
    int nM, nN, nwg, G, c;
    __host__ __device__ void init(int M, int N, int G_, int c_) { nM = M / BM; nN = N / BM; nwg = nM * nN; G = G_; c = c_; }
    __host__ __device__ bool next(int i, Unit& u) const {
        const long L = (long)i * G + c; if (L >= nwg) return false;
        int wgid = (int)L; { const int q = nwg / NXCD, r = nwg % NXCD, xcd = wgid % NXCD, off = wgid / NXCD; wgid = (xcd < r ? xcd * (q + 1) : r * (q + 1) + (xcd - r) * q) + off; }
        const int nig = WGM * nN, gid = wgid / nig, fm = gid * WGM, gsz = (nM - fm) < WGM ? (nM - fm) : WGM;
        u.pm = fm + ((wgid % nig) % gsz); u.pn = (wgid % nig) / gsz; return true;
    }
    __device__ __forceinline__ void a_ready(const Unit&) const {}
    __device__ __forceinline__ void done(const Unit&) const {}
};
__device__ __forceinline__ unsigned cvt_pk_bf16(float lo, float hi) { unsigned r; asm volatile("v_cvt_pk_bf16_f32 %0, %1, %2" : "=v"(r) : "v"(lo), "v"(hi)); return r; }
typedef unsigned u32x4 __attribute__((ext_vector_type(4)));
struct EpiStoreBf16 {
    static constexpr bool PERM = true, AFTER_DRAIN = false;
    bf16_t* O; int ldc; int pad;
    __device__ __forceinline__ void operator()(const f32x4 (&acc)[2][2][4][2], const Unit& u, int wr, int wc, int fr, int fq) const {
        const int row0 = u.pm * BM + wr * 64 + fr, col0 = u.pn * BM + wc * 32 + 8 * fq;
#pragma unroll
        for (int ai = 0; ai < 2; ++ai)
#pragma unroll
            for (int m = 0; m < 4; ++m) { bf16_t* rowp = O + (size_t)(row0 + ai * HALF + m * 16) * ldc + col0;
#pragma unroll
                for (int bj = 0; bj < 2; ++bj) { const f32x4 v0 = acc[ai][bj][m][0], v1 = acc[ai][bj][m][1];
                    u32x4 w; w.x = cvt_pk_bf16(v0[0], v0[1]); w.y = cvt_pk_bf16(v0[2], v0[3]); w.z = cvt_pk_bf16(v1[0], v1[1]); w.w = cvt_pk_bf16(v1[2], v1[3]);
                    *(u32x4*)(rowp + bj * HALF) = w; } }
    }
};

struct EpiZ {
    static constexpr bool PERM = true, AFTER_DRAIN = false;
    bf16_t* Z; const float* rope; bf16_t *vtn, *vtnc, *vtw, *vtwc; int row_base; int pad; PG8_LAS bf16_t* vscr0;
    __device__ __forceinline__ void operator()(const f32x4 (&acc)[2][2][4][2], const Unit& u, int wr, int wc, int fr, int fq) const {
        PG8_LAS bf16_t* vscr = vscr0 + (wr * 4 + wc) * 512;
        const int grow0 = row_base + u.pm * BM;
        const bool lat = grow0 < 16384;
        const int b = lat ? (grow0 >> 12) : ((grow0 - 16384) >> 8), len = lat ? 4096 : 256;
        const int tpos0 = (lat ? (grow0 & 4095) : ((grow0 - 16384) & 255)) + wr * 64 + fr;
#pragma unroll
        for (int bj = 0; bj < 2; ++bj) {
            const int cb = 2 * u.pn + bj;
            const int col0 = cb * 128 + wc * 32 + 8 * fq;
            if ((cb >= 4 && cb < 8) || cb == 9) {
                const int cw = wc * 32;
                bf16_t* vbase;
                if (cb == 9) vbase = (lat ? vtw : vtwc) + ((size_t)(b * 2 + (cw >> 6)) * 64 + (cw & 63)) * len;
                else vbase = (lat ? vtn : vtnc) + ((size_t)(b * 8 + (cb - 4) * 2 + (cw >> 6)) * 64 + (cw & 63)) * len;
                const int lane = fq * 16 + fr, rc = lane >> 1, rh = lane & 1;
                const int tposw = tpos0 - fr;
#pragma unroll
                for (int ai = 0; ai < 2; ++ai)
#pragma unroll
                    for (int m = 0; m < 4; ++m) {
#pragma unroll
                        for (int n = 0; n < 2; ++n)
#pragma unroll
                            for (int i = 0; i < 4; ++i) { const unsigned w = cvt_pk_bf16(acc[ai][bj][m][n][i], 0.f); vscr[(8 * fq + 4 * n + i) * 16 + fr] = (bf16_t)(w & 0xffffu); }
                        asm volatile("s_waitcnt lgkmcnt(0)" ::: "memory");
                        const u32x4 v = *(const PG8_LAS u32x4*)(vscr + rc * 16 + rh * 8);
                        asm volatile("s_waitcnt lgkmcnt(0)" ::: "memory");
                        *(u32x4*)(vbase + (size_t)rc * len + tposw + ai * HALF + m * 16 + rh * 8) = v;
                    }
            } else {
                const bool is_rope = lat && (cb == 8 || (cb >= 14 && cb < 18));
                const bool is_gate = cb >= 22;
#pragma unroll
                for (int ai = 0; ai < 2; ++ai)
#pragma unroll
                    for (int m = 0; m < 4; ++m) {
                        f32x4 v0 = acc[ai][bj][m][0], v1 = acc[ai][bj][m][1];
                        if (is_gate) {
#pragma unroll
                            for (int i = 0; i < 4; ++i) { v0[i] = __builtin_amdgcn_rcpf(1.f + __builtin_amdgcn_exp2f(-1.4426950408889634f * v0[i])); v1[i] = __builtin_amdgcn_rcpf(1.f + __builtin_amdgcn_exp2f(-1.4426950408889634f * v1[i])); }
                        } else if (is_rope) {
                            const int tp = tpos0 + ai * HALF + m * 16;
                            const int pos = (wc & 1) ? (tp & 63) : (tp >> 6);
                            const float* tb = rope + pos * 16 + 8 * (fq & 1);
                            const f32x4 c0 = *(const f32x4*)tb, c1 = *(const f32x4*)(tb + 4), s0 = *(const f32x4*)(tb + 1024), s1 = *(const f32x4*)(tb + 1028);
                            f32x4 p0, p1;
#pragma unroll
                            for (int i = 0; i < 4; ++i) { p0[i] = __shfl_xor(v0[i], 32); p1[i] = __shfl_xor(v1[i], 32); }
                            if (fq < 2) { v0 = v0 * c0 - p0 * s0; v1 = v1 * c1 - p1 * s1; }
                            else { v0 = p0 * s0 + v0 * c0; v1 = p1 * s1 + v1 * c1; }
                        }
                        u32x4 w; w.x = cvt_pk_bf16(v0[0], v0[1]); w.y = cvt_pk_bf16(v0[2], v0[3]); w.z = cvt_pk_bf16(v1[0], v1[1]); w.w = cvt_pk_bf16(v1[2], v1[3]);
                        *(u32x4*)(Z + (size_t)(grow0 + ai * HALF + wr * 64 + m * 16 + fr) * 5888 + col0) = w;
                    }
            }
        }
    }
};
constexpr int NTM_STACK = 68;
struct EpiMergeSeg {
    static constexpr bool PERM = true, AFTER_DRAIN = false;
    const bf16_t* Z; bf16_t* M;
    __device__ __forceinline__ void operator()(const f32x4 (&acc)[2][2][4][2], const Unit& u, int wr, int wc, int fr, int fq) const {
        const int seg = u.pn >> 2, tn = u.pn & 3, tm = u.pm - seg * NTM_STACK;
        const int row0 = tm * BM + wr * 64 + fr, col0 = tn * BM + wc * 32 + 8 * fq;
        const bf16_t* zb = Z + (size_t)row0 * 5888 + 2816 + seg * 1024 + col0; bf16_t* mb = M + (size_t)row0 * 1024 + col0;
#pragma unroll
        for (int ai = 0; ai < 2; ++ai) {
            u32x4 g[4][2], o[4][2];
#pragma unroll
            for (int m = 0; m < 4; ++m)
#pragma unroll
                for (int bj = 0; bj < 2; ++bj) { const size_t ro = (size_t)(ai * HALF + m * 16);
                    g[m][bj] = *(const u32x4*)(zb + ro * 5888 + bj * HALF);
                    o[m][bj] = seg ? *(const u32x4*)(mb + ro * 1024 + bj * HALF) : (u32x4){0u, 0u, 0u, 0u}; }
            __builtin_amdgcn_sched_barrier(0);
#pragma unroll
            for (int m = 0; m < 4; ++m)
#pragma unroll
                for (int bj = 0; bj < 2; ++bj) { const u32x4 gg = g[m][bj], oo = o[m][bj]; const f32x4 v0 = acc[ai][bj][m][0], v1 = acc[ai][bj][m][1];
                    u32x4 w;
                    w.x = cvt_pk_bf16(__uint_as_float(gg.x << 16) * v0[0] + __uint_as_float(oo.x << 16), __uint_as_float(gg.x & 0xffff0000u) * v0[1] + __uint_as_float(oo.x & 0xffff0000u));
                    w.y = cvt_pk_bf16(__uint_as_float(gg.y << 16) * v0[2] + __uint_as_float(oo.y << 16), __uint_as_float(gg.y & 0xffff0000u) * v0[3] + __uint_as_float(oo.y & 0xffff0000u));
                    w.z = cvt_pk_bf16(__uint_as_float(gg.z << 16) * v1[0] + __uint_as_float(oo.z << 16), __uint_as_float(gg.z & 0xffff0000u) * v1[1] + __uint_as_float(oo.z & 0xffff0000u));
                    w.w = cvt_pk_bf16(__uint_as_float(gg.w << 16) * v1[2] + __uint_as_float(oo.w << 16), __uint_as_float(gg.w & 0xffff0000u) * v1[3] + __uint_as_float(oo.w & 0xffff0000u));
                    *(u32x4*)(mb + (size_t)(ai * HALF + m * 16) * 1024 + bj * HALF) = w; }
            __builtin_amdgcn_sched_barrier(0);
        }
    }
};
struct MergeOrder {
    int ntiles, G, c, pad;
    __device__ bool next(int i, Unit& u) const { const int ti = (i / 3) * G + c, seg = i % 3; if (ti >= ntiles) return false; u.pm = seg * NTM_STACK + (ti >> 2); u.pn = seg * 4 + (ti & 3); return true; }
    __device__ __forceinline__ void a_ready(const Unit&) const {}
    __device__ __forceinline__ void done(const Unit&) const {}
};
struct EpiResid {
    static constexpr bool PERM = false, AFTER_DRAIN = false;
    const float* Sl; const float* Sc; float* Xl; float* Xc; const float* modl; int gate_idx; int pad;
    __device__ __forceinline__ void operator()(const f32x4 (&acc)[2][2][4][2], const Unit& u, int wr, int wc, int fr, int fq) const {
        const int mrow = u.pm < 64 ? (u.pm >> 4) : 4;
        const size_t boff = u.pm < 64 ? (size_t)u.pm * BM * 1024 : (size_t)(u.pm - 64) * BM * 1024;
        const int col0 = u.pn * BM + wc * 32 + 4 * fq;
        const float* sbase = (u.pm < 64 ? Sl : Sc) + boff + (size_t)(wr * 64 + fr) * 1024 + col0; float* dbase = (u.pm < 64 ? Xl : Xc) + boff + (size_t)(wr * 64 + fr) * 1024 + col0;
        const float* gt = modl + (size_t)mrow * 6144 + gate_idx * 1024 + col0;
        f32x4 gv[2][2];
#pragma unroll
        for (int bj = 0; bj < 2; ++bj)
#pragma unroll
            for (int n = 0; n < 2; ++n) gv[bj][n] = *(const f32x4*)(gt + bj * HALF + 16 * n);
#pragma unroll
        for (int ai = 0; ai < 2; ++ai) {
            f32x4 x[4][2][2];
#pragma unroll
            for (int m = 0; m < 4; ++m)
#pragma unroll
                for (int bj = 0; bj < 2; ++bj)
#pragma unroll
                    for (int n = 0; n < 2; ++n) x[m][bj][n] = *(const f32x4*)(sbase + (size_t)(ai * HALF + m * 16) * 1024 + bj * HALF + 16 * n);
            __builtin_amdgcn_sched_barrier(0);
#pragma unroll
            for (int m = 0; m < 4; ++m)
#pragma unroll
                for (int bj = 0; bj < 2; ++bj)
#pragma unroll
                    for (int n = 0; n < 2; ++n) *(f32x4*)(dbase + (size_t)(ai * HALF + m * 16) * 1024 + bj * HALF + 16 * n) = x[m][bj][n] + gv[bj][n] * acc[ai][bj][m][n];
            __builtin_amdgcn_sched_barrier(0);
        }
    }
};
struct ZLastOrder {
    StaticOrder S0; int G, c;
    __device__ bool next(int i, Unit& u) const {
        const long L = (long)i * G + c;
        if (L < S0.nwg) return S0.next(i, u);
        const int e = (int)(L - S0.nwg); if (e >= 20) return false;
        u.pm = 64 + e / 5; u.pn = e % 5; return true;
    }
    __device__ __forceinline__ void a_ready(const Unit&) const {}
    __device__ __forceinline__ void done(const Unit&) const {}
};
template <class Epi, class Sched, bool ALIGN_EPI = false, bool SP2 = false>
__device__ __forceinline__ void gemm_phase(PG8_LAS unsigned char* lds, const Gemm g, const Sched& S, const Epi& E, const int WV) {
    const int tid = opaque_tid(WV), wid = __builtin_amdgcn_readfirstlane(tid >> 6), lane = tid & 63, wr = wid >> 2, wc = wid & 3, fr = lane & 15, fq = lane >> 4;
    const int K = g.K, nt = K / BK;
    unsigned voffA[2], voffB[2];
#pragma unroll
    for (int i = 0; i < 2; ++i) { int R, C; stage_rc(tid * 16 + i * 8192, R, C); const int Rb = Epi::PERM ? ((R & ~31) + perm32(R & 31)) : R;
        voffA[i] = (unsigned)(R * K + C) * 2u; voffB[i] = (unsigned)(Rb * K + C) * 2u; }
    const size_t kstep = (size_t)(BK * 2);
    const size_t hstep = (size_t)HALF * K * 2;
    const size_t tstep = 2 * hstep;
    const unsigned ldsw = (unsigned)wid * 1024u;
    const int aoff = lds_byte(wr * 64 + fr, fq * 8), boff = lds_byte(wc * 32 + fr, fq * 8);
#define PG8_SA(b, h) (((b) * 2 + (h)) * HTB)
#define PG8_SB(b, h) ((4 + (b) * 2 + (h)) * HTB)
#define PG8_STAGE(bufoff, gbase, voff) do { _Pragma("unroll") for (int _i = 0; _i < 2; ++_i) \
        __builtin_amdgcn_global_load_lds((const unsigned*)((const char*)(gbase) + (voff)[_i]), (PG8_LAS unsigned*)(lds + (bufoff) + ldsw + _i * 8192), 16, 0, 0); } while (0)
#define PG8_LDA(dst, b, h) do { _Pragma("unroll") for (int m = 0; m < 4; ++m) _Pragma("unroll") for (int k = 0; k < 2; ++k) dst[m][k] = *(const PG8_LAS bf16x8*)(lds + PG8_SA(b, h) + aoff + m * 2048 + k * 1024); } while (0)
#define PG8_LDB(dst, b, h) do { _Pragma("unroll") for (int n = 0; n < 2; ++n) _Pragma("unroll") for (int k = 0; k < 2; ++k) dst[n][k] = *(const PG8_LAS bf16x8*)(lds + PG8_SB(b, h) + boff + n * 2048 + k * 1024); } while (0)
#define PG8_MMA(ai, bj, At, Bt) do { __builtin_amdgcn_s_setprio(1); _Pragma("unroll") for (int m = 0; m < 4; ++m) _Pragma("unroll") for (int n = 0; n < 2; ++n) _Pragma("unroll") for (int k = 0; k < 2; ++k) \
        acc[ai][bj][m][n] = __builtin_amdgcn_mfma_f32_16x16x32_bf16(Bt[n][k], At[m][k], acc[ai][bj][m][n], 0, 0, 0); __builtin_amdgcn_s_setprio(0); } while (0)
#define PG8_WAIT_V(n) asm volatile("s_waitcnt vmcnt(" #n ")" ::: "memory")
#define PG8_WAIT_L(n) asm volatile("s_waitcnt lgkmcnt(" #n ")" ::: "memory")
#define PG8_BAR __builtin_amdgcn_s_barrier()
#define PG8_SCHED __builtin_amdgcn_sched_barrier(0)
    Unit cur, nxt; int ui = 0;
    if (!S.next(0, cur)) return;
    f32x4 acc[2][2][4][2];
#pragma unroll
    for (int a = 0; a < 2; ++a)
#pragma unroll
        for (int b = 0; b < 2; ++b)
#pragma unroll
            for (int m = 0; m < 4; ++m)
#pragma unroll
                for (int n = 0; n < 2; ++n) acc[a][b][m][n] = (f32x4){0.f, 0.f, 0.f, 0.f};
    bf16x8 At[4][2], B0[2][2], B1[2][2];
    const char* cA = (const char*)g.A + (size_t)cur.pm * tstep; const char* cB = (const char*)g.Bt + (size_t)cur.pn * tstep;
    S.a_ready(cur);
    if constexpr (SP2) {
        PG8_STAGE(PG8_SB(0, 0), cB, voffB); PG8_STAGE(PG8_SB(0, 1), cB + hstep, voffB); PG8_STAGE(PG8_SA(0, 0), cA, voffA); PG8_STAGE(PG8_SA(0, 1), cA + hstep, voffA);
        if (wr == 1) PG8_BAR;
        PG8_WAIT_V(2); PG8_BAR;
        PG8_STAGE(PG8_SB(1, 0), cB + kstep, voffB); PG8_STAGE(PG8_SA(1, 0), cA + kstep, voffA); PG8_STAGE(PG8_SB(1, 1), cB + hstep + kstep, voffB);
        PG8_WAIT_V(6); PG8_BAR;
    } else {
        PG8_STAGE(PG8_SB(0, 0), cB, voffB); PG8_STAGE(PG8_SA(0, 0), cA, voffA); PG8_STAGE(PG8_SB(0, 1), cB + hstep, voffB); PG8_STAGE(PG8_SA(0, 1), cA + hstep, voffA);
        if (wr == 1) PG8_BAR;
        PG8_WAIT_V(4); PG8_BAR;
        PG8_STAGE(PG8_SB(1, 0), cB + kstep, voffB); PG8_STAGE(PG8_SA(1, 0), cA + kstep, voffA); PG8_STAGE(PG8_SB(1, 1), cB + hstep + kstep, voffB);
        PG8_WAIT_V(6); PG8_BAR;
    }
    for (;;) {
        const bool has_next = S.next(ui + 1, nxt);
        const char* nA = has_next ? (const char*)g.A + (size_t)nxt.pm * tstep : cA; const char* nB = has_next ? (const char*)g.Bt + (size_t)nxt.pn * tstep : cB;
        for (int t = 0; t < nt; t += 2) {
            const bool last = (t == nt - 2);
            const char* a1 = cA + (size_t)(t + 1) * kstep;
            const char* a2 = last ? nA : cA + (size_t)(t + 2) * kstep; const char* b2 = last ? nB : cB + (size_t)(t + 2) * kstep;
            const char* a3 = a2 + kstep; const char* b3 = b2 + kstep;
            if (last && has_next) S.a_ready(nxt);
            if constexpr (SP2) {
            PG8_LDB(B0, 0, 0); PG8_LDB(B1, 0, 1); PG8_SCHED; PG8_LDA(At, 0, 0); PG8_STAGE(PG8_SA(1, 1), a1 + hstep, voffA);
            PG8_WAIT_V(8); PG8_WAIT_L(0); PG8_BAR; PG8_MMA(0, 0, At, B0); PG8_MMA(0, 1, At, B1); PG8_BAR; PG8_SCHED;
            PG8_LDA(At, 0, 1); PG8_STAGE(PG8_SB(0, 0), b2, voffB); PG8_STAGE(PG8_SB(0, 1), b2 + hstep, voffB); PG8_STAGE(PG8_SA(0, 0), a2, voffA);
            PG8_WAIT_V(8); PG8_WAIT_L(0); PG8_BAR; PG8_MMA(1, 0, At, B0); PG8_MMA(1, 1, At, B1); PG8_BAR; PG8_SCHED;
            PG8_LDB(B0, 1, 0); PG8_LDB(B1, 1, 1); PG8_SCHED; PG8_LDA(At, 1, 0); PG8_STAGE(PG8_SA(0, 1), a2 + hstep, voffA);
            PG8_WAIT_V(8); PG8_WAIT_L(0); PG8_BAR; PG8_MMA(0, 0, At, B0); PG8_MMA(0, 1, At, B1); PG8_BAR; PG8_SCHED;
            PG8_LDA(At, 1, 1); PG8_STAGE(PG8_SB(1, 0), b3, voffB); PG8_STAGE(PG8_SB(1, 1), b3 + hstep, voffB); PG8_STAGE(PG8_SA(1, 0), a3, voffA);
            PG8_WAIT_V(8); PG8_WAIT_L(0); PG8_BAR; PG8_MMA(1, 0, At, B0); PG8_MMA(1, 1, At, B1); PG8_BAR; PG8_SCHED;
            } else {
            PG8_LDB(B0, 0, 0); PG8_SCHED; PG8_LDA(At, 0, 0); PG8_STAGE(PG8_SA(1, 1), a1 + hstep, voffA);
            PG8_WAIT_L(8); PG8_BAR; PG8_WAIT_L(0); PG8_MMA(0, 0, At, B0); PG8_BAR; PG8_SCHED;
            PG8_LDB(B1, 0, 1); PG8_STAGE(PG8_SB(0, 0), b2, voffB);
            PG8_BAR; PG8_WAIT_L(0); PG8_MMA(0, 1, At, B1); PG8_BAR;
            PG8_LDA(At, 0, 1); PG8_STAGE(PG8_SA(0, 0), a2, voffA);
            PG8_BAR; PG8_WAIT_L(0); PG8_MMA(1, 0, At, B0); PG8_BAR; PG8_SCHED;
            PG8_STAGE(PG8_SB(0, 1), b2 + hstep, voffB);
            PG8_WAIT_V(6); PG8_BAR; PG8_MMA(1, 1, At, B1); PG8_BAR;
            PG8_LDB(B0, 1, 0); PG8_SCHED; PG8_LDA(At, 1, 0); PG8_STAGE(PG8_SA(0, 1), a2 + hstep, voffA);
            PG8_WAIT_L(8); PG8_BAR; PG8_WAIT_L(0); PG8_MMA(0, 0, At, B0); PG8_BAR; PG8_SCHED;
            PG8_LDB(B1, 1, 1); PG8_STAGE(PG8_SB(1, 0), b3, voffB);
            PG8_BAR; PG8_WAIT_L(0); PG8_MMA(0, 1, At, B1); PG8_BAR;
            PG8_LDA(At, 1, 1); PG8_STAGE(PG8_SA(1, 0), a3, voffA);
            PG8_BAR; PG8_WAIT_L(0); PG8_MMA(1, 0, At, B0); PG8_BAR; PG8_SCHED;
            PG8_STAGE(PG8_SB(1, 1), b3 + hstep, voffB);
            PG8_WAIT_V(6); PG8_BAR; PG8_MMA(1, 1, At, B1); PG8_BAR;
            }
        }
        if constexpr (ALIGN_EPI) { if (wr == 0) PG8_BAR; }
        if constexpr (!Epi::AFTER_DRAIN) { E(acc, cur, wr, wc, fr, fq); S.done(cur); }
        if (!has_next) break;
#pragma unroll
        for (int a = 0; a < 2; ++a)
#pragma unroll
            for (int b = 0; b < 2; ++b)
#pragma unroll
                for (int m = 0; m < 4; ++m)
#pragma unroll
                    for (int n = 0; n < 2; ++n) acc[a][b][m][n] = (f32x4){0.f, 0.f, 0.f, 0.f};
        cur = nxt; cA = nA; cB = nB; ++ui;
        if constexpr (ALIGN_EPI) { if (wr == 1) PG8_BAR; }
    }
    PG8_WAIT_V(0);
    if constexpr (!ALIGN_EPI) { if (wr == 0) PG8_BAR; }
    PG8_BAR;
    if constexpr (Epi::AFTER_DRAIN) { E.fused(acc, cur, wr, wc, fr, fq, lds, wid, lane); S.done(cur); }
#undef PG8_SA
#undef PG8_SB
#undef PG8_STAGE
#undef PG8_LDA
#undef PG8_LDB
#undef PG8_MMA
#undef PG8_WAIT_V
#undef PG8_WAIT_L
#undef PG8_BAR
#undef PG8_SCHED
}
}

struct Params {
    const float *x, *c, *ctx, *c_ctx, *ada_w, *ada_b, *norm1_g, *norm2_g, *w_in, *pool_w, *pool_scale, *na_rpb, *swa_sink, *wba, *wbb, *wbc, *w_out, *peer_wq, *peer_keys, *peer_u, *peer_v, *final_g;
    float* out; unsigned char* ws;
};
#define TID (opaque_tid(WV))
#define BID ((int)blockIdx.x)
#define NBLK ((int)gridDim.x)

__device__ __forceinline__ void tr_tiles(const float* __restrict__ W, bf16_t* __restrict__ Wt, int K, int N, float* tile  , const int WV, int vblk, int nvblk) {
    const int ntn = N / 64, ntiles = (K / 128) * ntn, tid = TID;
    for (int vb = vblk; vb < ntiles; vb += nvblk) {
        const int k0 = (vb / ntn) * 128, n0 = (vb % ntn) * 64;
        float4 v[4];
#pragma unroll
        for (int i = 0; i < 4; ++i) { const int idx = tid + i * NTHREADS, r = idx >> 4, c4 = (idx & 15) * 4; v[i] = *(const float4*)(W + (size_t)(k0 + r) * N + n0 + c4); }
#pragma unroll
        for (int i = 0; i < 4; ++i) { const int idx = tid + i * NTHREADS, r = idx >> 4, c4 = (idx & 15) * 4; float* tp = tile + r * 65 + c4; tp[0] = v[i].x; tp[1] = v[i].y; tp[2] = v[i].z; tp[3] = v[i].w; }
        __syncthreads();
#pragma unroll
        for (int i = 0; i < 2; ++i) { const int idx = tid + i * NTHREADS, nn = idx >> 4, kg = (idx & 15) * 8; const float* tp = tile + kg * 65 + nn;
            uint4 o; o.x = pk2(tp[0], tp[65]); o.y = pk2(tp[130], tp[195]); o.z = pk2(tp[260], tp[325]); o.w = pk2(tp[390], tp[455]);
            *(uint4*)(Wt + (size_t)(n0 + nn) * K + k0 + kg) = o; }
        __syncthreads();
    }
}
__device__ __forceinline__ void conv_bf16(const float* __restrict__ src, bf16_t* __restrict__ dst, size_t n8, const int WV, int vblk, int nvblk) {
    for (size_t i = (size_t)vblk * NTHREADS + TID; i < n8; i += (size_t)nvblk * NTHREADS) {
        const float4 a = ((const float4*)src)[2 * i], b = ((const float4*)src)[2 * i + 1];
        uint4 o; o.x = pk2(a.x, a.y); o.y = pk2(a.z, a.w); o.z = pk2(b.x, b.y); o.w = pk2(b.z, b.w);
        ((uint4*)dst)[i] = o;
    }
}
__device__ __forceinline__ void conv_fp8_rows(const float* __restrict__ src, unsigned* __restrict__ dst, float* __restrict__ inv, int nrows, const int WV, int vblk = -1, int nvblk = 0) {
    const int tid = TID, lane = tid & 63;
    const int gw = (vblk >= 0 ? vblk : BID) * 8 + (tid >> 6), gstride = (vblk >= 0 ? nvblk : NBLK) * 8;
    for (int row = gw; row < nrows; row += gstride) {
        const float4* sp = (const float4*)(src + (size_t)row * D);
        float4 v[4]; float amax = 0.f;
#pragma unroll
        for (int i = 0; i < 4; ++i) { v[i] = sp[i * 64 + lane]; amax = fmaxf(amax, fmaxf(fmaxf(fabsf(v[i].x), fabsf(v[i].y)), fmaxf(fabsf(v[i].z), fabsf(v[i].w)))); }
#pragma unroll
        for (int o = 32; o > 0; o >>= 1) amax = fmaxf(amax, __shfl_xor(amax, o));
        const int k = (int)((__float_as_uint(amax) >> 23) & 255u) - 127;
        const bool ok = amax > 1e-30f;
        const float s = ok ? __uint_as_float((unsigned)(127 + 7 - k) << 23) : 1.f;
#pragma unroll
        for (int i = 0; i < 4; ++i) { int w = __builtin_amdgcn_cvt_pk_fp8_f32(v[i].x * s, v[i].y * s, 0, false); w = __builtin_amdgcn_cvt_pk_fp8_f32(v[i].z * s, v[i].w * s, w, true);
            dst[(size_t)row * 256 + i * 64 + lane] = (unsigned)w; }
        if (lane == 0) inv[row] = ok ? __uint_as_float((unsigned)(127 - 7 + k) << 23) : 1.f;
    }
}
__device__ __forceinline__ void copy_f4(const float* __restrict__ src, float* __restrict__ dst, size_t n4, const int WV) {
    for (size_t i = (size_t)BID * NTHREADS + TID; i < n4; i += (size_t)NBLK * NTHREADS) ((float4*)dst)[i] = ((const float4*)src)[i];
}
__device__ __forceinline__ void ph_prep_weights(const Params& p, int l, float* smem, const int WV, int vblk, int nvblk) {
    unsigned char* ws = p.ws;
    unsigned char* wl = ws + WS_W + l * W_LAYER;
    tr_tiles(p.w_in + (size_t)l * D * IN_COLS, (bf16_t*)(wl + W_WIN), D, IN_COLS, smem, WV, vblk, nvblk);
    tr_tiles(p.wbb + (size_t)l * 512 * D, (bf16_t*)(wl + W_WB), 512, D, smem, WV, vblk, nvblk);
    tr_tiles(p.wbc + (size_t)l * 512 * D, (bf16_t*)(wl + W_WC), 512, D, smem, WV, vblk, nvblk);
    tr_tiles(p.w_out + (size_t)l * D * D, (bf16_t*)(wl + W_WO), D, D, smem, WV, vblk, nvblk);
    tr_tiles(p.peer_wq + (size_t)l * D * 2048, (bf16_t*)(wl + W_WQ), D, 2048, smem, WV, vblk, nvblk);
    {
        const float* pw = p.pool_w + (size_t)l * 4 * 128 * 128; const float* ps = p.pool_scale + l * 512; const float* wba = p.wba + (size_t)l * 512 * D; bf16_t* WaT = (bf16_t*)(wl + W_WA);
        for (int idx = vblk * NTHREADS + TID; idx < 512 * D; idx += nvblk * NTHREADS) {
            const int n = idx % D, kk = idx / D, g = kk / 128, c = kk % 128;
            float acc = 0.f;
#pragma unroll 8
            for (int e = 0; e < 128; ++e) acc += pw[(g * 128 + c) * 128 + e] * ps[g * 128 + e] * wba[(size_t)(g * 128 + e) * D + n];
            WaT[(size_t)n * 512 + kk] = f2bf(acc);
        }
    }
    conv_bf16(p.peer_keys + (size_t)l * 8 * 2 * 128 * 128, (bf16_t*)(wl + W_KEYS), (size_t)8 * 2 * 128 * 128 / 8, WV, vblk, nvblk);
}
__device__ __forceinline__ void ph_prep(const Params& p, float* smem, const int WV) {
    unsigned char* ws = p.ws;
    ph_prep_weights(p, 0, smem, WV, BID, NBLK);
#if !FILL_W1
    ph_prep_weights(p, 1, smem, WV, BID, NBLK);
#endif
    {
        float* sv = smem; float* part = smem + 5 * 1024; float* mod = (float*)(ws + WS_MOD);
        const int tid = TID, lane = tid & 63, wid = tid >> 6;
        for (int vb = BID; vb < 2 * 96; vb += NBLK) {
            const int l = vb / 96, j0 = (vb % 96) * 64;
            for (int i = tid; i < 5 * 1024; i += NTHREADS) { const int r = i >> 10, k = i & 1023; const float v = r < 4 ? p.c[r * 1024 + k] : p.c_ctx[k]; sv[i] = v / (1.f + __expf(-v)); }
            __syncthreads();
            float a0 = 0.f, a1 = 0.f, a2 = 0.f, a3 = 0.f, a4 = 0.f;
            const float* w = p.ada_w + ((size_t)l * 1024 + wid * 128) * 6144 + j0 + lane;
#pragma unroll 16
            for (int k = 0; k < 128; ++k) { const float xw = w[(size_t)k * 6144]; const int kk = wid * 128 + k;
                a0 += sv[kk] * xw; a1 += sv[1024 + kk] * xw; a2 += sv[2048 + kk] * xw; a3 += sv[3072 + kk] * xw; a4 += sv[4096 + kk] * xw; }
            part[(wid * 5 + 0) * 64 + lane] = a0; part[(wid * 5 + 1) * 64 + lane] = a1; part[(wid * 5 + 2) * 64 + lane] = a2; part[(wid * 5 + 3) * 64 + lane] = a3; part[(wid * 5 + 4) * 64 + lane] = a4;
            __syncthreads();
            if (tid < 320) { const int r = tid >> 6; float s = 0.f;
#pragma unroll
                for (int w8 = 0; w8 < 8; ++w8) s += part[(w8 * 5 + r) * 64 + lane];
                mod[((size_t)l * 5 + r) * 6144 + j0 + lane] = s + p.ada_b[l * 6144 + j0 + lane]; }
            __syncthreads();
        }
    }
    {
        float* tab = (float*)(ws + WS_ROPE);
        for (int i = BID * NTHREADS + TID; i < 1024; i += NBLK * NTHREADS) { const int pos = i / 16, fi = i % 16; const float inv = powf(10000.0f, -(float)fi / 16.0f), ang = (float)pos * inv; tab[i] = cosf(ang); tab[1024 + i] = sinf(ang); }
    }
}

typedef float f32x2v __attribute__((ext_vector_type(2)));
__device__ __forceinline__ float wave_sum(float v) {
#pragma unroll
    for (int o = 32; o > 0; o >>= 1) v += __shfl_xor(v, o);
    return v;
}
__device__ __forceinline__ void ph_norm_mod(const float* __restrict__ Xl, const float* __restrict__ Xc, const float* __restrict__ g, const float* __restrict__ modl, int shift_idx, int scale_idx, bf16_t* __restrict__ H, int nrows, unsigned* __restrict__ H8, const int WV) {
    const int lane = TID & 63, gw = BID * 8 + (TID >> 6);
    for (int row = gw; row < nrows; row += NBLK * 8) {
        const float* src = row < T_LAT ? Xl + (size_t)row * D : Xc + (size_t)(row - T_LAT) * D;
        const int mrow = row < T_LAT ? row / S : 4;
        float4 v[4]; float ss = 0.f;
#pragma unroll
        for (int i = 0; i < 4; ++i) { v[i] = ((const float4*)src)[i * 64 + lane]; ss += v[i].x * v[i].x + v[i].y * v[i].y + v[i].z * v[i].z + v[i].w * v[i].w; }
        ss = wave_sum(ss);
        const float rstd = rsqrtf(ss * (1.0f / D) + EPS);
        const float* sh = modl + (size_t)mrow * 6144 + shift_idx * 1024; const float* sc = modl + (size_t)mrow * 6144 + scale_idx * 1024;
#pragma unroll
        for (int i = 0; i < 4; ++i) { const int k = (i * 64 + lane) * 4;
            const float4 gg = *(const float4*)(g + k), s4 = *(const float4*)(sc + k), h4 = *(const float4*)(sh + k);
            uint2 w; w.x = pk2(v[i].x * rstd * gg.x * (1.f + s4.x) + h4.x, v[i].y * rstd * gg.y * (1.f + s4.y) + h4.y);
            w.y = pk2(v[i].z * rstd * gg.z * (1.f + s4.z) + h4.z, v[i].w * rstd * gg.w * (1.f + s4.w) + h4.w);
            *(uint2*)(H + (size_t)row * D + k) = w;
            if (H8) {
                const float h0 = 8.f * lo16(w.x), h1 = 8.f * hi16(w.x), h2 = 8.f * lo16(w.y), h3 = 8.f * hi16(w.y);
                int hi = __builtin_amdgcn_cvt_pk_fp8_f32(h0, h1, 0, false); hi = __builtin_amdgcn_cvt_pk_fp8_f32(h2, h3, hi, true);
                const f32x2v d0 = __builtin_amdgcn_cvt_pk_f32_fp8(hi, false), d1 = __builtin_amdgcn_cvt_pk_f32_fp8(hi, true);
                int lo = __builtin_amdgcn_cvt_pk_fp8_f32(h0 - d0[0], h1 - d0[1], 0, false); lo = __builtin_amdgcn_cvt_pk_fp8_f32(h2 - d1[0], h3 - d1[1], lo, true);
                H8[(size_t)row * 256 + i * 64 + lane] = (unsigned)hi; H8[(size_t)T_ALL * 256 + (size_t)row * 256 + i * 64 + lane] = (unsigned)lo; } }
    }
}
__device__ __forceinline__ void ph_pool(const bf16_t* __restrict__ Z, bf16_t* __restrict__ Pa, int rows, int tid) {
    for (int idx = BID * NTHREADS + tid; idx < rows * 64; idx += NBLK * NTHREADS) {
        const int c8 = idx & 63, row = idx >> 6, g = c8 >> 4, w = 2 << g;
        const bool lat = row < T_LAT; const int len = lat ? S : L; const int t = lat ? (row & (S - 1)) : ((row - T_LAT) & (L - 1)); const int base = row - t;
        int lo = t - w / 2; if (lo < 0) lo = 0; int hi = t - w / 2 + w; if (hi > len) hi = len;
        float sum[8];
#pragma unroll
        for (int i = 0; i < 8; ++i) sum[i] = 0.f;
        const bf16_t* zp = Z + (size_t)base * IN_COLS + OFF_A + c8 * 8;
        for (int tt = lo; tt < hi; ++tt) { const uint4 v = *(const uint4*)(zp + (size_t)tt * IN_COLS);
            sum[0] += lo16(v.x); sum[1] += hi16(v.x); sum[2] += lo16(v.y); sum[3] += hi16(v.y); sum[4] += lo16(v.z); sum[5] += hi16(v.z); sum[6] += lo16(v.w); sum[7] += hi16(v.w); }
        const uint4 sv = *(const uint4*)(zp + (size_t)t * IN_COLS); const float inv = 1.f / (float)(hi - lo);
        uint4 o; o.x = pk2(sum[0] * inv - lo16(sv.x), sum[1] * inv - hi16(sv.x)); o.y = pk2(sum[2] * inv - lo16(sv.y), sum[3] * inv - hi16(sv.y));
        o.z = pk2(sum[4] * inv - lo16(sv.z), sum[5] * inv - hi16(sv.z)); o.w = pk2(sum[6] * inv - lo16(sv.w), sum[7] * inv - hi16(sv.w));
        *(uint4*)(Pa + (size_t)row * 512 + c8 * 8) = o;
    }
}
typedef short bf16x8v __attribute__((ext_vector_type(8)));
typedef float f32x4v __attribute__((ext_vector_type(4)));
constexpr float LOG2E = 1.4426950408889634f;
constexpr float QK_SCALE2 = 0.125f * LOG2E;
constexpr float MASKED = -3.0e38f;
__device__ __forceinline__ unsigned cvtpk(float lo, float hi) { unsigned r; asm volatile("v_cvt_pk_bf16_f32 %0, %1, %2" : "=v"(r) : "v"(lo), "v"(hi)); return r; }
__device__ __forceinline__ f32x4v mfma16(bf16x8v a, bf16x8v b, f32x4v c) { return __builtin_amdgcn_mfma_f32_16x16x32_bf16(a, b, c, 0, 0, 0); }
struct AttnSt { f32x4v o[4]; float m, l; };
__device__ __forceinline__ int clampi(int v, int lo, int hi) { return v < lo ? lo : (v > hi ? hi : v); }
template <class Dsc> __device__ __forceinline__ void attn_load_k(const Dsc& dsc, int c, bf16x8v (&kf)[2][2]) {
#pragma unroll
    for (int tt = 0; tt < 2; ++tt) { const bf16_t* kb = dsc.kbase(c); const unsigned ko = dsc.koff(c, tt); kf[tt][0] = *(const bf16x8v*)(kb + ko); kf[tt][1] = *(const bf16x8v*)(kb + (ko + 32u)); }
}
template <class Dsc> __device__ __forceinline__ void attn_load_v(const Dsc& dsc, int c, bf16x8v (&vf)[4]) {
    const bf16_t* vb = dsc.vbase(c); const unsigned vo = dsc.voff(c); const unsigned vs = dsc.vstride16();
#pragma unroll
    for (int dt = 0; dt < 4; ++dt) vf[dt] = *(const bf16x8v*)(vb + (size_t)(dt * vs) + vo);
}
template <int VAR, class Dsc>
__device__ __forceinline__ void attn_chunk4(const Dsc& dsc, int c, int, const bf16x8v (&kf)[2][2], const bf16x8v (&vf)[4], const bf16x8v (&qf)[4][2], AttnSt (&st)[4], int lane) {
#pragma unroll
    for (int t = 0; t < 4; ++t) {
        if (!dsc.tile_live(t, c)) continue;
        f32x4v s[2];
#pragma unroll
        for (int tt = 0; tt < 2; ++tt) { f32x4v acc = (f32x4v){0.f, 0.f, 0.f, 0.f}; acc = mfma16(kf[tt][0], qf[t][0], acc); acc = mfma16(kf[tt][1], qf[t][1], acc); s[tt] = acc; }
#pragma unroll
        for (int tt = 0; tt < 2; ++tt)
#pragma unroll
            for (int r = 0; r < 4; ++r) s[tt][r] = dsc.score(t, c, tt, r, s[tt][r]);
        float gmax = fmaxf(fmaxf(fmaxf(s[0][0], s[0][1]), fmaxf(s[0][2], s[0][3])), fmaxf(fmaxf(s[1][0], s[1][1]), fmaxf(s[1][2], s[1][3])));
        if (__any(gmax > st[t].m + 8.0f)) {
            gmax = fmaxf(gmax, __shfl_xor(gmax, 16)); gmax = fmaxf(gmax, __shfl_xor(gmax, 32));
            const float mnew = fmaxf(st[t].m, gmax), alpha = __builtin_amdgcn_exp2f(st[t].m - mnew);
            st[t].m = mnew; st[t].l *= alpha;
            const int gb = (lane >> 4) * 4;
#pragma unroll
            for (int r = 0; r < 4; ++r) { const float ar = __shfl(alpha, gb + r);
#pragma unroll
                for (int dt = 0; dt < 4; ++dt) st[t].o[dt][r] *= ar; }
        }
        const float mref = st[t].m;
        float psum = 0.f;
#pragma unroll
        for (int tt = 0; tt < 2; ++tt)
#pragma unroll
            for (int r = 0; r < 4; ++r) { const float pv = __builtin_amdgcn_exp2f(s[tt][r] - mref); s[tt][r] = pv; psum += pv; }
        st[t].l += psum;
        union { unsigned u[4]; bf16x8v v; } pf;
        pf.u[0] = cvtpk(s[0][0], s[0][1]); pf.u[1] = cvtpk(s[0][2], s[0][3]); pf.u[2] = cvtpk(s[1][0], s[1][1]); pf.u[3] = cvtpk(s[1][2], s[1][3]);
#pragma unroll
        for (int dt = 0; dt < 4; ++dt) st[t].o[dt] = mfma16(pf.v, vf[dt], st[t].o[dt]);
    }
}
template <int VAR, class Dsc>
__device__ __forceinline__ void attn_stream4(const Dsc& dsc, int nc, const bf16x8v (&qf)[4][2], AttnSt (&st)[4], int lane) {
    bf16x8v kA[2][2], kB[2][2], vf[4];
    attn_load_k(dsc, 0, kA);
#pragma unroll 1
    for (int c = 0; c < nc; c += 2) {
        attn_load_k(dsc, (c + 1 < nc) ? c + 1 : c, kB); attn_load_v(dsc, c, vf);
        __builtin_amdgcn_sched_barrier(0);
        attn_chunk4<VAR>(dsc, c, c, kA, vf, qf, st, lane); __builtin_amdgcn_sched_barrier(0);
        if (c + 1 < nc) {
            attn_load_k(dsc, (c + 2 < nc) ? c + 2 : c + 1, kA); attn_load_v(dsc, c + 1, vf);
            __builtin_amdgcn_sched_barrier(0);
            attn_chunk4<VAR>(dsc, c + 1, c + 1, kB, vf, qf, st, lane); __builtin_amdgcn_sched_barrier(0);
        }
    }
}
__device__ __forceinline__ void attn_finish(AttnSt& st, float sink2, bool has_sink, bf16_t* orow  , int lane, bf16_t* scr  ) {
    float l = st.l; l += __shfl_xor(l, 16); l += __shfl_xor(l, 32);
    if (has_sink) l += __builtin_amdgcn_exp2f(sink2 - st.m);
    const float inv = 1.0f / l;
    const int gb = (lane >> 4) * 4, d = lane & 15;
#pragma unroll
    for (int r = 0; r < 4; ++r) { const float ir = __shfl(inv, gb + r);
#pragma unroll
        for (int dt = 0; dt < 4; ++dt) scr[(gb + r) * 64 + dt * 16 + d] = f2bf(st.o[dt][r] * ir); }
    asm volatile("s_waitcnt lgkmcnt(0)" ::: "memory");
    const int row = lane >> 2, part = lane & 3;
    const uint4 a = *(const uint4*)(scr + row * 64 + part * 16), b = *(const uint4*)(scr + row * 64 + part * 16 + 8);
    asm volatile("s_waitcnt lgkmcnt(0)" ::: "memory");
    *(uint4*)(orow + (size_t)row * 512 + part * 16) = a; *(uint4*)(orow + (size_t)row * 512 + part * 16 + 8) = b;
}
__device__ __forceinline__ void attn_init_st(AttnSt& st) {
#pragma unroll
    for (int dt = 0; dt < 4; ++dt) st.o[dt] = (f32x4v){0.f, 0.f, 0.f, 0.f};
    st.m = -1.0e30f; st.l = 0.f;
}
struct Na4Dsc {
    const bf16_t* kb0;
    const bf16_t* vb0;
    const float* rpb;
    unsigned ko[2], vo;
    int dc0; float mk[8];
    int Rlo, r0, nrow;
    __device__ __forceinline__ int crow(int c) const { return c < nrow ? c : nrow - 1; }
    __device__ __forceinline__ const bf16_t* kbase(int c) const { return kb0 + (size_t)crow(c) * 64 * IN_COLS; }
    __device__ __forceinline__ unsigned koff(int, int tt) const { return ko[tt]; }
    __device__ __forceinline__ const bf16_t* vbase(int c) const { return vb0 + crow(c) * 64; }
    __device__ __forceinline__ unsigned voff(int) const { return vo; }
    __device__ __forceinline__ unsigned vstride16() const { return 16u * S; }
    __device__ __forceinline__ bool tile_live(int t, int c) const { const int R0 = clampi(r0 + t - 4, 0, 56), kr = Rlo + c; return c < nrow && kr >= R0 && kr <= R0 + 7; }
    __device__ __forceinline__ float score(int t, int c, int tt, int r, float raw) const {
        const float bias = rpb[(Rlo + c - (r0 + t) + 7) * 31 + dc0 + 4 * tt + r];
        return raw * QK_SCALE2 + bias + mk[tt * 4 + r];
    }
};
struct Ctx4Dsc {
    const bf16_t* kb0;
    const bf16_t* vb0;
    unsigned ko[2], vo;
    __device__ __forceinline__ const bf16_t* kbase(int c) const { return kb0 + (size_t)c * 32 * IN_COLS; }
    __device__ __forceinline__ unsigned koff(int, int tt) const { return ko[tt]; }
    __device__ __forceinline__ const bf16_t* vbase(int c) const { return vb0 + c * 32; }
    __device__ __forceinline__ unsigned voff(int) const { return vo; }
    __device__ __forceinline__ unsigned vstride16() const { return 16u * L; }
    __device__ __forceinline__ bool tile_live(int, int) const { return true; }
    __device__ __forceinline__ float score(int, int, int, int, float raw) const { return raw * QK_SCALE2; }
};
struct Swa4Dsc {
    const bf16_t* zrow;
    const bf16_t* vrow;
    int p0, kslot0, g8, qpos, dS;
    __device__ __forceinline__ const bf16_t* kbase(int) const { return zrow; }
    __device__ __forceinline__ unsigned koff(int c, int tt) const { const int pos = clampi(p0 - 128 + 32 * c + kslot0 + 4 * tt, 0, S - 1); return (unsigned)pos * (unsigned)IN_COLS + (unsigned)g8; }
    __device__ __forceinline__ const bf16_t* vbase(int) const { return vrow; }
    __device__ __forceinline__ unsigned voff(int c) const { const int pos = clampi(p0 - 128 + 32 * c + g8, 0, S - 8); return (unsigned)(dS + pos); }
    __device__ __forceinline__ unsigned vstride16() const { return 16u * S; }
    __device__ __forceinline__ bool tile_live(int, int c) const { const int pos0 = p0 - 128 + 32 * c; return c < 9 && pos0 + 31 >= 0 && pos0 < S; }
    __device__ __forceinline__ float score(int, int c, int tt, int r, float raw) const {
        const int pos0 = p0 - 128 + 32 * c;
        if (c >= 1 && c <= 7 && pos0 >= 0 && pos0 + 31 < S) return raw * QK_SCALE2;
        const int pos = pos0 + g8 + 4 * tt + r; const int dlt = qpos - pos;
        return (pos >= 0 && pos < S && dlt <= 128 && dlt >= -128) ? raw * QK_SCALE2 : MASKED;
    }
};
template <int VAR>
__device__ __forceinline__ void ph_attn(const bf16_t* __restrict__ Z, const bf16_t* __restrict__ vtn, const bf16_t* __restrict__ vtnc, const bf16_t* __restrict__ vtw, const bf16_t* __restrict__ vtwc,
                                        const float* __restrict__ rpb, const float* __restrict__ sink, bf16_t* __restrict__ Ob, bf16_t* __restrict__ Oc, bool do_ctx, float* smem, bf16_t* __restrict__ Pa, int rows, const int WV) {
    const int tid = TID, lane = tid & 63, wid = tid >> 6;
    for (int i = tid; i < 8 * 465 + 64; i += NTHREADS) smem[i] = (i >= 16 && i < 16 + 8 * 465) ? rpb[i - 16] * LOG2E : 0.f;
    if (VAR == 0) ph_pool(Z, Pa, rows, tid);
    __syncthreads();
    const int q = lane & 15, g = lane >> 4, kslot0 = (q >> 2) * 8 + (q & 3);
    bf16_t* oscr = (bf16_t*)((unsigned char*)smem + 16384 + wid * 2048);
    const int wu = __builtin_amdgcn_readfirstlane(wid);
    const int vcu = (NBLK % 8 == 0) ? (BID % 8) * (NBLK / 8) + BID / 8 : BID;
    const int nunits = 2048 + 2048 + (do_ctx ? 256 : 0);
    const unsigned ko0 = (unsigned)kslot0 * IN_COLS + 8u * g, ko1 = ko0 + 4u * IN_COLS, qo = (unsigned)q * IN_COLS + 8u * g;
    for (int uu = vcu * 8 + wu; uu < nunits; uu += NBLK * 8) {
        const int u = uu >= 4096 ? uu : (((uu & 255) < 128) ? ((uu >> 8) * 128 + (uu & 127)) : (2048 + (uu >> 8) * 128 + (uu & 127)));
        if ((VAR == 6 || VAR == 8 || VAR == 9) && u >= 2048) continue;
        if (VAR == 7 && (u < 2048 || u >= 4096)) continue;
        AttnSt st[4]; bf16x8v qf[4][2];
#pragma unroll
        for (int t = 0; t < 4; ++t) attn_init_st(st[t]);
        if (u < 2048) {
            const int cb = u & 3, r4 = (u >> 2) & 15, h = (u >> 6) & 7, b = u >> 9, r0 = r4 * 4;
            const int Rlo = clampi(r0 - 4, 0, 56), Rhi = clampi(r0 + 3 - 4, 0, 56) + 7, nrow = Rhi - Rlo + 1;
            const int C0 = clampi(cb * 16 - 8, 0, 32), qc = cb * 16 + q;
            const size_t t0 = (size_t)b * S + r0 * GW + cb * 16;
            const bf16_t* qp = Z + t0 * IN_COLS + OFF_QN + h * 64;
#pragma unroll
            for (int t = 0; t < 4; ++t) { qf[t][0] = *(const bf16x8v*)(qp + (size_t)t * GW * IN_COLS + qo); qf[t][1] = *(const bf16x8v*)(qp + (size_t)t * GW * IN_COLS + (qo + 32u)); }
            Na4Dsc dl; dl.kb0 = Z + ((size_t)b * S + Rlo * GW + C0) * IN_COLS + OFF_KN + h * 64;
            dl.vb0 = vtn + (size_t)(b * 8 + h) * 64 * S + Rlo * GW + C0; dl.rpb = smem + 16 + h * 465;
            dl.ko[0] = ko0; dl.ko[1] = ko1; dl.vo = (unsigned)q * S + 8u * g;
            dl.dc0 = C0 + 8 * g - qc + 15; dl.Rlo = Rlo; dl.r0 = r0; dl.nrow = nrow;
            { const int qs = clampi(qc - 8, 0, 48);
#pragma unroll
              for (int j = 0; j < 8; ++j) { const int kc = C0 + 8 * g + j; dl.mk[j] = (kc >= qs && kc < qs + 16) ? 0.f : MASKED; } }
            if (VAR != 8) attn_stream4<VAR>(dl, nrow, qf, st, lane);
            Ctx4Dsc dc; dc.kb0 = Z + ((size_t)T_LAT + b * L) * IN_COLS + OFF_KN + h * 64; dc.vb0 = vtnc + (size_t)(b * 8 + h) * 64 * L;
            dc.ko[0] = ko0; dc.ko[1] = ko1; dc.vo = (unsigned)q * L + 8u * g;
            attn_stream4<VAR>(dc, 8, qf, st, lane);
#pragma unroll
            for (int t = 0; t < 4; ++t) { if (VAR != 9) attn_finish(st[t], 0.f, false, Ob + (t0 + (size_t)t * GW) * 512 + h * 64, lane, oscr); else if (st[t].l == 12345.f) Ob[lane] = 0; }
        } else if (u < 4096) {
            const int v = u - 2048, qt = v & 255, g2 = (v >> 8) & 1, b = v >> 9, p0 = qt * 16;
            const size_t t0 = (size_t)b * S + p0;
            const bf16_t* qp = Z + t0 * IN_COLS + OFF_QW + g2 * 256;
#pragma unroll
            for (int t = 0; t < 4; ++t) { qf[t][0] = *(const bf16x8v*)(qp + t * 64 + qo); qf[t][1] = *(const bf16x8v*)(qp + t * 64 + (qo + 32u)); }
            Swa4Dsc dl; dl.zrow = Z + (size_t)b * S * IN_COLS + OFF_KW + g2 * 64; dl.vrow = vtw + (size_t)(b * 2 + g2) * 64 * S;
            dl.p0 = p0; dl.kslot0 = kslot0; dl.g8 = 8 * g; dl.qpos = p0 + q; dl.dS = q * S;
            attn_stream4<VAR>(dl, 9, qf, st, lane);
            Ctx4Dsc dc; dc.kb0 = Z + ((size_t)T_LAT + b * L) * IN_COLS + OFF_KW + g2 * 64; dc.vb0 = vtwc + (size_t)(b * 2 + g2) * 64 * L;
            dc.ko[0] = ko0; dc.ko[1] = ko1; dc.vo = (unsigned)q * L + 8u * g;
            attn_stream4<VAR>(dc, 8, qf, st, lane);
#pragma unroll
            for (int t = 0; t < 4; ++t) attn_finish(st[t], sink[g2 * 4 + t] * LOG2E, true, Oc + t0 * 512 + (g2 * 4 + t) * 64, lane, oscr);
        } else {
            const int v = u - 4096, which = v >> 7;
            if (which == 0) {
                const int qt4 = v & 3, h = (v >> 2) & 7, b = (v >> 5) & 3;
                const size_t t0 = (size_t)T_LAT + b * L + qt4 * 64;
                const bf16_t* qp = Z + t0 * IN_COLS + OFF_QN + h * 64;
#pragma unroll
                for (int t = 0; t < 4; ++t) { qf[t][0] = *(const bf16x8v*)(qp + (size_t)t * 16 * IN_COLS + qo); qf[t][1] = *(const bf16x8v*)(qp + (size_t)t * 16 * IN_COLS + (qo + 32u)); }
                Ctx4Dsc dc; dc.kb0 = Z + ((size_t)T_LAT + b * L) * IN_COLS + OFF_KN + h * 64; dc.vb0 = vtnc + (size_t)(b * 8 + h) * 64 * L;
                dc.ko[0] = ko0; dc.ko[1] = ko1; dc.vo = (unsigned)q * L + 8u * g;
                attn_stream4<VAR>(dc, 8, qf, st, lane);
#pragma unroll
                for (int t = 0; t < 4; ++t) attn_finish(st[t], 0.f, false, Ob + (t0 + t * 16) * 512 + h * 64, lane, oscr);
            } else {
                const int w = v - 128, qt = w & 15, g2 = (w >> 4) & 1, b = (w >> 5) & 3;
                const size_t t0 = (size_t)T_LAT + b * L + qt * 16;
                const bf16_t* qp = Z + t0 * IN_COLS + OFF_QW + g2 * 256;
#pragma unroll
                for (int t = 0; t < 4; ++t) { qf[t][0] = *(const bf16x8v*)(qp + t * 64 + qo); qf[t][1] = *(const bf16x8v*)(qp + t * 64 + (qo + 32u)); }
                Ctx4Dsc dc; dc.kb0 = Z + ((size_t)T_LAT + b * L) * IN_COLS + OFF_KW + g2 * 64; dc.vb0 = vtwc + (size_t)(b * 2 + g2) * 64 * L;
                dc.ko[0] = ko0; dc.ko[1] = ko1; dc.vo = (unsigned)q * L + 8u * g;
                attn_stream4<VAR>(dc, 8, qf, st, lane);
#pragma unroll
                for (int t = 0; t < 4; ++t) attn_finish(st[t], sink[g2 * 4 + t] * LOG2E, true, Oc + t0 * 512 + (g2 * 4 + t) * 64, lane, oscr);
            }
        }
    }
}

__device__ __forceinline__ int f2key(float v) { const int b = __float_as_int(v); return b ^ ((b >> 31) & 0x7fffffff); }
__device__ __forceinline__ float key2f(int k) { return __int_as_float(k ^ ((k >> 31) & 0x7fffffff)); }
__device__ __forceinline__ float embed(float v, unsigned mask, unsigned code) { return __uint_as_float((__float_as_uint(v) & ~mask) | code); }
template <int N> __device__ __forceinline__ void bitonic_merge_desc(int (&a)[N]) {
#pragma unroll
    for (int j = N >> 1; j > 0; j >>= 1)
#pragma unroll
        for (int i = 0; i < N; ++i) { const int l = i ^ j; if (l > i) { const int hi = max(a[i], a[l]), lo = min(a[i], a[l]); a[i] = hi; a[l] = lo; } }
}
template <int N> __device__ __forceinline__ void bitonic_sort_desc(int (&a)[N]) {
#pragma unroll
    for (int k = 2; k <= N; k <<= 1)
#pragma unroll
        for (int j = k >> 1; j > 0; j >>= 1)
#pragma unroll
            for (int i = 0; i < N; ++i) { const int l = i ^ j; if (l > i) { const int hi = max(a[i], a[l]), lo = min(a[i], a[l]); if ((i & k) == 0) { a[i] = hi; a[l] = lo; } else { a[i] = lo; a[l] = hi; } } }
}
__device__ __forceinline__ void xlane_top16(int (&h)[16], int mask) {
    int m[16];
#pragma unroll
    for (int i = 0; i < 16; ++i) m[i] = max(h[i], __shfl_xor(h[15 - i], mask));
    bitonic_merge_desc<16>(m);
#pragma unroll
    for (int i = 0; i < 16; ++i) h[i] = m[i];
}
__device__ __forceinline__ void ph_peer_topk(const bf16_t* __restrict__ Q, const bf16_t* __restrict__ keys, int* __restrict__ eidx, float* __restrict__ egate, int rows, float* smem, const int WV) {
    const int tid = TID, lane = tid & 63, wid = tid >> 6, n = lane & 15, g = lane >> 4;
    unsigned char* kl = (unsigned char*)smem;
    unsigned char* lidx = kl + 131072 + 1024 + wid * 512;
    const int KNEG = (int)0x80000001;
    const int ngroups = rows / 16, npass = ((ngroups + 7) / 8) * 8;
    const int wu = __builtin_amdgcn_readfirstlane(wid);
    int hcur = -1;
    for (int ps = BID; ps < npass; ps += NBLK) {
        const int h = ps & 7, grp = (ps >> 3) * 8 + wu;
        if (h != hcur) {
            __syncthreads();
            const uint4* src = (const uint4*)(keys + (size_t)h * 2 * 128 * 128);
#pragma unroll
            for (int i = 0; i < 8; ++i) { const int cid = tid + i * NTHREADS; const uint4 v = src[cid]; const int row = (cid >> 4) & 127, ch = cid & 15;
                *(uint4*)(kl + ((cid >> 4) * 256 + ((ch ^ (row & 15)) << 4))) = v; }
            __syncthreads();
            hcur = h;
        }
        if (grp >= ngroups) continue;
        const int t0 = grp * 16;
        float tops[2][16];
        bf16x8v qfa[2][4];
        { const bf16_t* qb = Q + (size_t)t0 * 2048 + h * 256; const unsigned qof = (unsigned)n * 2048u + 8u * g;
#pragma unroll
          for (int pp = 0; pp < 2; ++pp)
#pragma unroll
            for (int ks = 0; ks < 4; ++ks) qfa[pp][ks] = *(const bf16x8v*)(qb + (qof + pp * 128 + ks * 32)); }
#pragma unroll
        for (int pp = 0; pp < 2; ++pp) {
            const bf16x8v (&qf)[4] = qfa[pp];
            int ka_[2][16];
#pragma unroll
            for (int T = 0; T < 8; ++T) {
                f32x4v acc = (f32x4v){0.f, 0.f, 0.f, 0.f};
#pragma unroll
                for (int ks = 0; ks < 4; ++ks) {
                    const bf16x8v a = *(const bf16x8v*)(kl + ((pp * 128 + T * 16 + n) * 256 + (((ks * 4 + g) ^ n) << 4)));
                    acc = mfma16(a, qf[ks], acc); }
#pragma unroll
                for (int r = 0; r < 4; ++r) ka_[T >> 2][(T & 3) * 4 + r] = f2key(embed(acc[r], 127u, (unsigned)(T * 16 + 4 * g + r)));
            }
            bitonic_sort_desc<16>(ka_[0]); bitonic_sort_desc<16>(ka_[1]);
            int hh[16];
#pragma unroll
            for (int i = 0; i < 16; ++i) hh[i] = max(ka_[0][i], ka_[1][15 - i]);
            bitonic_merge_desc<16>(hh);
            xlane_top16(hh, 16); xlane_top16(hh, 32);
#pragma unroll
            for (int i = 0; i < 16; ++i) tops[pp][i] = key2f(hh[i]);
            if (g == 0) {
#pragma unroll
                for (int i = 0; i < 16; ++i) lidx[(n * 2 + pp) * 16 + i] = (unsigned char)(__float_as_uint(tops[pp][i]) & 127u);
            }
        }
        float bsel[4];
#pragma unroll
        for (int jj = 0; jj < 4; ++jj) bsel[jj] = g == 0 ? tops[1][4 * jj] : (g == 1 ? tops[1][4 * jj + 1] : (g == 2 ? tops[1][4 * jj + 2] : tops[1][4 * jj + 3]));
        int ca[16], ce[16];
#pragma unroll
        for (int i = 0; i < 16; ++i) ca[i] = f2key(embed(tops[0][i] + bsel[0], 255u, (unsigned)((i << 4) | g)));
#pragma unroll
        for (int i = 0; i < 3; ++i) ce[i] = f2key(embed(tops[0][i] + bsel[1], 255u, (unsigned)((i << 4) | 4 | g)));
        ce[3] = f2key(embed(tops[0][0] + bsel[2], 255u, (unsigned)(8 | g)));
        ce[4] = f2key(embed(tops[0][0] + bsel[3], 255u, (unsigned)(12 | g)));
#pragma unroll
        for (int i = 5; i < 16; ++i) ce[i] = KNEG;
        bitonic_sort_desc<16>(ce);
        int cb[16];
#pragma unroll
        for (int i = 0; i < 16; ++i) cb[i] = max(ca[i], ce[15 - i]);
        bitonic_sort_desc<16>(cb);
        xlane_top16(cb, 16); xlane_top16(cb, 32);
        float best[16];
#pragma unroll
        for (int rd = 0; rd < 16; ++rd) best[rd] = key2f(cb[rd]);
        float ex[16]; float sum = 0.f;
#pragma unroll
        for (int rd = 0; rd < 16; ++rd) { ex[rd] = __builtin_amdgcn_exp2f((best[rd] - best[0]) * LOG2E); sum += ex[rd]; }
        const float inv = 1.0f / sum;
        asm volatile("s_waitcnt lgkmcnt(0)" ::: "memory");
        int eo[4]; float go[4];
#pragma unroll
        for (int rr = 0; rr < 4; ++rr) {
            const float bv = g == 0 ? best[rr] : (g == 1 ? best[4 + rr] : (g == 2 ? best[8 + rr] : best[12 + rr]));
            const float ev = g == 0 ? ex[rr] : (g == 1 ? ex[4 + rr] : (g == 2 ? ex[8 + rr] : ex[12 + rr]));
            const unsigned code = __float_as_uint(bv) & 255u;
            eo[rr] = (int)lidx[(n * 2 + 0) * 16 + (code >> 4)] * 128 + (int)lidx[(n * 2 + 1) * 16 + (code & 15u)];
            go[rr] = ev * inv;
        }
        const size_t o = (size_t)(t0 + n) * 128 + h * 16 + 4 * g;
        *(int4*)(eidx + o) = make_int4(eo[0], eo[1], eo[2], eo[3]);
        *(float4*)(egate + o) = make_float4(go[0], go[1], go[2], go[3]);
        asm volatile("s_waitcnt lgkmcnt(0)" ::: "memory");
    }
}
__device__ __forceinline__ void ph_peer_gather_bf16(const bf16_t* __restrict__ H, const bf16_t* __restrict__ U, const bf16_t* __restrict__ V, const int* __restrict__ eidx, const float* __restrict__ egate,
                                               const float* __restrict__ modl, float* __restrict__ Xl, float* __restrict__ Xc, int rows,
                                               int mode, const float* __restrict__ gn, const float* __restrict__ modn, bf16_t* __restrict__ Hn, float* smem, bool dry, const int WV) {
    const int tid = TID, lane = tid & 63, wid = tid >> 6, m = lane & 15, gk = lane >> 4;
    float* wl = smem + wid * 128;
    for (int t = BID * 8 + wid; t < rows; t += NBLK * 8) {
        const int e0 = eidx[(size_t)t * 128 + lane], e1 = eidx[(size_t)t * 128 + 64 + lane];
        const bf16_t* rp[8];
#pragma unroll
        for (int T = 0; T < 8; ++T) { const int e = __shfl(T < 4 ? e0 : e1, (T & 3) * 16 + m); rp[T] = U + (size_t)e * D + 8 * gk; }
        f32x4v acc[8];
#pragma unroll
        for (int T = 0; T < 8; ++T) acc[T] = (f32x4v){0.f, 0.f, 0.f, 0.f};
        const bf16_t* hp = H + (size_t)t * D + 8 * gk;
#pragma unroll 2
        for (int ks = 0; ks < 32; ++ks) {
            const bf16x8v hb = *(const bf16x8v*)(hp + ks * 32);
#pragma unroll
            for (int T = 0; T < 8; ++T) { const bf16x8v a = *(const bf16x8v*)(rp[T] + ks * 32); acc[T] = mfma16(a, hb, acc[T]); }
        }
        const int myT = m >> 1, r0 = (m & 1) * 2;
        float va = 0.f, vb = 0.f;
#pragma unroll
        for (int T = 0; T < 8; ++T) { const float x0 = r0 ? acc[T][2] : acc[T][0], x1 = r0 ? acc[T][3] : acc[T][1]; if (myT == T) { va = x0; vb = x1; } }
        const int ee = myT * 16 + 4 * gk + r0;
        const float2 gg = *(const float2*)(egate + (size_t)t * 128 + ee);
        float2 ww; ww.x = gg.x * 0.5f * va * (1.f + erff(va * 0.70710678118654752f)); ww.y = gg.y * 0.5f * vb * (1.f + erff(vb * 0.70710678118654752f));
        *(float2*)(wl + ee) = ww;
        asm volatile("s_waitcnt lgkmcnt(0)" ::: "memory");
        const float w0 = wl[lane], w1 = wl[64 + lane];
        asm volatile("s_waitcnt lgkmcnt(0)" ::: "memory");
        float out[16];
#pragma unroll
        for (int i = 0; i < 16; ++i) out[i] = 0.f;
        const bf16_t* vb0 = V + lane * 8;
#pragma unroll
        for (int hh = 0; hh < 2; ++hh) {
            const int ev = hh ? e1 : e0; const int wbits = __float_as_int(hh ? w1 : w0);
#pragma unroll 8
            for (int k = 0; k < 64; ++k) {
                const int e = __builtin_amdgcn_readlane(ev, k); const float w = __int_as_float(__builtin_amdgcn_readlane(wbits, k));
                const bf16_t* vp = vb0 + (size_t)e * D;
                const uint4 a = *(const uint4*)vp, b = *(const uint4*)(vp + 512);
                out[0] += w * lo16(a.x); out[1] += w * hi16(a.x); out[2] += w * lo16(a.y); out[3] += w * hi16(a.y); out[4] += w * lo16(a.z); out[5] += w * hi16(a.z); out[6] += w * lo16(a.w); out[7] += w * hi16(a.w);
                out[8] += w * lo16(b.x); out[9] += w * hi16(b.x); out[10] += w * lo16(b.y); out[11] += w * hi16(b.y); out[12] += w * lo16(b.z); out[13] += w * hi16(b.z); out[14] += w * lo16(b.w); out[15] += w * hi16(b.w);
            }
        }
        const int mrow = t < T_LAT ? t / S : 4;
        float* xp = t < T_LAT ? Xl + (size_t)t * D : Xc + (size_t)(t - T_LAT) * D;
        const float* gt = modl + (size_t)mrow * 6144 + 5 * 1024;
        float xr[16]; float ss = 0.f;
#pragma unroll
        for (int q4 = 0; q4 < 4; ++q4) { const int col = (q4 >> 1) * 512 + lane * 8 + (q4 & 1) * 4;
            const float4 x = *(const float4*)(xp + col), g4 = *(const float4*)(gt + col);
            xr[q4 * 4 + 0] = x.x + g4.x * out[q4 * 4 + 0]; xr[q4 * 4 + 1] = x.y + g4.y * out[q4 * 4 + 1]; xr[q4 * 4 + 2] = x.z + g4.z * out[q4 * 4 + 2]; xr[q4 * 4 + 3] = x.w + g4.w * out[q4 * 4 + 3];
#pragma unroll
            for (int i = 0; i < 4; ++i) ss += xr[q4 * 4 + i] * xr[q4 * 4 + i]; }
        ss = wave_sum(ss);
        const float rstd = rsqrtf(ss * (1.0f / D) + EPS);
        if (dry && rstd != 12345.678f) continue;
        if (mode == 0) {
            const float* shn = modn + (size_t)mrow * 6144; const float* scn = shn + 1024;
#pragma unroll
            for (int q4 = 0; q4 < 4; ++q4) { const int col = (q4 >> 1) * 512 + lane * 8 + (q4 & 1) * 4;
                *(float4*)(xp + col) = make_float4(xr[q4 * 4], xr[q4 * 4 + 1], xr[q4 * 4 + 2], xr[q4 * 4 + 3]);
                const float4 g4 = *(const float4*)(gn + col), s4 = *(const float4*)(scn + col), h4 = *(const float4*)(shn + col);
                uint2 w; w.x = pk2(xr[q4 * 4] * rstd * g4.x * (1.f + s4.x) + h4.x, xr[q4 * 4 + 1] * rstd * g4.y * (1.f + s4.y) + h4.y);
                w.y = pk2(xr[q4 * 4 + 2] * rstd * g4.z * (1.f + s4.z) + h4.z, xr[q4 * 4 + 3] * rstd * g4.w * (1.f + s4.w) + h4.w);
                *(uint2*)(Hn + (size_t)t * D + col) = w; }
        } else {
#pragma unroll
            for (int q4 = 0; q4 < 4; ++q4) { const int col = (q4 >> 1) * 512 + lane * 8 + (q4 & 1) * 4;
                const float4 g4 = *(const float4*)(gn + col);
                *(float4*)(xp + col) = make_float4(xr[q4 * 4] * rstd * g4.x, xr[q4 * 4 + 1] * rstd * g4.y, xr[q4 * 4 + 2] * rstd * g4.z, xr[q4 * 4 + 3] * rstd * g4.w); }
        }
    }
}

typedef long i64v;
typedef long i64x2v __attribute__((ext_vector_type(2)));
__device__ __forceinline__ f32x4v mfma8(i64v a, i64v b, f32x4v c) { return __builtin_amdgcn_mfma_f32_16x16x32_fp8_fp8(a, b, c, 0, 0, 0); }
__device__ __forceinline__ void ph_peer_gather_fp8(const unsigned char* __restrict__ H8, const unsigned char* __restrict__ U8, const unsigned char* __restrict__ V8, const float* __restrict__ isu, const float* __restrict__ isv,
                                               const int* __restrict__ eidx, const float* __restrict__ egate,
                                               const float* __restrict__ modl, float* __restrict__ Xl, float* __restrict__ Xc, int rows,
                                               int mode, const float* __restrict__ gn, const float* __restrict__ modn, bf16_t* Hn, float* smem, bool dry, const int WV) {
    const int tid = TID, lane = tid & 63, wid = tid >> 6, m = lane & 15, gk = lane >> 4;
    float* wl = smem + wid * 128;
    const int myT = m >> 1, r0 = (m & 1) * 2, ee = myT * 16 + 4 * gk + r0;
    int t = BID * 8 + wid;
    int e0n = 0, e1n = 0;
    if (t < rows) { e0n = eidx[(size_t)t * 128 + lane]; e1n = eidx[(size_t)t * 128 + 64 + lane]; }
    for (; t < rows; t += NBLK * 8) {
        const int e0 = e0n, e1 = e1n;
        { const int tn = t + NBLK * 8; if (tn < rows) { e0n = eidx[(size_t)tn * 128 + lane]; e1n = eidx[(size_t)tn * 128 + 64 + lane]; } }
        const int ida0 = __shfl(e0, ee & 63), ida1 = __shfl(e1, ee & 63), idb0 = __shfl(e0, (ee + 1) & 63), idb1 = __shfl(e1, (ee + 1) & 63);
        const int ida = ee < 64 ? ida0 : ida1, idb = ee < 64 ? idb0 : idb1;
        const float sua = isu[ida], sub = isu[idb], sv0 = isv[e0], sv1 = isv[e1];
        const float2 gg = *(const float2*)(egate + (size_t)t * 128 + ee);
        unsigned rp[8];
#pragma unroll
        for (int T = 0; T < 8; ++T) { const int e = __shfl(T < 4 ? e0 : e1, (T & 3) * 16 + m); rp[T] = (unsigned)e * (unsigned)D + 16u * (unsigned)gk; }
        f32x4v acc[8];
#pragma unroll
        for (int T = 0; T < 8; ++T) acc[T] = (f32x4v){0.f, 0.f, 0.f, 0.f};
        const unsigned char* hp = H8 + (size_t)t * D + 16 * gk;
#if RING_U
        i64x2v A[URING][8], Bh[URING], Bl[URING];
#define GLOADK(ks) do { _Pragma("unroll") for (int T = 0; T < 8; ++T) A[(ks) % URING][T] = *(const i64x2v*)(U8 + (rp[T] + (unsigned)((ks) * 64))); \
                        Bh[(ks) % URING] = *(const i64x2v*)(hp + (ks) * 64); Bl[(ks) % URING] = *(const i64x2v*)(hp + (size_t)T_ALL * D + (ks) * 64); } while (0)
#pragma unroll
        for (int k0 = 0; k0 < URING - 1; ++k0) GLOADK(k0);
#pragma unroll
        for (int ks = 0; ks < 16; ++ks) {
            if (ks + URING - 1 < 16) GLOADK(ks + URING - 1);
            __builtin_amdgcn_sched_barrier(0);
#pragma unroll
            for (int T = 0; T < 8; ++T) { const i64x2v a = A[ks % URING][T];
                acc[T] = mfma8(a[0], Bh[ks % URING][0], acc[T]); acc[T] = mfma8(a[0], Bl[ks % URING][0], acc[T]); acc[T] = mfma8(a[1], Bh[ks % URING][1], acc[T]); acc[T] = mfma8(a[1], Bl[ks % URING][1], acc[T]); }
            __builtin_amdgcn_sched_barrier(0);
        }
#undef GLOADK
#else
#pragma unroll 2
        for (int ks = 0; ks < 16; ++ks) {
            const i64x2v bh = *(const i64x2v*)(hp + ks * 64), bl = *(const i64x2v*)(hp + (size_t)T_ALL * D + ks * 64);
            i64x2v a[8];
#pragma unroll
            for (int T = 0; T < 8; ++T) a[T] = *(const i64x2v*)(U8 + (rp[T] + (unsigned)(ks * 64)));
#pragma unroll
            for (int T = 0; T < 8; ++T) { acc[T] = mfma8(a[T][0], bh[0], acc[T]); acc[T] = mfma8(a[T][0], bl[0], acc[T]); acc[T] = mfma8(a[T][1], bh[1], acc[T]); acc[T] = mfma8(a[T][1], bl[1], acc[T]); }
        }
#endif
        float va = 0.f, vb = 0.f;
#pragma unroll
        for (int T = 0; T < 8; ++T) { const float x0 = r0 ? acc[T][2] : acc[T][0], x1 = r0 ? acc[T][3] : acc[T][1]; if (myT == T) { va = x0; vb = x1; } }
        va *= 0.125f * sua; vb *= 0.125f * sub;
        float2 ww; ww.x = gg.x * 0.5f * va * (1.f + erff(va * 0.70710678118654752f)); ww.y = gg.y * 0.5f * vb * (1.f + erff(vb * 0.70710678118654752f));
        *(float2*)(wl + ee) = ww;
        asm volatile("s_waitcnt lgkmcnt(0)" ::: "memory");
        const float w0 = wl[lane] * sv0, w1 = wl[64 + lane] * sv1;
        asm volatile("s_waitcnt lgkmcnt(0)" ::: "memory");
        float out[16];
#pragma unroll
        for (int i = 0; i < 16; ++i) out[i] = 0.f;
        const unsigned voff = 16u * (unsigned)lane;
#if RING_V
        uint4 VR[VRING][VCH];
#define VLOADC(c, slot) do { const int ev_ = (((c) * VCH) & 64) ? e1 : e0; _Pragma("unroll") for (int j = 0; j < VCH; ++j) { const int e = __builtin_amdgcn_readlane(ev_, (((c) * VCH) & 63) + j); VR[slot][j] = *(const uint4*)(V8 + ((unsigned)e * (unsigned)D + voff)); } } while (0)
#define VCOMPC(c, slot) do { const int wb_ = __float_as_int((((c) * VCH) & 64) ? w1 : w0); _Pragma("unroll") for (int j = 0; j < VCH; ++j) { const float w = __int_as_float(__builtin_amdgcn_readlane(wb_, (((c) * VCH) & 63) + j)); \
            const unsigned aw[4] = {VR[slot][j].x, VR[slot][j].y, VR[slot][j].z, VR[slot][j].w}; \
            _Pragma("unroll") for (int q = 0; q < 4; ++q) { const f32x2v d0 = __builtin_amdgcn_cvt_pk_f32_fp8((int)aw[q], false), d1 = __builtin_amdgcn_cvt_pk_f32_fp8((int)aw[q], true); \
                out[4 * q] += w * d0[0]; out[4 * q + 1] += w * d0[1]; out[4 * q + 2] += w * d1[0]; out[4 * q + 3] += w * d1[1]; } } } while (0)
        constexpr int NVC = 128 / VCH;
#pragma unroll
        for (int s0 = 0; s0 < VRING - 1; ++s0) VLOADC(s0, s0);
#pragma unroll 1
        for (int cb = 0; cb < NVC; cb += VRING) {
#pragma unroll
            for (int s0 = 0; s0 < VRING; ++s0) {
                if (cb + s0 < NVC) {
                    if (cb + s0 + VRING - 1 < NVC) VLOADC(cb + s0 + VRING - 1, (s0 + VRING - 1) % VRING);
                    __builtin_amdgcn_sched_barrier(0); VCOMPC(cb + s0, s0); __builtin_amdgcn_sched_barrier(0);
                }
            }
        }
#undef VLOADC
#undef VCOMPC
#else
#pragma unroll
        for (int hh = 0; hh < 2; ++hh) {
            const int ev = hh ? e1 : e0; const int wbits = __float_as_int(hh ? w1 : w0);
#pragma unroll 16
            for (int k = 0; k < 64; ++k) {
                const int e = __builtin_amdgcn_readlane(ev, k); const float w = __int_as_float(__builtin_amdgcn_readlane(wbits, k));
                const uint4 a = *(const uint4*)(V8 + ((unsigned)e * (unsigned)D + voff));
                const unsigned aw[4] = {a.x, a.y, a.z, a.w};
#pragma unroll
                for (int q = 0; q < 4; ++q) { const f32x2v d0 = __builtin_amdgcn_cvt_pk_f32_fp8((int)aw[q], false), d1 = __builtin_amdgcn_cvt_pk_f32_fp8((int)aw[q], true);
                    out[4 * q] += w * d0[0]; out[4 * q + 1] += w * d0[1]; out[4 * q + 2] += w * d1[0]; out[4 * q + 3] += w * d1[1]; }
            }
        }
#endif
        const int mrow = t < T_LAT ? t / S : 4;
        float* xp = (t < T_LAT ? Xl + (size_t)t * D : Xc + (size_t)(t - T_LAT) * D) + lane * 16;
        const float* gt = modl + (size_t)mrow * 6144 + 5 * 1024 + lane * 16;
        float xr[16]; float ss = 0.f;
#pragma unroll
        for (int q4 = 0; q4 < 4; ++q4) {
            const float4 x = *(const float4*)(xp + q4 * 4), g4 = *(const float4*)(gt + q4 * 4);
            xr[q4 * 4 + 0] = x.x + g4.x * out[q4 * 4 + 0]; xr[q4 * 4 + 1] = x.y + g4.y * out[q4 * 4 + 1]; xr[q4 * 4 + 2] = x.z + g4.z * out[q4 * 4 + 2]; xr[q4 * 4 + 3] = x.w + g4.w * out[q4 * 4 + 3];
#pragma unroll
            for (int i = 0; i < 4; ++i) ss += xr[q4 * 4 + i] * xr[q4 * 4 + i]; }
        ss = wave_sum(ss);
        const float rstd = rsqrtf(ss * (1.0f / D) + EPS);
        if (dry && rstd != 12345.678f) continue;
        if (mode == 0) {
            const float* shn = modn + (size_t)mrow * 6144 + lane * 16; const float* scn = shn + 1024; const float* gp = gn + lane * 16;
#pragma unroll
            for (int q4 = 0; q4 < 4; ++q4) {
                *(float4*)(xp + q4 * 4) = make_float4(xr[q4 * 4], xr[q4 * 4 + 1], xr[q4 * 4 + 2], xr[q4 * 4 + 3]);
                const float4 g4 = *(const float4*)(gp + q4 * 4), s4 = *(const float4*)(scn + q4 * 4), h4 = *(const float4*)(shn + q4 * 4);
                uint2 w; w.x = pk2(xr[q4 * 4] * rstd * g4.x * (1.f + s4.x) + h4.x, xr[q4 * 4 + 1] * rstd * g4.y * (1.f + s4.y) + h4.y);
                w.y = pk2(xr[q4 * 4 + 2] * rstd * g4.z * (1.f + s4.z) + h4.z, xr[q4 * 4 + 3] * rstd * g4.w * (1.f + s4.w) + h4.w);
                *(uint2*)(Hn + (size_t)t * D + lane * 16 + q4 * 4) = w; }
        } else {
            const float* gp = gn + lane * 16;
#pragma unroll
            for (int q4 = 0; q4 < 4; ++q4) { const float4 g4 = *(const float4*)(gp + q4 * 4);
                *(float4*)(xp + q4 * 4) = make_float4(xr[q4 * 4] * rstd * g4.x, xr[q4 * 4 + 1] * rstd * g4.y, xr[q4 * 4 + 2] * rstd * g4.z, xr[q4 * 4 + 3] * rstd * g4.w); }
        }
    }
}

#define LAS __attribute__((address_space(3)))
#define XB_TMO      128
#define XB_XCNT(j)  (256  + 64 * (j))
#define XB_XSUB(j)  (1280 + 64 * (j))
#define XB_XGEN(j)  (2304 + 64 * (j))
#define XB_TOP      3328
#define XB_TOPGEN   3392
#define XCD_BAR_WORDS 3456
#define XB_SPIN_CAP (1u << 18)

__device__ __forceinline__ unsigned xb_ld(unsigned* p)              { return __hip_atomic_load(p, __ATOMIC_RELAXED, __HIP_MEMORY_SCOPE_AGENT); }
__device__ __forceinline__ unsigned xb_add(unsigned* p, unsigned v) { return __hip_atomic_fetch_add(p, v, __ATOMIC_RELAXED, __HIP_MEMORY_SCOPE_AGENT); }
__device__ __forceinline__ unsigned xb_xcc_id() { return (unsigned)__builtin_amdgcn_s_getreg((3 << 11) | 20) & 0xFu; }
#define XB_SPIN(cond, bar) do { unsigned _sp = 0; while (cond) { __builtin_amdgcn_s_sleep(1); \
    if ((++_sp & 255u) == 0u) { if (xb_ld(&(bar)[XB_TMO])) break; if (_sp > XB_SPIN_CAP) { atomicAdd(&(bar)[XB_TMO], 1u); break; } } } } while (0)

struct XcdBarrier {
    unsigned* bar; unsigned x; int wv;
    volatile LAS unsigned* st;
};

__device__ __forceinline__ XcdBarrier xcd_barrier_post(unsigned* bar, volatile LAS unsigned* st, int wv) {
    XcdBarrier b; b.bar = bar; b.x = xb_xcc_id(); b.st = st; b.wv = wv;
    if (wv == 0 && lane_id() == 0) (void)xb_add(&bar[XB_XCNT(b.x)], 1u);
    return b;
}
__device__ __forceinline__ void xcd_barrier_complete(unsigned* bar, unsigned x, unsigned& nloc, unsigned& nx) {
    const unsigned G = gridDim.x * gridDim.y * gridDim.z;
    unsigned sum, cnt, mine, sp = 0u;
    for (;;) {
        sum = 0u; cnt = 0u; mine = 0u;
#pragma unroll
        for (unsigned j = 0; j < 16; ++j) { const unsigned c = xb_ld(&bar[XB_XCNT(j)]); sum += c; cnt += (c > 0u) ? 1u : 0u; mine = (j == x) ? c : mine; }
        if (sum == G) break;
        __builtin_amdgcn_s_sleep(1);
        if ((++sp & 255u) == 0u) { if (xb_ld(&bar[XB_TMO])) break; if (sp > XB_SPIN_CAP) { atomicAdd(&bar[XB_TMO], 1u); break; } }
    }
    nloc = mine > 0u ? mine : 1u; nx = cnt > 0u ? cnt : 1u;
}

__device__ __forceinline__ void xcd_barrier(const XcdBarrier& b) {
    asm volatile("s_waitcnt vmcnt(0)" ::: "memory");
    __syncthreads();
    if (b.wv == 0 && lane_id() == 0) {
        unsigned* bar = b.bar;
        __builtin_amdgcn_s_waitcnt(0);
        unsigned nloc = b.st[0], nx = b.st[1];
        if (nloc == 0u) { xcd_barrier_complete(bar, b.x, nloc, nx); b.st[0] = nloc; b.st[1] = nx; }
        const unsigned old = xb_add(&bar[XB_XSUB(b.x)], 1u);
        const unsigned gen = old / nloc;
        if (old + 1u == (gen + 1u) * nloc) {
            __builtin_amdgcn_fence(__ATOMIC_RELEASE, "agent");
            asm volatile("s_waitcnt vmcnt(0)" ::: "memory");
            const unsigned og = xb_add(&bar[XB_TOP], 1u);
            const unsigned tg = og / nx;
            if (og + 1u == (tg + 1u) * nx) xb_add(&bar[XB_TOPGEN], 1u);
            else XB_SPIN(xb_ld(&bar[XB_TOPGEN]) == tg, bar);
            __builtin_amdgcn_fence(__ATOMIC_ACQUIRE, "agent");
            xb_add(&bar[XB_XGEN(b.x)], 1u);
            asm volatile("s_waitcnt vmcnt(0)" ::: "memory");
        } else {
            XB_SPIN(xb_ld(&bar[XB_XGEN(b.x)]) == gen, bar);
            __builtin_amdgcn_fence(__ATOMIC_ACQUIRE, "agent");
            asm volatile("s_waitcnt vmcnt(0)" ::: "memory");
        }
    }
    __syncthreads();
}

__device__ __forceinline__ unsigned char* launder(unsigned char* q) { size_t z = 0; asm volatile("" : "+s"(z)); return q + z; }
__device__ __forceinline__ void ph_fill_tables(const Params& p, const int WV) {
    const int nidle = NBLK - 16; if (BID < 16 || nidle <= 0) return;
    unsigned char* ws = launder(p.ws);
#pragma unroll 1
    for (int tb = 0; tb < 4; ++tb) {
        const int l = tb >> 1, isv = tb & 1;
        unsigned char* tl = ws + (l == 0 ? WS_TAB0 : WS_TAB1);
        const float* src = (isv ? p.peer_v : p.peer_u) + (size_t)l * NEXP * D;
        conv_fp8_rows(src, (unsigned*)(tl + (size_t)isv * NEXP * D), (float*)(tl + (size_t)2 * NEXP * D) + isv * NEXP, NEXP, WV, BID - 16, nidle);
    }
}
struct WsPtrs { float *mod, *rope, *XC, *X; bf16_t *H, *Z, *vtn, *vtnc, *vtw, *vtwc, *AT; int* eidx; float* egate; unsigned char* wl; const float* modl; const unsigned char *U8, *V8, *H8; const float *isu, *isv; const bf16_t *U, *V; };
__device__ __forceinline__ WsPtrs mkptrs(const Params& p, int l) {
    unsigned char* ws = launder(p.ws); WsPtrs P;
    P.mod = (float*)(ws + WS_MOD); P.rope = (float*)(ws + WS_ROPE); P.XC = (float*)(ws + WS_XC); P.X = (float*)launder((unsigned char*)p.out);
    P.H = (bf16_t*)(ws + WS_H); P.Z = (bf16_t*)(ws + WS_Z); P.vtn = (bf16_t*)(ws + WS_VTN); P.vtnc = (bf16_t*)(ws + WS_VTNC); P.vtw = (bf16_t*)(ws + WS_VTW); P.vtwc = (bf16_t*)(ws + WS_VTWC);
    P.AT = (bf16_t*)(ws + WS_AT); P.eidx = (int*)(ws + WS_EIDX); P.egate = (float*)(ws + WS_EGATE);
    P.wl = ws + WS_W + l * W_LAYER; P.modl = P.mod + (size_t)l * 5 * 6144; P.U = (const bf16_t*)(ws + WS_TAB0); P.V = P.U + (size_t)NEXP * D; P.U8 = ws + ((l == 0) ? WS_TAB0 : WS_TAB1); P.V8 = P.U8 + (size_t)NEXP * D; P.isu = (const float*)(P.U8 + (size_t)2 * NEXP * D); P.isv = P.isu + NEXP; P.H8 = ws + WS_H8;
    return P;
}
__global__ void __launch_bounds__(NTHREADS, 2) mega_fwd(Params p) {
    extern __shared__ __attribute__((aligned(16))) unsigned char lds[];
    cg::grid_group grid = cg::this_grid();
    int WV; asm volatile("v_readfirstlane_b32 %0, %1" : "=s"(WV) : "v"((int)threadIdx.x >> 6));
    PG8_LAS unsigned char* ldsr = (PG8_LAS unsigned char*)lds;
    float* smem = (float*)lds;
    volatile LAS unsigned* bst = (volatile LAS unsigned*)((LAS unsigned char*)lds + 131072 + 256);
    if (WV == 0 && lane_id() < 2) bst[lane_id()] = 0u;
    __syncthreads();
    XcdBarrier xbar = xcd_barrier_post((unsigned*)(p.ws + WS_CTL), bst, WV);

#ifndef PROBE_DUP
#define PROBE_DUP 0
#endif

#define SYNC() xcd_barrier(xbar)
#define DUP(k, PH) do { PH; SYNC(); if (PROBE_DUP == (k)) { PH; SYNC(); } } while (0)
#define PH_NORM1() { const WsPtrs P = mkptrs(p, l); ph_norm_mod(p.x, p.ctx, p.norm1_g, P.modl, 0, 1, P.H, T_ALL, nullptr, WV); }
#define PH_ZGEMM() {     \
            const WsPtrs P = mkptrs(p, l); \
            pg8::EpiZ E{P.Z, P.rope, P.vtn, P.vtnc, P.vtw, P.vtwc, 0, 0, (PG8_LAS bf16_t*)(ldsr + 131072 + 1024)}; \
            pg8::Gemm g{P.H, (const bf16_t*)(P.wl + W_WIN), T_ALL, IN_COLS, D}; \
            if (!last) { pg8::StaticOrder So; So.init(T_ALL, IN_COLS, NBLK, BID); pg8::gemm_phase<pg8::EpiZ, pg8::StaticOrder, true, true>(ldsr, g, So, E, WV); } \
            else { pg8::ZLastOrder So; So.S0.init(T_LAT, IN_COLS, NBLK, BID); So.G = NBLK; So.c = BID; pg8::gemm_phase<pg8::EpiZ, pg8::ZLastOrder, true, true>(ldsr, g, So, E, WV); } }
#define PH_ATTN() { const WsPtrs P = mkptrs(p, l); ph_attn<0>(P.Z, P.vtn, P.vtnc, P.vtw, P.vtwc, p.na_rpb + (size_t)l * 8 * 15 * 31, p.swa_sink + l * 8, P.AT + (size_t)T_ALL * 512, P.AT + (size_t)2 * T_ALL * 512, !last, smem, P.AT, rows, WV); }
#define PH_MERGE() {     \
            const WsPtrs P = mkptrs(p, l); \
            pg8::Gemm g{P.AT, (const bf16_t*)(P.wl + W_WA), 3 * T_ALL, 3 * D, 512}; pg8::MergeOrder Mo{(rows / 256) * 4, NBLK, BID, 0}; pg8::EpiMergeSeg E{P.Z, P.H}; \
            pg8::gemm_phase<pg8::EpiMergeSeg, pg8::MergeOrder, false, true>(ldsr, g, Mo, E, WV); \
            if (l == 0 && FP8_L0) ph_fill_tables(p, WV); }
#define PH_OUT(GIDX) {     \
            const WsPtrs P = mkptrs(p, l); \
            pg8::Gemm g{P.H, (const bf16_t*)(P.wl + W_WO), rows, D, D}; pg8::StaticOrder So; So.init(rows, D, NBLK, BID); pg8::EpiResid E{l == 0 ? p.x : P.X, l == 0 ? p.ctx : P.XC, P.X, P.XC, P.modl, GIDX, 0}; \
            pg8::gemm_phase<pg8::EpiResid, pg8::StaticOrder, true, true>(ldsr, g, So, E, WV); \
            if (l == 0 && FILL_W1 && BID >= 16 && NBLK > 16) { __syncthreads(); ph_prep_weights(p, 1, smem, WV, BID - 16, NBLK - 16); } }
#define PH_NORM2() { const WsPtrs P = mkptrs(p, l); ph_norm_mod(P.X, P.XC, p.norm2_g + l * D, P.modl, 3, 4, P.H, rows, (last || FP8_L0) ? (unsigned*)P.H8 : nullptr, WV); }
#define PH_QGEMM() { const WsPtrs P = mkptrs(p, l); \
            pg8::Gemm g{P.H, (const bf16_t*)(P.wl + W_WQ), rows, 2048, D}; pg8::StaticOrder So; So.init(rows, 2048, NBLK, BID); pg8::EpiStoreBf16 E{P.Z, 2048, 0}; \
            pg8::gemm_phase<pg8::EpiStoreBf16, pg8::StaticOrder, true, true>(ldsr, g, So, E, WV); }
#define PH_TOPK() { const WsPtrs P = mkptrs(p, l); ph_peer_topk(P.Z, (const bf16_t*)(P.wl + W_KEYS), P.eidx, P.egate, rows, smem, WV); }
#define PH_GATHER(DRY) { const WsPtrs P = mkptrs(p, l); \
            if (!last && !FP8_L0) ph_peer_gather_bf16(P.H, P.U, P.V, P.eidx, P.egate, P.modl, P.X, P.XC, rows, 0, p.norm1_g + D, P.modl + 5 * 6144, P.H, smem, DRY, WV); \
            else ph_peer_gather_fp8(P.H8, P.U8, P.V8, P.isu, P.isv, P.eidx, P.egate, P.modl, P.X, P.XC, rows, last ? 1 : 0, last ? p.final_g : p.norm1_g + D, P.modl + 5 * 6144, P.H, smem, DRY, WV); }

    ph_prep(p, smem, WV);
    grid.sync();
    if (PROBE_DUP == 1) { ph_prep(p, smem, WV); SYNC(); }
#define LAYER_BODY(LIDX) { constexpr int l = LIDX; \
        const bool last = (l == 1); \
        const int rows = last ? T_LAT : T_ALL; \
        if (l == 0) { PH_NORM1(); SYNC(); } \
        DUP(2, PH_ZGEMM()); \
        DUP(3, PH_ATTN()); \
        if (PROBE_DUP >= 30) { const WsPtrs P = mkptrs(p, l); bf16_t* dmy = (bf16_t*)(launder(p.ws) + WS_TAB0 + (size_t)34 * 1048576); ph_attn<PROBE_DUP - 30>(P.Z, P.vtn, P.vtnc, P.vtw, P.vtwc, p.na_rpb + (size_t)l * 8 * 15 * 31, p.swa_sink + l * 8, dmy, dmy, !last, smem, P.AT, rows, WV); SYNC(); } \
        DUP(4, PH_MERGE()); \
        PH_OUT(2); SYNC(); \
        DUP(5, PH_NORM2()); \
        DUP(6, PH_QGEMM()); \
        DUP(7, PH_TOPK()); \
        if (PROBE_DUP == 8) { PH_GATHER(true); SYNC(); } \
        PH_GATHER(false); SYNC(); \
    }
    LAYER_BODY(0)
    LAYER_BODY(1)
}

extern "C" void kernel_launch(void* const* d_in, const int* in_sizes, int n_in, void* d_out, int out_size, void* d_ws, size_t ws_size, hipStream_t stream) {
    static int grid_blocks = 0;
    if (grid_blocks == 0) {
        if (ws_size < WS_END || n_in != 22) { fprintf(stderr, "kernel_launch: workspace %zu < %zu or n_in %d != 22\n", ws_size, (size_t)WS_END, n_in); grid_blocks = -1; return; }
        int dev = 0, cus = 0, per_cu = 0;
        (void)hipGetDevice(&dev); (void)hipDeviceGetAttribute(&cus, hipDeviceAttributeMultiprocessorCount, dev);
        if (hipFuncSetAttribute((const void*)mega_fwd, hipFuncAttributeMaxDynamicSharedMemorySize, LDS_BYTES) != hipSuccess) { fprintf(stderr, "kernel_launch: hipFuncSetAttribute failed\n"); grid_blocks = -1; return; }
        if (hipOccupancyMaxActiveBlocksPerMultiprocessor(&per_cu, (const void*)mega_fwd, NTHREADS, LDS_BYTES) != hipSuccess || per_cu < 1) { fprintf(stderr, "kernel_launch: occupancy query says %d\n", per_cu); per_cu = 1; }
        (void)hipGetLastError();
        grid_blocks = cus * 1;
        fprintf(stderr, "kernel_launch: %d CUs, occupancy query %d per CU, grid %d\n", cus, per_cu, grid_blocks);
    }
    if (grid_blocks < 0) return;
    (void)hipMemsetAsync((char*)d_ws + WS_CTL, 0, CTL_BYTES, stream);
    Params p{};
    p.x = (const float*)d_in[0]; p.c = (const float*)d_in[1]; p.ctx = (const float*)d_in[2]; p.c_ctx = (const float*)d_in[3]; p.ada_w = (const float*)d_in[4]; p.ada_b = (const float*)d_in[5];
    p.norm1_g = (const float*)d_in[6]; p.norm2_g = (const float*)d_in[7]; p.w_in = (const float*)d_in[8]; p.pool_w = (const float*)d_in[9]; p.pool_scale = (const float*)d_in[10]; p.na_rpb = (const float*)d_in[11];
    p.swa_sink = (const float*)d_in[12]; p.wba = (const float*)d_in[13]; p.wbb = (const float*)d_in[14]; p.wbc = (const float*)d_in[15]; p.w_out = (const float*)d_in[16]; p.peer_wq = (const float*)d_in[17];
    p.peer_keys = (const float*)d_in[18]; p.peer_u = (const float*)d_in[19]; p.peer_v = (const float*)d_in[20]; p.final_g = (const float*)d_in[21];
    p.out = (float*)d_out; p.ws = (unsigned char*)d_ws;
    void* args[] = {&p};
    const hipError_t e = hipLaunchCooperativeKernel((const void*)mega_fwd, dim3(grid_blocks), dim3(NTHREADS), args, LDS_BYTES, stream);
    if (e != hipSuccess) fprintf(stderr, "kernel_launch: cooperative launch failed: %s (grid %d)\n", hipGetErrorString(e), grid_blocks);
}
```
